# Optimizing an MI355X kernel written in HIP

```python
import math
import jax, jax.numpy as jnp
from jax import lax
import numpy as np

D_MODEL = 1024
BATCH = 4
SEQ = 8192
DEPTH = 1

D_RNN = D_MODEL
RNN_HEADS = 16
RNN_BLOCK = D_RNN // RNN_HEADS
C_RGLRU = 8.0
LRU_CONV = 4
D_HYENA = D_MODEL
HY_CONV = 3
HY_EMB = 33
HY_BANDS = (HY_EMB - 1) // 2
HY_FF = 64
HY_FAST_DECAY = 0.3
HY_SLOW_DECAY = 1.5
HY_TARGET = 1e-2
N_IN = 2 * D_RNN + 3 * D_HYENA + 2 * D_MODEL
N_EXPERTS = 32
TOP_K = 4
D_FF_EXPERT = D_MODEL
SWIGLU_LIMIT = 7.0
SWIGLU_ALPHA = 1.702
MOE_BLOCK = 512
EPS = 1e-5

kernel_name = 'hybrid_rglru_hyena_moe_encoder'


def rmsnorm(x, g):
    xf = x.astype(jnp.float32)
    y = xf * lax.rsqrt(jnp.mean(xf * xf, axis=-1, keepdims=True) + EPS)
    return (y * g.astype(jnp.float32)).astype(x.dtype)


def depthwise_conv(x, w, b, pad_left):
    width = w.shape[0]
    L = x.shape[1]
    xp = jnp.pad(x, ((0, 0), (pad_left, width - 1 - pad_left), (0, 0)))
    out = b
    for k in range(width):
        out = out + w[k] * xp[:, k:k + L]
    return out


def linear_scan(a, b):
    def combine(left, right):
        a_l, b_l = left
        a_r, b_r = right
        return a_l * a_r, a_r * b_l + b_r
    _, h = lax.associative_scan(combine, (a, b), axis=1)
    return h


def rglru_direction(xr, wa, ba, wi, bi, lam):
    B, L, _ = xr.shape
    xh = xr.reshape(B, L, RNN_HEADS, RNN_BLOCK)
    r = jax.nn.sigmoid(jnp.einsum('blhi,hij->blhj', xh, wa).reshape(B, L, D_RNN) + ba)
    i = jax.nn.sigmoid(jnp.einsum('blhi,hij->blhj', xh, wi).reshape(B, L, D_RNN) + bi)
    log_a = -C_RGLRU * r * jax.nn.softplus(-lam)
    a = jnp.exp(log_a)
    mult = jnp.sqrt(-jnp.expm1(2.0 * log_a))
    return linear_scan(a, mult * (i * xr))


def rglru_bidirectional(xr, wa, ba, wi, bi, lam):
    xf = xr.astype(jnp.float32)
    h_fwd = rglru_direction(xf, wa[0], ba[0], wi[0], bi[0], lam[0])
    h_bwd = jnp.flip(rglru_direction(jnp.flip(xf, 1), wa[1], ba[1], wi[1], bi[1], lam[1]), 1)
    return (h_fwd + h_bwd).astype(xr.dtype)


def hyena_filter(L, w1, b1, w2, b2, w3, b3, w4, freq):
    f32 = jnp.float32
    t = jnp.linspace(0.0, 1.0, L, dtype=f32)[:, None]
    w = 2.0 * math.pi * jnp.arange(L, dtype=f32)[:, None] / L
    bands = jnp.linspace(1e-4, HY_BANDS - 1, HY_BANDS, dtype=f32)[None, :]
    feats = jnp.concatenate([t, jnp.cos(w * bands), -jnp.sin(w * bands)], axis=-1)
    fr = freq.astype(f32)
    hh = jnp.sin(fr * (feats @ w1.astype(f32) + b1.astype(f32)))
    hh = jnp.sin(fr * (hh @ w2.astype(f32) + b2.astype(f32)))
    hh = jnp.sin(fr * (hh @ w3.astype(f32) + b3.astype(f32)))
    k = (hh @ w4.astype(f32)).reshape(L, 2, D_HYENA)
    deltas = jnp.linspace(math.log(HY_TARGET) / HY_SLOW_DECAY, math.log(HY_TARGET) / HY_FAST_DECAY, D_HYENA, dtype=f32)
    k = k * jnp.exp(-t * jnp.abs(deltas))[:, None, :]
    k_fwd = k[:, 0].at[0].add(k[0, 1])
    k_bwd = k[1:, 1]
    k_circ = jnp.concatenate([k_fwd, jnp.zeros((1, D_HYENA), f32), k_bwd[::-1]], axis=0)
    return k_circ / jnp.sum(jnp.abs(k_circ), axis=0, keepdims=True)


def hyena_mixer(p_hy, conv_w, conv_b, w1, b1, w2, b2, w3, b3, w4, freq, bias):
    B, L, _ = p_hy.shape
    q = depthwise_conv(p_hy, conv_w, conv_b, 1)
    v = q[..., :D_HYENA]
    x1 = q[..., D_HYENA:2 * D_HYENA]
    x2 = q[..., 2 * D_HYENA:]
    z = (x2 * v).astype(jnp.float32)
    k_circ = hyena_filter(L, w1, b1, w2, b2, w3, b3, w4, freq)
    K = jnp.fft.rfft(k_circ, n=2 * L, axis=0)
    Z = jnp.fft.rfft(z, n=2 * L, axis=1)
    conv = jnp.fft.irfft(Z * K[None], n=2 * L, axis=1)[:, :L]
    return x1 * (conv + bias.astype(jnp.float32) * z).astype(p_hy.dtype)


def moe_ffn(h, w_router, b_router, w_gate_up, b_gate_up, w_down, b_down):
    B, L, D = h.shape
    T = B * L
    N = T * TOP_K
    hf = h.reshape(T, D)
    logits = (hf @ w_router + b_router).astype(jnp.float32)
    top_vals, top_idx = lax.top_k(logits, TOP_K)
    gates = jax.nn.softmax(top_vals, axis=-1).astype(h.dtype)
    e_flat = top_idx.reshape(N)
    tok_flat = jnp.arange(N, dtype=jnp.int32) // TOP_K
    g_flat = gates.reshape(N)
    order = jnp.argsort(e_flat)
    e_sorted = e_flat[order]
    counts = jnp.zeros((N_EXPERTS,), jnp.int32).at[e_flat].add(1)
    starts = jnp.cumsum(counts) - counts
    padded = ((counts + MOE_BLOCK - 1) // MOE_BLOCK) * MOE_BLOCK
    pad_ends = jnp.cumsum(padded)
    pad_starts = pad_ends - padded
    dest = pad_starts[e_sorted] + jnp.arange(N, dtype=jnp.int32) - starts[e_sorted]
    n_blocks = (N + MOE_BLOCK - 1) // MOE_BLOCK + N_EXPERTS
    n_slots = n_blocks * MOE_BLOCK
    slot_tok = jnp.full((n_slots,), T, jnp.int32).at[dest].set(tok_flat[order])
    slot_gate = jnp.zeros((n_slots,), h.dtype).at[dest].set(g_flat[order])
    block_e = jnp.minimum(jnp.searchsorted(pad_ends, jnp.arange(n_blocks, dtype=jnp.int32) * MOE_BLOCK, side='right'), N_EXPERTS - 1)
    h_pad = jnp.concatenate([hf, jnp.zeros((1, D), hf.dtype)], axis=0)

    def run_block(args):
        tok, gate, e = args
        xb = h_pad[tok]
        gu = xb @ w_gate_up[e] + b_gate_up[e]
        g_ = jnp.minimum(gu[:, :D_FF_EXPERT], SWIGLU_LIMIT)
        u_ = jnp.clip(gu[:, D_FF_EXPERT:], -SWIGLU_LIMIT, SWIGLU_LIMIT)
        act = (u_ + 1.0) * (g_ * jax.nn.sigmoid(SWIGLU_ALPHA * g_))
        return (act @ w_down[e] + b_down[e]) * gate[:, None]

    yb = lax.map(run_block, (slot_tok.reshape(n_blocks, MOE_BLOCK), slot_gate.reshape(n_blocks, MOE_BLOCK), block_e))
    y = jax.ops.segment_sum(yb.reshape(n_slots, D), slot_tok, num_segments=T + 1)[:T]
    return y.reshape(B, L, D)


def setup_inputs(seed: int = 0) -> dict:
    key = jax.random.key(seed)
    ks = jax.random.split(key, 40)
    f32 = jnp.float32

    def nrm(k, shape, scale):
        return jax.random.normal(k, shape, f32) * scale

    a_c = jax.random.uniform(ks[9], (2, D_RNN), f32, minval=0.9, maxval=0.999)
    a0 = a_c ** (1.0 / C_RGLRU)
    lru_lambda = jnp.log(a0) - jnp.log1p(-a0)
    return {
        'x': nrm(ks[0], (BATCH, SEQ, D_MODEL), 1.0),
        'g_mix': 1.0 + nrm(ks[1], (D_MODEL,), 0.01),
        'w_in': nrm(ks[2], (D_MODEL, N_IN), D_MODEL ** -0.5),
        'b_in': nrm(ks[3], (N_IN,), 0.01),
        'lru_conv_w': nrm(ks[4], (LRU_CONV, D_RNN), LRU_CONV ** -0.5),
        'lru_conv_b': nrm(ks[5], (D_RNN,), 0.01),
        'lru_wa': nrm(ks[6], (2, RNN_HEADS, RNN_BLOCK, RNN_BLOCK), RNN_BLOCK ** -0.5),
        'lru_ba': nrm(ks[7], (2, D_RNN), 0.01),
        'lru_wi': nrm(ks[8], (2, RNN_HEADS, RNN_BLOCK, RNN_BLOCK), RNN_BLOCK ** -0.5),
        'lru_bi': nrm(ks[10], (2, D_RNN), 0.01),
        'lru_lambda': lru_lambda,
        'w_lru_br': nrm(ks[11], (D_RNN, D_MODEL), D_RNN ** -0.5),
        'hy_conv_w': nrm(ks[12], (HY_CONV, 3 * D_HYENA), HY_CONV ** -0.5),
        'hy_conv_b': nrm(ks[13], (3 * D_HYENA,), 0.01),
        'hy_w1': nrm(ks[14], (HY_EMB, HY_FF), HY_EMB ** -0.5),
        'hy_b1': nrm(ks[15], (HY_FF,), 0.1),
        'hy_w2': nrm(ks[16], (HY_FF, HY_FF), HY_FF ** -0.5),
        'hy_b2': nrm(ks[17], (HY_FF,), 0.1),
        'hy_w3': nrm(ks[18], (HY_FF, HY_FF), HY_FF ** -0.5),
        'hy_b3': nrm(ks[19], (HY_FF,), 0.1),
        'hy_w4': nrm(ks[20], (HY_FF, 2 * D_HYENA), HY_FF ** -0.5),
        'hy_sin_freq': 1.0 + nrm(ks[21], (HY_FF,), 0.01),
        'hy_bias': nrm(ks[22], (D_HYENA,), 1.0),
        'w_hy_br': nrm(ks[23], (D_HYENA, D_MODEL), D_HYENA ** -0.5),
        'w_out': nrm(ks[24], (D_MODEL, D_MODEL), D_MODEL ** -0.5),
        'g_ffn': 1.0 + nrm(ks[25], (D_MODEL,), 0.01),
        'w_router': nrm(ks[26], (D_MODEL, N_EXPERTS), D_MODEL ** -0.5),
        'b_router': nrm(ks[27], (N_EXPERTS,), 0.01),
        'w_gate_up': nrm(ks[28], (N_EXPERTS, D_MODEL, 2 * D_FF_EXPERT), D_MODEL ** -0.5),
        'b_gate_up': nrm(ks[29], (N_EXPERTS, 2 * D_FF_EXPERT), 0.01),
        'w_down': nrm(ks[30], (N_EXPERTS, D_FF_EXPERT, D_MODEL), D_FF_EXPERT ** -0.5),
        'b_down': nrm(ks[31], (N_EXPERTS, D_MODEL), 0.01),
        'g_final': 1.0 + nrm(ks[32], (D_MODEL,), 0.01),
    }


def reference(x, g_mix, w_in, b_in, lru_conv_w, lru_conv_b, lru_wa, lru_ba, lru_wi, lru_bi, lru_lambda, w_lru_br, hy_conv_w, hy_conv_b, hy_w1, hy_b1, hy_w2, hy_b2, hy_w3, hy_b3, hy_w4, hy_sin_freq, hy_bias, w_hy_br, w_out, g_ffn, w_router, b_router, w_gate_up, b_gate_up, w_down, b_down, g_final):
    h = x
    o1 = D_RNN
    o2 = 2 * D_RNN
    o3 = o2 + 3 * D_HYENA
    o4 = o3 + D_MODEL
    for _ in range(DEPTH):
        u = rmsnorm(h, g_mix)
        p = u @ w_in + b_in
        xr = depthwise_conv(p[..., :o1], lru_conv_w, lru_conv_b, LRU_CONV // 2)
        h_rnn = rglru_bidirectional(xr, lru_wa, lru_ba, lru_wi, lru_bi, lru_lambda)
        y_lru = jax.nn.gelu(p[..., o1:o2]) * h_rnn
        y_hy = hyena_mixer(p[..., o2:o3], hy_conv_w, hy_conv_b, hy_w1, hy_b1, hy_w2, hy_b2, hy_w3, hy_b3, hy_w4, hy_sin_freq, hy_bias)
        gate_lru = jax.nn.sigmoid(p[..., o3:o4])
        gate_hy = jax.nn.sigmoid(p[..., o4:])
        mix = gate_lru * (y_lru @ w_lru_br) + gate_hy * (y_hy @ w_hy_br)
        h = h + mix @ w_out
        h = h + moe_ffn(rmsnorm(h, g_ffn), w_router, b_router, w_gate_up, b_gate_up, w_down, b_down)
    return rmsnorm(h, g_final)
```

```cpp
#include <hip/hip_runtime.h>
#include <hip/hip_cooperative_groups.h>
#include <cstdio>
#include <cstdint>
namespace cg = cooperative_groups;

typedef unsigned short bf16_t;
typedef float f32x4 __attribute__((ext_vector_type(4)));
typedef float f32x2 __attribute__((ext_vector_type(2)));
typedef unsigned u32x4 __attribute__((ext_vector_type(4)));
typedef unsigned u32x2 __attribute__((ext_vector_type(2)));
typedef short bf16x8 __attribute__((ext_vector_type(8)));

constexpr int T = 32768, D = 1024, L = 8192, NB = 4, NE = 32, TOPK = 4, NIN = 7168, L2X = 16384;
constexpr int HEADS = 16, HB = 64, HYFF = 64, HYEMB = 33;
constexpr int NPAD = T * TOPK + NE * 256;
constexpr float EPS = 1e-5f;

constexpr size_t MiB = 1u << 20;
constexpr size_t WS_CTL = 0;
constexpr size_t CTL_BYTES = 64 * 1024;
constexpr size_t WS_NORM = 1 * MiB;
constexpr size_t WS_HH3 = 2 * MiB;
constexpr size_t WS_LIST = 4 * MiB;
constexpr size_t WS_GLIST = 8 * MiB;
constexpr size_t WS_TOKSLOT = 12 * MiB;
constexpr size_t WS_SUMM = 13 * MiB;
constexpr size_t WS_WIN = 16 * MiB;
constexpr size_t WS_WLRU = 30 * MiB, WS_WHY = 32 * MiB, WS_WOUT = 34 * MiB;
constexpr size_t WS_U = 36 * MiB;
constexpr size_t WS_YLRU = 36 * MiB, WS_HN = 36 * MiB;
constexpr size_t WS_YHY = 100 * MiB;
constexpr size_t WS_PG = 164 * MiB;
constexpr size_t WS_P0 = 292 * MiB;
constexpr size_t WS_P1 = 356 * MiB;
constexpr size_t WS_PHY = 420 * MiB;
constexpr size_t WS_MIX = 292 * MiB;
constexpr size_t WS_MIXF = 420 * MiB;
constexpr size_t WS_ACT = 292 * MiB;
constexpr size_t WS_R2 = 612 * MiB;
constexpr size_t WS_YZ = 612 * MiB;
constexpr size_t WS_KF = 868 * MiB;
constexpr size_t WS_WDN = 612 * MiB;
constexpr size_t WS_WGU = 676 * MiB;
constexpr size_t WS_YS = 676 * MiB;
constexpr size_t WS_XR = 612 * MiB;
constexpr size_t WS_HF = 740 * MiB;
constexpr size_t WS_KC = 868 * MiB;
constexpr size_t WS_END = 1024 * MiB;

__device__ __forceinline__ float bf2f(bf16_t b) { return __uint_as_float(((unsigned)b) << 16); }
__device__ __forceinline__ bf16_t f2bf(float f) { unsigned u = __float_as_uint(f); u += 0x7fffu + ((u >> 16) & 1u); return (bf16_t)(u >> 16); }
__device__ __forceinline__ unsigned pk2(float lo, float hi) { return (unsigned)f2bf(lo) | ((unsigned)f2bf(hi) << 16); }
__device__ __forceinline__ float sigmoidf_(float x) { return 1.0f / (1.0f + __expf(-x)); }
__device__ __forceinline__ float gelu_tanh(float x) { const float u = 0.7978845608028654f * (x + 0.044715f * x * x * x); return x * sigmoidf_(2.0f * u); }
__device__ __forceinline__ float swiglu(float g, float u) { const float g_ = fminf(g, 7.0f); const float u_ = fminf(fmaxf(u, -7.0f), 7.0f); return (u_ + 1.0f) * (g_ * sigmoidf_(1.702f * g_)); }
__device__ __forceinline__ float wave_sum(float v) {
#pragma unroll
    for (int o = 1; o < 64; o <<= 1) v += __shfl_xor(v, o);
    return v;
}
__device__ __forceinline__ int expert_offpad(const int* cnt, int e) { int o = 0; for (int i = 0; i < e; ++i) o += (cnt[i] + 255) & ~255; return o; }
__device__ __forceinline__ float hy_delta_abs(int c) {
    const float lo = -4.605170185988091f / 1.5f, hi = -4.605170185988091f / 0.3f;
    return fabsf(lo + (hi - lo) * ((float)c / 1023.0f));
}
namespace nv {

__global__ void __launch_bounds__(256) k_rms(const float* __restrict__ x, const float* __restrict__ g, bf16_t* __restrict__ U) {
    const int row = blockIdx.x * 4 + (threadIdx.x >> 6), lane = threadIdx.x & 63;
    const f32x4* xr = (const f32x4*)(x + (size_t)row * D) + lane;
    f32x4 v[4]; float s = 0.f;
#pragma unroll
    for (int j = 0; j < 4; ++j) { v[j] = xr[64 * j]; s += v[j].x * v[j].x + v[j].y * v[j].y + v[j].z * v[j].z + v[j].w * v[j].w; }
    const float rstd = rsqrtf(wave_sum(s) * (1.0f / D) + EPS);
#pragma unroll
    for (int j = 0; j < 4; ++j) {
        const f32x4 gg = ((const f32x4*)g)[lane + 64 * j];
        u32x2 w; w.x = pk2(v[j].x * rstd * gg.x, v[j].y * rstd * gg.y); w.y = pk2(v[j].z * rstd * gg.z, v[j].w * rstd * gg.w);
        ((u32x2*)(U + (size_t)row * D))[lane + 64 * j] = w;
    }
}

template <class AF, class BF, class EF, bool DUAL>
__device__ __forceinline__ void gemm_tile(int m0, int n0, int K, const AF& A, const BF& B, const EF& E) {
    __shared__ float sA[16][68], sB[16][68], sB2[DUAL ? 16 : 1][68];
    const int tid = threadIdx.x, tx = tid & 15, ty = tid >> 4;
    float acc[4][4], acc2[4][4];
#pragma unroll
    for (int i = 0; i < 4; ++i)
#pragma unroll
        for (int j = 0; j < 4; ++j) { acc[i][j] = 0.f; acc2[i][j] = 0.f; }
    for (int k0 = 0; k0 < K; k0 += 16) {
#pragma unroll
        for (int r = 0; r < 4; ++r) { const int e = tid + 256 * r; const int m = e >> 4, k = e & 15; sA[k][m] = A(m0 + m, k0 + k); }
#pragma unroll
        for (int r = 0; r < 4; ++r) { const int e = tid + 256 * r; const int k = e >> 6, n = e & 63; sB[k][n] = B(k0 + k, n0 + n, 0); if (DUAL) sB2[k][n] = B(k0 + k, n0 + n, 1); }
        __syncthreads();
#pragma unroll
        for (int k = 0; k < 16; ++k) {
            float a[4], b[4], b2[4];
#pragma unroll
            for (int i = 0; i < 4; ++i) a[i] = sA[k][ty * 4 + i];
#pragma unroll
            for (int j = 0; j < 4; ++j) { b[j] = sB[k][tx * 4 + j]; b2[j] = DUAL ? sB2[k][tx * 4 + j] : 0.f; }
#pragma unroll
            for (int i = 0; i < 4; ++i)
#pragma unroll
                for (int j = 0; j < 4; ++j) { acc[i][j] += a[i] * b[j]; if (DUAL) acc2[i][j] += a[i] * b2[j]; }
        }
        __syncthreads();
    }
#pragma unroll
    for (int i = 0; i < 4; ++i)
#pragma unroll
        for (int j = 0; j < 4; ++j) E(m0 + ty * 4 + i, n0 + tx * 4 + j, acc[i][j], acc2[i][j]);
}

__global__ void __launch_bounds__(256) k_gemm1(const bf16_t* __restrict__ U, const float* __restrict__ w_in, const float* __restrict__ b_in,
                                               bf16_t* P0, bf16_t* P1, bf16_t* PHY, bf16_t* PG) {
    auto A = [&](int m, int k) { return bf2f(U[(size_t)m * D + k]); };
    auto B = [&](int k, int n, int) { return w_in[(size_t)k * NIN + n]; };
    auto E = [&](int m, int n, float acc, float) {
        const float v = acc + b_in[n]; const int seg = n >> 10;
        if (seg == 0) P0[(size_t)m * D + n] = f2bf(v);
        else if (seg == 1) P1[(size_t)m * D + (n - 1024)] = f2bf(gelu_tanh(v));
        else if (seg < 5) PHY[(size_t)m * 3072 + (n - 2048)] = f2bf(v);
        else PG[(size_t)m * 2048 + (n - 5120)] = f2bf(sigmoidf_(v));
    };
    gemm_tile<decltype(A), decltype(B), decltype(E), false>(blockIdx.y * 64, blockIdx.x * 64, D, A, B, E);
}

__global__ void __launch_bounds__(256) k_lru_xr(const bf16_t* __restrict__ P0, const float* __restrict__ cw, const float* __restrict__ cb, float* __restrict__ XR) {
    const size_t idx = (size_t)blockIdx.x * 256 + threadIdx.x; const int c = (int)(idx & (D - 1)); const int t = (int)(idx >> 10); const int tl = t & (L - 1);
    float v = cb[c];
#pragma unroll
    for (int k = 0; k < 4; ++k) { const int tt = tl + k - 2; if (tt >= 0 && tt < L) v += cw[k * D + c] * bf2f(P0[(size_t)(t + k - 2) * D + c]); }
    XR[idx] = v;
}
__global__ void __launch_bounds__(64) k_lru_scan(const float* __restrict__ XR, const float* __restrict__ wa, const float* __restrict__ ba, const float* __restrict__ wi, const float* __restrict__ bi,
                                                 const float* __restrict__ lam, const bf16_t* __restrict__ P1, float* __restrict__ HF, bf16_t* __restrict__ YLRU) {
    const int b = blockIdx.x >> 4, h = blockIdx.x & 15, j = threadIdx.x, c = h * 64 + j;
    for (int dir = 0; dir < 2; ++dir) {
        float wa_r[64], wi_r[64];
#pragma unroll
        for (int i = 0; i < 64; ++i) { wa_r[i] = wa[(((size_t)dir * 16 + h) * 64 + i) * 64 + j]; wi_r[i] = wi[(((size_t)dir * 16 + h) * 64 + i) * 64 + j]; }
        const float ba_c = ba[dir * D + c], bi_c = bi[dir * D + c];
        const float lm = lam[dir * D + c]; const float sp = log1pf(expf(-lm));
        float hs = 0.f;
        for (int step = 0; step < L; ++step) {
            const int t = dir == 0 ? step : L - 1 - step; const size_t row = (size_t)b * L + t;
            const float xv = XR[row * D + c];
            float ra = ba_c, ia = bi_c;
#pragma unroll
            for (int i = 0; i < 64; ++i) { const float xi = __shfl(xv, i); ra += xi * wa_r[i]; ia += xi * wi_r[i]; }
            const float r = sigmoidf_(ra), ig = sigmoidf_(ia);
            const float la = -8.0f * r * sp; const float a = expf(la); const float mult = sqrtf(-expm1f(2.0f * la));
            hs = a * hs + mult * (ig * xv);
            if (dir == 0) HF[row * D + c] = hs;
            else YLRU[row * D + c] = f2bf(bf2f(P1[row * D + c]) * (HF[row * D + c] + hs));
        }
    }
}

__global__ void __launch_bounds__(64) k_hy_mlp(const float* __restrict__ w1, const float* __restrict__ b1, const float* __restrict__ w2, const float* __restrict__ b2,
                                               const float* __restrict__ w3, const float* __restrict__ b3, const float* __restrict__ freq, float* __restrict__ HH3) {
    __shared__ float feat[HYEMB], h1[64], h2[64];
    const int t = blockIdx.x, u = threadIdx.x;
    if (u < HYEMB) {
        float f;
        if (u == 0) f = (float)t / (float)(L - 1);
        else { const int j = (u - 1) & 15; const float band = 1e-4f + (float)j * ((15.0f - 1e-4f) / 15.0f); const float w = 6.283185307179586f * (float)t / (float)L; const float arg = w * band;
               f = (u <= 16) ? cosf(arg) : -sinf(arg); }
        feat[u] = f;
    }
    __syncthreads();
    const float fr = freq[u];
    float s = b1[u];
    for (int f = 0; f < HYEMB; ++f) s += feat[f] * w1[f * 64 + u];
    h1[u] = sinf(fr * s);
    __syncthreads();
    s = b2[u];
    for (int f = 0; f < 64; ++f) s += h1[f] * w2[f * 64 + u];
    h2[u] = sinf(fr * s);
    __syncthreads();
    s = b3[u];
    for (int f = 0; f < 64; ++f) s += h2[f] * w3[f * 64 + u];
    HH3[t * 64 + u] = sinf(fr * s);
}
__device__ __forceinline__ float hy_kraw(const float* __restrict__ HH3, const float* __restrict__ w4, int t, int dir, int c) {
    float s = 0.f;
    for (int u = 0; u < 64; ++u) s += HH3[t * 64 + u] * w4[u * 2048 + dir * 1024 + c];
    const float tt = (float)t / (float)(L - 1);
    return s * expf(-tt * hy_delta_abs(c));
}
__global__ void __launch_bounds__(256) k_hy_kc(const float* __restrict__ HH3, const float* __restrict__ w4, float* __restrict__ KC) {
    const size_t idx = (size_t)blockIdx.x * 256 + threadIdx.x; const int c = (int)(idx & (D - 1)); const int n = (int)(idx >> 10);
    float v;
    if (n == L) v = 0.f;
    else if (n < L) { v = hy_kraw(HH3, w4, n, 0, c); if (n == 0) v += hy_kraw(HH3, w4, 0, 1, c); }
    else v = hy_kraw(HH3, w4, 2 * L - n, 1, c);
    KC[idx] = v;
}
__global__ void __launch_bounds__(256) k_hy_norm(const float* __restrict__ KC, float* __restrict__ NORM) {
    const int c = blockIdx.x * 256 + threadIdx.x; float s = 0.f;
    for (int n = 0; n < L2X; ++n) s += fabsf(KC[(size_t)n * D + c]);
    NORM[c] = s;
}
__device__ __forceinline__ float hy_q(const bf16_t* __restrict__ PHY, const float* __restrict__ cw, const float* __restrict__ cb, size_t row, int seg, int c) {
    const int tl = (int)(row & (L - 1)); const int col = seg * 1024 + c; float v = cb[col];
#pragma unroll
    for (int k = 0; k < 3; ++k) { const int tt = tl + k - 1; if (tt >= 0 && tt < L) v += cw[k * 3072 + col] * bf2f(PHY[(row + k - 1) * 3072 + col]); }
    return v;
}
__global__ void __launch_bounds__(256) k_hy_conv(const bf16_t* __restrict__ PHY, const float* __restrict__ cw, const float* __restrict__ cb, const float* __restrict__ KC, const float* __restrict__ NORM,
                                                 const float* __restrict__ hbias, bf16_t* __restrict__ YHY) {
    __shared__ float zs[64][64], ks[127][64];
    const int c0 = blockIdx.x * 64, t0 = blockIdx.y * 64, b = blockIdx.z; const int tid = threadIdx.x, cl = tid & 63, tg = tid >> 6, c = c0 + cl;
    float acc[16];
#pragma unroll
    for (int i = 0; i < 16; ++i) acc[i] = 0.f;
    for (int s0 = 0; s0 < L; s0 += 64) {
        for (int r = tg; r < 64; r += 4) { const size_t row = (size_t)b * L + s0 + r; zs[r][cl] = hy_q(PHY, cw, cb, row, 2, c) * hy_q(PHY, cw, cb, row, 0, c); }
        for (int r = tg; r < 127; r += 4) { const int lag = (t0 - s0 + r - 63) & (L2X - 1); ks[r][cl] = KC[(size_t)lag * D + c]; }
        __syncthreads();
        for (int sl = 0; sl < 64; ++sl) { const float zv = zs[sl][cl];
#pragma unroll
            for (int i = 0; i < 16; ++i) acc[i] += ks[tg * 16 + i - sl + 63][cl] * zv; }
        __syncthreads();
    }
    const float inv = 1.0f / NORM[c], hb = hbias[c];
#pragma unroll
    for (int i = 0; i < 16; ++i) { const size_t row = (size_t)b * L + t0 + tg * 16 + i;
        const float z = hy_q(PHY, cw, cb, row, 2, c) * hy_q(PHY, cw, cb, row, 0, c), x1 = hy_q(PHY, cw, cb, row, 1, c);
        YHY[row * D + c] = f2bf(x1 * (acc[i] * inv + hb * z)); }
}

__global__ void __launch_bounds__(256) k_mix1(const bf16_t* __restrict__ YLRU, const float* __restrict__ w, const bf16_t* __restrict__ PG, float* __restrict__ MIXF) {
    auto A = [&](int m, int k) { return bf2f(YLRU[(size_t)m * D + k]); };
    auto B = [&](int k, int n, int) { return w[(size_t)k * D + n]; };
    auto E = [&](int m, int n, float acc, float) { MIXF[(size_t)m * D + n] = bf2f(PG[(size_t)m * 2048 + n]) * acc; };
    gemm_tile<decltype(A), decltype(B), decltype(E), false>(blockIdx.y * 64, blockIdx.x * 64, D, A, B, E);
}
__global__ void __launch_bounds__(256) k_mix2(const bf16_t* __restrict__ YHY, const float* __restrict__ w, const bf16_t* __restrict__ PG, const float* __restrict__ MIXF, bf16_t* __restrict__ MIX) {
    auto A = [&](int m, int k) { return bf2f(YHY[(size_t)m * D + k]); };
    auto B = [&](int k, int n, int) { return w[(size_t)k * D + n]; };
    auto E = [&](int m, int n, float acc, float) { MIX[(size_t)m * D + n] = f2bf(MIXF[(size_t)m * D + n] + bf2f(PG[(size_t)m * 2048 + 1024 + n]) * acc); };
    gemm_tile<decltype(A), decltype(B), decltype(E), false>(blockIdx.y * 64, blockIdx.x * 64, D, A, B, E);
}
__global__ void __launch_bounds__(256) k_hres(const bf16_t* __restrict__ MIX, const float* __restrict__ w, const float* __restrict__ x, float* __restrict__ H) {
    auto A = [&](int m, int k) { return bf2f(MIX[(size_t)m * D + k]); };
    auto B = [&](int k, int n, int) { return w[(size_t)k * D + n]; };
    auto E = [&](int m, int n, float acc, float) { H[(size_t)m * D + n] = x[(size_t)m * D + n] + acc; };
    gemm_tile<decltype(A), decltype(B), decltype(E), false>(blockIdx.y * 64, blockIdx.x * 64, D, A, B, E);
}
__global__ void __launch_bounds__(256) k_router(const float* __restrict__ H, const float* __restrict__ g, const float* __restrict__ wr, const float* __restrict__ br,
                                                bf16_t* __restrict__ HN, int* cnt, int* __restrict__ LIST, float* __restrict__ GLIST, int* __restrict__ TOKSLOT) {
    __shared__ float hs[4][D];
    const int w = threadIdx.x >> 6, lane = threadIdx.x & 63, t = blockIdx.x * 4 + w;
    const f32x4* xr = (const f32x4*)(H + (size_t)t * D) + lane;
    f32x4 v[4]; float s = 0.f;
#pragma unroll
    for (int j = 0; j < 4; ++j) { v[j] = xr[64 * j]; s += v[j].x * v[j].x + v[j].y * v[j].y + v[j].z * v[j].z + v[j].w * v[j].w; }
    const float rstd = rsqrtf(wave_sum(s) * (1.0f / D) + EPS);
#pragma unroll
    for (int j = 0; j < 4; ++j) {
        const f32x4 gg = ((const f32x4*)g)[lane + 64 * j];
        const f32x4 o = {v[j].x * rstd * gg.x, v[j].y * rstd * gg.y, v[j].z * rstd * gg.z, v[j].w * rstd * gg.w};
        u32x2 pw; pw.x = pk2(o.x, o.y); pw.y = pk2(o.z, o.w);
        ((u32x2*)(HN + (size_t)t * D))[lane + 64 * j] = pw;
        ((f32x4*)hs[w])[lane + 64 * j] = o;
    }
    __syncthreads();
    const int e = lane & 31, half = lane >> 5;
    float lg = 0.f;
    for (int k = half * 512; k < half * 512 + 512; ++k) lg += hs[w][k] * wr[k * NE + e];
    lg += __shfl_xor(lg, 32);
    lg += br[e];
    float val = lg; int te[4]; float tv[4];
#pragma unroll
    for (int r = 0; r < 4; ++r) {
        float m = val; int mi = e;
#pragma unroll
        for (int off = 16; off >= 1; off >>= 1) { const float om = __shfl_xor(m, off); const int oi = __shfl_xor(mi, off); if (om > m || (om == m && oi < mi)) { m = om; mi = oi; } }
        te[r] = mi; tv[r] = m; if (e == mi) val = -3.0e38f;
    }
    const float e0 = 1.0f, e1 = __expf(tv[1] - tv[0]), e2 = __expf(tv[2] - tv[0]), e3 = __expf(tv[3] - tv[0]); const float inv = 1.0f / (e0 + e1 + e2 + e3);
    if (lane < 4) {
        const int ee = lane == 0 ? te[0] : lane == 1 ? te[1] : lane == 2 ? te[2] : te[3];
        const float gg = (lane == 0 ? e0 : lane == 1 ? e1 : lane == 2 ? e2 : e3) * inv;
        const int lp = atomicAdd(&cnt[ee], 1);
        LIST[ee * T + lp] = t; GLIST[ee * T + lp] = gg; TOKSLOT[t * 4 + lane] = ee * T + lp;
    }
}
__global__ void __launch_bounds__(256) k_gateup(const bf16_t* __restrict__ HN, const int* __restrict__ cnt, const int* __restrict__ LIST, const float* __restrict__ wgu, const float* __restrict__ bgu, bf16_t* __restrict__ ACT) {
    const int e = blockIdx.z, m0 = blockIdx.y * 64, n0 = blockIdx.x * 64; const int ce = cnt[e]; if (m0 >= ce) return;
    const int off = expert_offpad(cnt, e);
    auto A = [&](int m, int k) { const int tok = m < ce ? LIST[e * T + m] : 0; return bf2f(HN[(size_t)tok * D + k]); };
    auto B = [&](int k, int n, int which) { return wgu[((size_t)e * D + k) * 2048 + which * 1024 + n]; };
    auto E = [&](int m, int n, float a1, float a2) { if (m < ce) ACT[(size_t)(off + m) * D + n] = f2bf(swiglu(a1 + bgu[e * 2048 + n], a2 + bgu[e * 2048 + 1024 + n])); };
    gemm_tile<decltype(A), decltype(B), decltype(E), true>(m0, n0, D, A, B, E);
}
__global__ void __launch_bounds__(256) k_down(const bf16_t* __restrict__ ACT, const int* __restrict__ cnt, const float* __restrict__ GLIST, const float* __restrict__ wdn, const float* __restrict__ bdn, bf16_t* __restrict__ YS) {
    const int e = blockIdx.z, m0 = blockIdx.y * 64, n0 = blockIdx.x * 64; const int ce = cnt[e]; if (m0 >= ce) return;
    const int off = expert_offpad(cnt, e);
    auto A = [&](int m, int k) { return m < ce ? bf2f(ACT[(size_t)(off + m) * D + k]) : 0.f; };
    auto B = [&](int k, int n, int) { return wdn[((size_t)e * D + k) * D + n]; };
    auto E = [&](int m, int n, float a1, float) { if (m < ce) YS[(size_t)(off + m) * D + n] = f2bf((a1 + bdn[e * D + n]) * GLIST[e * T + m]); };
    gemm_tile<decltype(A), decltype(B), decltype(E), false>(m0, n0, D, A, B, E);
}
__global__ void __launch_bounds__(256) k_final(const float* H, const bf16_t* __restrict__ YS, const int* __restrict__ cnt, const int* __restrict__ TOKSLOT, const float* __restrict__ g, float* out) {
    const int t = blockIdx.x * 4 + (threadIdx.x >> 6), lane = threadIdx.x & 63;
    f32x4 v[4];
#pragma unroll
    for (int j = 0; j < 4; ++j) v[j] = ((const f32x4*)(H + (size_t)t * D))[lane + 64 * j];
    for (int k = 0; k < 4; ++k) {
        const int sl = TOKSLOT[t * 4 + k]; const int e = sl >> 15, lp = sl & (T - 1); const size_t row = (size_t)expert_offpad(cnt, e) + lp;
#pragma unroll
        for (int j = 0; j < 4; ++j) { const u32x2 w = ((const u32x2*)(YS + row * D))[lane + 64 * j];
            v[j].x += __uint_as_float(w.x << 16); v[j].y += __uint_as_float(w.x & 0xffff0000u); v[j].z += __uint_as_float(w.y << 16); v[j].w += __uint_as_float(w.y & 0xffff0000u); }
    }
    float s = 0.f;
#pragma unroll
    for (int j = 0; j < 4; ++j) s += v[j].x * v[j].x + v[j].y * v[j].y + v[j].z * v[j].z + v[j].w * v[j].w;
    const float rstd = rsqrtf(wave_sum(s) * (1.0f / D) + EPS);
#pragma unroll
    for (int j = 0; j < 4; ++j) { const f32x4 gg = ((const f32x4*)g)[lane + 64 * j];
        ((f32x4*)(out + (size_t)t * D))[lane + 64 * j] = (f32x4){v[j].x * rstd * gg.x, v[j].y * rstd * gg.y, v[j].z * rstd * gg.z, v[j].w * rstd * gg.w}; }
}
}
extern "C" void kernel_launch(void* const* d_in, const int* in_sizes, int n_in, void* d_out, int out_size, void* d_ws, size_t ws_size, hipStream_t stream) {
    if (n_in != 33 || out_size != T * D || ws_size < WS_END) { fprintf(stderr, "kernel_launch: unexpected shapes n_in %d out %d ws %zu\n", n_in, out_size, ws_size); return; }
    const float* in[33]; for (int i = 0; i < 33; ++i) in[i] = (const float*)d_in[i];
    unsigned char* ws = (unsigned char*)d_ws; float* out = (float*)d_out;
    int* cnt = (int*)(ws + WS_CTL); float* NORM = (float*)(ws + WS_NORM); float* HH3 = (float*)(ws + WS_HH3);
    int* LIST = (int*)(ws + WS_LIST); float* GLIST = (float*)(ws + WS_GLIST); int* TOKSLOT = (int*)(ws + WS_TOKSLOT);
    bf16_t* U = (bf16_t*)(ws + WS_U); bf16_t* YLRU = (bf16_t*)(ws + WS_YLRU); bf16_t* HN = (bf16_t*)(ws + WS_HN); bf16_t* YHY = (bf16_t*)(ws + WS_YHY);
    bf16_t* PG = (bf16_t*)(ws + WS_PG); bf16_t* P0 = (bf16_t*)(ws + WS_P0); bf16_t* P1 = (bf16_t*)(ws + WS_P1); bf16_t* PHY = (bf16_t*)(ws + WS_PHY);
    bf16_t* MIX = (bf16_t*)(ws + WS_MIX); float* MIXF = (float*)(ws + WS_MIXF); bf16_t* ACT = (bf16_t*)(ws + WS_ACT); bf16_t* YS = (bf16_t*)(ws + WS_YS);
    float* XR = (float*)(ws + WS_XR); float* HF = (float*)(ws + WS_HF); float* KC = (float*)(ws + WS_KC);
    (void)hipMemsetAsync(ws + WS_CTL, 0, CTL_BYTES, stream);
    nv::k_rms<<<T / 4, 256, 0, stream>>>(in[0], in[1], U);
    nv::k_gemm1<<<dim3(NIN / 64, T / 64), 256, 0, stream>>>(U, in[2], in[3], P0, P1, PHY, PG);
    nv::k_lru_xr<<<T * (D / 256), 256, 0, stream>>>(P0, in[4], in[5], XR);
    nv::k_lru_scan<<<NB * HEADS, 64, 0, stream>>>(XR, in[6], in[7], in[8], in[9], in[10], P1, HF, YLRU);
    nv::k_hy_mlp<<<L, 64, 0, stream>>>(in[14], in[15], in[16], in[17], in[18], in[19], in[21], HH3);
    nv::k_hy_kc<<<L2X * (D / 256), 256, 0, stream>>>(HH3, in[20], KC);
    nv::k_hy_norm<<<D / 256, 256, 0, stream>>>(KC, NORM);
    nv::k_hy_conv<<<dim3(D / 64, L / 64, NB), 256, 0, stream>>>(PHY, in[12], in[13], KC, NORM, in[22], YHY);
    nv::k_mix1<<<dim3(D / 64, T / 64), 256, 0, stream>>>(YLRU, in[11], PG, MIXF);
    nv::k_mix2<<<dim3(D / 64, T / 64), 256, 0, stream>>>(YHY, in[23], PG, MIXF, MIX);
    nv::k_hres<<<dim3(D / 64, T / 64), 256, 0, stream>>>(MIX, in[24], in[0], out);
    nv::k_router<<<T / 4, 256, 0, stream>>>(out, in[25], in[26], in[27], HN, cnt, LIST, GLIST, TOKSLOT);
    nv::k_gateup<<<dim3(D / 64, T / 64, NE), 256, 0, stream>>>(HN, cnt, LIST, in[28], in[29], ACT);
    nv::k_down<<<dim3(D / 64, T / 64, NE), 256, 0, stream>>>(ACT, cnt, GLIST, in[30], in[31], YS);
    nv::k_final<<<T / 4, 256, 0, stream>>>(out, YS, cnt, TOKSLOT, in[32], out);
}
```

```cpp
#include <hip/hip_runtime.h>
#include <hip/hip_cooperative_groups.h>
#include <cstdio>
#include <cstdint>
namespace cg = cooperative_groups;

typedef unsigned short bf16_t;
typedef float f32x4 __attribute__((ext_vector_type(4)));
typedef float f32x2 __attribute__((ext_vector_type(2)));
typedef unsigned u32x4 __attribute__((ext_vector_type(4)));
typedef unsigned u32x2 __attribute__((ext_vector_type(2)));
typedef short bf16x8 __attribute__((ext_vector_type(8)));

constexpr int T = 32768, D = 1024, L = 8192, NB = 4, NE = 32, TOPK = 4, NIN = 7168, L2X = 16384;
constexpr int HEADS = 16, HBLK = 64, HYFF = 64, HYEMB = 33;
constexpr int NPAD = T * TOPK + NE * 256;
constexpr float EPS = 1e-5f;

constexpr size_t MiB = 1u << 20;
constexpr size_t WS_CTL = 0;
constexpr size_t CTL_BYTES = 64 * 1024;
constexpr size_t WS_NORM = 4096;
constexpr size_t WS_HH3 = 2 * MiB;
constexpr size_t WS_WRG = 4 * MiB;
constexpr size_t WS_TOPE = 5 * MiB;
constexpr size_t WS_TOPG = 6 * MiB;
constexpr size_t WS_TOKRS = 7 * MiB;
constexpr size_t WS_ROWTOK = 8 * MiB;
constexpr size_t WS_ROWGATE = 9 * MiB;
constexpr size_t WS_ROWRS = 10 * MiB;
constexpr size_t WS_TOKROW = 11 * MiB;
constexpr size_t WS_WLRUF = 13 * MiB;
constexpr size_t WS_SUMM = 996 * MiB;
constexpr size_t WS_CARRY = 1004 * MiB;
constexpr size_t WS_WIN = 16 * MiB;
constexpr size_t WS_WLRU = 30 * MiB, WS_WHY = 32 * MiB, WS_WOUT = 34 * MiB;
constexpr size_t WS_U = 36 * MiB;
constexpr size_t WS_YLRU = 36 * MiB, WS_HN = 36 * MiB;
constexpr size_t WS_YHY = 100 * MiB;
constexpr size_t WS_PG = 164 * MiB;
constexpr size_t WS_P0 = 292 * MiB;
constexpr size_t WS_P1 = 356 * MiB;
constexpr size_t WS_PHY = 420 * MiB;
constexpr size_t WS_MIX = 292 * MiB;
constexpr size_t WS_MIXF = 420 * MiB;
constexpr size_t WS_ACT = 292 * MiB;
constexpr size_t WS_R2 = 612 * MiB;
constexpr size_t WS_YZ = 612 * MiB;
constexpr size_t WS_KF = 868 * MiB;
constexpr size_t WS_WDN = 612 * MiB;
constexpr size_t WS_WGU = 676 * MiB;
constexpr size_t WS_YS = 676 * MiB;
constexpr size_t WS_XR = 612 * MiB;
constexpr size_t WS_HF = 740 * MiB;
constexpr size_t WS_KC = 868 * MiB;
constexpr size_t WS_END = 1024 * MiB;

__device__ __forceinline__ float bf2f(bf16_t b) { return __uint_as_float(((unsigned)b) << 16); }
__device__ __forceinline__ bf16_t f2bf(float f) { unsigned u = __float_as_uint(f); u += 0x7fffu + ((u >> 16) & 1u); return (bf16_t)(u >> 16); }
__device__ __forceinline__ unsigned pk2(float lo, float hi) { return (unsigned)f2bf(lo) | ((unsigned)f2bf(hi) << 16); }
__device__ __forceinline__ float sigmoidf_(float x) { return 1.0f / (1.0f + __expf(-x)); }
__device__ __forceinline__ float gelu_tanh(float x) { const float u = 0.7978845608028654f * (x + 0.044715f * x * x * x); return x * sigmoidf_(2.0f * u); }
__device__ __forceinline__ float swiglu(float g, float u) { const float g_ = fminf(g, 7.0f); const float u_ = fminf(fmaxf(u, -7.0f), 7.0f); return (u_ + 1.0f) * (g_ * sigmoidf_(1.702f * g_)); }
__device__ __forceinline__ float wave_sum(float v) {
#pragma unroll
    for (int o = 1; o < 64; o <<= 1) v += __shfl_xor(v, o);
    return v;
}
__device__ __forceinline__ int expert_offpad(const int* cnt, int e) { int o = 0; for (int i = 0; i < e; ++i) o += (cnt[i] + 255) & ~255; return o; }
__device__ __forceinline__ float hy_delta_abs(int c) {
    const float lo = -4.605170185988091f / 1.5f, hi = -4.605170185988091f / 0.3f;
    return fabsf(lo + (hi - lo) * ((float)c / 1023.0f));
}
#define LAS __attribute__((address_space(3)))
constexpr int NWAVES = 8, NTHREADS = 512, LDS_BYTES = 147456, MISC_OFF = 131072;

namespace pg8 {
constexpr int BM = 256, BK = 64, HALF = 128, HTB = HALF * BK * 2, NXCD = 8, WGM = 8, KD = 1024;
__host__ __device__ __forceinline__ int lds_byte(int r, int c) { const int st = (r >> 4) * 2 + (c >> 5), rr = r & 15, cc = c & 31, ob = rr * 64 + cc * 2; return st * 1024 + (ob ^ (((ob >> 9) & 1) << 5)); }
__host__ __device__ __forceinline__ void stage_rc(int b, int& R, int& C) { const int st = b / 1024, sb = b % 1024, swz = sb ^ (((sb >> 9) & 1) << 5); R = (st >> 1) * 16 + swz / 64; C = (st & 1) * 32 + (swz % 64) / 2; }
__host__ __device__ __forceinline__ int perm32(int rho) { const int n = rho >> 4, i = rho & 15; return 8 * (i >> 2) + 4 * n + (i & 3); }

struct Unit { const char* A; const char* B; int pm, pn, e, gm; };

struct DenseOrder {
    int nM, nN, nwg, G, c;
    __device__ __forceinline__ void init(int nM_, int nN_, int G_, int c_) { nM = nM_; nN = nN_; nwg = nM * nN; G = G_; c = c_; }
    __device__ __forceinline__ bool tile(int i, int& pm, int& pn) const {
        const long Lx = (long)i * G + c; if (Lx >= nwg) return false;
        int wgid = (int)Lx; { const int q = nwg / NXCD, r = nwg % NXCD, xcd = wgid % NXCD, off = wgid / NXCD; wgid = (xcd < r ? xcd * (q + 1) : r * (q + 1) + (xcd - r) * q) + off; }
        const int nig = WGM * nN, gid = wgid / nig, fm = gid * WGM, gsz = (nM - fm) < WGM ? (nM - fm) : WGM;
        pm = fm + ((wgid % nig) % gsz); pn = (wgid % nig) / gsz; return true;
    }
};

__device__ __forceinline__ unsigned cvt_pk_bf16(float lo, float hi) { unsigned r; asm volatile("v_cvt_pk_bf16_f32 %0, %1, %2" : "=v"(r) : "v"(lo), "v"(hi)); return r; }

template <class Epi, class Sched, bool GATHER>
__device__ __forceinline__ void gemm_phase(LAS unsigned char* lds, const Sched& S, const Epi& E) {
    const int tid = threadIdx.x, wid = __builtin_amdgcn_readfirstlane(tid >> 6), lane = tid & 63, wr = wid >> 2, wc = wid & 3, fr = lane & 15, fq = lane >> 4;
    constexpr int K = KD, nt = K / BK;
    int Rr[2], Cc[2]; unsigned voffB[2];
#pragma unroll
    for (int i = 0; i < 2; ++i) { int R, C; stage_rc(tid * 16 + i * 8192, R, C); Rr[i] = R; Cc[i] = C; const int Rb = (R & ~31) + perm32(R & 31); voffB[i] = (unsigned)(Rb * K + C) * 2u; }
    constexpr size_t kstep = (size_t)(BK * 2);
    constexpr size_t hstep = (size_t)HALF * K * 2;
    const unsigned ldsw = (unsigned)wid * 1024u;
    const int aoff = lds_byte(wr * 64 + fr, fq * 8), boff = lds_byte(wc * 32 + fr, fq * 8);
#define PG8_SA(b, h) (((b) * 2 + (h)) * HTB)
#define PG8_SB(b, h) ((4 + (b) * 2 + (h)) * HTB)
#define PG8_GLDS(gp, lp) __builtin_amdgcn_global_load_lds((const unsigned*)(gp), (LAS unsigned*)(lp), 16, 0, 0)
#define PG8_STAGEB(bufoff, gbase) do { PG8_GLDS((const char*)(gbase) + voffB[0], lds + (bufoff) + ldsw); PG8_GLDS((const char*)(gbase) + voffB[1], lds + (bufoff) + ldsw + 8192); } while (0)
#define PG8_STAGEA(bufoff, gbase, o0, o1) do { PG8_GLDS((const char*)(gbase) + (o0), lds + (bufoff) + ldsw); PG8_GLDS((const char*)(gbase) + (o1), lds + (bufoff) + ldsw + 8192); } while (0)
#define PG8_LDA(dst, b, h) do { _Pragma("unroll") for (int m = 0; m < 4; ++m) _Pragma("unroll") for (int k = 0; k < 2; ++k) dst[m][k] = *(const LAS bf16x8*)(lds + PG8_SA(b, h) + aoff + m * 2048 + k * 1024); } while (0)
#define PG8_LDB(dst, b, h) do { _Pragma("unroll") for (int n = 0; n < 2; ++n) _Pragma("unroll") for (int k = 0; k < 2; ++k) dst[n][k] = *(const LAS bf16x8*)(lds + PG8_SB(b, h) + boff + n * 2048 + k * 1024); } while (0)
#define PG8_MMA(ai, bj, At, Bt) do { __builtin_amdgcn_s_setprio(1); _Pragma("unroll") for (int m = 0; m < 4; ++m) _Pragma("unroll") for (int n = 0; n < 2; ++n) _Pragma("unroll") for (int k = 0; k < 2; ++k) \
        acc[ai][bj][m][n] = __builtin_amdgcn_mfma_f32_16x16x32_bf16(Bt[n][k], At[m][k], acc[ai][bj][m][n], 0, 0, 0); __builtin_amdgcn_s_setprio(0); } while (0)
#define PG8_WAIT_V(n) asm volatile("s_waitcnt vmcnt(" #n ")" ::: "memory")
#define PG8_WAIT_L(n) asm volatile("s_waitcnt lgkmcnt(" #n ")" ::: "memory")
#define PG8_BAR __builtin_amdgcn_s_barrier()
#define PG8_SCHED __builtin_amdgcn_sched_barrier(0)
    Unit cur, nxt; int ui = 0;
    if (!S.next(0, cur)) return;
    unsigned oc[2][2], on[2][2];
#pragma unroll
    for (int h = 0; h < 2; ++h)
#pragma unroll
        for (int i = 0; i < 2; ++i) { oc[h][i] = GATHER ? S.a_off(cur, h * HALF + Rr[i], Cc[i]) : (unsigned)(Rr[i] * K + Cc[i]) * 2u + (unsigned)(h * hstep); on[h][i] = oc[h][i]; }
    f32x4 acc[2][2][4][2];
#pragma unroll
    for (int a = 0; a < 2; ++a)
#pragma unroll
        for (int b = 0; b < 2; ++b)
#pragma unroll
            for (int m = 0; m < 4; ++m)
#pragma unroll
                for (int n = 0; n < 2; ++n) acc[a][b][m][n] = (f32x4){0.f, 0.f, 0.f, 0.f};
    bf16x8 At[4][2], B0[2][2], B1[2][2];
    const char* cA = cur.A; const char* cB = cur.B;
    PG8_STAGEB(PG8_SB(0, 0), cB); PG8_STAGEB(PG8_SB(0, 1), cB + hstep); PG8_STAGEA(PG8_SA(0, 0), cA, oc[0][0], oc[0][1]); PG8_STAGEA(PG8_SA(0, 1), cA, oc[1][0], oc[1][1]);
    if (wr == 1) PG8_BAR;
    PG8_WAIT_V(2); PG8_BAR;
    PG8_STAGEB(PG8_SB(1, 0), cB + kstep); PG8_STAGEA(PG8_SA(1, 0), cA + kstep, oc[0][0], oc[0][1]); PG8_STAGEB(PG8_SB(1, 1), cB + hstep + kstep);
    PG8_WAIT_V(6); PG8_BAR;
    for (;;) {
        const bool has_next = S.next(ui + 1, nxt);
        const char* nA = has_next ? nxt.A : cA; const char* nB = has_next ? nxt.B : cB;
        if (GATHER) {
#pragma unroll
            for (int h = 0; h < 2; ++h)
#pragma unroll
                for (int i = 0; i < 2; ++i) on[h][i] = has_next ? S.a_off(nxt, h * HALF + Rr[i], Cc[i]) : oc[h][i];
        }
        for (int t = 0; t < nt; t += 2) {
            const bool last = (t == nt - 2);
            const char* a1 = cA + (size_t)(t + 1) * kstep;
            const char* a2 = last ? nA : cA + (size_t)(t + 2) * kstep; const char* b2 = last ? nB : cB + (size_t)(t + 2) * kstep;
            const char* a3 = a2 + kstep; const char* b3 = b2 + kstep;
            const unsigned x00 = (GATHER && last) ? on[0][0] : oc[0][0], x01 = (GATHER && last) ? on[0][1] : oc[0][1], x10 = (GATHER && last) ? on[1][0] : oc[1][0], x11 = (GATHER && last) ? on[1][1] : oc[1][1];
            PG8_LDB(B0, 0, 0); PG8_LDB(B1, 0, 1); PG8_SCHED; PG8_LDA(At, 0, 0); PG8_STAGEA(PG8_SA(1, 1), a1, oc[1][0], oc[1][1]);
            PG8_WAIT_V(8); PG8_WAIT_L(0); PG8_BAR; PG8_MMA(0, 0, At, B0); PG8_MMA(0, 1, At, B1); PG8_BAR; PG8_SCHED;
            PG8_LDA(At, 0, 1); PG8_STAGEB(PG8_SB(0, 0), b2); PG8_STAGEB(PG8_SB(0, 1), b2 + hstep); PG8_STAGEA(PG8_SA(0, 0), a2, x00, x01);
            PG8_WAIT_V(8); PG8_WAIT_L(0); PG8_BAR; PG8_MMA(1, 0, At, B0); PG8_MMA(1, 1, At, B1); PG8_BAR; PG8_SCHED;
            PG8_LDB(B0, 1, 0); PG8_LDB(B1, 1, 1); PG8_SCHED; PG8_LDA(At, 1, 0); PG8_STAGEA(PG8_SA(0, 1), a2, x10, x11);
            PG8_WAIT_V(8); PG8_WAIT_L(0); PG8_BAR; PG8_MMA(0, 0, At, B0); PG8_MMA(0, 1, At, B1); PG8_BAR; PG8_SCHED;
            PG8_LDA(At, 1, 1); PG8_STAGEB(PG8_SB(1, 0), b3); PG8_STAGEB(PG8_SB(1, 1), b3 + hstep); PG8_STAGEA(PG8_SA(1, 0), a3, x00, x01);
            PG8_WAIT_V(8); PG8_WAIT_L(0); PG8_BAR; PG8_MMA(1, 0, At, B0); PG8_MMA(1, 1, At, B1); PG8_BAR; PG8_SCHED;
        }
        if (wr == 0) PG8_BAR;
        E(acc, cur, wr, wc, fr, fq);
        if (!has_next) break;
#pragma unroll
        for (int a = 0; a < 2; ++a)
#pragma unroll
            for (int b = 0; b < 2; ++b)
#pragma unroll
                for (int m = 0; m < 4; ++m)
#pragma unroll
                    for (int n = 0; n < 2; ++n) acc[a][b][m][n] = (f32x4){0.f, 0.f, 0.f, 0.f};
        cur = nxt; cA = nA; cB = nB; ++ui;
        if (GATHER) {
#pragma unroll
            for (int h = 0; h < 2; ++h)
#pragma unroll
                for (int i = 0; i < 2; ++i) oc[h][i] = on[h][i];
        }
        if (wr == 1) PG8_BAR;
    }
    PG8_WAIT_V(0);
    PG8_BAR;
#undef PG8_SA
#undef PG8_SB
#undef PG8_GLDS
#undef PG8_STAGEA
#undef PG8_STAGEB
#undef PG8_LDA
#undef PG8_LDB
#undef PG8_MMA
#undef PG8_WAIT_V
#undef PG8_WAIT_L
#undef PG8_BAR
#undef PG8_SCHED
}

__device__ __forceinline__ void store8bf(bf16_t* p, const f32x4 v0, const f32x4 v1) {
    u32x4 w; w.x = cvt_pk_bf16(v0[0], v0[1]); w.y = cvt_pk_bf16(v0[2], v0[3]); w.z = cvt_pk_bf16(v1[0], v1[1]); w.w = cvt_pk_bf16(v1[2], v1[3]); *(u32x4*)p = w;
}
__device__ __forceinline__ void load8bf(const bf16_t* p, f32x4& v0, f32x4& v1) {
    const u32x4 w = *(const u32x4*)p;
    v0 = (f32x4){__uint_as_float(w.x << 16), __uint_as_float(w.x & 0xffff0000u), __uint_as_float(w.y << 16), __uint_as_float(w.y & 0xffff0000u)};
    v1 = (f32x4){__uint_as_float(w.z << 16), __uint_as_float(w.z & 0xffff0000u), __uint_as_float(w.w << 16), __uint_as_float(w.w & 0xffff0000u)};
}
#define EPI_ROWS(ai, m) ((ai) * HALF + wr * 64 + (m) * 16 + fr)
#define EPI_COLS(bj) ((bj) * HALF + wc * 32 + 8 * fq)

struct EpiIn {
    bf16_t *P0, *P1, *PHY, *PG; const float* bias;
    __device__ __forceinline__ void operator()(const f32x4 (&acc)[2][2][4][2], const Unit& u, int wr, int wc, int fr, int fq) const {
        const int seg = u.pn >> 2; bf16_t* dst; int ld, colt; int act = 0;
        if (seg == 0) { dst = P0; ld = 1024; colt = u.pn * 256; }
        else if (seg == 1) { dst = P1; ld = 1024; colt = u.pn * 256 - 1024; act = 1; }
        else if (seg < 5) { dst = PHY; ld = 3072; colt = u.pn * 256 - 2048; }
        else { dst = PG; ld = 2048; colt = u.pn * 256 - 5120; act = 2; }
        f32x4 bv[2][2];
#pragma unroll
        for (int bj = 0; bj < 2; ++bj)
#pragma unroll
            for (int n = 0; n < 2; ++n) bv[bj][n] = *(const f32x4*)(bias + u.pn * 256 + EPI_COLS(bj) + 4 * n);
#pragma unroll
        for (int ai = 0; ai < 2; ++ai)
#pragma unroll
            for (int m = 0; m < 4; ++m) { bf16_t* rowp = dst + (size_t)(u.pm * BM + EPI_ROWS(ai, m)) * ld + colt;
#pragma unroll
                for (int bj = 0; bj < 2; ++bj) { f32x4 v0 = acc[ai][bj][m][0] + bv[bj][0], v1 = acc[ai][bj][m][1] + bv[bj][1];
                    if (act == 1) {
#pragma unroll
                        for (int j = 0; j < 4; ++j) { v0[j] = gelu_tanh(v0[j]); v1[j] = gelu_tanh(v1[j]); } }
                    else if (act == 2) {
#pragma unroll
                        for (int j = 0; j < 4; ++j) { v0[j] = sigmoidf_(v0[j]); v1[j] = sigmoidf_(v1[j]); } }
                    store8bf(rowp + EPI_COLS(bj), v0, v1); } }
    }
};
struct EpiMix {
    const bf16_t* PG; float* MIXF; bf16_t* MIX;
    __device__ __forceinline__ void operator()(const f32x4 (&acc)[2][2][4][2], const Unit& u, int wr, int wc, int fr, int fq) const {
#pragma unroll
        for (int ai = 0; ai < 2; ++ai)
#pragma unroll
            for (int m = 0; m < 4; ++m) { const size_t row = (size_t)(u.pm * BM + EPI_ROWS(ai, m));
#pragma unroll
                for (int bj = 0; bj < 2; ++bj) { const int col = u.pn * 256 + EPI_COLS(bj);
                    f32x4 g0, g1; load8bf(PG + row * 2048 + u.e * 1024 + col, g0, g1);
                    float* mf = MIXF + row * 1024 + col;
                    if (u.e == 0) { *(f32x4*)mf = g0 * acc[ai][bj][m][0]; *(f32x4*)(mf + 4) = g1 * acc[ai][bj][m][1]; }
                    else { const f32x4 p0 = *(const f32x4*)mf, p1 = *(const f32x4*)(mf + 4); store8bf(MIX + row * 1024 + col, p0 + g0 * acc[ai][bj][m][0], p1 + g1 * acc[ai][bj][m][1]); } } }
    }
};
struct EpiH {
    const float* x; float* H; bf16_t* HB;
    __device__ __forceinline__ void operator()(const f32x4 (&acc)[2][2][4][2], const Unit& u, int wr, int wc, int fr, int fq) const {
#pragma unroll
        for (int ai = 0; ai < 2; ++ai)
#pragma unroll
            for (int m = 0; m < 4; ++m) { const size_t row = (size_t)(u.pm * BM + EPI_ROWS(ai, m));
#pragma unroll
                for (int bj = 0; bj < 2; ++bj) { const size_t o = row * 1024 + u.pn * 256 + EPI_COLS(bj);
                    const f32x4 v0 = *(const f32x4*)(x + o) + acc[ai][bj][m][0], v1 = *(const f32x4*)(x + o + 4) + acc[ai][bj][m][1];
                    *(f32x4*)(H + o) = v0; *(f32x4*)(H + o + 4) = v1; store8bf(HB + o, v0, v1); } }
    }
};
struct EpiGU {
    const float* bgu; const float* ROWRS; bf16_t* ACT;
    __device__ __forceinline__ void operator()(const f32x4 (&acc)[2][2][4][2], const Unit& u, int wr, int wc, int fr, int fq) const {
        const int colp = u.pn * 128 + wc * 32 + 8 * fq;
        f32x4 bg[2], bu[2];
#pragma unroll
        for (int n = 0; n < 2; ++n) { bg[n] = *(const f32x4*)(bgu + u.e * 2048 + colp + 4 * n); bu[n] = *(const f32x4*)(bgu + u.e * 2048 + 1024 + colp + 4 * n); }
#pragma unroll
        for (int ai = 0; ai < 2; ++ai)
#pragma unroll
            for (int m = 0; m < 4; ++m) { const size_t row = (size_t)u.gm * BM + EPI_ROWS(ai, m); const float rs = ROWRS[row];
                f32x4 o[2];
#pragma unroll
                for (int n = 0; n < 2; ++n) { const f32x4 g = acc[ai][0][m][n] * rs + bg[n], uu = acc[ai][1][m][n] * rs + bu[n];
#pragma unroll
                    for (int j = 0; j < 4; ++j) o[n][j] = swiglu(g[j], uu[j]); }
                store8bf(ACT + row * 1024 + colp, o[0], o[1]); }
    }
};
struct EpiDN {
    const float* bdn; const float* ROWGATE; bf16_t* YS;
    __device__ __forceinline__ void operator()(const f32x4 (&acc)[2][2][4][2], const Unit& u, int wr, int wc, int fr, int fq) const {
        f32x4 bv[2][2];
#pragma unroll
        for (int bj = 0; bj < 2; ++bj)
#pragma unroll
            for (int n = 0; n < 2; ++n) bv[bj][n] = *(const f32x4*)(bdn + u.e * 1024 + u.pn * 256 + EPI_COLS(bj) + 4 * n);
#pragma unroll
        for (int ai = 0; ai < 2; ++ai)
#pragma unroll
            for (int m = 0; m < 4; ++m) { const size_t row = (size_t)u.gm * BM + EPI_ROWS(ai, m); const float gt = ROWGATE[row];
#pragma unroll
                for (int bj = 0; bj < 2; ++bj) store8bf(YS + row * 1024 + u.pn * 256 + EPI_COLS(bj), (acc[ai][bj][m][0] + bv[bj][0]) * gt, (acc[ai][bj][m][1] + bv[bj][1]) * gt); }
    }
};

struct SchedDense {
    DenseOrder O; const char* A; const char* B;
    __device__ __forceinline__ bool next(int i, Unit& u) const { int pm, pn; if (!O.tile(i, pm, pn)) return false; u.pm = pm; u.pn = pn; u.e = 0; u.gm = pm;
        u.A = A + (size_t)pm * (BM * KD * 2); u.B = B + (size_t)pn * (BM * KD * 2); return true; }
    __device__ __forceinline__ unsigned a_off(const Unit&, int, int) const { return 0u; }
};
struct SchedMix {
    DenseOrder O; const char* A0; const char* A1; const char* B0; const char* B1;
    __device__ __forceinline__ bool next(int i, Unit& u) const { int pm, pn; if (!O.tile(i >> 1, pm, pn)) return false; const int w = i & 1; u.pm = pm; u.pn = pn; u.e = w; u.gm = pm;
        u.A = (w ? A1 : A0) + (size_t)pm * (BM * KD * 2); u.B = (w ? B1 : B0) + (size_t)pn * (BM * KD * 2); return true; }
    __device__ __forceinline__ unsigned a_off(const Unit&, int, int) const { return 0u; }
};
template <int NT, bool GATHER> struct SchedMoE {
    const LAS int* ptile; int G, c; const char* A; const char* B; size_t bstride  ; const int* ROWTOK;
    __device__ __forceinline__ bool next(int i, Unit& u) const {
        const int total = ptile[32] * NT; const long Lx = (long)i * G + c; if (Lx >= total) return false;
        const int gm = (int)(Lx / NT), pn = (int)(Lx % NT); int e = 0;
#pragma unroll 1
        for (int q = 1; q < 32; ++q) e += (ptile[q] <= gm) ? 1 : 0;
        u.pm = gm; u.gm = gm; u.pn = pn; u.e = e;
        u.A = GATHER ? A : A + (size_t)gm * (BM * KD * 2); u.B = B + (size_t)e * bstride + (size_t)pn * (BM * KD * 2); return true; }
    __device__ __forceinline__ unsigned a_off(const Unit& u, int r, int c) const { return (unsigned)ROWTOK[u.gm * BM + r] * (unsigned)(KD * 2) + (unsigned)(c * 2); }
};
}
struct Args { const float* in[33]; float* out; unsigned char* ws; int ph_lo, ph_hi; };
#define LDS_WAIT() asm volatile("s_waitcnt lgkmcnt(0)" ::: "memory")

struct Frame {
    LAS unsigned char* lds; int tid, lane, wave, G, bid; const float* const* in; float* out; unsigned char* ws;
};

namespace hy {
constexpr int TW128_OFF = MISC_OFF + 1024, TWT_OFF = MISC_OFF + 2048;

__host__ __device__ constexpr float twc16(int m) { return m == 0 ? 1.f : m == 1 ? 0.92387953251128674f : m == 2 ? 0.70710678118654752f : m == 3 ? 0.38268343236508977f : m == 4 ? 0.f : m == 5 ? -0.38268343236508977f : m == 6 ? -0.70710678118654752f : -0.92387953251128674f; }
__host__ __device__ constexpr float tws16(int m) { return m == 0 ? 0.f : m == 1 ? 0.38268343236508977f : m == 2 ? 0.70710678118654752f : m == 3 ? 0.92387953251128674f : m == 4 ? 1.f : m == 5 ? 0.92387953251128674f : m == 6 ? 0.70710678118654752f : 0.38268343236508977f; }
template <int N> __host__ __device__ constexpr int brev(int i) { int r = 0; for (int b = 1, c = N >> 1; b < N; b <<= 1, c >>= 1) if (i & b) r |= c; return r; }

template <int N, bool INV> __device__ __forceinline__ void fft_reg(float (&xr)[N], float (&xi)[N]) {
#pragma unroll
    for (int len = N; len >= 2; len >>= 1) {
        const int half = len >> 1;
#pragma unroll
        for (int start = 0; start < N; start += len) {
#pragma unroll
            for (int j = 0; j < half; ++j) {
                const int i0 = start + j, i1 = i0 + half;
                const float ar = xr[i0], ai = xi[i0], br = xr[i1], bi = xi[i1];
                xr[i0] = ar + br; xi[i0] = ai + bi;
                const float tr = ar - br, ti = ai - bi;
                const int m = j * (16 / len);
                if (m == 0) { xr[i1] = tr; xi[i1] = ti; }
                else if (m == 4) { if (INV) { xr[i1] = -ti; xi[i1] = tr; } else { xr[i1] = ti; xi[i1] = -tr; } }
                else { const float c = twc16(m), s = INV ? tws16(m) : -tws16(m); xr[i1] = tr * c - ti * s; xi[i1] = tr * s + ti * c; }
            }
        }
    }
}
__device__ __forceinline__ void cmul(float& xr, float& xi, float c, float s) { const float r = xr * c - xi * s, i = xr * s + xi * c; xr = r; xi = i; }

__device__ __forceinline__ void init_tw128(Frame& F) {
    __syncthreads();
    if (F.tid < 128) { float s, c; sincospif((float)F.tid * (1.0f / 64.0f), &s, &c); ((LAS f32x2*)(F.lds + TW128_OFF))[F.tid] = (f32x2){c, s}; }
    __syncthreads();
}
__device__ __forceinline__ void tile_tw(Frame& F, int a, bool inv) {
    if (F.tid < 128) { const int m = (a * F.tid) & (L2X - 1); float s, c; sincospif((float)m * (1.0f / 8192.0f), &s, &c); ((LAS f32x2*)(F.lds + TWT_OFF))[F.tid] = (f32x2){c, inv ? s : -s}; }
}
template <bool INV> __device__ __forceinline__ void stage1(Frame& F, float (&r0)[16], float (&i0)[16], float (&r1)[16], float (&i1)[16], int s) {
    fft_reg<16, INV>(r0, i0); fft_reg<16, INV>(r1, i1);
    const LAS f32x2* tw = (const LAS f32x2*)(F.lds + TW128_OFF); LAS f32x4* tile = (LAS f32x4*)F.lds;
#pragma unroll
    for (int q = 0; q < 16; ++q) { const int p = brev<16>(q); const f32x2 w = tw[s * q]; const float c = w.x, sn = INV ? w.y : -w.y;
        float a = r0[p], b = i0[p], cc = r1[p], d = i1[p]; cmul(a, b, c, sn); cmul(cc, d, c, sn);
        tile[(s * 16 + q) * 64 + F.lane] = (f32x4){a, b, cc, d}; }
}
__device__ __forceinline__ void stage2_read(Frame& F, float (&r0)[8], float (&i0)[8], float (&r1)[8], float (&i1)[8], int qq) {
    const LAS f32x4* tile = (const LAS f32x4*)F.lds;
#pragma unroll
    for (int s = 0; s < 8; ++s) { const f32x4 v = tile[(s * 16 + qq) * 64 + F.lane]; r0[s] = v.x; i0[s] = v.y; r1[s] = v.z; i1[s] = v.w; }
}
__device__ __forceinline__ void hyq2(const bf16_t* __restrict__ PHY, size_t row, int tl, int col, const float (&w)[3][2], const float (&b)[2], float& q0, float& q1) {
    q0 = b[0]; q1 = b[1];
#pragma unroll
    for (int k = 0; k < 3; ++k) { const int tt = tl + k - 1; const bool ok = (tt >= 0) && (tt < L);
        const unsigned u = ok ? *(const unsigned*)(PHY + (row + k - 1) * 3072 + col) : 0u;
        q0 += w[k][0] * __uint_as_float(u << 16); q1 += w[k][1] * __uint_as_float(u & 0xffff0000u); }
}
struct ConvW { float w[3][3][2]; float b[3][2]; };
__device__ __forceinline__ void load_convw(ConvW& W, const float* __restrict__ cw, const float* __restrict__ cb, int c0) {
#pragma unroll
    for (int seg = 0; seg < 3; ++seg) {
#pragma unroll
        for (int k = 0; k < 3; ++k) { const f32x2 v = *(const f32x2*)(cw + k * 3072 + seg * 1024 + c0); W.w[seg][k][0] = v.x; W.w[seg][k][1] = v.y; }
        const f32x2 v = *(const f32x2*)(cb + seg * 1024 + c0); W.b[seg][0] = v.x; W.b[seg][1] = v.y; }
}

__device__ __forceinline__ void filter_pass_a(Frame& F) {
    const float* HH3 = (const float*)(F.ws + WS_HH3); const float* w4 = F.in[20]; float* NORM = (float*)(F.ws + WS_NORM); f32x4* YK = (f32x4*)(F.ws + WS_KF);
    const int s = F.wave; const LAS f32x2* twt = (const LAS f32x2*)(F.lds + TWT_OFF);
    for (int tl = F.bid; tl < 128 * 8; tl += F.G) {
        const int n1 = tl >> 3, ct = tl & 7, c0 = ct * 128 + 2 * F.lane;
        tile_tw(F, n1, false);
        float r0[16], i0[16], r1[16], i1[16];
#pragma unroll
        for (int j = 0; j < 16; ++j) { r0[j] = 0.f; r1[j] = 0.f; i0[j] = 0.f; i1[j] = 0.f; }
        const float da0 = hy_delta_abs(c0), da1 = hy_delta_abs(c0 + 1);
#pragma unroll 1
        for (int u = 0; u < 64; ++u) {
            const f32x2 wf = *(const f32x2*)(w4 + u * 2048 + c0), wb = *(const f32x2*)(w4 + u * 2048 + 1024 + c0);
#pragma unroll
            for (int j = 0; j < 16; ++j) { const int n = n1 + 128 * (s + 8 * j); const int t = j < 8 ? n : ((2 * L - n) & (L - 1));
                const float h = HH3[t * 64 + u];
                r0[j] += h * (j < 8 ? wf.x : wb.x); r1[j] += h * (j < 8 ? wf.y : wb.y); }
            if (n1 == 0 && s == 0) { const float h = HH3[u]; i0[0] += h * wb.x; i1[0] += h * wb.y; }
        }
        float na0 = 0.f, na1 = 0.f;
#pragma unroll
        for (int j = 0; j < 16; ++j) { const int n = n1 + 128 * (s + 8 * j); const int t = j < 8 ? n : ((2 * L - n) & (L - 1)); const float tt = (float)t * (1.0f / (float)(L - 1));
            float v0 = r0[j] * __expf(-tt * da0), v1 = r1[j] * __expf(-tt * da1);
            if (n == L) { v0 = 0.f; v1 = 0.f; }
            if (j == 0) { v0 += i0[0]; v1 += i1[0]; }
            r0[j] = v0; r1[j] = v1; na0 += fabsf(v0); na1 += fabsf(v1); }
        i0[0] = 0.f; i1[0] = 0.f;
        atomicAdd(NORM + c0, na0); atomicAdd(NORM + c0 + 1, na1);
        stage1<false>(F, r0, i0, r1, i1, s);
        __syncthreads();
#pragma unroll
        for (int h = 0; h < 2; ++h) { const int qq = s + 8 * h; float a0[8], b0[8], a1[8], b1[8];
            stage2_read(F, a0, b0, a1, b1, qq); fft_reg<8, false>(a0, b0); fft_reg<8, false>(a1, b1);
#pragma unroll
            for (int r = 0; r < 8; ++r) { const int p = brev<8>(r), k2 = qq + 16 * r; const f32x2 w = twt[k2];
                float x0 = a0[p], y0 = b0[p], x1 = a1[p], y1 = b1[p]; cmul(x0, y0, w.x, w.y); cmul(x1, y1, w.x, w.y);
                YK[((size_t)k2 * 128 + n1) * 512 + (c0 >> 1)] = (f32x4){x0, y0, x1, y1}; } }
        __syncthreads();
    }
}
__device__ __forceinline__ void filter_pass_b(Frame& F) {
    const float* NORM = (const float*)(F.ws + WS_NORM); f32x4* KF = (f32x4*)(F.ws + WS_KF); const int s = F.wave;
    for (int tl = F.bid; tl < 128 * 8; tl += F.G) {
        const int k2 = tl >> 3, ct = tl & 7, c0 = ct * 128 + 2 * F.lane; const size_t base = (size_t)k2 * 128 * 512 + (c0 >> 1);
        const float sc0 = 1.0f / ((float)L2X * NORM[c0]), sc1 = 1.0f / ((float)L2X * NORM[c0 + 1]);
        float r0[16], i0[16], r1[16], i1[16];
#pragma unroll
        for (int j = 0; j < 16; ++j) { const f32x4 v = KF[base + (size_t)(s + 8 * j) * 512]; r0[j] = v.x; i0[j] = v.y; r1[j] = v.z; i1[j] = v.w; }
        stage1<false>(F, r0, i0, r1, i1, s);
        __syncthreads();
#pragma unroll
        for (int h = 0; h < 2; ++h) { const int qq = s + 8 * h; float a0[8], b0[8], a1[8], b1[8];
            stage2_read(F, a0, b0, a1, b1, qq); fft_reg<8, false>(a0, b0); fft_reg<8, false>(a1, b1);
#pragma unroll
            for (int r = 0; r < 8; ++r) { const int p = brev<8>(r), k1 = qq + 16 * r;
                KF[base + (size_t)k1 * 512] = (f32x4){a0[p] * sc0, b0[p] * sc0, a1[p] * sc1, b1[p] * sc1}; } }
        __syncthreads();
    }
}
__device__ __forceinline__ void data_pass_a(Frame& F) {
    const bf16_t* PHY = (const bf16_t*)(F.ws + WS_PHY); f32x4* YZ = (f32x4*)(F.ws + WS_YZ); const int s = F.wave; const LAS f32x2* twt = (const LAS f32x2*)(F.lds + TWT_OFF);
    for (int tl = F.bid; tl < 2 * 128 * 8; tl += F.G) {
        const int ct = tl & 7, n1 = (tl >> 3) & 127, p = tl >> 10, c0 = ct * 128 + 2 * F.lane;
        tile_tw(F, n1, false);
        ConvW W; load_convw(W, F.in[12], F.in[13], c0);
        float r0[16], i0[16], r1[16], i1[16];
#pragma unroll
        for (int j = 0; j < 8; ++j) { const int t = n1 + 128 * (s + 8 * j);
#pragma unroll
            for (int bb = 0; bb < 2; ++bb) { const size_t row = (size_t)(2 * p + bb) * L + t; float v0, v1, x0, x1;
                hyq2(PHY, row, t, c0, W.w[0], W.b[0], v0, v1); hyq2(PHY, row, t, 2048 + c0, W.w[2], W.b[2], x0, x1);
                if (bb == 0) { r0[j] = x0 * v0; r1[j] = x1 * v1; } else { i0[j] = x0 * v0; i1[j] = x1 * v1; } } }
#pragma unroll
        for (int j = 8; j < 16; ++j) { r0[j] = 0.f; i0[j] = 0.f; r1[j] = 0.f; i1[j] = 0.f; }
        stage1<false>(F, r0, i0, r1, i1, s);
        __syncthreads();
#pragma unroll
        for (int h = 0; h < 2; ++h) { const int qq = s + 8 * h; float a0[8], b0[8], a1[8], b1[8];
            stage2_read(F, a0, b0, a1, b1, qq); fft_reg<8, false>(a0, b0); fft_reg<8, false>(a1, b1);
#pragma unroll
            for (int r = 0; r < 8; ++r) { const int pp = brev<8>(r), k2 = qq + 16 * r; const f32x2 w = twt[k2];
                float x0 = a0[pp], y0 = b0[pp], x1 = a1[pp], y1 = b1[pp]; cmul(x0, y0, w.x, w.y); cmul(x1, y1, w.x, w.y);
                YZ[(((size_t)p * 128 + k2) * 128 + n1) * 512 + (c0 >> 1)] = (f32x4){x0, y0, x1, y1}; } }
        __syncthreads();
    }
}
__device__ __forceinline__ void data_pass_b(Frame& F) {
    f32x4* YZ = (f32x4*)(F.ws + WS_YZ); const f32x4* KF = (const f32x4*)(F.ws + WS_KF); const int s = F.wave;
    const LAS f32x2* twt = (const LAS f32x2*)(F.lds + TWT_OFF); const LAS f32x2* tw = (const LAS f32x2*)(F.lds + TW128_OFF); LAS f32x4* tile = (LAS f32x4*)F.lds;
    for (int tl = F.bid; tl < 128 * 8; tl += F.G) {
        const int k2 = tl >> 3, ct = tl & 7, c0 = ct * 128 + 2 * F.lane; const size_t kbase = (size_t)k2 * 128 * 512 + (c0 >> 1);
        tile_tw(F, k2, true);
#pragma unroll 1
        for (int p = 0; p < 2; ++p) {
            const size_t base = ((size_t)p * 128 + k2) * 128 * 512 + (c0 >> 1);
            { float r0[16], i0[16], r1[16], i1[16];
#pragma unroll
              for (int j = 0; j < 16; ++j) { const f32x4 v = YZ[base + (size_t)(s + 8 * j) * 512]; r0[j] = v.x; i0[j] = v.y; r1[j] = v.z; i1[j] = v.w; }
              stage1<false>(F, r0, i0, r1, i1, s); }
            __syncthreads();
            float g0r[2][8], g0i[2][8], g1r[2][8], g1i[2][8];
#pragma unroll
            for (int h = 0; h < 2; ++h) { const int qq = s + 8 * h; float a0[8], b0[8], a1[8], b1[8];
                stage2_read(F, a0, b0, a1, b1, qq); fft_reg<8, false>(a0, b0); fft_reg<8, false>(a1, b1);
#pragma unroll
                for (int r = 0; r < 8; ++r) { const int pp = brev<8>(r); const f32x4 kf = KF[kbase + (size_t)(qq + 16 * r) * 512];
                    g0r[h][r] = a0[pp] * kf.x - b0[pp] * kf.y; g0i[h][r] = a0[pp] * kf.y + b0[pp] * kf.x; g1r[h][r] = a1[pp] * kf.z - b1[pp] * kf.w; g1i[h][r] = a1[pp] * kf.w + b1[pp] * kf.z; }
                fft_reg<8, true>(g0r[h], g0i[h]); fft_reg<8, true>(g1r[h], g1i[h]); }
            __syncthreads();
#pragma unroll
            for (int h = 0; h < 2; ++h) { const int qq = s + 8 * h;
#pragma unroll
                for (int b = 0; b < 8; ++b) { const int pp = brev<8>(b); const f32x2 w = tw[b * qq];
                    float x0 = g0r[h][pp], y0 = g0i[h][pp], x1 = g1r[h][pp], y1 = g1i[h][pp]; cmul(x0, y0, w.x, w.y); cmul(x1, y1, w.x, w.y);
                    tile[(b * 16 + qq) * 64 + F.lane] = (f32x4){x0, y0, x1, y1}; } }
            __syncthreads();
            { float r0[16], i0[16], r1[16], i1[16];
#pragma unroll
              for (int q = 0; q < 16; ++q) { const f32x4 v = tile[(s * 16 + q) * 64 + F.lane]; r0[q] = v.x; i0[q] = v.y; r1[q] = v.z; i1[q] = v.w; }
              fft_reg<16, true>(r0, i0); fft_reg<16, true>(r1, i1);
#pragma unroll
              for (int a = 0; a < 16; ++a) { const int pp = brev<16>(a), m2 = s + 8 * a; const f32x2 w = twt[m2];
                  float x0 = r0[pp], y0 = i0[pp], x1 = r1[pp], y1 = i1[pp]; cmul(x0, y0, w.x, w.y); cmul(x1, y1, w.x, w.y);
                  YZ[base + (size_t)m2 * 512] = (f32x4){x0, y0, x1, y1}; } }
            __syncthreads();
        }
    }
}
__device__ __forceinline__ void data_pass_c(Frame& F) {
    const bf16_t* PHY = (const bf16_t*)(F.ws + WS_PHY); const f32x4* YZ = (const f32x4*)(F.ws + WS_YZ); bf16_t* YHY = (bf16_t*)(F.ws + WS_YHY); const float* hbias = F.in[22]; const int s = F.wave;
    for (int tl = F.bid; tl < 2 * 128 * 8; tl += F.G) {
        const int ct = tl & 7, m2 = (tl >> 3) & 127, p = tl >> 10, c0 = ct * 128 + 2 * F.lane;
        { float r0[16], i0[16], r1[16], i1[16];
#pragma unroll
          for (int j = 0; j < 16; ++j) { const f32x4 v = YZ[(((size_t)p * 128 + (s + 8 * j)) * 128 + m2) * 512 + (c0 >> 1)]; r0[j] = v.x; i0[j] = v.y; r1[j] = v.z; i1[j] = v.w; }
          stage1<true>(F, r0, i0, r1, i1, s); }
        __syncthreads();
        ConvW W; load_convw(W, F.in[12], F.in[13], c0); const f32x2 hb = *(const f32x2*)(hbias + c0);
#pragma unroll
        for (int h = 0; h < 2; ++h) { const int qq = s + 8 * h; float a0[8], b0[8], a1[8], b1[8];
            stage2_read(F, a0, b0, a1, b1, qq); fft_reg<8, true>(a0, b0); fft_reg<8, true>(a1, b1);
#pragma unroll
            for (int r = 0; r < 4; ++r) { const int pp = brev<8>(r), t = 128 * (qq + 16 * r) + m2;
#pragma unroll
                for (int bb = 0; bb < 2; ++bb) { const size_t row = (size_t)(2 * p + bb) * L + t; float v0, v1, x0, x1, q0, q1;
                    hyq2(PHY, row, t, c0, W.w[0], W.b[0], v0, v1); hyq2(PHY, row, t, 1024 + c0, W.w[1], W.b[1], q0, q1); hyq2(PHY, row, t, 2048 + c0, W.w[2], W.b[2], x0, x1);
                    const float cv0 = bb == 0 ? a0[pp] : b0[pp], cv1 = bb == 0 ? a1[pp] : b1[pp];
                    const float y0 = q0 * (cv0 + hb.x * (x0 * v0)), y1 = q1 * (cv1 + hb.y * (x1 * v1));
                    *(unsigned*)(YHY + row * 1024 + c0) = pk2(y0, y1); } } }
        __syncthreads();
    }
}
}
namespace lru {
constexpr int TC = 64, NCH = L / TC, MB = TC / 16;

__device__ __forceinline__ void prep_wfrag(Frame& F) {
    const float* wa = F.in[6]; const float* wi = F.in[8]; u32x4* WF = (u32x4*)(F.ws + WS_WLRUF);
    for (int idx = F.bid * NTHREADS + F.tid; idx < 2 * 16 * 2 * 4 * 2 * 64; idx += F.G * NTHREADS) {
        const int lane = idx & 63, s = (idx >> 6) & 1, n = (idx >> 7) & 3, mat = (idx >> 9) & 1, h = (idx >> 10) & 15, dir = idx >> 14;
        const float* W = (mat == 0 ? wa : wi) + ((size_t)(dir * 16 + h) * 64) * 64; const int jo = 16 * n + (lane & 15), i0 = 32 * s + 8 * (lane >> 4);
        u32x4 o; o.x = pk2(W[(i0 + 0) * 64 + jo], W[(i0 + 1) * 64 + jo]); o.y = pk2(W[(i0 + 2) * 64 + jo], W[(i0 + 3) * 64 + jo]);
        o.z = pk2(W[(i0 + 4) * 64 + jo], W[(i0 + 5) * 64 + jo]); o.w = pk2(W[(i0 + 6) * 64 + jo], W[(i0 + 7) * 64 + jo]);
        WF[idx] = o;
    }
}

template <int STAGE> __device__ __forceinline__ void stage(Frame& F) {
    const bf16_t* P0 = (const bf16_t*)(F.ws + WS_P0); const bf16_t* P1 = (const bf16_t*)(F.ws + WS_P1); bf16_t* YLRU = (bf16_t*)(F.ws + WS_YLRU);
    const float* cw = F.in[4]; const float* cb = F.in[5]; const float* ba = F.in[7]; const float* bi = F.in[9]; const float* lam = F.in[10];
    const u32x4* WF = (const u32x4*)(F.ws + WS_WLRUF); f32x2* SUMM = (f32x2*)(F.ws + WS_SUMM); const float* CARRY = (const float*)(F.ws + WS_CARRY);
    LAS float* cwl = (LAS float*)(F.lds + MISC_OFF + 4096 + F.wave * 1280);
    LAS float* hfl = (LAS float*)(F.lds + F.wave * 16384) + F.lane;
    const int lane = F.lane, j = lane & 15, q = lane >> 4;
    const int gw = F.bid * NWAVES + F.wave, NGW = F.G * NWAVES;
    bf16x8 idf[2];
#pragma unroll
    for (int par = 0; par < 2; ++par) { const int kp = 16 * par + j;
#pragma unroll
        for (int jj = 0; jj < 8; ++jj) idf[par][jj] = (short)((q == (kp >> 3) && jj == (kp & 7)) ? 0x3F80 : 0); }
#pragma unroll 1
    for (int task = gw; task < NB * NCH * 16; task += NGW) {
        const int h = task & 15, chunk = (task >> 4) & (NCH - 1), b = task >> 11; const int t0 = chunk * TC; const size_t rowbase = (size_t)b * L + t0;
        asm volatile("" ::: "memory");
#pragma unroll
        for (int tap = 0; tap < 4; ++tap) cwl[tap * 64 + lane] = cw[tap * 1024 + 64 * h + lane];
        cwl[256 + lane] = cb[64 * h + lane];
        LDS_WAIT();
#pragma unroll
        for (int dir = 0; dir < 2; ++dir) {
            bf16x8 wfr[2][4][2];
#pragma unroll
            for (int mat = 0; mat < 2; ++mat)
#pragma unroll
                for (int n = 0; n < 4; ++n)
#pragma unroll
                    for (int s = 0; s < 2; ++s) { const u32x4 v = WF[(((((dir * 16 + h) * 2 + mat) * 4 + n) * 2 + s) * 64) + lane]; wfr[mat][n][s] = __builtin_bit_cast(bf16x8, v); }
            float bac[4], bic[4], spc[4], cin[4], atot[4];
#pragma unroll
            for (int n = 0; n < 4; ++n) { const int c = 64 * h + 16 * n + j; bac[n] = ba[dir * 1024 + c]; bic[n] = bi[dir * 1024 + c]; spc[n] = log1pf(expf(-lam[dir * 1024 + c]));
                cin[n] = STAGE == 2 ? CARRY[((size_t)(dir * NB + b) * NCH + chunk) * 1024 + c] : 0.f; atot[n] = 1.f; }
#pragma unroll 1
            for (int mm = 0; mm < MB; ++mm) {
                const int m = dir == 0 ? mm : MB - 1 - mm;
                bf16x8 afr[2];
#pragma unroll
                for (int s = 0; s < 2; ++s) { const int chb = 32 * s + 8 * q; float x8[8];
                    { const f32x4 b0 = *(const LAS f32x4*)(cwl + 256 + chb), b1 = *(const LAS f32x4*)(cwl + 256 + chb + 4);
                      x8[0] = b0.x; x8[1] = b0.y; x8[2] = b0.z; x8[3] = b0.w; x8[4] = b1.x; x8[5] = b1.y; x8[6] = b1.z; x8[7] = b1.w; }
#pragma unroll
                    for (int tap = 0; tap < 4; ++tap) { const int tl = t0 + 16 * m + j + tap - 2; const bool ok = (tl >= 0) && (tl < L);
                        u32x4 pv = (u32x4){0u, 0u, 0u, 0u}; if (ok) pv = *(const u32x4*)(P0 + ((size_t)b * L + tl) * 1024 + 64 * h + chb);
                        const f32x4 w0 = *(const LAS f32x4*)(cwl + tap * 64 + chb), w1 = *(const LAS f32x4*)(cwl + tap * 64 + chb + 4);
                        x8[0] += w0.x * __uint_as_float(pv.x << 16); x8[1] += w0.y * __uint_as_float(pv.x & 0xffff0000u); x8[2] += w0.z * __uint_as_float(pv.y << 16); x8[3] += w0.w * __uint_as_float(pv.y & 0xffff0000u);
                        x8[4] += w1.x * __uint_as_float(pv.z << 16); x8[5] += w1.y * __uint_as_float(pv.z & 0xffff0000u); x8[6] += w1.z * __uint_as_float(pv.w << 16); x8[7] += w1.w * __uint_as_float(pv.w & 0xffff0000u); }
                    u32x4 pk; pk.x = pk2(x8[0], x8[1]); pk.y = pk2(x8[2], x8[3]); pk.z = pk2(x8[4], x8[5]); pk.w = pk2(x8[6], x8[7]); afr[s] = __builtin_bit_cast(bf16x8, pk); }
#pragma unroll
                for (int n = 0; n < 4; ++n) {
                    __builtin_amdgcn_sched_barrier(0);
                    const f32x4 z4 = (f32x4){0.f, 0.f, 0.f, 0.f};
                    const f32x4 dx = __builtin_amdgcn_mfma_f32_16x16x32_bf16(afr[n >> 1], idf[n & 1], z4, 0, 0, 0);
                    f32x4 da = __builtin_amdgcn_mfma_f32_16x16x32_bf16(afr[0], wfr[0][n][0], z4, 0, 0, 0); da = __builtin_amdgcn_mfma_f32_16x16x32_bf16(afr[1], wfr[0][n][1], da, 0, 0, 0);
                    f32x4 di = __builtin_amdgcn_mfma_f32_16x16x32_bf16(afr[0], wfr[1][n][0], z4, 0, 0, 0); di = __builtin_amdgcn_mfma_f32_16x16x32_bf16(afr[1], wfr[1][n][1], di, 0, 0, 0);
                    float av[4], bv[4];
#pragma unroll
                    for (int r = 0; r < 4; ++r) { const float rg = sigmoidf_(da[r] + bac[n]), ig = sigmoidf_(di[r] + bic[n]); const float la = -8.0f * rg * spc[n]; const float a = __expf(la);
                        const float mult = sqrtf(fmaxf(fmaf(-a, a, 1.0f), 0.f)); av[r] = a; bv[r] = mult * (ig * dx[r]); }
                    float P[4], S[4];
                    if (dir == 0) { P[0] = av[0]; S[0] = bv[0];
#pragma unroll
                        for (int r = 1; r < 4; ++r) { P[r] = P[r - 1] * av[r]; S[r] = av[r] * S[r - 1] + bv[r]; } }
                    else { P[3] = av[3]; S[3] = bv[3];
#pragma unroll
                        for (int r = 2; r >= 0; --r) { P[r] = P[r + 1] * av[r]; S[r] = av[r] * S[r + 1] + bv[r]; } }
                    const float PT = dir == 0 ? P[3] : P[0], ST = dir == 0 ? S[3] : S[0];
                    float pt[4], st[4];
#pragma unroll
                    for (int g = 0; g < 4; ++g) { pt[g] = __shfl(PT, j + 16 * g); st[g] = __shfl(ST, j + 16 * g); }
                    float C = cin[n], Cq = 0.f;
#pragma unroll
                    for (int gg = 0; gg < 4; ++gg) { const int g = dir == 0 ? gg : 3 - gg; if (g == q) Cq = C; C = pt[g] * C + st[g]; }
                    cin[n] = C; atot[n] *= (pt[0] * pt[1]) * (pt[2] * pt[3]);
                    if (STAGE == 2) {
                        f32x4 hv;
#pragma unroll
                        for (int r = 0; r < 4; ++r) hv[r] = S[r] + P[r] * Cq;
                        if (dir == 0) {
#pragma unroll
                            for (int r = 0; r < 4; ++r) hfl[((m * 4 + n) * 4 + r) * 64] = hv[r]; }
                        else {
#pragma unroll
                            for (int r = 0; r < 4; ++r) { const size_t o = (rowbase + 16 * m + 4 * q + r) * 1024 + 64 * h + 16 * n + j;
                                YLRU[o] = f2bf(bf2f(P1[o]) * (hfl[((m * 4 + n) * 4 + r) * 64] + hv[r])); } }
                    }
                }
            }
            if (STAGE == 1 && q == 0) {
#pragma unroll
                for (int n = 0; n < 4; ++n) SUMM[((size_t)(dir * NB + b) * NCH + chunk) * 1024 + 64 * h + 16 * n + j] = (f32x2){atot[n], cin[n]};
            }
        }
    }
}
__device__ __forceinline__ void carry(Frame& F) {
    const f32x2* SUMM = (const f32x2*)(F.ws + WS_SUMM); float* CARRY = (float*)(F.ws + WS_CARRY);
    for (int idx = F.bid * NTHREADS + F.tid; idx < 2 * NB * 1024; idx += F.G * NTHREADS) {
        const int c = idx & 1023, db = idx >> 10, dir = db >> 2; const size_t base = (size_t)db * NCH * 1024 + c;
        float C = 0.f;
#pragma unroll 1
        for (int k0 = 0; k0 < NCH; k0 += 16) {
            f32x2 v[16];
#pragma unroll
            for (int i = 0; i < 16; ++i) { const int k = dir == 0 ? (k0 + i) : (NCH - 1 - k0 - i); v[i] = SUMM[base + (size_t)k * 1024]; }
#pragma unroll
            for (int i = 0; i < 16; ++i) { const int k = dir == 0 ? (k0 + i) : (NCH - 1 - k0 - i); CARRY[base + (size_t)k * 1024] = C; C = v[i].x * C + v[i].y; }
        }
    }
}
}
__device__ __forceinline__ void transpose_item(const float* __restrict__ W, int ldw, int k0, int n0, bf16_t* __restrict__ WT, size_t orow0, const float* __restrict__ kscale, LAS float* scr, int lane) {
    const int r8 = lane >> 3, c4 = (lane & 7) * 4;
#pragma unroll
    for (int i = 0; i < 8; ++i) { const int kk = 8 * i + r8; f32x4 v = *(const f32x4*)(W + (size_t)(k0 + kk) * ldw + n0 + c4);
        if (kscale) { const float s = kscale[k0 + kk]; v = v * s; }
        scr[kk * 33 + c4 + 0] = v.x; scr[kk * 33 + c4 + 1] = v.y; scr[kk * 33 + c4 + 2] = v.z; scr[kk * 33 + c4 + 3] = v.w; }
    LDS_WAIT();
    const int c = lane & 7;
#pragma unroll
    for (int j = 0; j < 4; ++j) { const int n = (lane >> 3) + 8 * j; const LAS float* s = scr + (8 * c) * 33 + n;
        u32x4 o; o.x = pk2(s[0 * 33], s[1 * 33]); o.y = pk2(s[2 * 33], s[3 * 33]); o.z = pk2(s[4 * 33], s[5 * 33]); o.w = pk2(s[6 * 33], s[7 * 33]);
        *(u32x4*)(WT + (orow0 + n) * 1024 + k0 + 8 * c) = o; }
    LDS_WAIT();
}

__device__ __forceinline__ void phase_prep(Frame& F) {
    LAS float* scr = (LAS float*)(F.lds + F.wave * 16384);
    const int gw = F.bid * NWAVES + F.wave, NGW = F.G * NWAVES;
    constexpr int I_IN = (1024 / 64) * (NIN / 32), I_SQ = (1024 / 64) * (1024 / 32);
    for (int it = gw; it < I_IN + 3 * I_SQ; it += NGW) {
        int r = it; const float* W; int N; bf16_t* WT;
        if (r < I_IN) { W = F.in[2]; N = NIN; WT = (bf16_t*)(F.ws + WS_WIN); }
        else { r -= I_IN; const int q = r / I_SQ; r -= q * I_SQ; N = 1024; W = q == 0 ? F.in[11] : q == 1 ? F.in[23] : F.in[24]; WT = (bf16_t*)(F.ws + (q == 0 ? WS_WLRU : q == 1 ? WS_WHY : WS_WOUT)); }
        const int nblk = N / 32, kb = r / nblk, nb = r % nblk;
        transpose_item(W, N, 64 * kb, 32 * nb, WT, (size_t)(32 * nb), nullptr, scr, F.lane);
    }
    { const float* x = F.in[0]; const float* g = F.in[1]; bf16_t* U = (bf16_t*)(F.ws + WS_U);
      for (int row = gw; row < T; row += NGW) {
        const f32x4* xr = (const f32x4*)(x + (size_t)row * D) + F.lane; f32x4 v[4]; float s = 0.f;
#pragma unroll
        for (int j = 0; j < 4; ++j) { v[j] = xr[64 * j]; s += v[j].x * v[j].x + v[j].y * v[j].y + v[j].z * v[j].z + v[j].w * v[j].w; }
        const float rstd = rsqrtf(wave_sum(s) * (1.0f / D) + EPS);
#pragma unroll
        for (int j = 0; j < 4; ++j) { const f32x4 gg = ((const f32x4*)g)[F.lane + 64 * j];
            u32x2 w; w.x = pk2(v[j].x * rstd * gg.x, v[j].y * rstd * gg.y); w.y = pk2(v[j].z * rstd * gg.z, v[j].w * rstd * gg.w);
            ((u32x2*)(U + (size_t)row * D))[F.lane + 64 * j] = w; } } }
    { const float *w1 = F.in[14], *b1 = F.in[15], *w2 = F.in[16], *b2 = F.in[17], *w3 = F.in[18], *b3 = F.in[19], *freq = F.in[21]; float* HH3 = (float*)(F.ws + WS_HH3);
      LAS float* feat = scr; LAS float* h1 = scr + 64; LAS float* h2 = scr + 128; const int u = F.lane; const float fr = freq[u];
#pragma unroll 1
      for (int t = gw; t < L; t += NGW) {
        asm volatile("" ::: "memory");
        if (u < HYEMB) { float f; if (u == 0) f = (float)t / (float)(L - 1);
            else { const int j = (u - 1) & 15; const float band = 1e-4f + (float)j * ((15.0f - 1e-4f) / 15.0f); const float arg = (6.283185307179586f * (float)t / (float)L) * band; f = (u <= 16) ? cosf(arg) : -sinf(arg); }
            feat[u] = f; }
        LDS_WAIT();
        float s = b1[u];
#pragma unroll 1
        for (int f = 0; f < HYEMB; ++f) s += feat[f] * w1[f * 64 + u];
        h1[u] = sinf(fr * s); LDS_WAIT();
        s = b2[u];
#pragma unroll 4
        for (int f = 0; f < 64; ++f) s += h1[f] * w2[f * 64 + u];
        h2[u] = sinf(fr * s); LDS_WAIT();
        s = b3[u];
#pragma unroll 4
        for (int f = 0; f < 64; ++f) s += h2[f] * w3[f * 64 + u];
        HH3[t * 64 + u] = sinf(fr * s); LDS_WAIT(); } }
    lru::prep_wfrag(F);
    { float* WRG = (float*)(F.ws + WS_WRG); const float* g = F.in[25]; const float* wr = F.in[26];
      for (int i = F.bid * NTHREADS + F.tid; i < D * NE; i += F.G * NTHREADS) WRG[i] = g[i >> 5] * wr[i]; }
}

__device__ __forceinline__ void phase_router_a(Frame& F) {
    LAS float* scr = (LAS float*)(F.lds + F.wave * 16384);
    const int gw = F.bid * NWAVES + F.wave, NGW = F.G * NWAVES;
    constexpr int I_GU = (1024 / 64) * (2048 / 32), I_DN = (1024 / 64) * (1024 / 32);
    for (int it = gw; it < NE * (I_GU + I_DN); it += NGW) {
        const int e = it / (I_GU + I_DN); int r = it - e * (I_GU + I_DN);
        if (r < I_GU) { const int kb = r / 64, nb = r % 64, n0 = 32 * nb; const int which = n0 >> 10, pn = (n0 & 1023) >> 7, j0 = n0 & 127;
            transpose_item(F.in[28] + (size_t)e * 1024 * 2048, 2048, 64 * kb, n0, (bf16_t*)(F.ws + WS_WGU), (size_t)e * 2048 + 256 * pn + 128 * which + j0, F.in[25], scr, F.lane); }
        else { r -= I_GU; const int kb = r / 32, nb = r % 32;
            transpose_item(F.in[30] + (size_t)e * 1024 * 1024, 1024, 64 * kb, 32 * nb, (bf16_t*)(F.ws + WS_WDN), (size_t)e * 1024 + 32 * nb, nullptr, scr, F.lane); }
    }
    __syncthreads();
    { const f32x4* src = (const f32x4*)(F.ws + WS_WRG); LAS f32x4* dst = (LAS f32x4*)F.lds;
      for (int i = F.tid; i < D * NE / 4; i += NTHREADS) dst[i] = src[i]; }
    LAS int* hist = (LAS int*)(F.lds + MISC_OFF);
    if (F.tid < 32) hist[F.tid] = 0;
    __syncthreads();
    const LAS float* wrg = (const LAS float*)F.lds;
    const float* H = F.out; const float* br = F.in[27];
    int* TOPE = (int*)(F.ws + WS_TOPE); float* TOPG = (float*)(F.ws + WS_TOPG); float* TOKRS = (float*)(F.ws + WS_TOKRS);
    for (int grp = F.bid * 4 + F.wave; F.wave < 4 && grp < T / 32; grp += F.G * 4) {
        const int i = F.lane & 31, hi = F.lane >> 5; const int t = grp * 32 + i;
        const float* xrow = H + (size_t)t * D + 4 * hi;
        typedef float f32x16 __attribute__((ext_vector_type(16)));
        f32x16 acc;
#pragma unroll
        for (int q = 0; q < 16; ++q) acc[q] = 0.f;
        float ss = 0.f;
#pragma unroll 4
        for (int q = 0; q < 128; ++q) {
            const f32x4 xv = *(const f32x4*)(xrow + 8 * q);
            ss += xv.x * xv.x + xv.y * xv.y + xv.z * xv.z + xv.w * xv.w;
#pragma unroll
            for (int c = 0; c < 4; ++c) { const float a = wrg[(8 * q + 4 * hi + c) * 32 + i];
                acc = __builtin_amdgcn_mfma_f32_32x32x2f32(a, xv[c], acc, 0, 0, 0); }
        }
        ss += __shfl_xor(ss, 32);
        const float rstd = rsqrtf(ss * (1.0f / D) + EPS);
        float v[16];
#pragma unroll
        for (int r = 0; r < 16; ++r) v[r] = acc[r] * rstd + br[(r & 3) + 8 * (r >> 2) + 4 * hi];
        float tv[4]; int te[4];
#pragma unroll
        for (int k = 0; k < 4; ++k) {
            float m = -3.0e38f; int mi = 0;
#pragma unroll
            for (int r = 0; r < 16; ++r) { const int ex = (r & 3) + 8 * (r >> 2) + 4 * hi; if (v[r] > m) { m = v[r]; mi = ex; } }
            const float om = __shfl_xor(m, 32); const int oi = __shfl_xor(mi, 32);
            if (om > m || (om == m && oi < mi)) { m = om; mi = oi; }
            tv[k] = m; te[k] = mi;
#pragma unroll
            for (int r = 0; r < 16; ++r) { const int ex = (r & 3) + 8 * (r >> 2) + 4 * hi; if (ex == mi) v[r] = -3.0e38f; }
        }
        const float e1 = __expf(tv[1] - tv[0]), e2 = __expf(tv[2] - tv[0]), e3 = __expf(tv[3] - tv[0]); const float inv = 1.0f / (1.0f + e1 + e2 + e3);
        if (hi == 0) {
            *(int4*)(TOPE + t * 4) = make_int4(te[0], te[1], te[2], te[3]);
            *(f32x4*)(TOPG + t * 4) = (f32x4){inv, e1 * inv, e2 * inv, e3 * inv};
            TOKRS[t] = rstd;
#pragma unroll
            for (int k = 0; k < 4; ++k) atomicAdd((int*)&hist[te[k]], 1);
        }
    }
    __syncthreads();
    if (F.tid < 32 && hist[F.tid] != 0) atomicAdd((int*)(F.ws + WS_CTL) + F.tid, hist[F.tid]);
}
__device__ __forceinline__ const LAS int* build_ptile(Frame& F) {
    LAS int* pt = (LAS int*)(F.lds + MISC_OFF + 256);
    __syncthreads();
    if (F.tid == 0) { const int* cnt = (const int*)(F.ws + WS_CTL); int o = 0; for (int e = 0; e < 32; ++e) { pt[e] = o; o += (cnt[e] + 255) >> 8; } pt[32] = o; }
    __syncthreads();
    return pt;
}
__device__ __forceinline__ void phase_router_b(Frame& F) {
    const LAS int* pt = build_ptile(F);
    LAS int* hist = (LAS int*)(F.lds + MISC_OFF); LAS int* base = hist + 32;
    const int* TOPE = (const int*)(F.ws + WS_TOPE); const float* TOPG = (const float*)(F.ws + WS_TOPG); const float* TOKRS = (const float*)(F.ws + WS_TOKRS);
    int* ROWTOK = (int*)(F.ws + WS_ROWTOK); float* ROWGATE = (float*)(F.ws + WS_ROWGATE); float* ROWRS = (float*)(F.ws + WS_ROWRS); int* TOKROW = (int*)(F.ws + WS_TOKROW);
    int* cursor = (int*)(F.ws + WS_CTL) + 64; const int* cnt = (const int*)(F.ws + WS_CTL);
    for (int chunk = F.bid; chunk < T * 4 / NTHREADS; chunk += F.G) {
        __syncthreads();
        if (F.tid < 32) hist[F.tid] = 0;
        __syncthreads();
        const int idx = chunk * NTHREADS + F.tid; const int e = TOPE[idx]; const int lr = atomicAdd((int*)&hist[e], 1);
        __syncthreads();
        if (F.tid < 32) base[F.tid] = hist[F.tid] ? atomicAdd(cursor + F.tid, hist[F.tid]) : 0;
        __syncthreads();
        const int row = pt[e] * 256 + base[e] + lr;
        ROWTOK[row] = idx >> 2; ROWGATE[row] = TOPG[idx]; ROWRS[row] = TOKRS[idx >> 2]; TOKROW[idx] = row;
    }
    if (F.bid == 0) for (int e = F.wave; e < 32; e += NWAVES) { const int r0 = pt[e] * 256 + cnt[e], r1 = pt[e + 1] * 256; for (int r = r0 + F.lane; r < r1; r += 64) { ROWTOK[r] = 0; ROWGATE[r] = 0.f; ROWRS[r] = 0.f; } }
}
__device__ __forceinline__ void phase_final(Frame& F) {
    const int gw = F.bid * NWAVES + F.wave, NGW = F.G * NWAVES;
    const float* H = F.out; float* out = F.out; const bf16_t* YS = (const bf16_t*)(F.ws + WS_YS); const int* TOKROW = (const int*)(F.ws + WS_TOKROW); const float* g = F.in[32];
    for (int t = gw; t < T; t += NGW) {
        f32x4 v[4];
#pragma unroll
        for (int j = 0; j < 4; ++j) v[j] = ((const f32x4*)(H + (size_t)t * D))[F.lane + 64 * j];
        const int4 rows = *(const int4*)(TOKROW + t * 4);
#pragma unroll
        for (int k = 0; k < 4; ++k) { const size_t row = (size_t)(k == 0 ? rows.x : k == 1 ? rows.y : k == 2 ? rows.z : rows.w);
#pragma unroll
            for (int j = 0; j < 4; ++j) { const u32x2 w = ((const u32x2*)(YS + row * D))[F.lane + 64 * j];
                v[j].x += __uint_as_float(w.x << 16); v[j].y += __uint_as_float(w.x & 0xffff0000u); v[j].z += __uint_as_float(w.y << 16); v[j].w += __uint_as_float(w.y & 0xffff0000u); } }
        float s = 0.f;
#pragma unroll
        for (int j = 0; j < 4; ++j) s += v[j].x * v[j].x + v[j].y * v[j].y + v[j].z * v[j].z + v[j].w * v[j].w;
        const float rstd = rsqrtf(wave_sum(s) * (1.0f / D) + EPS);
#pragma unroll
        for (int j = 0; j < 4; ++j) { const f32x4 gg = ((const f32x4*)g)[F.lane + 64 * j];
            ((f32x4*)(out + (size_t)t * D))[F.lane + 64 * j] = (f32x4){v[j].x * rstd * gg.x, v[j].y * rstd * gg.y, v[j].z * rstd * gg.z, v[j].w * rstd * gg.w}; }
    }
}

__global__ void __launch_bounds__(NTHREADS, 2) mega(Args args) {
    extern __shared__ __attribute__((aligned(16))) unsigned char lds_raw[];
    cg::grid_group grid = cg::this_grid();
    Frame F; F.lds = (LAS unsigned char*)lds_raw; F.tid = threadIdx.x; F.lane = F.tid & 63; F.wave = __builtin_amdgcn_readfirstlane(F.tid >> 6); F.G = gridDim.x; F.bid = blockIdx.x;
    F.in = args.in; F.out = args.out; F.ws = args.ws;
    const int lo = args.ph_lo, hi = args.ph_hi;
#define IN(k) (lo <= (k) && (k) < hi)
#define SEAM(k) do { if (IN(k) && IN((k) + 1)) grid.sync(); } while (0)
    unsigned char* ws = args.ws;
    if (IN(0)) { phase_prep(F); } SEAM(0);
    if (IN(1)) {
        pg8::SchedDense S; S.O.init(T / 256, NIN / 256, F.G, F.bid); S.A = (const char*)(ws + WS_U); S.B = (const char*)(ws + WS_WIN);
        pg8::EpiIn E{(bf16_t*)(ws + WS_P0), (bf16_t*)(ws + WS_P1), (bf16_t*)(ws + WS_PHY), (bf16_t*)(ws + WS_PG), args.in[3]};
        pg8::gemm_phase<pg8::EpiIn, pg8::SchedDense, false>(F.lds, S, E);
        hy::init_tw128(F); hy::filter_pass_a(F);
    } SEAM(1);
    if (IN(2)) { hy::init_tw128(F); hy::data_pass_a(F); hy::filter_pass_b(F); __syncthreads(); lru::stage<1>(F); } SEAM(2);
    if (IN(3)) { lru::carry(F); hy::init_tw128(F); hy::data_pass_b(F); } SEAM(3);
    if (IN(4)) { hy::init_tw128(F); hy::data_pass_c(F); __syncthreads(); lru::stage<2>(F); } SEAM(4);
    if (IN(5)) {
        pg8::SchedMix S; S.O.init(T / 256, D / 256, F.G, F.bid); S.A0 = (const char*)(ws + WS_YLRU); S.A1 = (const char*)(ws + WS_YHY); S.B0 = (const char*)(ws + WS_WLRU); S.B1 = (const char*)(ws + WS_WHY);
        pg8::EpiMix E{(const bf16_t*)(ws + WS_PG), (float*)(ws + WS_MIXF), (bf16_t*)(ws + WS_MIX)};
        pg8::gemm_phase<pg8::EpiMix, pg8::SchedMix, false>(F.lds, S, E);
    } SEAM(5);
    if (IN(6)) {
        pg8::SchedDense S; S.O.init(T / 256, D / 256, F.G, F.bid); S.A = (const char*)(ws + WS_MIX); S.B = (const char*)(ws + WS_WOUT);
        pg8::EpiH E{args.in[0], args.out, (bf16_t*)(ws + WS_HN)};
        pg8::gemm_phase<pg8::EpiH, pg8::SchedDense, false>(F.lds, S, E);
    } SEAM(6);
    if (IN(7)) { phase_router_a(F); } SEAM(7);
    if (IN(8)) { phase_router_b(F); } SEAM(8);
    if (IN(9)) {
        const LAS int* pt = build_ptile(F);
        pg8::SchedMoE<8, true> S{pt, F.G, F.bid, (const char*)(ws + WS_HN), (const char*)(ws + WS_WGU), (size_t)2048 * 1024 * 2, (const int*)(ws + WS_ROWTOK)};
        pg8::EpiGU E{args.in[29], (const float*)(ws + WS_ROWRS), (bf16_t*)(ws + WS_ACT)};
        pg8::gemm_phase<pg8::EpiGU, pg8::SchedMoE<8, true>, true>(F.lds, S, E);
    } SEAM(9);
    if (IN(10)) {
        const LAS int* pt = build_ptile(F);
        pg8::SchedMoE<4, false> S{pt, F.G, F.bid, (const char*)(ws + WS_ACT), (const char*)(ws + WS_WDN), (size_t)1024 * 1024 * 2, nullptr};
        pg8::EpiDN E{args.in[31], (const float*)(ws + WS_ROWGATE), (bf16_t*)(ws + WS_YS)};
        pg8::gemm_phase<pg8::EpiDN, pg8::SchedMoE<4, false>, false>(F.lds, S, E);
    } SEAM(10);
    if (IN(11)) { phase_final(F); }
#undef IN
#undef SEAM
}
static int g_grid = 0;
static void launch_mega(Args a, int lo, int hi, hipStream_t stream) {
    a.ph_lo = lo; a.ph_hi = hi; void* params[] = {&a};
    hipError_t e = hipLaunchCooperativeKernel((const void*)mega, dim3(g_grid), dim3(NTHREADS), params, LDS_BYTES, stream);
    if (e != hipSuccess) fprintf(stderr, "kernel_launch: cooperative launch [%d,%d) failed: %s (grid %d)\n", lo, hi, hipGetErrorString(e), g_grid);
}
extern "C" void kernel_launch(void* const* d_in, const int* in_sizes, int n_in, void* d_out, int out_size, void* d_ws, size_t ws_size, hipStream_t stream) {
    if (n_in != 33 || out_size != T * D || ws_size < WS_END) { fprintf(stderr, "kernel_launch: unexpected shapes n_in %d out %d ws %zu\n", n_in, out_size, ws_size); return; }
    if (g_grid == 0) {
        int dev = 0, cus = 0, per_cu = 0;
        (void)hipGetDevice(&dev); (void)hipDeviceGetAttribute(&cus, hipDeviceAttributeMultiprocessorCount, dev);
        if (hipFuncSetAttribute((const void*)mega, hipFuncAttributeMaxDynamicSharedMemorySize, LDS_BYTES) != hipSuccess) { fprintf(stderr, "kernel_launch: hipFuncSetAttribute failed\n"); g_grid = -1; return; }
        if (hipOccupancyMaxActiveBlocksPerMultiprocessor(&per_cu, (const void*)mega, NTHREADS, LDS_BYTES) != hipSuccess || per_cu < 1) { fprintf(stderr, "kernel_launch: occupancy query says %d\n", per_cu); g_grid = -1; return; }
        g_grid = cus;
    }
    if (g_grid < 0) return;
    const float* in[33]; for (int i = 0; i < 33; ++i) in[i] = (const float*)d_in[i];
    unsigned char* ws = (unsigned char*)d_ws; float* out = (float*)d_out;
    int* cnt = (int*)(ws + WS_CTL); float* NORM = (float*)(ws + WS_NORM); float* HH3 = (float*)(ws + WS_HH3);
    bf16_t* YLRU = (bf16_t*)(ws + WS_YLRU); bf16_t* HN = (bf16_t*)(ws + WS_HN); bf16_t* YHY = (bf16_t*)(ws + WS_YHY);
    bf16_t* PG = (bf16_t*)(ws + WS_PG); bf16_t* P0 = (bf16_t*)(ws + WS_P0); bf16_t* P1 = (bf16_t*)(ws + WS_P1); bf16_t* PHY = (bf16_t*)(ws + WS_PHY);
    bf16_t* MIX = (bf16_t*)(ws + WS_MIX); float* MIXF = (float*)(ws + WS_MIXF); bf16_t* ACT = (bf16_t*)(ws + WS_ACT); bf16_t* YS = (bf16_t*)(ws + WS_YS);
    float* XR = (float*)(ws + WS_XR); float* HF = (float*)(ws + WS_HF); float* KC = (float*)(ws + WS_KC);
    int* ROWTOK = (int*)(ws + WS_ROWTOK); float* ROWGATE = (float*)(ws + WS_ROWGATE); float* ROWRS = (float*)(ws + WS_ROWRS);
    (void)hipMemsetAsync(ws + WS_CTL, 0, CTL_BYTES, stream);
    Args a{}; for (int i = 0; i < 33; ++i) a.in[i] = in[i]; a.out = out; a.ws = ws;
    launch_mega(a, 0, 12, stream);
}
```

```cpp
#define DUPMASK 0x0
#define DESYNC1 4
#define DN_REVERSE 1
#define P2_ALTERNATE 1
#define P5_ALTERNATE 1
#include <hip/hip_runtime.h>
#include <hip/hip_cooperative_groups.h>
#include <cstdio>
#include <cstdint>
namespace cg = cooperative_groups;

typedef unsigned short bf16_t;
typedef float f32x4 __attribute__((ext_vector_type(4)));
typedef float f32x2 __attribute__((ext_vector_type(2)));
typedef unsigned u32x4 __attribute__((ext_vector_type(4)));
typedef unsigned u32x2 __attribute__((ext_vector_type(2)));
typedef short bf16x8 __attribute__((ext_vector_type(8)));

constexpr int T = 32768, D = 1024, L = 8192, NB = 4, NE = 32, TOPK = 4, NIN = 7168, L2X = 16384;
constexpr int HEADS = 16, HBLK = 64, HYFF = 64, HYEMB = 33;
constexpr int NPAD = T * TOPK + NE * 256;
constexpr float EPS = 1e-5f;

constexpr size_t MiB = 1u << 20;
constexpr size_t WS_CTL = 0;
constexpr size_t CTL_BYTES = 64 * 1024;
constexpr size_t WS_NORM = 4096;
constexpr size_t WS_HH3 = 2 * MiB;
constexpr size_t WS_WRG = 4 * MiB;
constexpr size_t WS_TOPE = 5 * MiB;
constexpr size_t WS_TOPG = 6 * MiB;
constexpr size_t WS_TOKRS = 7 * MiB;
constexpr size_t WS_ROWTOK = 8 * MiB;
constexpr size_t WS_ROWGATE = 9 * MiB;
constexpr size_t WS_ROWRS = 10 * MiB;
constexpr size_t WS_TOKROW = 11 * MiB;
constexpr size_t WS_WF4 = 14 * MiB;
constexpr size_t WS_NORMP = 15 * MiB;
constexpr size_t WS_EROWTOK = 164 * MiB, WS_EROWRS = 168 * MiB, WS_EROWGATE = 172 * MiB;
constexpr size_t WS_WLRUF = 13 * MiB;
constexpr size_t WS_SUMM = 996 * MiB;
constexpr size_t WS_CARRY = 1004 * MiB;
constexpr size_t WS_WIN = 16 * MiB;
constexpr size_t WS_WLRU = 30 * MiB, WS_WHY = 32 * MiB, WS_WOUT = 34 * MiB;
constexpr size_t WS_U = 36 * MiB;
constexpr size_t WS_Z16 = 36 * MiB, WS_HN = 36 * MiB;
constexpr size_t WS_YHY = 100 * MiB;
constexpr size_t WS_PG = 164 * MiB;
constexpr size_t WS_P0 = 292 * MiB;
constexpr size_t WS_P1 = 356 * MiB;
constexpr size_t WS_PHY = 420 * MiB;
constexpr size_t WS_MIX = 356 * MiB;
constexpr size_t WS_HS = 740 * MiB;
constexpr size_t WS_YLRU = 292 * MiB;
constexpr size_t WS_AF = 804 * MiB, WS_AB = 932 * MiB;
constexpr size_t WS_MIXF = 484 * MiB;
constexpr size_t WS_ACT = 292 * MiB;
constexpr size_t WS_R2 = 612 * MiB;
constexpr size_t WS_YZ = 612 * MiB;
constexpr size_t WS_KF = 868 * MiB;
constexpr size_t WS_WDN = 612 * MiB;
constexpr size_t WS_WGU = 676 * MiB;
constexpr size_t WS_YS = 676 * MiB;
constexpr size_t WS_XR = 612 * MiB;
constexpr size_t WS_HF = 740 * MiB;
constexpr size_t WS_KC = 868 * MiB;
constexpr size_t WS_END = 1024 * MiB;

__device__ __forceinline__ float bf2f(bf16_t b) { return __uint_as_float(((unsigned)b) << 16); }
__device__ __forceinline__ bf16_t f2bf(float f) { unsigned u = __float_as_uint(f); u += 0x7fffu + ((u >> 16) & 1u); return (bf16_t)(u >> 16); }
__device__ __forceinline__ unsigned pk2(float lo, float hi) { unsigned r; asm("v_cvt_pk_bf16_f32 %0, %1, %2" : "=v"(r) : "v"(lo), "v"(hi)); return r; }
__device__ __forceinline__ float fexp(float x) { return __builtin_amdgcn_exp2f(x * 1.4426950408889634f); }
__device__ __forceinline__ float sigmoidf_(float x) { return __builtin_amdgcn_rcpf(1.0f + fexp(-x)); }
__device__ __forceinline__ float gelu_tanh(float x) { const float u = 0.7978845608028654f * (x + 0.044715f * x * x * x); return x * sigmoidf_(2.0f * u); }
__device__ __forceinline__ float swiglu(float g, float u) { const float g_ = fminf(g, 7.0f); const float u_ = fminf(fmaxf(u, -7.0f), 7.0f); return (u_ + 1.0f) * (g_ * sigmoidf_(1.702f * g_)); }
__device__ __forceinline__ float wave_sum(float v) {
#pragma unroll
    for (int o = 1; o < 64; o <<= 1) v += __shfl_xor(v, o);
    return v;
}
__device__ __forceinline__ int expert_offpad(const int* cnt, int e) { int o = 0; for (int i = 0; i < e; ++i) o += (cnt[i] + 255) & ~255; return o; }
__device__ __forceinline__ float hy_delta_abs(int c) {
    const float lo = -4.605170185988091f / 1.5f, hi = -4.605170185988091f / 0.3f;
    return fabsf(lo + (hi - lo) * ((float)c / 1023.0f));
}
#define LAS __attribute__((address_space(3)))
constexpr int NWAVES = 8, NTHREADS = 512, LDS_BYTES = 147456, MISC_OFF = 131072;

namespace pg8 {
constexpr int BM = 256, BK = 64, HALF = 128, HTB = HALF * BK * 2, NXCD = 8, WGM = 8, KD = 1024;
__host__ __device__ __forceinline__ int lds_byte(int r, int c) { const int st = (r >> 4) * 2 + (c >> 5), rr = r & 15, cc = c & 31, ob = rr * 64 + cc * 2; return st * 1024 + (ob ^ (((ob >> 9) & 1) << 5)); }
__host__ __device__ __forceinline__ void stage_rc(int b, int& R, int& C) { const int st = b / 1024, sb = b % 1024, swz = sb ^ (((sb >> 9) & 1) << 5); R = (st >> 1) * 16 + swz / 64; C = (st & 1) * 32 + (swz % 64) / 2; }
__host__ __device__ __forceinline__ int perm32(int rho) { const int n = rho >> 4, i = rho & 15; return 8 * (i >> 2) + 4 * n + (i & 3); }

struct Unit { const char* A; const char* B; int pm, pn, e, gm; };

struct DenseOrder {
    int nM, nN, nwg, G, c;
    __device__ __forceinline__ void init(int nM_, int nN_, int G_, int c_) { nM = nM_; nN = nN_; nwg = nM * nN; G = G_; c = c_; }
    __device__ __forceinline__ bool tile(int i, int& pm, int& pn) const {
        const long Lx = (long)i * G + c; if (Lx >= nwg) return false;
        int wgid = (int)Lx; { const int q = nwg / NXCD, r = nwg % NXCD, xcd = wgid % NXCD, off = wgid / NXCD; wgid = (xcd < r ? xcd * (q + 1) : r * (q + 1) + (xcd - r) * q) + off; }
        const int nig = WGM * nN, gid = wgid / nig, fm = gid * WGM, gsz = (nM - fm) < WGM ? (nM - fm) : WGM;
        pm = fm + ((wgid % nig) % gsz); pn = (wgid % nig) / gsz; return true;
    }
};

__device__ __forceinline__ unsigned cvt_pk_bf16(float lo, float hi) { unsigned r; asm volatile("v_cvt_pk_bf16_f32 %0, %1, %2" : "=v"(r) : "v"(lo), "v"(hi)); return r; }

template <class Epi, class Sched, bool GATHER>
__device__ __forceinline__ void gemm_phase(LAS unsigned char* lds, const Sched& S, const Epi& E) {
    int tid_ = threadIdx.x; asm volatile("" : "+v"(tid_));
    const int tid = tid_, wid = __builtin_amdgcn_readfirstlane(tid >> 6), lane = tid & 63, wr = wid >> 2, wc = wid & 3, fr = lane & 15, fq = lane >> 4;
    constexpr int K = KD, nt = K / BK;
    int Rr[2], Cc[2]; unsigned voffB[2];
#pragma unroll
    for (int i = 0; i < 2; ++i) { int R, C; stage_rc(tid * 16 + i * 8192, R, C); Rr[i] = R; Cc[i] = C; const int Rb = (R & ~31) + perm32(R & 31); voffB[i] = (unsigned)(Rb * K + C) * 2u; }
    constexpr size_t kstep = (size_t)(BK * 2);
    constexpr size_t hstep = (size_t)HALF * K * 2;
    const unsigned ldsw = (unsigned)wid * 1024u;
    const int aoff = lds_byte(wr * 64 + fr, fq * 8), boff = lds_byte(wc * 32 + fr, fq * 8);
#define PG8_SA(b, h) (((b) * 2 + (h)) * HTB)
#define PG8_SB(b, h) ((4 + (b) * 2 + (h)) * HTB)
#define PG8_GLDS(gp, lp) __builtin_amdgcn_global_load_lds((const unsigned*)(gp), (LAS unsigned*)(lp), 16, 0, 0)
#define PG8_STAGEB(bufoff, gbase) do { PG8_GLDS((const char*)(gbase) + voffB[0], lds + (bufoff) + ldsw); PG8_GLDS((const char*)(gbase) + voffB[1], lds + (bufoff) + ldsw + 8192); } while (0)
#define PG8_STAGEA(bufoff, gbase, o0, o1) do { PG8_GLDS((const char*)(gbase) + (o0), lds + (bufoff) + ldsw); PG8_GLDS((const char*)(gbase) + (o1), lds + (bufoff) + ldsw + 8192); } while (0)
#define PG8_LDA(dst, b, h) do { _Pragma("unroll") for (int m = 0; m < 4; ++m) _Pragma("unroll") for (int k = 0; k < 2; ++k) dst[m][k] = *(const LAS bf16x8*)(lds + PG8_SA(b, h) + aoff + m * 2048 + k * 1024); } while (0)
#define PG8_LDB(dst, b, h) do { _Pragma("unroll") for (int n = 0; n < 2; ++n) _Pragma("unroll") for (int k = 0; k < 2; ++k) dst[n][k] = *(const LAS bf16x8*)(lds + PG8_SB(b, h) + boff + n * 2048 + k * 1024); } while (0)
#define PG8_MMA(ai, bj, At, Bt) do { __builtin_amdgcn_s_setprio(1); _Pragma("unroll") for (int m = 0; m < 4; ++m) _Pragma("unroll") for (int n = 0; n < 2; ++n) _Pragma("unroll") for (int k = 0; k < 2; ++k) \
        acc[ai][bj][m][n] = __builtin_amdgcn_mfma_f32_16x16x32_bf16(Bt[n][k], At[m][k], acc[ai][bj][m][n], 0, 0, 0); __builtin_amdgcn_s_setprio(0); } while (0)
#define PG8_WAIT_V(n) asm volatile("s_waitcnt vmcnt(" #n ")" ::: "memory")
#define PG8_WAIT_L(n) asm volatile("s_waitcnt lgkmcnt(" #n ")" ::: "memory")
#define PG8_WAIT_V8_UNLESS(flag) asm volatile("s_cmp_lg_u32 %0, 0\n\ts_cbranch_scc1 .Lskipw%=\n\ts_waitcnt vmcnt(8)\n.Lskipw%=:" :: "s"(flag) : "scc", "memory")
#define PG8_BAR __builtin_amdgcn_s_barrier()
#define PG8_SCHED __builtin_amdgcn_sched_barrier(0)
    Unit cur, nxt; int ui = 0;
    if (!S.next(0, cur)) return;
    LAS int* tokbuf = (LAS int*)(lds + MISC_OFF + 3072);
#define PG8_AOFF(par, h, i) (GATHER ? ((unsigned)tokbuf[(par) * 256 + (h) * HALF + Rr[i]] * (unsigned)(K * 2) + (unsigned)(Cc[i] * 2)) : ((unsigned)(Rr[i] * K + Cc[i]) * 2u + (unsigned)((h) * hstep)))
    LAS float* side = (LAS float*)(lds + MISC_OFF + 6144);
    if (GATHER || Sched::NSIDE > 0) {
        if (GATHER && tid < 256) tokbuf[tid] = S.ROWTOK_row(cur, tid);
        if (Sched::NSIDE > 0 && tid < 256 * Sched::NSIDE) side[tid] = *S.side_addr(cur, tid >> 8, tid & 255);
        asm volatile("s_waitcnt vmcnt(0) lgkmcnt(0)" ::: "memory"); __builtin_amdgcn_s_barrier(); }
    f32x4 acc[2][2][4][2];
#pragma unroll
    for (int a = 0; a < 2; ++a)
#pragma unroll
        for (int b = 0; b < 2; ++b)
#pragma unroll
            for (int m = 0; m < 4; ++m)
#pragma unroll
                for (int n = 0; n < 2; ++n) acc[a][b][m][n] = (f32x4){0.f, 0.f, 0.f, 0.f};
    bf16x8 At[4][2], B0[2][2], B1[2][2];
    const char* cA = cur.A; const char* cB = cur.B;
    PG8_STAGEB(PG8_SB(0, 0), cB); PG8_STAGEB(PG8_SB(0, 1), cB + hstep); PG8_STAGEA(PG8_SA(0, 0), cA, PG8_AOFF(0, 0, 0), PG8_AOFF(0, 0, 1)); PG8_STAGEA(PG8_SA(0, 1), cA, PG8_AOFF(0, 1, 0), PG8_AOFF(0, 1, 1));
    if (wr == 1) PG8_BAR;
    PG8_WAIT_V(2); PG8_BAR;
    PG8_STAGEB(PG8_SB(1, 0), cB + kstep); PG8_STAGEA(PG8_SA(1, 0), cA + kstep, PG8_AOFF(0, 0, 0), PG8_AOFF(0, 0, 1)); PG8_STAGEB(PG8_SB(1, 1), cB + hstep + kstep);
    PG8_WAIT_V(6); PG8_BAR;
    for (;;) {
        const bool has_next = S.next(ui + 1, nxt);
        const char* nA = has_next ? nxt.A : cA; const char* nB = has_next ? nxt.B : cB;
        const int pc = ui & 1, pn_ = has_next ? (pc ^ 1) : pc;
        if (Sched::NSIDE > 0 && has_next && wid < 4 * Sched::NSIDE) __builtin_amdgcn_global_load_lds((const unsigned*)S.side_addr(nxt, wid >> 2, (wid & 3) * 64 + lane), (LAS unsigned*)(side + ((ui + 1) % 3) * 512 + wid * 64), 4, 0, 0);
        if (GATHER && has_next && wid < 4) __builtin_amdgcn_global_load_lds((const unsigned*)(S.ROWTOK + S.rowoff(nxt) + wid * 64 + lane), (LAS unsigned*)(tokbuf + pn_ * 256 + wid * 64), 4, 0, 0);
        for (int t = 0; t < nt; t += 2) {
            const bool last = (t == nt - 2);
            const char* a1 = cA + (size_t)(t + 1) * kstep;
            const char* a2 = last ? nA : cA + (size_t)(t + 2) * kstep; const char* b2 = last ? nB : cB + (size_t)(t + 2) * kstep;
            const char* a3 = a2 + kstep; const char* b3 = b2 + kstep;
            const int px = last ? pn_ : pc;
            PG8_LDB(B0, 0, 0); PG8_LDB(B1, 0, 1); PG8_SCHED; PG8_LDA(At, 0, 0); PG8_STAGEA(PG8_SA(1, 1), a1, PG8_AOFF(pc, 1, 0), PG8_AOFF(pc, 1, 1));
            PG8_WAIT_V(8); PG8_WAIT_L(0); PG8_BAR; PG8_MMA(0, 0, At, B0); PG8_MMA(0, 1, At, B1); PG8_BAR; PG8_SCHED;
            PG8_LDA(At, 0, 1); PG8_STAGEB(PG8_SB(0, 0), b2); PG8_STAGEB(PG8_SB(0, 1), b2 + hstep); PG8_STAGEA(PG8_SA(0, 0), a2, PG8_AOFF(px, 0, 0), PG8_AOFF(px, 0, 1));
            PG8_WAIT_V(8); PG8_WAIT_L(0); PG8_BAR; PG8_MMA(1, 0, At, B0); PG8_MMA(1, 1, At, B1); PG8_BAR; PG8_SCHED;
            PG8_LDB(B0, 1, 0); PG8_LDB(B1, 1, 1); PG8_SCHED; PG8_LDA(At, 1, 0); PG8_STAGEA(PG8_SA(0, 1), a2, PG8_AOFF(px, 1, 0), PG8_AOFF(px, 1, 1));
            PG8_WAIT_V(8); PG8_WAIT_L(0); PG8_BAR; PG8_MMA(0, 0, At, B0); PG8_MMA(0, 1, At, B1); PG8_BAR; PG8_SCHED;
            PG8_LDA(At, 1, 1); PG8_STAGEB(PG8_SB(1, 0), b3); PG8_STAGEB(PG8_SB(1, 1), b3 + hstep); PG8_STAGEA(PG8_SA(1, 0), a3, PG8_AOFF(px, 0, 0), PG8_AOFF(px, 0, 1));
            PG8_WAIT_V(8); PG8_WAIT_L(0); PG8_BAR; PG8_MMA(1, 0, At, B0); PG8_MMA(1, 1, At, B1); PG8_BAR; PG8_SCHED;
        }
        if (wr == 0) PG8_BAR;
        bool keep = false;
        if constexpr (Epi::CHAIN) keep = E(acc, cur, wr, wc, fr, fq, (const LAS float*)(side + (ui % 3) * 512)); else E(acc, cur, wr, wc, fr, fq, (const LAS float*)(side + (ui % 3) * 512));
        if (!has_next) break;
        if (!keep) {
#pragma unroll
        for (int a = 0; a < 2; ++a)
#pragma unroll
            for (int b = 0; b < 2; ++b)
#pragma unroll
                for (int m = 0; m < 4; ++m)
#pragma unroll
                    for (int n = 0; n < 2; ++n) acc[a][b][m][n] = (f32x4){0.f, 0.f, 0.f, 0.f};
        }
        cur = nxt; cA = nA; cB = nB; ++ui;
        if (wr == 1) PG8_BAR;
    }
    PG8_WAIT_V(0);
    PG8_BAR;
#undef PG8_SA
#undef PG8_AOFF
#undef PG8_SB
#undef PG8_GLDS
#undef PG8_STAGEA
#undef PG8_STAGEB
#undef PG8_LDA
#undef PG8_LDB
#undef PG8_MMA
#undef PG8_WAIT_V
#undef PG8_WAIT_L
#undef PG8_WAIT_V8_UNLESS
#undef PG8_BAR
#undef PG8_SCHED
}

__device__ __forceinline__ void store8bf(bf16_t* p, const f32x4 v0, const f32x4 v1) {
    u32x4 w; w.x = cvt_pk_bf16(v0[0], v0[1]); w.y = cvt_pk_bf16(v0[2], v0[3]); w.z = cvt_pk_bf16(v1[0], v1[1]); w.w = cvt_pk_bf16(v1[2], v1[3]); *(u32x4*)p = w;
}
__device__ __forceinline__ void load8bf(const bf16_t* p, f32x4& v0, f32x4& v1) {
    const u32x4 w = *(const u32x4*)p;
    v0 = (f32x4){__uint_as_float(w.x << 16), __uint_as_float(w.x & 0xffff0000u), __uint_as_float(w.y << 16), __uint_as_float(w.y & 0xffff0000u)};
    v1 = (f32x4){__uint_as_float(w.z << 16), __uint_as_float(w.z & 0xffff0000u), __uint_as_float(w.w << 16), __uint_as_float(w.w & 0xffff0000u)};
}
__device__ __forceinline__ f32x2 lo2(const f32x4 v) { return (f32x2){v.x, v.y}; }
__device__ __forceinline__ f32x2 hi2(const f32x4 v) { return (f32x2){v.z, v.w}; }
__device__ __forceinline__ f32x2 sigmoid2(const f32x2 x) { const f32x2 t = x * -1.4426950408889634f; const f32x2 d = (f32x2){__builtin_amdgcn_exp2f(t.x), __builtin_amdgcn_exp2f(t.y)} + 1.0f; return (f32x2){__builtin_amdgcn_rcpf(d.x), __builtin_amdgcn_rcpf(d.y)}; }
__device__ __forceinline__ f32x2 swiglu2(const f32x2 g, const f32x2 u) {
    const f32x2 g_ = (f32x2){fminf(g.x, 7.0f), fminf(g.y, 7.0f)}; const f32x2 u_ = (f32x2){fminf(fmaxf(u.x, -7.0f), 7.0f), fminf(fmaxf(u.y, -7.0f), 7.0f)};
    const f32x2 t = g_ * (-1.702f * 1.4426950408889634f); const f32x2 d = (f32x2){__builtin_amdgcn_exp2f(t.x), __builtin_amdgcn_exp2f(t.y)} + 1.0f;
    const f32x2 p = g_ * (f32x2){__builtin_amdgcn_rcpf(d.x), __builtin_amdgcn_rcpf(d.y)}; return u_ * p + p; }
__device__ __forceinline__ void store8bf2(bf16_t* p, const f32x2 a, const f32x2 b, const f32x2 c, const f32x2 d) {
    u32x4 w; w.x = cvt_pk_bf16(a.x, a.y); w.y = cvt_pk_bf16(b.x, b.y); w.z = cvt_pk_bf16(c.x, c.y); w.w = cvt_pk_bf16(d.x, d.y); *(u32x4*)p = w; }
#define EPI_ROWS(ai, m) ((ai) * HALF + wr * 64 + (m) * 16 + fr)
#define EPI_COLS(bj) ((bj) * HALF + wc * 32 + 8 * fq)

struct EpiNone {
    static constexpr bool CHAIN = false;
    __device__ __forceinline__ void operator()(const f32x4 (&acc)[2][2][4][2], const Unit&, int, int, int, int, const LAS float*) const {
#pragma unroll
        for (int a = 0; a < 2; ++a)
#pragma unroll
            for (int b = 0; b < 2; ++b)
#pragma unroll
                for (int m = 0; m < 4; ++m)
#pragma unroll
                    for (int n = 0; n < 2; ++n) asm volatile("" :: "v"(acc[a][b][m][n]));
    }
};
struct EpiProbeStore {
    static constexpr bool CHAIN = false;
    bf16_t* dst;
    __device__ __forceinline__ void operator()(const f32x4 (&acc)[2][2][4][2], const Unit& u, int wr, int wc, int fr, int fq, const LAS float* side) const {
#pragma unroll
        for (int ai = 0; ai < 2; ++ai)
#pragma unroll
            for (int m = 0; m < 4; ++m) {
#if defined(PROBE_LOCAL)
                bf16_t* rowp = dst + (size_t)(blockIdx.x * 256 + EPI_ROWS(ai, m)) * 256;
#elif defined(PROBE_MIXED)
                bf16_t* rowp = (blockIdx.x & 3) ? dst + (size_t)(blockIdx.x * 256 + EPI_ROWS(ai, m)) * 256 : dst + (size_t)(u.pm * BM + EPI_ROWS(ai, m)) * 4096 + (u.pn & 15) * 256;
#elif defined(PROBE_WIDE)
                bf16_t* rowp = dst + (size_t)(u.pm * BM + EPI_ROWS(ai, m)) * 4096 + (u.pn & 15) * 256;
#else
                bf16_t* rowp = dst + (size_t)(u.pm * BM + EPI_ROWS(ai, m)) * 1024 + (u.pn & 3) * 256;
#endif
#pragma unroll
                for (int bj = 0; bj < 2; ++bj) store8bf(rowp + EPI_COLS(bj), acc[ai][bj][m][0], acc[ai][bj][m][1]); }
    }
};
struct EpiIn {
    static constexpr bool CHAIN = false;
    bf16_t *P0, *P1, *PHY, *PG; const float* bias;
    __device__ __forceinline__ void operator()(const f32x4 (&acc)[2][2][4][2], const Unit& u, int wr, int wc, int fr, int fq, const LAS float* side) const {
        const int seg = u.pn >> 2; bf16_t* dst; int ld, colt; int act = 0;
        if (seg == 0) { dst = P0; ld = 1024; colt = u.pn * 256; }
        else if (seg == 1) { dst = P1; ld = 1024; colt = u.pn * 256 - 1024; }
        else if (seg < 5) { dst = PHY; ld = 3072; colt = u.pn * 256 - 2048; }
        else { dst = PG; ld = 2048; colt = (u.pn - 20) * 128; act = 2; }
        f32x4 bv[2][2];
#pragma unroll
        for (int bj = 0; bj < 2; ++bj)
#pragma unroll
            for (int n = 0; n < 2; ++n) bv[bj][n] = *(const LAS f32x4*)(side + EPI_COLS(bj) + 4 * n);
        if (act == 2) {
#pragma unroll
            for (int ai = 0; ai < 2; ++ai)
#pragma unroll
                for (int m = 0; m < 4; ++m) { bf16_t* rowp = dst + (size_t)(u.pm * BM + EPI_ROWS(ai, m)) * ld + colt + wc * 32 + 8 * fq;
                    f32x2 rho[4], sh[4];
#pragma unroll
                    for (int n = 0; n < 2; ++n)
#pragma unroll
                        for (int hh = 0; hh < 2; ++hh) {
                            const f32x2 al = (hh ? hi2(acc[ai][0][m][n]) : lo2(acc[ai][0][m][n])) + (hh ? hi2(bv[0][n]) : lo2(bv[0][n]));
                            f32x2 ah = (hh ? hi2(acc[ai][1][m][n]) : lo2(acc[ai][1][m][n])) + (hh ? hi2(bv[1][n]) : lo2(bv[1][n]));
                            ah = (f32x2){fmaxf(ah.x, -80.0f), fmaxf(ah.y, -80.0f)};
                            const f32x2 tl = al * -1.4426950408889634f, th = ah * -1.4426950408889634f;
                            const f32x2 dl = (f32x2){__builtin_amdgcn_exp2f(tl.x), __builtin_amdgcn_exp2f(tl.y)} + 1.0f, dh = (f32x2){__builtin_amdgcn_exp2f(th.x), __builtin_amdgcn_exp2f(th.y)} + 1.0f;
                            sh[2 * n + hh] = (f32x2){__builtin_amdgcn_rcpf(dh.x), __builtin_amdgcn_rcpf(dh.y)};
                            rho[2 * n + hh] = dh * (f32x2){__builtin_amdgcn_rcpf(dl.x), __builtin_amdgcn_rcpf(dl.y)}; }
                    store8bf2(rowp, rho[0], rho[1], rho[2], rho[3]); store8bf2(rowp + 1024, sh[0], sh[1], sh[2], sh[3]); }
            return;
        }
#pragma unroll
        for (int ai = 0; ai < 2; ++ai)
#pragma unroll
            for (int m = 0; m < 4; ++m) { bf16_t* rowp = dst + (size_t)(u.pm * BM + EPI_ROWS(ai, m)) * ld + colt;
#pragma unroll
                for (int bj = 0; bj < 2; ++bj) { f32x2 a = lo2(acc[ai][bj][m][0]) + lo2(bv[bj][0]), b = hi2(acc[ai][bj][m][0]) + hi2(bv[bj][0]), c = lo2(acc[ai][bj][m][1]) + lo2(bv[bj][1]), d = hi2(acc[ai][bj][m][1]) + hi2(bv[bj][1]);
                    store8bf2(rowp + EPI_COLS(bj), a, b, c, d); } }
    }
};
struct EpiMix {
    static constexpr bool CHAIN = true;
    const bf16_t* PG; bf16_t* MIX;
    __device__ __forceinline__ bool operator()(f32x4 (&acc)[2][2][4][2], const Unit& u, int wr, int wc, int fr, int fq, const LAS float*) const {
#pragma unroll
        for (int ai = 0; ai < 2; ++ai)
#pragma unroll
            for (int m = 0; m < 4; ++m) { const size_t row = (size_t)(u.pm * BM + EPI_ROWS(ai, m));
#pragma unroll
                for (int bj = 0; bj < 2; ++bj) { const int col = u.pn * 256 + EPI_COLS(bj);
                    f32x4 h0, h1; load8bf(PG + row * 2048 + (u.e == 0 ? 0 : 1024) + col, h0, h1);
                    if (u.e == 0) { acc[ai][bj][m][0] *= h0; acc[ai][bj][m][1] *= h1; }
                    else store8bf(MIX + row * 1024 + col, h0 * acc[ai][bj][m][0], h1 * acc[ai][bj][m][1]); } }
        return u.e == 0;
    }
};
struct EpiH {
    static constexpr bool CHAIN = false;
    const float* x; bf16_t* HB;
    __device__ __forceinline__ void operator()(const f32x4 (&acc)[2][2][4][2], const Unit& u, int wr, int wc, int fr, int fq, const LAS float* side) const {
#pragma unroll
        for (int ai = 0; ai < 2; ++ai)
#pragma unroll
            for (int m = 0; m < 4; ++m) { const size_t row = (size_t)(u.pm * BM + EPI_ROWS(ai, m));
#pragma unroll
                for (int bj = 0; bj < 2; ++bj) { const size_t o = row * 1024 + u.pn * 256 + EPI_COLS(bj);
                    const f32x4 v0 = *(const f32x4*)(x + o) + acc[ai][bj][m][0], v1 = *(const f32x4*)(x + o + 4) + acc[ai][bj][m][1];
                    store8bf(HB + o, v0, v1); } }
    }
};
struct EpiGU {
    static constexpr bool CHAIN = false;
    const float* bgu; const float* ROWRS; bf16_t* ACT;
    __device__ __forceinline__ void operator()(const f32x4 (&acc)[2][2][4][2], const Unit& u, int wr, int wc, int fr, int fq, const LAS float* side) const {
        const int colp = u.pn * 128 + wc * 32 + 8 * fq;
        f32x4 bg[2], bu[2];
#pragma unroll
        for (int n = 0; n < 2; ++n) { bg[n] = *(const LAS f32x4*)(side + wc * 32 + 8 * fq + 4 * n); bu[n] = *(const LAS f32x4*)(side + 128 + wc * 32 + 8 * fq + 4 * n); }
#pragma unroll
        for (int ai = 0; ai < 2; ++ai)
#pragma unroll
            for (int m = 0; m < 4; ++m) { const size_t row = (size_t)u.gm * BM + EPI_ROWS(ai, m); const float rs = side[256 + EPI_ROWS(ai, m)];
                f32x2 o[4];
#pragma unroll
                for (int n = 0; n < 2; ++n) {
                    o[2 * n] = swiglu2(lo2(acc[ai][0][m][n]) * rs + lo2(bg[n]), lo2(acc[ai][1][m][n]) * rs + lo2(bu[n]));
                    o[2 * n + 1] = swiglu2(hi2(acc[ai][0][m][n]) * rs + hi2(bg[n]), hi2(acc[ai][1][m][n]) * rs + hi2(bu[n])); }
                store8bf2(ACT + row * 1024 + colp, o[0], o[1], o[2], o[3]); }
    }
};
struct EpiDN {
    static constexpr bool CHAIN = false;
    const float* bdn; const float* ROWGATE; bf16_t* YS;
    __device__ __forceinline__ void operator()(const f32x4 (&acc)[2][2][4][2], const Unit& u, int wr, int wc, int fr, int fq, const LAS float* side) const {
        f32x4 bv[2][2];
#pragma unroll
        for (int bj = 0; bj < 2; ++bj)
#pragma unroll
            for (int n = 0; n < 2; ++n) bv[bj][n] = *(const LAS f32x4*)(side + EPI_COLS(bj) + 4 * n);
#pragma unroll
        for (int ai = 0; ai < 2; ++ai)
#pragma unroll
            for (int m = 0; m < 4; ++m) { const size_t row = (size_t)u.gm * BM + EPI_ROWS(ai, m); const float gt = side[256 + EPI_ROWS(ai, m)];
#pragma unroll
                for (int bj = 0; bj < 2; ++bj) store8bf2(YS + row * 1024 + u.pn * 256 + EPI_COLS(bj), (lo2(acc[ai][bj][m][0]) + lo2(bv[bj][0])) * gt, (hi2(acc[ai][bj][m][0]) + hi2(bv[bj][0])) * gt,
                                                         (lo2(acc[ai][bj][m][1]) + lo2(bv[bj][1])) * gt, (hi2(acc[ai][bj][m][1]) + hi2(bv[bj][1])) * gt); }
    }
};

template <int NS> struct SchedDenseT {
    static constexpr int NSIDE = NS; const float* bias;
    __device__ __forceinline__ const float* side_addr(const Unit& u, int, int idx) const {
        const int p = u.pn - 20; return p < 0 ? bias + u.pn * 256 + idx : bias + (idx < 128 ? 5120 + 128 * p + idx : 6144 + 128 * p + (idx - 128)); }
    DenseOrder O; const char* A; const char* B;
    __device__ __forceinline__ bool next(int i, Unit& u) const { int pm, pn; if (!O.tile(i, pm, pn)) return false; u.pm = pm; u.pn = pn; u.e = 0; u.gm = pm;
        u.A = A + (size_t)pm * (BM * KD * 2); u.B = B + (size_t)pn * (BM * KD * 2); return true; }
    static constexpr const unsigned* ROWTOK = nullptr; __device__ __forceinline__ int ROWTOK_row(const Unit&, int) const { return 0; } __device__ __forceinline__ size_t rowoff(const Unit&) const { return 0; }
};
struct SchedDenseProbe {
    static constexpr int NSIDE = 0; __device__ __forceinline__ const float* side_addr(const Unit&, int, int) const { return nullptr; }
    DenseOrder O; const char* A; const char* B;
    __device__ __forceinline__ bool next(int i, Unit& u) const { int pm, pn; if (!O.tile(i, pm, pn)) return false; u.pm = pm; u.pn = pn; u.e = 0; u.gm = pm;
        u.A = A + (size_t)(pm & 1) * (BM * KD * 2); u.B = B + (size_t)(pn & 1) * (BM * KD * 2); return true; }
    static constexpr const unsigned* ROWTOK = nullptr; __device__ __forceinline__ int ROWTOK_row(const Unit&, int) const { return 0; } __device__ __forceinline__ size_t rowoff(const Unit&) const { return 0; }
};
struct SchedMix {
    static constexpr int NSIDE = 0; __device__ __forceinline__ const float* side_addr(const Unit&, int, int) const { return nullptr; }
    DenseOrder O; const char* A0; const char* A1; const char* B0; const char* B1;
    __device__ __forceinline__ bool next(int i, Unit& u) const { int pm, pn; if (!O.tile(i >> 1, pm, pn)) return false; const int w = i & 1; u.pm = pm; u.pn = pn; u.e = w; u.gm = pm;
        u.A = (w ? A1 : A0) + (size_t)pm * (BM * KD * 2); u.B = (w ? B1 : B0) + (size_t)pn * (BM * KD * 2); return true; }
    static constexpr const unsigned* ROWTOK = nullptr; __device__ __forceinline__ int ROWTOK_row(const Unit&, int) const { return 0; } __device__ __forceinline__ size_t rowoff(const Unit&) const { return 0; }
};
template <int NT, bool GATHER> struct SchedMoE {
    static constexpr int NSIDE = 2; const float* sbias; const float* srow;
    __device__ __forceinline__ const float* side_addr(const Unit& u, int k, int idx) const {
        if (k == 1) return srow + (size_t)u.e * T + u.pm + idx;
        return NT == 8 ? sbias + u.e * 2048 + (idx < 128 ? 128 * u.pn + idx : 1024 + 128 * u.pn + idx - 128) : sbias + u.e * 1024 + 256 * u.pn + idx; }
    const LAS int* ptile; int G, c; const char* A; const char* B; size_t bstride  ; const int* ROWTOK;
    __device__ __forceinline__ bool next(int i, Unit& u) const {
        const int ngm = __builtin_amdgcn_readfirstlane(ptile[32]);
        int gm, pn;
        if (G == 256) {
            const int x = c & 7, y = c >> 3; gm = i * (256 / NT) + x * (32 / NT) + y / NT; pn = y % NT;
#ifdef LAST_SPREAD
            if ((i + 1) * (256 / NT) > ngm) gm = i * (256 / NT) + (y / NT) * 8 + x;
#endif
            if (gm >= ngm) return false;
#ifdef DN_REVERSE
            if (NT == 4) gm = ngm - 1 - gm;
#endif
        } else { const long Lx = (long)i * G + c; if (Lx >= (long)ngm * NT) return false; gm = (int)(Lx / NT); pn = (int)(Lx % NT); }
        int e = 0;
#pragma unroll 1
        for (int q = 1; q < 32; ++q) e += (__builtin_amdgcn_readfirstlane(ptile[q]) <= gm) ? 1 : 0;
        u.pm = (gm - __builtin_amdgcn_readfirstlane(ptile[e])) * BM; u.gm = gm; u.pn = pn; u.e = e;
        u.A = GATHER ? A : A + (size_t)gm * (BM * KD * 2); u.B = B + (size_t)e * bstride + (size_t)pn * (BM * KD * 2); return true; }
    __device__ __forceinline__ int ROWTOK_row(const Unit& u, int r) const { return GATHER ? ROWTOK[(size_t)u.e * T + u.pm + r] : 0; }
    __device__ __forceinline__ size_t rowoff(const Unit& u) const { return (size_t)u.e * T + u.pm; }
};
}
struct Args { const float* in[33]; float* out; unsigned char* ws; int ph_lo, ph_hi, li, pad; };
#define LDS_WAIT() asm volatile("s_waitcnt lgkmcnt(0)" ::: "memory")

struct Frame {
    LAS unsigned char* lds; int tid, lane, wave, G, bid; const float* const* in; float* out; unsigned char* ws;
};

#ifndef DUPMASK
#define DUPMASK 0
#endif
#define REP(bit) for (int rep_ = 0; rep_ < (((DUPMASK >> (bit)) & 1) ? 2 : 1); ++rep_)

#define XB_TMO      128
#define XB_XCNT(j)  (256  + 64 * (j))
#define XB_XSUB(j)  (1280 + 64 * (j))
#define XB_XGEN(j)  (2304 + 64 * (j))
#define XB_TOP      3328
#define XB_TOPGEN   3392
#define XCD_BAR_WORDS 3456
#define XB_SPIN_CAP (1u << 18)

__device__ __forceinline__ unsigned xb_ld(unsigned* p)              { return __hip_atomic_load(p, __ATOMIC_RELAXED, __HIP_MEMORY_SCOPE_AGENT); }
__device__ __forceinline__ unsigned xb_add(unsigned* p, unsigned v) { return __hip_atomic_fetch_add(p, v, __ATOMIC_RELAXED, __HIP_MEMORY_SCOPE_AGENT); }
__device__ __forceinline__ unsigned xb_xcc_id() { return (unsigned)__builtin_amdgcn_s_getreg((3 << 11) | 20) & 0xFu; }
#define XB_SPIN(cond, bar) do { unsigned _sp = 0; while (cond) { __builtin_amdgcn_s_sleep(1); \
    if ((++_sp & 255u) == 0u) { if (xb_ld(&(bar)[XB_TMO])) break; if (_sp > XB_SPIN_CAP) { atomicAdd(&(bar)[XB_TMO], 1u); break; } } } } while (0)

struct XcdBarrier {
    unsigned* bar; unsigned x;
    volatile LAS unsigned* st;
};

__device__ __forceinline__ XcdBarrier xcd_barrier_post(unsigned* bar, volatile LAS unsigned* st) {
    XcdBarrier b; b.bar = bar; b.x = xb_xcc_id(); b.st = st;
    if (threadIdx.x == 0) (void)xb_add(&bar[XB_XCNT(b.x)], 1u);
    return b;
}
__device__ __forceinline__ void xcd_barrier_complete(unsigned* bar, unsigned x, unsigned& nloc, unsigned& nx) {
    const unsigned G = gridDim.x * gridDim.y * gridDim.z;
    unsigned sum, cnt, mine, sp = 0u;
    for (;;) {
        sum = 0u; cnt = 0u; mine = 0u;
#pragma unroll
        for (unsigned j = 0; j < 16; ++j) { const unsigned c = xb_ld(&bar[XB_XCNT(j)]); sum += c; cnt += (c > 0u) ? 1u : 0u; mine = (j == x) ? c : mine; }
        if (sum == G) break;
        __builtin_amdgcn_s_sleep(1);
        if ((++sp & 255u) == 0u) { if (xb_ld(&bar[XB_TMO])) break; if (sp > XB_SPIN_CAP) { atomicAdd(&bar[XB_TMO], 1u); break; } }
    }
    nloc = mine > 0u ? mine : 1u; nx = cnt > 0u ? cnt : 1u;
}

__device__ __forceinline__ void xcd_barrier(const XcdBarrier& b) {
    asm volatile("s_waitcnt vmcnt(0)" ::: "memory");
    __syncthreads();
    if (threadIdx.x == 0) {
        unsigned* bar = b.bar;
        __builtin_amdgcn_s_waitcnt(0);
        unsigned nloc = b.st[0], nx = b.st[1];
        if (nloc == 0u) { xcd_barrier_complete(bar, b.x, nloc, nx); b.st[0] = nloc; b.st[1] = nx; }
        const unsigned old = xb_add(&bar[XB_XSUB(b.x)], 1u);
        const unsigned gen = old / nloc;
        if (old + 1u == (gen + 1u) * nloc) {
            __builtin_amdgcn_fence(__ATOMIC_RELEASE, "agent");
            asm volatile("s_waitcnt vmcnt(0)" ::: "memory");
            const unsigned og = xb_add(&bar[XB_TOP], 1u);
            const unsigned tg = og / nx;
            if (og + 1u == (tg + 1u) * nx) xb_add(&bar[XB_TOPGEN], 1u);
            else XB_SPIN(xb_ld(&bar[XB_TOPGEN]) == tg, bar);
            __builtin_amdgcn_fence(__ATOMIC_ACQUIRE, "agent");
            xb_add(&bar[XB_XGEN(b.x)], 1u);
            asm volatile("s_waitcnt vmcnt(0)" ::: "memory");
        } else {
            XB_SPIN(xb_ld(&bar[XB_XGEN(b.x)]) == gen, bar);
            __builtin_amdgcn_fence(__ATOMIC_ACQUIRE, "agent");
            asm volatile("s_waitcnt vmcnt(0)" ::: "memory");
        }
    }
    __syncthreads();
}


__device__ __forceinline__ void stagger_delay(int cls, int ticks_per_class) {
    if (cls > 0) { const unsigned long long t0 = __builtin_amdgcn_s_memrealtime(); const unsigned long long want = (unsigned long long)(cls * ticks_per_class);
        while (__builtin_amdgcn_s_memrealtime() - t0 < want) __builtin_amdgcn_s_sleep(32); }
}
namespace hy {
constexpr int TW128_OFF = MISC_OFF + 1024, TWT_OFF = MISC_OFF + 2048;

__host__ __device__ constexpr float twc16(int m) { return m == 0 ? 1.f : m == 1 ? 0.92387953251128674f : m == 2 ? 0.70710678118654752f : m == 3 ? 0.38268343236508977f : m == 4 ? 0.f : m == 5 ? -0.38268343236508977f : m == 6 ? -0.70710678118654752f : -0.92387953251128674f; }
__host__ __device__ constexpr float tws16(int m) { return m == 0 ? 0.f : m == 1 ? 0.38268343236508977f : m == 2 ? 0.70710678118654752f : m == 3 ? 0.92387953251128674f : m == 4 ? 1.f : m == 5 ? 0.92387953251128674f : m == 6 ? 0.70710678118654752f : 0.38268343236508977f; }
template <int N> __host__ __device__ constexpr int brev(int i) { int r = 0; for (int b = 1, c = N >> 1; b < N; b <<= 1, c >>= 1) if (i & b) r |= c; return r; }

typedef f32x2 P2;
template <int N, bool INV> __device__ __forceinline__ void fft_reg(P2 (&xr)[N], P2 (&xi)[N]) {
#pragma unroll
    for (int len = N; len >= 2; len >>= 1) {
        const int half = len >> 1;
#pragma unroll
        for (int start = 0; start < N; start += len) {
#pragma unroll
            for (int j = 0; j < half; ++j) {
                const int i0 = start + j, i1 = i0 + half;
                const P2 ar = xr[i0], ai = xi[i0], br = xr[i1], bi = xi[i1];
                xr[i0] = ar + br; xi[i0] = ai + bi;
                const P2 tr = ar - br, ti = ai - bi;
                const int m = j * (16 / len);
                if (m == 0) { xr[i1] = tr; xi[i1] = ti; }
                else if (m == 4) { if (INV) { xr[i1] = -ti; xi[i1] = tr; } else { xr[i1] = ti; xi[i1] = -tr; } }
                else { const float c = twc16(m), s = INV ? tws16(m) : -tws16(m); xr[i1] = tr * c - ti * s; xi[i1] = tr * s + ti * c; }
            }
        }
    }
}
__device__ __forceinline__ unsigned pkh(float a, float b) { return __builtin_bit_cast(unsigned, __builtin_amdgcn_cvt_pkrtz(a, b)); }
__device__ __forceinline__ u32x2 pkc(const P2 re, const P2 im) { u32x2 r; r.x = pkh(re.x, re.y); r.y = pkh(im.x, im.y); return r; }
__device__ __forceinline__ float h2f_lo(unsigned u) { return (float)__builtin_bit_cast(_Float16, (unsigned short)(u & 0xffffu)); }
__device__ __forceinline__ float h2f_hi(unsigned u) { return (float)__builtin_bit_cast(_Float16, (unsigned short)(u >> 16)); }
__device__ __forceinline__ P2 unpk2(unsigned u) { return (P2){h2f_lo(u), h2f_hi(u)}; }
__device__ __forceinline__ P2 bf2p(unsigned u) { return (P2){__uint_as_float(u << 16), __uint_as_float(u & 0xffff0000u)}; }
__device__ __forceinline__ void cmul(P2& xr, P2& xi, float c, float s) { const P2 r = xr * c - xi * s, i = xr * s + xi * c; xr = r; xi = i; }

__device__ __forceinline__ void init_tw128(Frame& F) {
    __syncthreads();
    if (F.tid < 128) { float s, c; sincospif((float)F.tid * (1.0f / 64.0f), &s, &c); ((LAS f32x2*)(F.lds + TW128_OFF))[F.tid] = (f32x2){c, s}; }
    __syncthreads();
}
__device__ __forceinline__ void tile_tw(Frame& F, int a, bool inv) {
    if (F.tid < 128) { const int m = (a * F.tid) & (L2X - 1); float s, c; sincospif((float)m * (1.0f / 8192.0f), &s, &c); ((LAS f32x2*)(F.lds + TWT_OFF))[F.tid] = (f32x2){c, inv ? s : -s}; }
}
template <bool INV> __device__ __forceinline__ void stage1(Frame& F, P2 (&xr)[16], P2 (&xi)[16], int s) {
    fft_reg<16, INV>(xr, xi);
    const LAS f32x2* tw = (const LAS f32x2*)(F.lds + TW128_OFF); LAS f32x4* tile = (LAS f32x4*)F.lds;
#pragma unroll
    for (int q = 0; q < 16; ++q) { const int p = brev<16>(q); const f32x2 w = tw[s * q]; const float c = w.x, sn = INV ? w.y : -w.y;
        P2 a = xr[p], b = xi[p]; cmul(a, b, c, sn);
        tile[(s * 16 + q) * 64 + F.lane] = (f32x4){a.x, a.y, b.x, b.y}; }
}
__device__ __forceinline__ void stage2_read(Frame& F, P2 (&xr)[8], P2 (&xi)[8], int qq) {
    const LAS f32x4* tile = (const LAS f32x4*)F.lds;
#pragma unroll
    for (int s = 0; s < 8; ++s) { const f32x4 v = tile[(s * 16 + qq) * 64 + F.lane]; xr[s] = (P2){v.x, v.y}; xi[s] = (P2){v.z, v.w}; }
}
__device__ __forceinline__ void hyq2(const bf16_t* __restrict__ PHY, size_t row, int tl, int col, const float (&w)[3][2], const float (&b)[2], float& q0, float& q1) {
    q0 = b[0]; q1 = b[1];
#pragma unroll
    for (int k = 0; k < 3; ++k) { const int tt = tl + k - 1; const bool ok = (tt >= 0) && (tt < L);
        const unsigned u = ok ? *(const unsigned*)(PHY + (row + k - 1) * 3072 + col) : 0u;
        q0 += w[k][0] * __uint_as_float(u << 16); q1 += w[k][1] * __uint_as_float(u & 0xffff0000u); }
}
struct ConvW { float w[3][3][2]; float b[3][2]; };
__device__ __forceinline__ void load_convw(ConvW& W, const float* __restrict__ cw, const float* __restrict__ cb, int c0) {
#pragma unroll
    for (int seg = 0; seg < 3; ++seg) {
#pragma unroll
        for (int k = 0; k < 3; ++k) { const f32x2 v = *(const f32x2*)(cw + k * 3072 + seg * 1024 + c0); W.w[seg][k][0] = v.x; W.w[seg][k][1] = v.y; }
        const f32x2 v = *(const f32x2*)(cb + seg * 1024 + c0); W.b[seg][0] = v.x; W.b[seg][1] = v.y; }
}


__device__ __forceinline__ void bf8_to_f(const u32x4 u, float (&f)[8]) {
    f[0] = __uint_as_float(u.x << 16); f[1] = __uint_as_float(u.x & 0xffff0000u); f[2] = __uint_as_float(u.y << 16); f[3] = __uint_as_float(u.y & 0xffff0000u);
    f[4] = __uint_as_float(u.z << 16); f[5] = __uint_as_float(u.z & 0xffff0000u); f[6] = __uint_as_float(u.w << 16); f[7] = __uint_as_float(u.w & 0xffff0000u);
}
__device__ __forceinline__ void prepass(Frame& F) {
    const bf16_t* PHY = (const bf16_t*)(F.ws + WS_PHY); bf16_t* Z16 = (bf16_t*)(F.ws + WS_Z16); bf16_t* X1Q = (bf16_t*)(F.ws + WS_YHY); const float* cw = F.in[12]; const float* cb = F.in[13];
    const int gw = F.bid * NWAVES + F.wave, NGW = F.G * NWAVES;
#pragma unroll 1
    for (int item = gw; item < (T / 16) * 2; item += NGW) {
        const int half = item & 1, row0 = (item >> 1) * 16, tl0 = row0 & (L - 1), c0 = half * 512 + 8 * F.lane;
        float w[3][3][8], bs[3][8];
#pragma unroll
        for (int seg = 0; seg < 3; ++seg) {
#pragma unroll
            for (int k = 0; k < 3; ++k) { const f32x4 a = *(const f32x4*)(cw + k * 3072 + seg * 1024 + c0), b = *(const f32x4*)(cw + k * 3072 + seg * 1024 + c0 + 4);
                w[seg][k][0] = a.x; w[seg][k][1] = a.y; w[seg][k][2] = a.z; w[seg][k][3] = a.w; w[seg][k][4] = b.x; w[seg][k][5] = b.y; w[seg][k][6] = b.z; w[seg][k][7] = b.w; }
            const f32x4 a = *(const f32x4*)(cb + seg * 1024 + c0), b = *(const f32x4*)(cb + seg * 1024 + c0 + 4);
            bs[seg][0] = a.x; bs[seg][1] = a.y; bs[seg][2] = a.z; bs[seg][3] = a.w; bs[seg][4] = b.x; bs[seg][5] = b.y; bs[seg][6] = b.z; bs[seg][7] = b.w; }
        const u32x4 zero4 = (u32x4){0u, 0u, 0u, 0u};
        u32x4 prev[3], cur[3];
#pragma unroll
        for (int seg = 0; seg < 3; ++seg) { prev[seg] = tl0 > 0 ? *(const u32x4*)(PHY + (size_t)(row0 - 1) * 3072 + seg * 1024 + c0) : zero4; cur[seg] = *(const u32x4*)(PHY + (size_t)row0 * 3072 + seg * 1024 + c0); }
#pragma unroll 1
        for (int sub = 0; sub < 4; ++sub) {
            u32x4 nx[4][3];
#pragma unroll
            for (int r = 0; r < 4; ++r)
#pragma unroll
                for (int seg = 0; seg < 3; ++seg) { const int tn = tl0 + sub * 4 + r + 1; nx[r][seg] = tn < L ? *(const u32x4*)(PHY + (size_t)(row0 + sub * 4 + r + 1) * 3072 + seg * 1024 + c0) : zero4; }
#pragma unroll
            for (int r = 0; r < 4; ++r) {
                float q[3][8];
#pragma unroll
                for (int seg = 0; seg < 3; ++seg) { float a[8], b[8], c[8]; bf8_to_f(prev[seg], a); bf8_to_f(cur[seg], b); bf8_to_f(nx[r][seg], c);
#pragma unroll
                    for (int e = 0; e < 8; ++e) q[seg][e] = bs[seg][e] + w[seg][0][e] * a[e] + w[seg][1][e] * b[e] + w[seg][2][e] * c[e];
                    prev[seg] = cur[seg]; cur[seg] = nx[r][seg]; }
                const size_t o = (size_t)(row0 + sub * 4 + r) * 1024 + c0;
                u32x4 zo, xo;
                zo.x = pk2(q[2][0] * q[0][0], q[2][1] * q[0][1]); zo.y = pk2(q[2][2] * q[0][2], q[2][3] * q[0][3]); zo.z = pk2(q[2][4] * q[0][4], q[2][5] * q[0][5]); zo.w = pk2(q[2][6] * q[0][6], q[2][7] * q[0][7]);
                xo.x = pk2(q[1][0], q[1][1]); xo.y = pk2(q[1][2], q[1][3]); xo.z = pk2(q[1][4], q[1][5]); xo.w = pk2(q[1][6], q[1][7]);
                *(u32x4*)(Z16 + o) = zo; *(u32x4*)(X1Q + o) = xo;
            }
        }
    }
}

__device__ __forceinline__ void prep_w4frag(Frame& F) {
    const float* w4 = F.in[20]; u32x4* WF4 = (u32x4*)(F.ws + WS_WF4);
    for (int idx = F.bid * NTHREADS + F.tid; idx < 2 * 64 * 2 * 64; idx += F.G * NTHREADS) {
        const int lane = idx & 63, s = (idx >> 6) & 1, cb = (idx >> 7) & 63, dir = idx >> 13; const int col = dir * 1024 + 16 * cb + (lane & 15), k0 = 32 * s + 8 * (lane >> 4);
        u32x4 o; o.x = pk2(w4[(k0 + 0) * 2048 + col], w4[(k0 + 1) * 2048 + col]); o.y = pk2(w4[(k0 + 2) * 2048 + col], w4[(k0 + 3) * 2048 + col]);
        o.z = pk2(w4[(k0 + 4) * 2048 + col], w4[(k0 + 5) * 2048 + col]); o.w = pk2(w4[(k0 + 6) * 2048 + col], w4[(k0 + 7) * 2048 + col]);
        WF4[idx] = o; }
}
__device__ __forceinline__ void fa_load(const float* __restrict__ w4, int c0, int bt, f32x2 (&wf)[16], f32x2 (&wb)[16]) {
#pragma unroll
    for (int e = 0; e < 16; ++e) { wf[e] = *(const f32x2*)(w4 + (16 * bt + e) * 2048 + c0); wb[e] = *(const f32x2*)(w4 + (16 * bt + e) * 2048 + 1024 + c0); }
}
__device__ __forceinline__ void fa_compute(const LAS f32x4* hrow, int bt, const f32x2 (&wf)[16], const f32x2 (&wb)[16], float (&r0)[16], float (&r1)[16], float& l0, float& l1, bool lag0) {
#pragma unroll
    for (int e4 = 0; e4 < 4; ++e4) { const int u4 = 4 * bt + e4; __builtin_amdgcn_sched_barrier(0);
#pragma unroll
        for (int j = 0; j < 16; ++j) { const f32x4 hv = hrow[(8 * j) * 16 + u4];
#pragma unroll
            for (int e = 0; e < 4; ++e) { r0[j] += hv[e] * (j < 8 ? wf[4 * e4 + e].x : wb[4 * e4 + e].x); r1[j] += hv[e] * (j < 8 ? wf[4 * e4 + e].y : wb[4 * e4 + e].y); } }
        if (lag0) { const f32x4 hv = hrow[u4];
#pragma unroll
            for (int e = 0; e < 4; ++e) { l0 += hv[e] * wb[4 * e4 + e].x; l1 += hv[e] * wb[4 * e4 + e].y; } } }
}
template <bool DRY = false> __device__ __forceinline__ void filter_pass_a(Frame& F, int k_lo = 0, int k_hi = 1 << 20) {
    const float* HH3 = (const float*)(F.ws + WS_HH3); const float* w4 = F.in[20]; float* NORM = (float*)(F.ws + WS_NORMP); u32x2* YK = (u32x2*)(F.ws + WS_KF);
    const int s = F.wave; const LAS f32x2* twt = (const LAS f32x2*)(F.lds + TWT_OFF);
    for (int kk = k_lo, tl = F.bid + k_lo * F.G; kk < k_hi && tl < 128 * 8; ++kk, tl += F.G) {
        const int n1 = tl >> 3, ct = tl & 7, c0 = ct * 128 + 2 * F.lane;
        tile_tw(F, n1, false);
        { const int rw = F.tid >> 2, part = F.tid & 3; const int n = n1 + 128 * rw; const int t = n < L ? n : ((2 * L - n) & (L - 1));
          const f32x4* src = (const f32x4*)(HH3 + t * 64 + part * 16); LAS f32x4* dst = (LAS f32x4*)(F.lds + rw * 256 + part * 64);
          const f32x4 a = src[0], b = src[1], c = src[2], d = src[3]; dst[0] = a; dst[1] = b; dst[2] = c; dst[3] = d; }
        __syncthreads();
        P2 xr[16], xi[16]; P2 lag0 = (P2){0.f, 0.f};
        const P2 da = (P2){hy_delta_abs(c0), hy_delta_abs(c0 + 1)};
        { const u32x4* WF4 = (const u32x4*)(F.ws + WS_WF4); const int cb = ct * 8 + s, jl = F.lane & 15, ql = F.lane >> 4;
          bf16x8 bfr[2][2];
#pragma unroll
          for (int dir = 0; dir < 2; ++dir)
#pragma unroll
              for (int ks = 0; ks < 2; ++ks) bfr[dir][ks] = __builtin_bit_cast(bf16x8, WF4[(((dir * 64 + cb) * 2 + ks) * 64) + F.lane]);
          LAS float* kt = (LAS float*)(F.lds + 32768);
#pragma unroll
          for (int m = 0; m < 8; ++m) {
              bf16x8 afr[2];
#pragma unroll
              for (int ks = 0; ks < 2; ++ks) { const LAS f32x4* hp = (const LAS f32x4*)(F.lds + (16 * m + jl) * 256 + (32 * ks + 8 * ql) * 4); const f32x4 x0 = hp[0], x1 = hp[1];
                  u32x4 pk; pk.x = pk2(x0.x, x0.y); pk.y = pk2(x0.z, x0.w); pk.z = pk2(x1.x, x1.y); pk.w = pk2(x1.z, x1.w); afr[ks] = __builtin_bit_cast(bf16x8, pk); }
              f32x4 d = (f32x4){0.f, 0.f, 0.f, 0.f};
              d = __builtin_amdgcn_mfma_f32_16x16x32_bf16(afr[0], bfr[m >> 2][0], d, 0, 0, 0); d = __builtin_amdgcn_mfma_f32_16x16x32_bf16(afr[1], bfr[m >> 2][1], d, 0, 0, 0);
#pragma unroll
              for (int r = 0; r < 4; ++r) kt[(16 * m + 4 * ql + r) * 132 + 16 * s + jl] = d[r]; }
          if (n1 == 0 && s == 0) { const LAS float* h0 = (const LAS float*)F.lds;
#pragma unroll 4
              for (int u = 0; u < 64; ++u) { const f32x2 wb = *(const f32x2*)(w4 + u * 2048 + 1024 + c0); lag0 += h0[u] * wb; } }
          __syncthreads();
#pragma unroll
          for (int j = 0; j < 16; ++j) xr[j] = *(const LAS f32x2*)(kt + (s + 8 * j) * 132 + 2 * F.lane);
        }
        __syncthreads();
        P2 na = (P2){0.f, 0.f};
#pragma unroll
        for (int j = 0; j < 16; ++j) { const int n = n1 + 128 * (s + 8 * j); const int t = j < 8 ? n : ((2 * L - n) & (L - 1)); const float tt = (float)t * (1.0f / (float)(L - 1));
            P2 v = xr[j] * (P2){fexp(-tt * da.x), fexp(-tt * da.y)};
            if (n == L) v = (P2){0.f, 0.f};
            if (j == 0) v += lag0;
            xr[j] = v; xi[j] = (P2){0.f, 0.f}; na += (P2){fabsf(v.x), fabsf(v.y)}; }
        { LAS f32x2* nred = (LAS f32x2*)(F.lds + MISC_OFF + 12288); nred[s * 64 + F.lane] = na; }
        stage1<false>(F, xr, xi, s);
        __syncthreads();
        if (s == 0) { const LAS f32x2* nred = (const LAS f32x2*)(F.lds + MISC_OFF + 12288); f32x2 a = nred[F.lane];
#pragma unroll
            for (int w = 1; w < 8; ++w) { const f32x2 b = nred[w * 64 + F.lane]; a.x += b.x; a.y += b.y; }
            if (!DRY) *(f32x2*)(NORM + (size_t)n1 * 1024 + c0) = a; else asm volatile("" :: "v"(a)); }
#pragma unroll
        for (int h = 0; h < 2; ++h) { const int qq = s + 8 * h; P2 a[8], b[8];
            stage2_read(F, a, b, qq); fft_reg<8, false>(a, b);
#pragma unroll
            for (int r = 0; r < 8; ++r) { const int p = brev<8>(r), k2 = qq + 16 * r; const f32x2 w = twt[k2];
                P2 x = a[p], y = b[p]; cmul(x, y, w.x, w.y);
                if (!DRY) YK[((size_t)k2 * 128 + n1) * 512 + (c0 >> 1)] = pkc(x, y); else asm volatile("" :: "v"(x), "v"(y)); } }
        __syncthreads();
    }
}
template <bool DRY = false> __device__ __forceinline__ void filter_pass_b(Frame& F) {
    const float* NORM = (const float*)(F.ws + WS_NORMP); u32x2* KF = (u32x2*)(F.ws + WS_KF); const int s = F.wave;
    for (int tl = F.bid; tl < 128 * 8; tl += F.G) {
        const int k2 = tl >> 3, ct = tl & 7, c0 = ct * 128 + 2 * F.lane; const size_t base = (size_t)k2 * 128 * 512 + (c0 >> 1);
        { LAS float* nsum = (LAS float*)(F.lds + MISC_OFF + 12288); const int ch = F.tid & 127, qt = F.tid >> 7; float a = 0.f;
#pragma unroll 8
          for (int i = 0; i < 32; ++i) a += NORM[(size_t)(qt * 32 + i) * 1024 + ct * 128 + ch];
          __syncthreads(); nsum[qt * 128 + ch] = a; __syncthreads(); }
        P2 sc;
        { const LAS float* nsum = (const LAS float*)(F.lds + MISC_OFF + 12288); const int ch = 2 * F.lane;
          sc.x = 1.0f / ((nsum[ch] + nsum[128 + ch]) + (nsum[256 + ch] + nsum[384 + ch])); sc.y = 1.0f / ((nsum[ch + 1] + nsum[128 + ch + 1]) + (nsum[256 + ch + 1] + nsum[384 + ch + 1])); }
        P2 xr[16], xi[16];
#pragma unroll
        for (int j = 0; j < 16; ++j) { const u32x2 u = KF[base + (size_t)(s + 8 * j) * 512]; xr[j] = unpk2(u.x); xi[j] = unpk2(u.y); }
        stage1<false>(F, xr, xi, s);
        __syncthreads();
#pragma unroll
        for (int h = 0; h < 2; ++h) { const int qq = s + 8 * h; P2 a[8], b[8];
            stage2_read(F, a, b, qq); fft_reg<8, false>(a, b);
#pragma unroll
            for (int r = 0; r < 8; ++r) { const int p = brev<8>(r), k1 = qq + 16 * r;
                const u32x2 o_ = pkc(a[p] * sc, b[p] * sc); if (!DRY) KF[base + (size_t)k1 * 512] = o_; else asm volatile("" :: "v"(o_)); } }
        __syncthreads();
    }
}
__device__ __forceinline__ void data_pass_a(Frame& F) {
    const bf16_t* Z16 = (const bf16_t*)(F.ws + WS_Z16); u32x2* YZ = (u32x2*)(F.ws + WS_YZ); const int s = F.wave; const LAS f32x2* twt = (const LAS f32x2*)(F.lds + TWT_OFF);
    unsigned zn[16];
    auto zload = [&](int tl, unsigned (&z)[16]) { const int ct = tl & 7, n1 = (tl >> 3) & 127, p = tl >> 10, c0 = ct * 128 + 2 * F.lane;
#pragma unroll
        for (int j = 0; j < 8; ++j) { const int t = n1 + 128 * (s + 8 * j);
            z[2 * j] = *(const unsigned*)(Z16 + ((size_t)(2 * p) * L + t) * 1024 + c0); z[2 * j + 1] = *(const unsigned*)(Z16 + ((size_t)(2 * p + 1) * L + t) * 1024 + c0); } };
    if (F.bid < 2 * 128 * 8) zload(F.bid, zn);
    for (int tl = F.bid; tl < 2 * 128 * 8; tl += F.G) {
        const int ct = tl & 7, n1 = (tl >> 3) & 127, p = tl >> 10, c0 = ct * 128 + 2 * F.lane;
        tile_tw(F, n1, false);
        P2 xr[16], xi[16];
#pragma unroll
        for (int j = 0; j < 8; ++j) { xr[j] = bf2p(zn[2 * j]); xi[j] = bf2p(zn[2 * j + 1]); }
        if (tl + F.G < 2 * 128 * 8) zload(tl + F.G, zn);
#pragma unroll
        for (int j = 8; j < 16; ++j) { xr[j] = (P2){0.f, 0.f}; xi[j] = (P2){0.f, 0.f}; }
        stage1<false>(F, xr, xi, s);
        __syncthreads();
#pragma unroll
        for (int h = 0; h < 2; ++h) { const int qq = s + 8 * h; P2 a[8], b[8];
            stage2_read(F, a, b, qq); fft_reg<8, false>(a, b);
#pragma unroll
            for (int r = 0; r < 8; ++r) { const int pp = brev<8>(r), k2 = qq + 16 * r; const f32x2 w = twt[k2];
                P2 x = a[pp], y = b[pp]; cmul(x, y, w.x, w.y);
                YZ[(((size_t)p * 128 + k2) * 128 + n1) * 512 + (c0 >> 1)] = pkc(x, y); } }
        __syncthreads();
    }
}
template <bool DRY = false> __device__ __forceinline__ void data_pass_b(Frame& F) {
    u32x2* YZ = (u32x2*)(F.ws + WS_YZ); const u32x2* KF = (const u32x2*)(F.ws + WS_KF); const int s = F.wave;
    const LAS f32x2* twt = (const LAS f32x2*)(F.lds + TWT_OFF); const LAS f32x2* tw = (const LAS f32x2*)(F.lds + TW128_OFF); LAS f32x4* tile = (LAS f32x4*)F.lds;
    int* qctr = (int*)(F.ws + WS_CTL) + 128 + (DRY ? 1 : 0); LAS int* qslot = (LAS int*)(F.lds + MISC_OFF + 768);
    for (;;) {
        __syncthreads();
        if (F.tid == 0) *qslot = atomicAdd(qctr, 1);
        __syncthreads();
        const int tl = *qslot; if (tl >= 128 * 8) break;
        const int k2 = tl >> 3, ct = tl & 7, c0 = ct * 128 + 2 * F.lane; const size_t kbase = (size_t)k2 * 128 * 512 + (c0 >> 1);
        tile_tw(F, k2, true);
#pragma unroll 1
        for (int p = 0; p < 2; ++p) {
            const size_t base = ((size_t)p * 128 + k2) * 128 * 512 + (c0 >> 1);
            u32x2 kfp[2][8];
#pragma unroll
            for (int h = 0; h < 2; ++h)
#pragma unroll
                for (int r = 0; r < 8; ++r) kfp[h][r] = KF[kbase + (size_t)(s + 8 * h + 16 * r) * 512];
            { P2 xr[16], xi[16];
#pragma unroll
              for (int j = 0; j < 16; ++j) { const u32x2 u = YZ[base + (size_t)(s + 8 * j) * 512]; xr[j] = unpk2(u.x); xi[j] = unpk2(u.y); }
              stage1<false>(F, xr, xi, s); }
            __syncthreads();
#pragma unroll
            for (int h = 0; h < 2; ++h) { const int qq = s + 8 * h; P2 a[8], b[8], gr[8], gi[8];
                if (h == 1) __builtin_amdgcn_sched_barrier(0);
                stage2_read(F, a, b, qq); fft_reg<8, false>(a, b);
#pragma unroll
                for (int r = 0; r < 8; ++r) { const int pp = brev<8>(r); const P2 kr = unpk2(kfp[h][r].x), ki = unpk2(kfp[h][r].y);
                    gr[r] = a[pp] * kr - b[pp] * ki; gi[r] = a[pp] * ki + b[pp] * kr; }
                fft_reg<8, true>(gr, gi);
#pragma unroll
                for (int bq = 0; bq < 8; ++bq) { const int pp = brev<8>(bq); const f32x2 w = tw[bq * qq];
                    P2 x = gr[pp], y = gi[pp]; cmul(x, y, w.x, w.y);
                    tile[(bq * 16 + qq) * 64 + F.lane] = (f32x4){x.x, x.y, y.x, y.y}; } }
            __syncthreads();
            { P2 xr[16], xi[16];
#pragma unroll
              for (int q = 0; q < 16; ++q) { const f32x4 v = tile[(s * 16 + q) * 64 + F.lane]; xr[q] = (P2){v.x, v.y}; xi[q] = (P2){v.z, v.w}; }
              fft_reg<16, true>(xr, xi);
#pragma unroll
              for (int a = 0; a < 16; ++a) { const int pp = brev<16>(a), m2 = s + 8 * a; const f32x2 w = twt[m2];
                  P2 x = xr[pp], y = xi[pp]; cmul(x, y, w.x, w.y);
                  if (!DRY) YZ[base + (size_t)m2 * 512] = pkc(x, y); else asm volatile("" :: "v"(x), "v"(y)); } }
            __syncthreads();
        }
    }
}
template <bool DRY = false> __device__ __forceinline__ void data_pass_c(Frame& F) {
    const bf16_t* Z16 = (const bf16_t*)(F.ws + WS_Z16); const u32x2* YZ = (const u32x2*)(F.ws + WS_YZ); bf16_t* YHY = (bf16_t*)(F.ws + WS_YHY); const float* hbias = F.in[22]; const int s = F.wave;
    u32x2 yzn[16];
    auto yzload = [&](int tl, u32x2 (&y)[16]) { const int ct = tl & 7, m2 = (tl >> 3) & 127, p = tl >> 10, c0 = ct * 128 + 2 * F.lane;
#pragma unroll
        for (int j = 0; j < 16; ++j) y[j] = YZ[(((size_t)p * 128 + (s + 8 * j)) * 128 + m2) * 512 + (c0 >> 1)]; };
    if (F.bid < 2 * 128 * 8) yzload(F.bid, yzn);
    for (int tl = F.bid; tl < 2 * 128 * 8; tl += F.G) {
        const int ct = tl & 7, m2 = (tl >> 3) & 127, p = tl >> 10, c0 = ct * 128 + 2 * F.lane;
        unsigned uzp[2][4][2], uxp[2][4][2];
#pragma unroll
        for (int h = 0; h < 2; ++h)
#pragma unroll
            for (int r = 0; r < 4; ++r)
#pragma unroll
                for (int bb = 0; bb < 2; ++bb) { const size_t row = (size_t)(2 * p + bb) * L + 128 * (s + 8 * h + 16 * r) + m2;
                    uzp[h][r][bb] = *(const unsigned*)(Z16 + row * 1024 + c0); uxp[h][r][bb] = *(const unsigned*)(YHY + row * 1024 + c0); }
        { P2 xr[16], xi[16];
#pragma unroll
          for (int j = 0; j < 16; ++j) { xr[j] = unpk2(yzn[j].x); xi[j] = unpk2(yzn[j].y); }
          if (tl + F.G < 2 * 128 * 8) yzload(tl + F.G, yzn);
          stage1<true>(F, xr, xi, s); }
        __syncthreads();
        const P2 hb = *(const f32x2*)(hbias + c0);
#pragma unroll
        for (int h = 0; h < 2; ++h) { const int qq = s + 8 * h; P2 a[8], b[8];
            stage2_read(F, a, b, qq); fft_reg<8, true>(a, b);
#pragma unroll
            for (int r = 0; r < 4; ++r) { const int pp = brev<8>(r), t = 128 * (qq + 16 * r) + m2;
#pragma unroll
                for (int bb = 0; bb < 2; ++bb) { const size_t row = (size_t)(2 * p + bb) * L + t;
                    const P2 z = bf2p(uzp[h][r][bb]), x1 = bf2p(uxp[h][r][bb]);
                    const P2 cv = (bb == 0 ? a[pp] : b[pp]) * (1.0f / (float)L2X);
                    const P2 y = x1 * (cv + hb * z);
                    if (!DRY) *(unsigned*)(YHY + row * 1024 + c0) = pk2(y.x, y.y); else asm volatile("" :: "v"(y)); } } }
        __syncthreads();
    }
}
}
namespace lru {
__device__ __forceinline__ f32x2 sig2(const f32x2 x) { const f32x2 t = x * -1.4426950408889634f; const f32x2 d = (f32x2){__builtin_amdgcn_exp2f(t.x), __builtin_amdgcn_exp2f(t.y)} + 1.0f; return (f32x2){__builtin_amdgcn_rcpf(d.x), __builtin_amdgcn_rcpf(d.y)}; }
constexpr int TC = 64, NCH = L / TC, MB = TC / 16;

__device__ __forceinline__ void prep_wfrag(Frame& F) {
    const float* wa = F.in[6]; const float* wi = F.in[8]; u32x4* WF = (u32x4*)(F.ws + WS_WLRUF);
    for (int idx = F.bid * NTHREADS + F.tid; idx < 2 * 16 * 2 * 4 * 2 * 64; idx += F.G * NTHREADS) {
        const int lane = idx & 63, s = (idx >> 6) & 1, n = (idx >> 7) & 3, mat = (idx >> 9) & 1, h = (idx >> 10) & 15, dir = idx >> 14;
        const float* W = (mat == 0 ? wa : wi) + ((size_t)(dir * 16 + h) * 64) * 64; const int jo = 16 * n + (lane & 15), i0 = 32 * s + 8 * (lane >> 4);
        u32x4 o; o.x = pk2(W[(i0 + 0) * 64 + jo], W[(i0 + 1) * 64 + jo]); o.y = pk2(W[(i0 + 2) * 64 + jo], W[(i0 + 3) * 64 + jo]);
        o.z = pk2(W[(i0 + 4) * 64 + jo], W[(i0 + 5) * 64 + jo]); o.w = pk2(W[(i0 + 6) * 64 + jo], W[(i0 + 7) * 64 + jo]);
        WF[idx] = o;
    }
}

__device__ __forceinline__ void load_rows(const bf16_t* __restrict__ P0, int b, int t0, int m, int h, int j, int q, u32x4 (&pv)[2][4]) {
#pragma unroll
    for (int s = 0; s < 2; ++s)
#pragma unroll
        for (int tap = 0; tap < 4; ++tap) { const int tl = t0 + 16 * m + j + tap - 2; const bool ok = (tl >= 0) && (tl < L);
            const size_t off = ok ? (WS_P0 - WS_CTL - 8192) + (((size_t)b * L + tl) * 1024 + 64 * h + 32 * s + 8 * q) * 2 : (size_t)0;
            pv[s][tap] = *(const u32x4*)((const char*)P0 + off); }
}
__device__ __forceinline__ void stage1(Frame& F) {
    const bf16_t* P0 = (const bf16_t*)(F.ws + WS_CTL + 8192);
    const float* cw = F.in[4]; const float* cb = F.in[5]; const float* ba = F.in[7]; const float* bi = F.in[9]; const float* lam = F.in[10];
    const u32x4* WF = (const u32x4*)(F.ws + WS_WLRUF); f32x2* SUMM = (f32x2*)(F.ws + WS_SUMM);
    u32x2* HS = (u32x2*)(F.ws + WS_HS); u32x2* AF = (u32x2*)(F.ws + WS_AF); u32x2* AB = (u32x2*)(F.ws + WS_AB);
    LAS float* cwl = (LAS float*)(F.lds + MISC_OFF + 4096);
    LAS unsigned* hfl = (LAS unsigned*)(F.lds + F.wave * 8192) + F.lane;
    const LAS u32x4* wl = (const LAS u32x4*)(F.lds + 65536) + F.lane;
    asm volatile("" : "+v"(wl)); asm volatile("" : "+v"(hfl));
    const int lane = F.lane, j = lane & 15, q = lane >> 4;
    bf16x8 idf[2];
#pragma unroll
    for (int par = 0; par < 2; ++par) { const int kp = 16 * par + j;
#pragma unroll
        for (int jj = 0; jj < 8; ++jj) idf[par][jj] = (short)((q == (kp >> 3) && jj == (kp & 7)) ? 0x3F80 : 0); }
#pragma unroll 1
    for (int bix = F.bid; bix < NB * 16 * (NCH / 8); bix += F.G) {
        const int h = (bix >> 4) & 15, b = bix >> 8, chunk = (bix & 15) * 8 + F.wave; const int t0 = chunk * TC; const int task = ((b * NCH + chunk) << 4) + h;
        __syncthreads();
        if (F.tid < 320) cwl[F.tid] = F.tid < 256 ? cw[(F.tid >> 6) * 1024 + 64 * h + (F.tid & 63)] : cb[64 * h + (F.tid & 63)];
#pragma unroll
        for (int i = 0; i < 4; ++i) { const int e = F.tid + 512 * i; const int dir_ = e >> 10, rest = e & 1023;
            ((LAS u32x4*)(F.lds + 65536))[e] = WF[((size_t)(dir_ * 16 + h) * 16) * 64 + rest]; }
        __syncthreads();
#pragma unroll
        for (int dir = 0; dir < 2; ++dir) {
            float bac[4], bic[4], spc[4], cst[4], arun[4];
#pragma unroll
            for (int n = 0; n < 4; ++n) { const int c = 64 * h + 16 * n + j; bac[n] = ba[dir * 1024 + c]; bic[n] = bi[dir * 1024 + c]; spc[n] = -8.0f * 1.4426950408889634f * log1pf(expf(-lam[dir * 1024 + c])); cst[n] = 0.f; arun[n] = 1.f; }
            u32x4 pvn[2][4];
            load_rows(P0, b, t0, dir == 0 ? 0 : MB - 1, h, j, q, pvn);
#pragma unroll 1
            for (int mm = 0; mm < MB; ++mm) {
                const int m = dir == 0 ? mm : MB - 1 - mm;
                bf16x8 afr[2];
#pragma unroll
                for (int s = 0; s < 2; ++s) { const int chb = 32 * s + 8 * q; f32x2 xp[4];
                    { const f32x4 b0 = *(const LAS f32x4*)(cwl + 256 + chb), b1 = *(const LAS f32x4*)(cwl + 256 + chb + 4);
                      xp[0] = (f32x2){b0.x, b0.y}; xp[1] = (f32x2){b0.z, b0.w}; xp[2] = (f32x2){b1.x, b1.y}; xp[3] = (f32x2){b1.z, b1.w}; }
#pragma unroll
                    for (int tap = 0; tap < 4; ++tap) { const u32x4 pq = pvn[s][tap];
                        const f32x4 w0 = *(const LAS f32x4*)(cwl + tap * 64 + chb), w1 = *(const LAS f32x4*)(cwl + tap * 64 + chb + 4);
                        xp[0] += (f32x2){w0.x, w0.y} * (f32x2){__uint_as_float(pq.x << 16), __uint_as_float(pq.x & 0xffff0000u)}; xp[1] += (f32x2){w0.z, w0.w} * (f32x2){__uint_as_float(pq.y << 16), __uint_as_float(pq.y & 0xffff0000u)};
                        xp[2] += (f32x2){w1.x, w1.y} * (f32x2){__uint_as_float(pq.z << 16), __uint_as_float(pq.z & 0xffff0000u)}; xp[3] += (f32x2){w1.z, w1.w} * (f32x2){__uint_as_float(pq.w << 16), __uint_as_float(pq.w & 0xffff0000u)}; }
                    u32x4 pk; pk.x = pk2(xp[0].x, xp[0].y); pk.y = pk2(xp[1].x, xp[1].y); pk.z = pk2(xp[2].x, xp[2].y); pk.w = pk2(xp[3].x, xp[3].y); afr[s] = __builtin_bit_cast(bf16x8, pk); }
                __builtin_amdgcn_sched_barrier(0);
                if (mm + 1 < MB) load_rows(P0, b, t0, dir == 0 ? m + 1 : m - 1, h, j, q, pvn);
                f32x4 dx[4], da[4], di[4];
#pragma unroll
                for (int n = 0; n < 4; ++n) { const f32x4 z4 = (f32x4){0.f, 0.f, 0.f, 0.f};
                    dx[n] = __builtin_amdgcn_mfma_f32_16x16x32_bf16(afr[n >> 1], idf[n & 1], z4, 0, 0, 0);
                    const bf16x8 wa0 = __builtin_bit_cast(bf16x8, wl[(((dir * 2 + 0) * 4 + n) * 2 + 0) * 64]), wa1 = __builtin_bit_cast(bf16x8, wl[(((dir * 2 + 0) * 4 + n) * 2 + 1) * 64]);
                    const bf16x8 wi0 = __builtin_bit_cast(bf16x8, wl[(((dir * 2 + 1) * 4 + n) * 2 + 0) * 64]), wi1 = __builtin_bit_cast(bf16x8, wl[(((dir * 2 + 1) * 4 + n) * 2 + 1) * 64]);
                    da[n] = __builtin_amdgcn_mfma_f32_16x16x32_bf16(afr[0], wa0, z4, 0, 0, 0); da[n] = __builtin_amdgcn_mfma_f32_16x16x32_bf16(afr[1], wa1, da[n], 0, 0, 0);
                    di[n] = __builtin_amdgcn_mfma_f32_16x16x32_bf16(afr[0], wi0, z4, 0, 0, 0); di[n] = __builtin_amdgcn_mfma_f32_16x16x32_bf16(afr[1], wi1, di[n], 0, 0, 0); }
                float P[4][4], S[4][4], PT[4], ST[4];
#pragma unroll
                for (int n = 0; n < 4; ++n) { float av[4], bv[4];
#pragma unroll
                    for (int hp = 0; hp < 2; ++hp) {
                        const f32x2 rg = sig2((f32x2){da[n][2 * hp], da[n][2 * hp + 1]} + bac[n]), ig = sig2((f32x2){di[n][2 * hp], di[n][2 * hp + 1]} + bic[n]);
                        const f32x2 tq = rg * spc[n];
                        const f32x2 a = (f32x2){__builtin_amdgcn_exp2f(tq.x), __builtin_amdgcn_exp2f(tq.y)};
                        const f32x2 w = 1.0f - a * a;
                        const f32x2 mult = (f32x2){__builtin_amdgcn_sqrtf(fmaxf(w.x, 0.f)), __builtin_amdgcn_sqrtf(fmaxf(w.y, 0.f))};
                        const f32x2 bq = mult * (ig * (f32x2){dx[n][2 * hp], dx[n][2 * hp + 1]});
                        av[2 * hp] = a.x; av[2 * hp + 1] = a.y; bv[2 * hp] = bq.x; bv[2 * hp + 1] = bq.y; }
                    if (dir == 0) { P[n][0] = av[0]; S[n][0] = bv[0];
#pragma unroll
                        for (int r = 1; r < 4; ++r) { P[n][r] = P[n][r - 1] * av[r]; S[n][r] = av[r] * S[n][r - 1] + bv[r]; } }
                    else { P[n][3] = av[3]; S[n][3] = bv[3];
#pragma unroll
                        for (int r = 2; r >= 0; --r) { P[n][r] = P[n][r + 1] * av[r]; S[n][r] = av[r] * S[n][r + 1] + bv[r]; } }
                    PT[n] = dir == 0 ? P[n][3] : P[n][0]; ST[n] = dir == 0 ? S[n][3] : S[n][0]; }
                float pt[4][4], st[4][4];
#pragma unroll
                for (int n = 0; n < 4; ++n)
#pragma unroll
                    for (int g = 0; g < 4; ++g) { pt[n][g] = __shfl(PT[n], j + 16 * g); st[n][g] = __shfl(ST[n], j + 16 * g); }
#pragma unroll
                for (int n = 0; n < 4; ++n) {
                    float C = cst[n], A = arun[n], Cq = 0.f, Aq = 1.f;
#pragma unroll
                    for (int gg = 0; gg < 4; ++gg) { const int g = dir == 0 ? gg : 3 - gg; if (g == q) { Cq = C; Aq = A; } C = pt[n][g] * C + st[n][g]; A *= pt[n][g]; }
                    cst[n] = C; arun[n] = A;
                    float hl[4], ac[4];
#pragma unroll
                    for (int hp = 0; hp < 2; ++hp) { const f32x2 pp = (f32x2){P[n][2 * hp], P[n][2 * hp + 1]}; const f32x2 hq = (f32x2){S[n][2 * hp], S[n][2 * hp + 1]} + pp * Cq, aq = pp * Aq;
                        hl[2 * hp] = hq.x; hl[2 * hp + 1] = hq.y; ac[2 * hp] = aq.x; ac[2 * hp + 1] = aq.y; }
                    const size_t fo = ((size_t)(task * MB + m) * 4 + n) * 64 + lane;
                    if (dir == 0) {
                        hfl[((m * 4 + n) * 2 + 0) * 64] = pk2(hl[0], hl[1]); hfl[((m * 4 + n) * 2 + 1) * 64] = pk2(hl[2], hl[3]);
                        AF[fo] = (u32x2){pk2(ac[0], ac[1]), pk2(ac[2], ac[3])};
                    } else {
                        { const unsigned u0 = hfl[((m * 4 + n) * 2 + 0) * 64], u1 = hfl[((m * 4 + n) * 2 + 1) * 64];
                          hl[0] += __uint_as_float(u0 << 16); hl[1] += __uint_as_float(u0 & 0xffff0000u); hl[2] += __uint_as_float(u1 << 16); hl[3] += __uint_as_float(u1 & 0xffff0000u); }
                        HS[fo] = (u32x2){pk2(hl[0], hl[1]), pk2(hl[2], hl[3])}; AB[fo] = (u32x2){pk2(ac[0], ac[1]), pk2(ac[2], ac[3])};
                    }
                }
            }
            if (q == 0) {
#pragma unroll
                for (int n = 0; n < 4; ++n) SUMM[((size_t)(dir * NB + b) * NCH + chunk) * 1024 + 64 * h + 16 * n + j] = (f32x2){arun[n], cst[n]};
            }
        }
    }
}
__device__ __forceinline__ void stage2(Frame& F) {
    const bf16_t* P1 = (const bf16_t*)(F.ws + WS_P1); bf16_t* YLRU = (bf16_t*)(F.ws + WS_YLRU); const float* CARRY = (const float*)(F.ws + WS_CARRY);
    const u32x2* HS = (const u32x2*)(F.ws + WS_HS); const u32x2* AF = (const u32x2*)(F.ws + WS_AF); const u32x2* AB = (const u32x2*)(F.ws + WS_AB);
    LAS float* buf = (LAS float*)(F.lds + F.wave * 8192);
    const int lane = F.lane, j = lane & 15, q = lane >> 4, tk = lane >> 2, cg = lane & 3;
    const int gw = F.bid * NWAVES + F.wave, NGW = F.G * NWAVES;
    struct In { u32x2 hs[4], af[4], ab[4]; float cf[4], cbk[4]; u32x4 g0, g1; };
    auto issue = [&](int item, In& I) {
        const int m = item & (MB - 1), task = item >> 2, h = task & 15, chunk = (task >> 4) & (NCH - 1), b = task >> 11;
#pragma unroll
        for (int n = 0; n < 4; ++n) { const size_t fo = ((size_t)item * 4 + n) * 64 + lane; I.hs[n] = HS[fo]; I.af[n] = AF[fo]; I.ab[n] = AB[fo];
            const int c = 64 * h + 16 * n + j; I.cf[n] = CARRY[((size_t)(0 * NB + b) * NCH + chunk) * 1024 + c]; I.cbk[n] = CARRY[((size_t)(1 * NB + b) * NCH + chunk) * 1024 + c]; }
        const size_t o = ((size_t)b * L + chunk * TC + 16 * m + tk) * 1024 + 64 * h + 16 * cg;
        I.g0 = *(const u32x4*)(P1 + o); I.g1 = *(const u32x4*)(P1 + o + 8); };
    auto finish = [&](int item, const In& I) {
        const int m = item & (MB - 1), task = item >> 2, h = task & 15, chunk = (task >> 4) & (NCH - 1), b = task >> 11;
#pragma unroll
        for (int n = 0; n < 4; ++n) {
            const float h0 = __uint_as_float(I.hs[n].x << 16) + __uint_as_float(I.af[n].x << 16) * I.cf[n] + __uint_as_float(I.ab[n].x << 16) * I.cbk[n];
            const float h1 = __uint_as_float(I.hs[n].x & 0xffff0000u) + __uint_as_float(I.af[n].x & 0xffff0000u) * I.cf[n] + __uint_as_float(I.ab[n].x & 0xffff0000u) * I.cbk[n];
            const float h2 = __uint_as_float(I.hs[n].y << 16) + __uint_as_float(I.af[n].y << 16) * I.cf[n] + __uint_as_float(I.ab[n].y << 16) * I.cbk[n];
            const float h3 = __uint_as_float(I.hs[n].y & 0xffff0000u) + __uint_as_float(I.af[n].y & 0xffff0000u) * I.cf[n] + __uint_as_float(I.ab[n].y & 0xffff0000u) * I.cbk[n];
            buf[(4 * q + 0) * 68 + 16 * n + j] = h0; buf[(4 * q + 1) * 68 + 16 * n + j] = h1; buf[(4 * q + 2) * 68 + 16 * n + j] = h2; buf[(4 * q + 3) * 68 + 16 * n + j] = h3;
        }
        LDS_WAIT();
        const size_t o = ((size_t)b * L + chunk * TC + 16 * m + tk) * 1024 + 64 * h + 16 * cg;
        const LAS f32x4* br = (const LAS f32x4*)(buf + tk * 68 + 16 * cg);
        const f32x4 v0 = br[0], v1 = br[1], v2 = br[2], v3 = br[3];
        float gg[16];
        { const unsigned w[8] = {I.g0.x, I.g0.y, I.g0.z, I.g0.w, I.g1.x, I.g1.y, I.g1.z, I.g1.w};
#pragma unroll
          for (int i = 0; i < 8; ++i) { gg[2 * i] = gelu_tanh(__uint_as_float(w[i] << 16)); gg[2 * i + 1] = gelu_tanh(__uint_as_float(w[i] & 0xffff0000u)); } }
        u32x4 y0, y1;
        y0.x = pk2(v0.x * gg[0], v0.y * gg[1]); y0.y = pk2(v0.z * gg[2], v0.w * gg[3]); y0.z = pk2(v1.x * gg[4], v1.y * gg[5]); y0.w = pk2(v1.z * gg[6], v1.w * gg[7]);
        y1.x = pk2(v2.x * gg[8], v2.y * gg[9]); y1.y = pk2(v2.z * gg[10], v2.w * gg[11]); y1.z = pk2(v3.x * gg[12], v3.y * gg[13]); y1.w = pk2(v3.z * gg[14], v3.w * gg[15]);
        *(u32x4*)(YLRU + o) = y0; *(u32x4*)(YLRU + o + 8) = y1;
        LDS_WAIT(); };
    constexpr int NIT = NB * NCH * 16 * MB;
    In A, B; int item = gw;
    if (item < NIT) issue(item, A);
#pragma unroll 1
    for (; item < NIT; item += 2 * NGW) {
        if (item + NGW < NIT) issue(item + NGW, B);
        finish(item, A);
        if (item + NGW >= NIT) break;
        if (item + 2 * NGW < NIT) issue(item + 2 * NGW, A);
        finish(item + NGW, B);
    }
}
__device__ __forceinline__ void carry(Frame& F) {
    const f32x2* SUMM = (const f32x2*)(F.ws + WS_SUMM); float* CARRY = (float*)(F.ws + WS_CARRY);
    for (int idx = F.bid * NTHREADS + F.tid; idx < 2 * NB * 1024; idx += F.G * NTHREADS) {
        const int c = idx & 1023, db = idx >> 10, dir = db >> 2; const size_t base = (size_t)db * NCH * 1024 + c;
        float C = 0.f;
#pragma unroll 1
        for (int k0 = 0; k0 < NCH; k0 += 16) {
            f32x2 v[16];
#pragma unroll
            for (int i = 0; i < 16; ++i) { const int k = dir == 0 ? (k0 + i) : (NCH - 1 - k0 - i); v[i] = SUMM[base + (size_t)k * 1024]; }
#pragma unroll
            for (int i = 0; i < 16; ++i) { const int k = dir == 0 ? (k0 + i) : (NCH - 1 - k0 - i); CARRY[base + (size_t)k * 1024] = C; C = v[i].x * C + v[i].y; }
        }
    }
}
}
__device__ __forceinline__ void transpose_item(const float* __restrict__ W, int ldw, int k0, int n0, bf16_t* __restrict__ WT, size_t orow0, const float* __restrict__ kscale, LAS float* scr, int lane) {
    const int r8 = lane >> 3, c4 = (lane & 7) * 4;
#pragma unroll
    for (int i = 0; i < 8; ++i) { const int kk = 8 * i + r8; f32x4 v = *(const f32x4*)(W + (size_t)(k0 + kk) * ldw + n0 + c4);
        if (kscale) { const float s = kscale[k0 + kk]; v = v * s; }
        scr[kk * 33 + c4 + 0] = v.x; scr[kk * 33 + c4 + 1] = v.y; scr[kk * 33 + c4 + 2] = v.z; scr[kk * 33 + c4 + 3] = v.w; }
    LDS_WAIT();
    const int c = lane & 7;
#pragma unroll
    for (int j = 0; j < 4; ++j) { const int n = (lane >> 3) + 8 * j; const LAS float* s = scr + (8 * c) * 33 + n;
        u32x4 o; o.x = pk2(s[0 * 33], s[1 * 33]); o.y = pk2(s[2 * 33], s[3 * 33]); o.z = pk2(s[4 * 33], s[5 * 33]); o.w = pk2(s[6 * 33], s[7 * 33]);
        *(u32x4*)(WT + (orow0 + n) * 1024 + k0 + 8 * c) = o; }
    LDS_WAIT();
}

__device__ __forceinline__ void phase_prep(Frame& F) {
    LAS float* scr = (LAS float*)(F.lds + F.wave * 16384);
    const int gw = F.bid * NWAVES + F.wave, NGW = F.G * NWAVES;
    constexpr int I_IN = (1024 / 64) * (NIN / 32), I_SQ = (1024 / 64) * (1024 / 32);
    for (int it = gw; it < I_IN + 3 * I_SQ; it += NGW) {
        int r = it; const float* W; int N; bf16_t* WT;
        if (r < I_IN) { W = F.in[2]; N = NIN; WT = (bf16_t*)(F.ws + WS_WIN); }
        else { r -= I_IN; const int q = r / I_SQ; r -= q * I_SQ; N = 1024; W = q == 0 ? F.in[11] : q == 1 ? F.in[23] : F.in[24]; WT = (bf16_t*)(F.ws + (q == 0 ? WS_WLRU : q == 1 ? WS_WHY : WS_WOUT)); }
        const int nblk = N / 32, kb = r / nblk, nb = r % nblk;
        int orow = 32 * nb;
        if (N == NIN && orow >= 5120) { const int which = (orow - 5120) >> 10, cc = (orow - 5120) & 1023; orow = 5120 + 256 * (cc >> 7) + 128 * which + (cc & 127); }
        transpose_item(W, N, 64 * kb, 32 * nb, WT, (size_t)orow, nullptr, scr, F.lane);
    }
    { const float* x = F.in[0]; const float* g = F.in[1]; bf16_t* U = (bf16_t*)(F.ws + WS_U);
      f32x4 gg[4];
#pragma unroll
      for (int j = 0; j < 4; ++j) gg[j] = ((const f32x4*)g)[F.lane + 64 * j];
      auto ld = [&](int row, f32x4 (&v)[4]) { const f32x4* xr = (const f32x4*)(x + (size_t)row * D) + F.lane;
#pragma unroll
          for (int j = 0; j < 4; ++j) v[j] = xr[64 * j]; };
      auto fin = [&](int row, const f32x4 (&v)[4]) { float s = 0.f;
#pragma unroll
          for (int j = 0; j < 4; ++j) s += v[j].x * v[j].x + v[j].y * v[j].y + v[j].z * v[j].z + v[j].w * v[j].w;
          const float rstd = rsqrtf(wave_sum(s) * (1.0f / D) + EPS);
#pragma unroll
          for (int j = 0; j < 4; ++j) { u32x2 w; w.x = pk2(v[j].x * rstd * gg[j].x, v[j].y * rstd * gg[j].y); w.y = pk2(v[j].z * rstd * gg[j].z, v[j].w * rstd * gg[j].w);
              ((u32x2*)(U + (size_t)row * D))[F.lane + 64 * j] = w; } };
      f32x4 va[4], vb[4], vc[4]; int row = gw;
      if (row < T) ld(row, va);
      if (row + NGW < T) ld(row + NGW, vb);
#pragma unroll 1
      for (; row < T; row += 3 * NGW) {
          if (row + 2 * NGW < T) ld(row + 2 * NGW, vc);
          fin(row, va);
          if (row + NGW >= T) break;
          if (row + 3 * NGW < T) ld(row + 3 * NGW, va);
          fin(row + NGW, vb);
          if (row + 2 * NGW >= T) break;
          if (row + 4 * NGW < T) ld(row + 4 * NGW, vb);
          fin(row + 2 * NGW, vc);
      } }
    { const float *w1 = F.in[14], *b1 = F.in[15], *w2 = F.in[16], *b2 = F.in[17], *w3 = F.in[18], *b3 = F.in[19], *freq = F.in[21]; float* HH3 = (float*)(F.ws + WS_HH3);
      LAS float* feat = scr; LAS float* h1 = scr + 64; LAS float* h2 = scr + 128; const int u = F.lane; const float fr = freq[u];
#pragma unroll 1
      for (int t = gw; t < L; t += NGW) {
        asm volatile("" ::: "memory");
        if (u < HYEMB) { float f; if (u == 0) f = (float)t / (float)(L - 1);
            else { const int j = (u - 1) & 15; const float band = 1e-4f + (float)j * ((15.0f - 1e-4f) / 15.0f); const float arg = (6.283185307179586f * (float)t / (float)L) * band; f = (u <= 16) ? cosf(arg) : -sinf(arg); }
            feat[u] = f; }
        LDS_WAIT();
        float s = b1[u];
#pragma unroll 1
        for (int f = 0; f < HYEMB; ++f) s += feat[f] * w1[f * 64 + u];
        h1[u] = sinf(fr * s); LDS_WAIT();
        s = b2[u];
#pragma unroll 4
        for (int f = 0; f < 64; ++f) s += h1[f] * w2[f * 64 + u];
        h2[u] = sinf(fr * s); LDS_WAIT();
        s = b3[u];
#pragma unroll 4
        for (int f = 0; f < 64; ++f) s += h2[f] * w3[f * 64 + u];
        HH3[t * 64 + u] = sinf(fr * s); LDS_WAIT(); } }
    lru::prep_wfrag(F); hy::prep_w4frag(F);
    { u32x4* WRGF = (u32x4*)(F.ws + WS_WRG); const float* g = F.in[25]; const float* wr = F.in[26];
      for (int idx = F.bid * NTHREADS + F.tid; idx < 32 * 2 * 2 * 64; idx += F.G * NTHREADS) {
          const int lane = idx & 63, part = (idx >> 6) & 1, tile = (idx >> 7) & 1, s = idx >> 8; const int e = 16 * tile + (lane & 15), k0 = 32 * s + 8 * (lane >> 4);
          float w[8];
#pragma unroll
          for (int jj = 0; jj < 8; ++jj) { const float v = g[k0 + jj] * wr[(k0 + jj) * 32 + e]; const float hi = __uint_as_float(pk2(v, v) << 16); w[jj] = part == 0 ? hi : v - hi; }
          u32x4 o; o.x = pk2(w[0], w[1]); o.y = pk2(w[2], w[3]); o.z = pk2(w[4], w[5]); o.w = pk2(w[6], w[7]); WRGF[idx] = o; } }
}

template <int KIND, bool DYN> __device__ __forceinline__ void convert_weights(Frame& F, int rank, int nranks, int rnd_lo = 0, int rnd_hi = 1 << 20) {
    LAS float* scr = (LAS float*)(F.lds + F.wave * 16384);
    const int gw = rank * NWAVES + F.wave, NGW = nranks * NWAVES;
    constexpr int IPE = KIND == 0 ? (1024 / 64) * (2048 / 32) : (1024 / 64) * (1024 / 32), TOTAL_ALL = NE * IPE;
    const int TOTAL = (long)rnd_hi * NGW < (long)TOTAL_ALL ? rnd_hi * NGW : TOTAL_ALL;
    int* ctr = (int*)(F.ws + WS_CTL) + 130;
    auto claim = [&]() { int v = 0; if (DYN && F.lane == 0) v = atomicAdd(ctr, 1); return v; };
    const float* Wc = nullptr; bf16_t* WTc = nullptr; size_t orowc = 0; int k0c = 0; f32x4 vc[8];
    auto decode_load = [&](int it, const float*& W, bf16_t*& WT, size_t& orow, int& k0, f32x4 (&v)[8]) {
        const int e = it / IPE, r = it - e * IPE; int ldw, n0;
        if (KIND == 0) { const int kb = r / 64, nb = r % 64; n0 = 32 * nb; const int which = n0 >> 10, pn = (n0 & 1023) >> 7, j0 = n0 & 127;
            W = F.in[28] + (size_t)e * 1024 * 2048; ldw = 2048; k0 = 64 * kb; WT = (bf16_t*)(F.ws + WS_WGU); orow = (size_t)e * 2048 + 256 * pn + 128 * which + j0; }
        else { const int kb = r / 32, nb = r % 32; n0 = 32 * nb;
            W = F.in[30] + (size_t)e * 1024 * 1024; ldw = 1024; k0 = 64 * kb; WT = (bf16_t*)(F.ws + WS_WDN); orow = (size_t)e * 1024 + 32 * nb; }
        const int r8 = F.lane >> 3, c4 = (F.lane & 7) * 4;
#pragma unroll
        for (int i = 0; i < 8; ++i) { const int kk = 8 * i + r8; v[i] = *(const f32x4*)(W + (size_t)(k0 + kk) * ldw + n0 + c4); if (KIND == 0) v[i] = v[i] * F.in[25][k0 + kk]; }
    };
    int it, itn, raw2 = 0;
    if (DYN) { const int r0 = claim(), r1 = claim(); raw2 = claim(); it = __builtin_amdgcn_readfirstlane(r0); itn = __builtin_amdgcn_readfirstlane(r1); }
    else { it = rnd_lo * NGW + gw; itn = it + NGW; }
    if (it < TOTAL) decode_load(it, Wc, WTc, orowc, k0c, vc);
#pragma unroll 1
    while (it < TOTAL) {
        const float* Wn = nullptr; bf16_t* WTn = nullptr; size_t orown = 0; int k0n = 0; f32x4 vn[8];
        const bool more = itn < TOTAL;
        if (more) decode_load(itn, Wn, WTn, orown, k0n, vn);
        { const int r8 = F.lane >> 3, c4 = (F.lane & 7) * 4;
#pragma unroll
          for (int i = 0; i < 8; ++i) { const int kk = 8 * i + r8; scr[kk * 33 + c4 + 0] = vc[i].x; scr[kk * 33 + c4 + 1] = vc[i].y; scr[kk * 33 + c4 + 2] = vc[i].z; scr[kk * 33 + c4 + 3] = vc[i].w; }
          LDS_WAIT();
          const int c = F.lane & 7;
#pragma unroll
          for (int j = 0; j < 4; ++j) { const int n = (F.lane >> 3) + 8 * j; const LAS float* s = scr + (8 * c) * 33 + n;
              u32x4 o; o.x = pk2(s[0 * 33], s[1 * 33]); o.y = pk2(s[2 * 33], s[3 * 33]); o.z = pk2(s[4 * 33], s[5 * 33]); o.w = pk2(s[6 * 33], s[7 * 33]);
              *(u32x4*)(WTc + (orowc + n) * 1024 + k0c + 8 * c) = o; }
          LDS_WAIT(); }
        if (more) { Wc = Wn; WTc = WTn; orowc = orown; k0c = k0n;
#pragma unroll
            for (int i = 0; i < 8; ++i) vc[i] = vn[i]; }
        it = itn;
        if (DYN) { itn = __builtin_amdgcn_readfirstlane(raw2); raw2 = claim(); } else itn += NGW;
    }
}
__device__ __forceinline__ void phase_router_a(Frame& F) {
#ifdef MIXDESYNC
    convert_weights<0, false>(F, F.bid, F.G, 2 * MIXDESYNC); convert_weights<1, false>(F, F.bid, F.G);
#else
    REP(11) { convert_weights<0, false>(F, F.bid, F.G); convert_weights<1, false>(F, F.bid, F.G); }
#endif
    __syncthreads();
    { const f32x4* src = (const f32x4*)(F.ws + WS_WRG); LAS f32x4* dst = (LAS f32x4*)F.lds;
      for (int i = F.tid; i < 32 * 2 * 2 * 64; i += NTHREADS) dst[i] = src[i]; }
    LAS int* hist = (LAS int*)(F.lds + MISC_OFF);
    if (F.tid < 32) hist[F.tid] = 0;
    __syncthreads();
    const LAS u32x4* wl = (const LAS u32x4*)F.lds + F.lane;
    const bf16_t* HB = (const bf16_t*)(F.ws + WS_HN); const float* br = F.in[27];
    int* EROWTOK = (int*)(F.ws + WS_EROWTOK); float* EROWRS = (float*)(F.ws + WS_EROWRS); float* EROWGATE = (float*)(F.ws + WS_EROWGATE); int* TOKCODE = (int*)(F.ws + WS_TOKROW); LAS int* base = hist + 32;
    for (int g0 = 0; g0 < T / 16; g0 += F.G * NWAVES) {
        const int grp = g0 + F.bid * NWAVES + F.wave; const bool act = grp < T / 16;
        int te_[4] = {0, 0, 0, 0}, lr_[4] = {0, 0, 0, 0}; float gt_[4] = {0.f, 0.f, 0.f, 0.f}, rs_ = 0.f;
        const int n = F.lane & 15, g = F.lane >> 4; const int t = grp * 16 + n;
        if (act) {
        const u32x4* hp = (const u32x4*)(HB + (size_t)t * D + 8 * g);
        f32x4 acc[2] = {(f32x4){0.f, 0.f, 0.f, 0.f}, (f32x4){0.f, 0.f, 0.f, 0.f}}; f32x2 ss2 = (f32x2){0.f, 0.f};
        u32x4 hb[8];
#pragma unroll
        for (int u = 0; u < 8; ++u) hb[u] = hp[u * 4];
#pragma unroll 1
        for (int s0 = 0; s0 < 32; s0 += 8) {
#pragma unroll
            for (int u = 0; u < 8; ++u) { const int s = s0 + u; const u32x4 cur = hb[u];
                if (s0 + 8 < 32) hb[u] = hp[(s + 8) * 4];
                const bf16x8 bfr = __builtin_bit_cast(bf16x8, cur);
#pragma unroll
                for (int tile = 0; tile < 2; ++tile) {
                    acc[tile] = __builtin_amdgcn_mfma_f32_16x16x32_bf16(__builtin_bit_cast(bf16x8, wl[((s * 2 + tile) * 2 + 0) * 64]), bfr, acc[tile], 0, 0, 0);
                    acc[tile] = __builtin_amdgcn_mfma_f32_16x16x32_bf16(__builtin_bit_cast(bf16x8, wl[((s * 2 + tile) * 2 + 1) * 64]), bfr, acc[tile], 0, 0, 0); }
                const f32x2 a = (f32x2){__uint_as_float(cur.x << 16), __uint_as_float(cur.x & 0xffff0000u)}, b = (f32x2){__uint_as_float(cur.y << 16), __uint_as_float(cur.y & 0xffff0000u)};
                const f32x2 c = (f32x2){__uint_as_float(cur.z << 16), __uint_as_float(cur.z & 0xffff0000u)}, d = (f32x2){__uint_as_float(cur.w << 16), __uint_as_float(cur.w & 0xffff0000u)};
                ss2 += a * a; ss2 += b * b; ss2 += c * c; ss2 += d * d; }
        }
        float ss = ss2.x + ss2.y; ss += __shfl_xor(ss, 16); ss += __shfl_xor(ss, 32);
        const float rstd = rsqrtf(ss * (1.0f / D) + EPS);
        float v[8];
#pragma unroll
        for (int q = 0; q < 8; ++q) v[q] = acc[q >> 2][q & 3] * rstd + br[16 * (q >> 2) + 4 * g + (q & 3)];
        float tv[4]; int te[4];
#pragma unroll
        for (int k = 0; k < 4; ++k) {
            float mx = -3.0e38f; int mi = 0;
#pragma unroll
            for (int q = 0; q < 8; ++q) { const int ex = 16 * (q >> 2) + 4 * g + (q & 3); if (v[q] > mx) { mx = v[q]; mi = ex; } }
#pragma unroll
            for (int o = 16; o <= 32; o <<= 1) { const float om = __shfl_xor(mx, o); const int oi = __shfl_xor(mi, o); if (om > mx || (om == mx && oi < mi)) { mx = om; mi = oi; } }
            tv[k] = mx; te[k] = mi;
#pragma unroll
            for (int q = 0; q < 8; ++q) { const int ex = 16 * (q >> 2) + 4 * g + (q & 3); if (ex == mi) v[q] = -3.0e38f; }
        }
        const float e1 = __expf(tv[1] - tv[0]), e2 = __expf(tv[2] - tv[0]), e3 = __expf(tv[3] - tv[0]); const float inv = 1.0f / (1.0f + e1 + e2 + e3);
        if (g == 0) {
            gt_[0] = inv; gt_[1] = e1 * inv; gt_[2] = e2 * inv; gt_[3] = e3 * inv; rs_ = rstd;
#pragma unroll
            for (int k = 0; k < 4; ++k) { te_[k] = te[k]; lr_[k] = atomicAdd((int*)&hist[te[k]], 1); }
        }
        }
        __syncthreads();
        if (F.tid < 32) base[F.tid] = hist[F.tid] != 0 ? atomicAdd((int*)(F.ws + WS_CTL) + F.tid, hist[F.tid]) : 0;
        __syncthreads();
        if (act && g == 0) { int code[4];
#pragma unroll
            for (int k = 0; k < 4; ++k) { const int e = te_[k], pos = base[e] + lr_[k]; const size_t o = (size_t)e * T + pos;
                EROWTOK[o] = t; EROWRS[o] = rs_; EROWGATE[o] = gt_[k]; code[k] = (e << 15) | pos; }
            *(int4*)(TOKCODE + t * 4) = make_int4(code[0], code[1], code[2], code[3]); }
        __syncthreads();
        if (F.tid < 32) hist[F.tid] = 0;
        __syncthreads();
    }
}
__device__ __forceinline__ const LAS int* build_ptile(Frame& F) {
    LAS int* pt = (LAS int*)(F.lds + MISC_OFF + 256);
    __syncthreads();
    if (F.tid == 0) { const int* cnt = (const int*)(F.ws + WS_CTL); int o = 0; for (int e = 0; e < 32; ++e) { pt[e] = o; o += (cnt[e] + 255) >> 8; } pt[32] = o; }
    __syncthreads();
    return pt;
}
__device__ __forceinline__ void phase_router_b(Frame& F) {
    const LAS int* pt = build_ptile(F);
    LAS int* hist = (LAS int*)(F.lds + MISC_OFF); LAS int* base = hist + 32;
    const int* TOPE = (const int*)(F.ws + WS_TOPE); const float* TOPG = (const float*)(F.ws + WS_TOPG); const float* TOKRS = (const float*)(F.ws + WS_TOKRS);
    int* ROWTOK = (int*)(F.ws + WS_ROWTOK); float* ROWGATE = (float*)(F.ws + WS_ROWGATE); float* ROWRS = (float*)(F.ws + WS_ROWRS); int* TOKROW = (int*)(F.ws + WS_TOKROW);
    int* cursor = (int*)(F.ws + WS_CTL) + 64; const int* cnt = (const int*)(F.ws + WS_CTL);
    for (int chunk = F.bid; chunk < T * 4 / NTHREADS; chunk += F.G) {
        __syncthreads();
        if (F.tid < 32) hist[F.tid] = 0;
        __syncthreads();
        const int idx = chunk * NTHREADS + F.tid; const int e = TOPE[idx]; const int lr = atomicAdd((int*)&hist[e], 1);
        __syncthreads();
        if (F.tid < 32) base[F.tid] = hist[F.tid] ? atomicAdd(cursor + F.tid, hist[F.tid]) : 0;
        __syncthreads();
        const int row = pt[e] * 256 + base[e] + lr;
        ROWTOK[row] = idx >> 2; ROWGATE[row] = TOPG[idx]; ROWRS[row] = TOKRS[idx >> 2]; TOKROW[idx] = row;
    }
    if (F.bid == 0) for (int e = F.wave; e < 32; e += NWAVES) { const int r0 = pt[e] * 256 + cnt[e], r1 = pt[e + 1] * 256; for (int r = r0 + F.lane; r < r1; r += 64) { ROWTOK[r] = 0; ROWGATE[r] = 0.f; ROWRS[r] = 0.f; } }
}
__device__ __forceinline__ void phase_final(Frame& F) {
    const int gw = F.bid * NWAVES + F.wave, NGW = F.G * NWAVES;
    float* out = F.out; const bf16_t* HB = (const bf16_t*)(F.ws + WS_HN); const bf16_t* YS = (const bf16_t*)(F.ws + WS_YS); const int* TOKROW = (const int*)(F.ws + WS_TOKROW); const float* g = F.in[32];
    const LAS int* pt = build_ptile(F);
    auto issue = [&](int t, const int4 rows, u32x2 (&d)[5][4]) {
#pragma unroll
        for (int j = 0; j < 4; ++j) d[0][j] = ((const u32x2*)(HB + (size_t)t * D))[F.lane + 64 * j];
#pragma unroll
        for (int k = 0; k < 4; ++k) { const int code = k == 0 ? rows.x : k == 1 ? rows.y : k == 2 ? rows.z : rows.w; const size_t row = (size_t)(pt[code >> 15] * 256 + (code & 32767));
#pragma unroll
            for (int j = 0; j < 4; ++j) d[1 + k][j] = ((const u32x2*)(YS + row * D))[F.lane + 64 * j]; } };
    auto finish = [&](int t, const u32x2 (&d)[5][4]) {
        f32x4 v[4];
#pragma unroll
        for (int j = 0; j < 4; ++j) { v[j] = (f32x4){__uint_as_float(d[0][j].x << 16), __uint_as_float(d[0][j].x & 0xffff0000u), __uint_as_float(d[0][j].y << 16), __uint_as_float(d[0][j].y & 0xffff0000u)};
#pragma unroll
            for (int k = 1; k < 5; ++k) { const u32x2 w = d[k][j];
                v[j].x += __uint_as_float(w.x << 16); v[j].y += __uint_as_float(w.x & 0xffff0000u); v[j].z += __uint_as_float(w.y << 16); v[j].w += __uint_as_float(w.y & 0xffff0000u); } }
        float s = 0.f;
#pragma unroll
        for (int j = 0; j < 4; ++j) s += v[j].x * v[j].x + v[j].y * v[j].y + v[j].z * v[j].z + v[j].w * v[j].w;
        const float rstd = rsqrtf(wave_sum(s) * (1.0f / D) + EPS);
#pragma unroll
        for (int j = 0; j < 4; ++j) { const f32x4 gg = ((const f32x4*)g)[F.lane + 64 * j];
            ((f32x4*)(out + (size_t)t * D))[F.lane + 64 * j] = (f32x4){v[j].x * rstd * gg.x, v[j].y * rstd * gg.y, v[j].z * rstd * gg.z, v[j].w * rstd * gg.w}; } };
    int t = gw;
    int4 rowsA = make_int4(0, 0, 0, 0), rowsB = make_int4(0, 0, 0, 0); u32x2 dA[5][4], dB[5][4];
    if (t < T) rowsA = *(const int4*)(TOKROW + t * 4);
    if (t + NGW < T) rowsB = *(const int4*)(TOKROW + (t + NGW) * 4);
    if (t < T) issue(t, rowsA, dA);
#pragma unroll 1
    for (; t < T; t += 2 * NGW) {
        const int t1 = t + NGW, t2 = t + 2 * NGW, t3 = t + 3 * NGW;
        if (t2 < T) rowsA = *(const int4*)(TOKROW + t2 * 4);
        if (t1 < T) issue(t1, rowsB, dB);
        finish(t, dA);
        if (t1 >= T) break;
        if (t3 < T) rowsB = *(const int4*)(TOKROW + t3 * 4);
        if (t2 < T) issue(t2, rowsA, dA);
        finish(t1, dB);
    }
}

__global__ void __launch_bounds__(NTHREADS, 2) mega(Args args) {
    extern __shared__ __attribute__((aligned(16))) unsigned char lds_raw[];
    cg::grid_group grid = cg::this_grid();
    Frame F; F.lds = (LAS unsigned char*)lds_raw; F.tid = threadIdx.x; F.lane = F.tid & 63; F.wave = __builtin_amdgcn_readfirstlane(F.tid >> 6); F.G = gridDim.x; F.bid = blockIdx.x;
    F.in = args.in; F.out = args.out; F.ws = args.ws;
    const int lo = args.ph_lo, hi = args.ph_hi;
    if (F.tid < 2) ((LAS unsigned*)(F.lds + MISC_OFF + 512))[F.tid] = 0u;
    __syncthreads();
    (void)xcd_barrier_post((unsigned*)(args.ws + WS_CTL + 16384) + args.li * XCD_BAR_WORDS, (volatile LAS unsigned*)(F.lds + MISC_OFF + 512));
#ifndef STAG1
#define STAG1 650
#endif
#define IN(k) (lo <= (k) && (k) < hi)
#define FRESH() do { size_t z_ = 0; F.tid = threadIdx.x; asm volatile("" : "+s"(z_), "+v"(F.tid)); F.ws = args.ws + z_; F.lane = F.tid & 63; ws = F.ws; } while (0)
#ifdef PROBE_PHASE
#define TS(k) do { if (blockIdx.x == 0 && threadIdx.x == 0) ((unsigned long long*)(args.ws + WS_CTL + 2048))[k] = __builtin_amdgcn_s_memrealtime(); } while (0)
#else
#define TS(k) do {} while (0)
#endif
#define SEAM(k) do { if (IN(k) && IN((k) + 1)) { if (hi > 1000) grid.sync();   else { XcdBarrier xb_; xb_.bar = (unsigned*)(args.ws + WS_CTL + 16384) + args.li * XCD_BAR_WORDS; xb_.x = xb_xcc_id(); xb_.st = (volatile LAS unsigned*)(F.lds + MISC_OFF + 512); xcd_barrier(xb_); if ((DUPMASK >> 21) & 1) xcd_barrier(xb_); } } } while (0)
    unsigned char* ws = args.ws;
    if (IN(0)) { TS(0); FRESH(); REP(0) phase_prep(F); } SEAM(0);
    if (IN(1)) { TS(1); FRESH();
        pg8::SchedDenseT<1> S; S.bias = args.in[3]; S.O.init(T / 256, NIN / 256, F.G, F.bid); S.A = (const char*)(ws + WS_U); S.B = (const char*)(ws + WS_WIN);
        pg8::EpiIn E{(bf16_t*)(ws + WS_P0), (bf16_t*)(ws + WS_P1), (bf16_t*)(ws + WS_PHY), (bf16_t*)(ws + WS_PG), args.in[3]};
#ifdef DESYNC1
        const int nbefore_ = DESYNC1 == 2 ? (((F.bid >> 3) & 1) ? 0 : 4) : DESYNC1 == 4 ? ((F.bid >> 3) & 3) : DESYNC1 == 3 ? 2 * ((F.bid >> 3) & 1) + 1 : 0;
        if (nbefore_ > 0) { hy::init_tw128(F); hy::filter_pass_a<false>(F, 0, nbefore_); __syncthreads(); }
#endif
        pg8::gemm_phase<pg8::EpiIn, pg8::SchedDenseT<1>, false>(F.lds, S, E); if ((DUPMASK >> 1) & 1) { pg8::gemm_phase<pg8::EpiIn, pg8::SchedDenseT<1>, false>(F.lds, S, E); } if ((DUPMASK >> 13) & 1) { pg8::EpiProbeStore E1{(bf16_t*)(ws + WS_YZ)}; pg8::gemm_phase<pg8::EpiProbeStore, pg8::SchedDenseT<1>, false>(F.lds, S, E1); } if ((DUPMASK >> 12) & 1) { pg8::EpiNone E0; pg8::gemm_phase<pg8::EpiNone, pg8::SchedDenseT<1>, false>(F.lds, S, E0); }
        if ((DUPMASK >> 18) & 1) { pg8::EpiNone E0; pg8::SchedDenseProbe SP; SP.O = S.O; SP.A = S.A; SP.B = S.B; pg8::gemm_phase<pg8::EpiNone, pg8::SchedDenseProbe, false>(F.lds, SP, E0); }
#ifdef DESYNC1
        if (nbefore_ < 4) { __syncthreads(); hy::init_tw128(F); hy::filter_pass_a<false>(F, nbefore_); }
#else
        hy::init_tw128(F); if ((DUPMASK >> 14) & 1) hy::filter_pass_a<true>(F); hy::filter_pass_a<false>(F);
#endif
    } SEAM(1);
#ifdef P2_ALTERNATE
    if (IN(2)) { TS(2); FRESH();
        const bool rev_ = ((F.bid >> 3) & 1) != 0;
        if (!rev_) { lru::stage1(F); __syncthreads(); hy::init_tw128(F); hy::filter_pass_b<false>(F); hy::prepass(F); }
        else { hy::prepass(F); __syncthreads(); FRESH(); hy::init_tw128(F); hy::filter_pass_b<false>(F); __syncthreads(); FRESH(); lru::stage1(F); }
    } SEAM(2);
#else
    if (IN(2)) { TS(2); FRESH(); REP(4) lru::stage1(F); __syncthreads(); hy::init_tw128(F); if ((DUPMASK >> 15) & 1) hy::filter_pass_b<true>(F); hy::filter_pass_b<false>(F); REP(2) hy::prepass(F); } SEAM(2);
#endif
    if (IN(3)) { TS(3); FRESH(); hy::init_tw128(F); REP(3) hy::data_pass_a(F); } SEAM(3);
    if (IN(4)) { TS(4); FRESH(); REP(16) lru::carry(F); hy::init_tw128(F); if ((DUPMASK >> 17) & 1) hy::data_pass_b<true>(F); hy::data_pass_b<false>(F); } SEAM(4);
#ifdef P5_ALTERNATE
    if (IN(5)) { TS(5); FRESH();
        if (((F.bid >> 3) & 1) == 0) { hy::init_tw128(F); hy::data_pass_c<false>(F); __syncthreads(); FRESH(); lru::stage2(F); }
        else { lru::stage2(F); __syncthreads(); FRESH(); hy::init_tw128(F); hy::data_pass_c<false>(F); }
    } SEAM(5);
#else
    if (IN(5)) { TS(5); FRESH(); hy::init_tw128(F); if ((DUPMASK >> 5) & 1) hy::data_pass_c<true>(F); hy::data_pass_c<false>(F); __syncthreads(); REP(6) lru::stage2(F); } SEAM(5);
#endif
    if (IN(6)) { TS(6); FRESH();
        pg8::SchedMix S; S.O.init(T / 256, D / 256, F.G, F.bid); S.A0 = (const char*)(ws + WS_YLRU); S.A1 = (const char*)(ws + WS_YHY); S.B0 = (const char*)(ws + WS_WLRU); S.B1 = (const char*)(ws + WS_WHY);
        pg8::EpiMix E{(const bf16_t*)(ws + WS_PG), (bf16_t*)(ws + WS_MIX)};
#ifdef MIXDESYNC
        const int cls_ = (F.bid >> 3) & 3; constexpr int RND_ = MIXDESYNC;
        if (cls_ > 0) { convert_weights<0, false>(F, F.bid, F.G, 0, RND_ * cls_ / 4); __syncthreads(); }
#endif
        pg8::gemm_phase<pg8::EpiMix, pg8::SchedMix, false>(F.lds, S, E); if ((DUPMASK >> 7) & 1) { pg8::gemm_phase<pg8::EpiMix, pg8::SchedMix, false>(F.lds, S, E); }
#ifdef MIXDESYNC
        __syncthreads(); convert_weights<0, false>(F, F.bid, F.G, RND_ * cls_ / 4, RND_);
#endif
    } SEAM(6);
    if (IN(7)) { TS(7); FRESH();
        pg8::SchedDenseT<0> S; S.bias = nullptr; S.O.init(T / 256, D / 256, F.G, F.bid); S.A = (const char*)(ws + WS_MIX); S.B = (const char*)(ws + WS_WOUT);
        pg8::EpiH E{args.in[0], (bf16_t*)(ws + WS_HN)};
        { u32x4* z = (u32x4*)(ws + WS_EROWTOK); const u32x4 z4 = (u32x4){0u, 0u, 0u, 0u};
          for (int i = F.bid * NTHREADS + F.tid; i < 3 * NE * T / 4; i += F.G * NTHREADS) z[i] = z4; }
#ifdef MIXDESYNC
        const int cls_ = (F.bid >> 3) & 3; constexpr int RND_ = MIXDESYNC; const int rrem_ = RND_;
        if (cls_ > 0) { convert_weights<0, false>(F, F.bid, F.G, RND_, RND_ + rrem_ * cls_ / 4); __syncthreads(); }
#endif
        pg8::gemm_phase<pg8::EpiH, pg8::SchedDenseT<0>, false>(F.lds, S, E); if ((DUPMASK >> 8) & 1) { pg8::gemm_phase<pg8::EpiH, pg8::SchedDenseT<0>, false>(F.lds, S, E); }
#ifdef MIXDESYNC
        __syncthreads(); convert_weights<0, false>(F, F.bid, F.G, RND_ + rrem_ * cls_ / 4, 2 * RND_);
#endif
    } SEAM(7);
    if (IN(8)) { TS(8); FRESH(); phase_router_a(F); } SEAM(8);
    if (IN(10)) { TS(10); FRESH();
        const LAS int* pt = build_ptile(F);
        pg8::SchedMoE<8, true> S{args.in[29], (const float*)(ws + WS_EROWRS), pt, F.G, F.bid, (const char*)(ws + WS_HN), (const char*)(ws + WS_WGU), (size_t)2048 * 1024 * 2, (const int*)(ws + WS_EROWTOK)};
        pg8::EpiGU E{args.in[29], (const float*)(ws + WS_ROWRS), (bf16_t*)(ws + WS_ACT)};
#ifdef DESYNC_GU
        { const int rounds_ = (pt[32] * 8 + F.G - 1) / F.G; pg8::Unit u_; if (!S.next(rounds_ - 1, u_)) stagger_delay(1, DESYNC_GU); }
#endif
        pg8::gemm_phase<pg8::EpiGU, pg8::SchedMoE<8, true>, true>(F.lds, S, E); if ((DUPMASK >> 9) & 1) { pg8::gemm_phase<pg8::EpiGU, pg8::SchedMoE<8, true>, true>(F.lds, S, E); }
        if ((DUPMASK >> 19) & 1) { pg8::EpiNone E0; pg8::gemm_phase<pg8::EpiNone, pg8::SchedMoE<8, true>, true>(F.lds, S, E0); }
    } SEAM(10);
    if (IN(11)) { TS(11); FRESH();
        const LAS int* pt = build_ptile(F);
        pg8::SchedMoE<4, false> S{args.in[31], (const float*)(ws + WS_EROWGATE), pt, F.G, F.bid, (const char*)(ws + WS_ACT), (const char*)(ws + WS_WDN), (size_t)1024 * 1024 * 2, nullptr};
        pg8::EpiDN E{args.in[31], (const float*)(ws + WS_ROWGATE), (bf16_t*)(ws + WS_YS)};
#ifdef DESYNC_DN
        { const int rounds_ = (pt[32] * 4 + F.G - 1) / F.G; pg8::Unit u_; if (!S.next(rounds_ - 1, u_)) stagger_delay(1, DESYNC_DN); }
#endif
        pg8::gemm_phase<pg8::EpiDN, pg8::SchedMoE<4, false>, false>(F.lds, S, E); if ((DUPMASK >> 10) & 1) { pg8::gemm_phase<pg8::EpiDN, pg8::SchedMoE<4, false>, false>(F.lds, S, E); }
        if ((DUPMASK >> 20) & 1) { pg8::EpiNone E0; pg8::gemm_phase<pg8::EpiNone, pg8::SchedMoE<4, false>, false>(F.lds, S, E0); }
    } SEAM(11);
    if (IN(12)) { TS(12); FRESH(); phase_final(F); }
#undef IN
#undef SEAM
}
static int g_grid = 0;
static void launch_mega(Args a, int lo, int hi, hipStream_t stream, int li = 0) {
    a.ph_lo = lo; a.ph_hi = hi; a.li = li; a.pad = 0; void* params[] = {&a};
    hipError_t e = hipLaunchCooperativeKernel((const void*)mega, dim3(g_grid), dim3(NTHREADS), params, LDS_BYTES, stream);
    if (e != hipSuccess) fprintf(stderr, "kernel_launch: cooperative launch [%d,%d) failed: %s (grid %d)\n", lo, hi, hipGetErrorString(e), g_grid);
}
extern "C" void kernel_launch(void* const* d_in, const int* in_sizes, int n_in, void* d_out, int out_size, void* d_ws, size_t ws_size, hipStream_t stream) {
    if (n_in != 33 || out_size != T * D || ws_size < WS_END) { fprintf(stderr, "kernel_launch: unexpected shapes n_in %d out %d ws %zu\n", n_in, out_size, ws_size); return; }
    if (g_grid == 0) {
        int dev = 0, cus = 0, per_cu = 0;
        (void)hipGetDevice(&dev); (void)hipDeviceGetAttribute(&cus, hipDeviceAttributeMultiprocessorCount, dev);
        if (hipFuncSetAttribute((const void*)mega, hipFuncAttributeMaxDynamicSharedMemorySize, LDS_BYTES) != hipSuccess) { fprintf(stderr, "kernel_launch: hipFuncSetAttribute failed\n"); g_grid = -1; return; }
        if (hipOccupancyMaxActiveBlocksPerMultiprocessor(&per_cu, (const void*)mega, NTHREADS, LDS_BYTES) != hipSuccess || per_cu < 1) { fprintf(stderr, "kernel_launch: occupancy query says %d\n", per_cu); g_grid = -1; return; }
        g_grid = cus;
    }
    if (g_grid < 0) return;
    const float* in[33]; for (int i = 0; i < 33; ++i) in[i] = (const float*)d_in[i];
    unsigned char* ws = (unsigned char*)d_ws; float* out = (float*)d_out;
    int* cnt = (int*)(ws + WS_CTL); float* NORM = (float*)(ws + WS_NORM); float* HH3 = (float*)(ws + WS_HH3);
    bf16_t* YLRU = (bf16_t*)(ws + WS_YLRU); bf16_t* HN = (bf16_t*)(ws + WS_HN); bf16_t* YHY = (bf16_t*)(ws + WS_YHY);
    bf16_t* PG = (bf16_t*)(ws + WS_PG); bf16_t* P0 = (bf16_t*)(ws + WS_P0); bf16_t* P1 = (bf16_t*)(ws + WS_P1); bf16_t* PHY = (bf16_t*)(ws + WS_PHY);
    bf16_t* MIX = (bf16_t*)(ws + WS_MIX); float* MIXF = (float*)(ws + WS_MIXF); bf16_t* ACT = (bf16_t*)(ws + WS_ACT); bf16_t* YS = (bf16_t*)(ws + WS_YS);
    float* XR = (float*)(ws + WS_XR); float* HF = (float*)(ws + WS_HF); float* KC = (float*)(ws + WS_KC);
    int* ROWTOK = (int*)(ws + WS_ROWTOK); float* ROWGATE = (float*)(ws + WS_ROWGATE); float* ROWRS = (float*)(ws + WS_ROWRS);
    (void)hipMemsetAsync(ws + WS_CTL, 0, CTL_BYTES, stream);
    Args a{}; for (int i = 0; i < 33; ++i) a.in[i] = in[i]; a.out = out; a.ws = ws;
    launch_mega(a, 0, 13, stream);
}
```

```cpp
#define DUPMASK 0x0
#define DESYNC1 4
#define DN_REVERSE 1
#define P2_ALTERNATE 1
#define YS_FP8 1
#include <hip/hip_runtime.h>
#include <hip/hip_cooperative_groups.h>
#include <cstdio>
#include <cstdint>
namespace cg = cooperative_groups;

typedef unsigned short bf16_t;
typedef float f32x4 __attribute__((ext_vector_type(4)));
typedef float f32x2 __attribute__((ext_vector_type(2)));
typedef unsigned u32x4 __attribute__((ext_vector_type(4)));
typedef unsigned u32x2 __attribute__((ext_vector_type(2)));
typedef short bf16x8 __attribute__((ext_vector_type(8)));

constexpr int T = 32768, D = 1024, L = 8192, NB = 4, NE = 32, TOPK = 4, NIN = 7168, L2X = 16384;
constexpr int HEADS = 16, HBLK = 64, HYFF = 64, HYEMB = 33;
constexpr int NPAD = T * TOPK + NE * 256;
constexpr float EPS = 1e-5f;

constexpr size_t MiB = 1u << 20;
constexpr size_t WS_CTL = 0;
constexpr size_t CTL_BYTES = 64 * 1024;
constexpr size_t WS_NORM = 4096;
constexpr size_t WS_HH3 = 2 * MiB;
constexpr size_t WS_WRG = 4 * MiB;
constexpr size_t WS_TOPE = 5 * MiB;
constexpr size_t WS_TOPG = 6 * MiB;
constexpr size_t WS_TOKRS = 7 * MiB;
constexpr size_t WS_ROWTOK = 8 * MiB;
constexpr size_t WS_ROWGATE = 9 * MiB;
constexpr size_t WS_ROWRS = 10 * MiB;
constexpr size_t WS_TOKROW = 11 * MiB;
constexpr size_t WS_WF4 = 14 * MiB;
constexpr size_t WS_NORMP = 15 * MiB;
constexpr size_t WS_EROWTOK = 164 * MiB, WS_EROWRS = 168 * MiB, WS_EROWGATE = 172 * MiB;
constexpr size_t WS_WLRUF = 13 * MiB;
constexpr size_t WS_SUMM = 996 * MiB;
constexpr size_t WS_CARRY = 1004 * MiB;
constexpr size_t WS_WIN = 16 * MiB;
constexpr size_t WS_WLRU = 30 * MiB, WS_WHY = 32 * MiB, WS_WOUT = 34 * MiB;
constexpr size_t WS_U = 36 * MiB;
constexpr size_t WS_Z16 = 36 * MiB, WS_HN = 36 * MiB;
constexpr size_t WS_YHY = 100 * MiB;
constexpr size_t WS_PG = 164 * MiB;
constexpr size_t WS_P0 = 292 * MiB;
constexpr size_t WS_P1 = 356 * MiB;
constexpr size_t WS_PHY = 420 * MiB;
constexpr size_t WS_MIX = 356 * MiB;
constexpr size_t WS_HS = 740 * MiB;
constexpr size_t WS_YLRU = 292 * MiB;
constexpr size_t WS_AF = 804 * MiB, WS_AB = 932 * MiB;
constexpr size_t WS_MIXF = 484 * MiB;
constexpr size_t WS_ACT = 292 * MiB;
constexpr size_t WS_R2 = 612 * MiB;
constexpr size_t WS_YZ = 612 * MiB;
constexpr size_t WS_KF = 868 * MiB;
constexpr size_t WS_WDN = 612 * MiB;
constexpr size_t WS_WGU = 676 * MiB;
constexpr size_t WS_YS = 676 * MiB;
constexpr size_t WS_XR = 612 * MiB;
constexpr size_t WS_HF = 740 * MiB;
constexpr size_t WS_KC = 868 * MiB;
constexpr size_t WS_END = 1024 * MiB;

__device__ __forceinline__ float bf2f(bf16_t b) { return __uint_as_float(((unsigned)b) << 16); }
__device__ __forceinline__ bf16_t f2bf(float f) { unsigned u = __float_as_uint(f); u += 0x7fffu + ((u >> 16) & 1u); return (bf16_t)(u >> 16); }
__device__ __forceinline__ unsigned pk2(float lo, float hi) { unsigned r; asm("v_cvt_pk_bf16_f32 %0, %1, %2" : "=v"(r) : "v"(lo), "v"(hi)); return r; }
__device__ __forceinline__ float fexp(float x) { return __builtin_amdgcn_exp2f(x * 1.4426950408889634f); }
__device__ __forceinline__ float sigmoidf_(float x) { return __builtin_amdgcn_rcpf(1.0f + fexp(-x)); }
__device__ __forceinline__ float gelu_tanh(float x) { const float u = 0.7978845608028654f * (x + 0.044715f * x * x * x); return x * sigmoidf_(2.0f * u); }
__device__ __forceinline__ float swiglu(float g, float u) { const float g_ = fminf(g, 7.0f); const float u_ = fminf(fmaxf(u, -7.0f), 7.0f); return (u_ + 1.0f) * (g_ * sigmoidf_(1.702f * g_)); }
__device__ __forceinline__ float wave_sum(float v) {
#pragma unroll
    for (int o = 1; o < 64; o <<= 1) v += __shfl_xor(v, o);
    return v;
}
__device__ __forceinline__ int expert_offpad(const int* cnt, int e) { int o = 0; for (int i = 0; i < e; ++i) o += (cnt[i] + 255) & ~255; return o; }
__device__ __forceinline__ float hy_delta_abs(int c) {
    const float lo = -4.605170185988091f / 1.5f, hi = -4.605170185988091f / 0.3f;
    return fabsf(lo + (hi - lo) * ((float)c / 1023.0f));
}
#define LAS __attribute__((address_space(3)))
constexpr int NWAVES = 8, NTHREADS = 512, LDS_BYTES = 147456, MISC_OFF = 131072;

namespace pg8 {
constexpr int BM = 256, BK = 64, HALF = 128, HTB = HALF * BK * 2, NXCD = 8, WGM = 8, KD = 1024;
__host__ __device__ __forceinline__ int lds_byte(int r, int c) { const int st = (r >> 4) * 2 + (c >> 5), rr = r & 15, cc = c & 31, ob = rr * 64 + cc * 2; return st * 1024 + (ob ^ (((ob >> 9) & 1) << 5)); }
__host__ __device__ __forceinline__ void stage_rc(int b, int& R, int& C) { const int st = b / 1024, sb = b % 1024, swz = sb ^ (((sb >> 9) & 1) << 5); R = (st >> 1) * 16 + swz / 64; C = (st & 1) * 32 + (swz % 64) / 2; }
__host__ __device__ __forceinline__ int perm32(int rho) { const int n = rho >> 4, i = rho & 15; return 8 * (i >> 2) + 4 * n + (i & 3); }

struct Unit { const char* A; const char* B; int pm, pn, e, gm; };

struct DenseOrder {
    int nM, nN, nwg, G, c;
    __device__ __forceinline__ void init(int nM_, int nN_, int G_, int c_) { nM = nM_; nN = nN_; nwg = nM * nN; G = G_; c = c_; }
    __device__ __forceinline__ bool tile(int i, int& pm, int& pn) const {
        const long Lx = (long)i * G + c; if (Lx >= nwg) return false;
        int wgid = (int)Lx; { const int q = nwg / NXCD, r = nwg % NXCD, xcd = wgid % NXCD, off = wgid / NXCD; wgid = (xcd < r ? xcd * (q + 1) : r * (q + 1) + (xcd - r) * q) + off; }
        const int nig = WGM * nN, gid = wgid / nig, fm = gid * WGM, gsz = (nM - fm) < WGM ? (nM - fm) : WGM;
        pm = fm + ((wgid % nig) % gsz); pn = (wgid % nig) / gsz; return true;
    }
};

__device__ __forceinline__ unsigned cvt_pk_bf16(float lo, float hi) { unsigned r; asm volatile("v_cvt_pk_bf16_f32 %0, %1, %2" : "=v"(r) : "v"(lo), "v"(hi)); return r; }

template <class Epi, class Sched, bool GATHER>
__device__ __forceinline__ void gemm_phase(LAS unsigned char* lds, const Sched& S, const Epi& E) {
    int tid_ = threadIdx.x; asm volatile("" : "+v"(tid_));
    const int tid = tid_, wid = __builtin_amdgcn_readfirstlane(tid >> 6), lane = tid & 63, wr = wid >> 2, wc = wid & 3, fr = lane & 15, fq = lane >> 4;
    constexpr int K = KD, nt = K / BK;
    int Rr[2], Cc[2]; unsigned voffB[2];
#pragma unroll
    for (int i = 0; i < 2; ++i) { int R, C; stage_rc(tid * 16 + i * 8192, R, C); Rr[i] = R; Cc[i] = C; const int Rb = (R & ~31) + perm32(R & 31); voffB[i] = (unsigned)(Rb * K + C) * 2u; }
    constexpr size_t kstep = (size_t)(BK * 2);
    constexpr size_t hstep = (size_t)HALF * K * 2;
    const unsigned ldsw = (unsigned)wid * 1024u;
    const int aoff = lds_byte(wr * 64 + fr, fq * 8), boff = lds_byte(wc * 32 + fr, fq * 8);
#define PG8_SA(b, h) (((b) * 2 + (h)) * HTB)
#define PG8_SB(b, h) ((4 + (b) * 2 + (h)) * HTB)
#define PG8_GLDS(gp, lp) __builtin_amdgcn_global_load_lds((const unsigned*)(gp), (LAS unsigned*)(lp), 16, 0, 0)
#define PG8_STAGEB(bufoff, gbase) do { PG8_GLDS((const char*)(gbase) + voffB[0], lds + (bufoff) + ldsw); PG8_GLDS((const char*)(gbase) + voffB[1], lds + (bufoff) + ldsw + 8192); } while (0)
#define PG8_STAGEA(bufoff, gbase, o0, o1) do { PG8_GLDS((const char*)(gbase) + (o0), lds + (bufoff) + ldsw); PG8_GLDS((const char*)(gbase) + (o1), lds + (bufoff) + ldsw + 8192); } while (0)
#define PG8_LDA(dst, b, h) do { _Pragma("unroll") for (int m = 0; m < 4; ++m) _Pragma("unroll") for (int k = 0; k < 2; ++k) dst[m][k] = *(const LAS bf16x8*)(lds + PG8_SA(b, h) + aoff + m * 2048 + k * 1024); } while (0)
#define PG8_LDB(dst, b, h) do { _Pragma("unroll") for (int n = 0; n < 2; ++n) _Pragma("unroll") for (int k = 0; k < 2; ++k) dst[n][k] = *(const LAS bf16x8*)(lds + PG8_SB(b, h) + boff + n * 2048 + k * 1024); } while (0)
#define PG8_MMA(ai, bj, At, Bt) do { __builtin_amdgcn_s_setprio(1); _Pragma("unroll") for (int m = 0; m < 4; ++m) _Pragma("unroll") for (int n = 0; n < 2; ++n) _Pragma("unroll") for (int k = 0; k < 2; ++k) \
        acc[ai][bj][m][n] = __builtin_amdgcn_mfma_f32_16x16x32_bf16(Bt[n][k], At[m][k], acc[ai][bj][m][n], 0, 0, 0); __builtin_amdgcn_s_setprio(0); } while (0)
#define PG8_WAIT_V(n) asm volatile("s_waitcnt vmcnt(" #n ")" ::: "memory")
#define PG8_WAIT_L(n) asm volatile("s_waitcnt lgkmcnt(" #n ")" ::: "memory")
#define PG8_WAIT_V8_UNLESS(flag) asm volatile("s_cmp_lg_u32 %0, 0\n\ts_cbranch_scc1 .Lskipw%=\n\ts_waitcnt vmcnt(8)\n.Lskipw%=:" :: "s"(flag) : "scc", "memory")
#define PG8_BAR __builtin_amdgcn_s_barrier()
#define PG8_SCHED __builtin_amdgcn_sched_barrier(0)
    Unit cur, nxt; int ui = 0;
    if (!S.next(0, cur)) return;
    LAS int* tokbuf = (LAS int*)(lds + MISC_OFF + 3072);
#define PG8_AOFF(par, h, i) (GATHER ? ((unsigned)tokbuf[(par) * 256 + (h) * HALF + Rr[i]] * (unsigned)(K * 2) + (unsigned)(Cc[i] * 2)) : ((unsigned)(Rr[i] * K + Cc[i]) * 2u + (unsigned)((h) * hstep)))
    LAS float* side = (LAS float*)(lds + MISC_OFF + 6144);
    if (GATHER || Sched::NSIDE > 0) {
        if (GATHER && tid < 256) tokbuf[tid] = S.ROWTOK_row(cur, tid);
        if (Sched::NSIDE > 0 && tid < 256 * Sched::NSIDE) side[tid] = *S.side_addr(cur, tid >> 8, tid & 255);
        asm volatile("s_waitcnt vmcnt(0) lgkmcnt(0)" ::: "memory"); __builtin_amdgcn_s_barrier(); }
    f32x4 acc[2][2][4][2];
#pragma unroll
    for (int a = 0; a < 2; ++a)
#pragma unroll
        for (int b = 0; b < 2; ++b)
#pragma unroll
            for (int m = 0; m < 4; ++m)
#pragma unroll
                for (int n = 0; n < 2; ++n) acc[a][b][m][n] = (f32x4){0.f, 0.f, 0.f, 0.f};
    bf16x8 At[4][2], B0[2][2], B1[2][2];
    const char* cA = cur.A; const char* cB = cur.B;
    PG8_STAGEB(PG8_SB(0, 0), cB); PG8_STAGEB(PG8_SB(0, 1), cB + hstep); PG8_STAGEA(PG8_SA(0, 0), cA, PG8_AOFF(0, 0, 0), PG8_AOFF(0, 0, 1)); PG8_STAGEA(PG8_SA(0, 1), cA, PG8_AOFF(0, 1, 0), PG8_AOFF(0, 1, 1));
    if (wr == 1) PG8_BAR;
    PG8_WAIT_V(2); PG8_BAR;
    PG8_STAGEB(PG8_SB(1, 0), cB + kstep); PG8_STAGEA(PG8_SA(1, 0), cA + kstep, PG8_AOFF(0, 0, 0), PG8_AOFF(0, 0, 1)); PG8_STAGEB(PG8_SB(1, 1), cB + hstep + kstep);
    PG8_WAIT_V(6); PG8_BAR;
    for (;;) {
        const bool has_next = S.next(ui + 1, nxt);
        const char* nA = has_next ? nxt.A : cA; const char* nB = has_next ? nxt.B : cB;
        const int pc = ui & 1, pn_ = has_next ? (pc ^ 1) : pc;
        if (Sched::NSIDE > 0 && has_next && wid < 4 * Sched::NSIDE) __builtin_amdgcn_global_load_lds((const unsigned*)S.side_addr(nxt, wid >> 2, (wid & 3) * 64 + lane), (LAS unsigned*)(side + ((ui + 1) % 3) * 512 + wid * 64), 4, 0, 0);
        if (GATHER && has_next && wid < 4) __builtin_amdgcn_global_load_lds((const unsigned*)(S.ROWTOK + S.rowoff(nxt) + wid * 64 + lane), (LAS unsigned*)(tokbuf + pn_ * 256 + wid * 64), 4, 0, 0);
        for (int t = 0; t < nt; t += 2) {
            const bool last = (t == nt - 2);
            const char* a1 = cA + (size_t)(t + 1) * kstep;
            const char* a2 = last ? nA : cA + (size_t)(t + 2) * kstep; const char* b2 = last ? nB : cB + (size_t)(t + 2) * kstep;
            const char* a3 = a2 + kstep; const char* b3 = b2 + kstep;
            const int px = last ? pn_ : pc;
            PG8_LDB(B0, 0, 0); PG8_LDB(B1, 0, 1); PG8_SCHED; PG8_LDA(At, 0, 0); PG8_STAGEA(PG8_SA(1, 1), a1, PG8_AOFF(pc, 1, 0), PG8_AOFF(pc, 1, 1));
            PG8_WAIT_V(8); PG8_WAIT_L(0); PG8_BAR; PG8_MMA(0, 0, At, B0); PG8_MMA(0, 1, At, B1); PG8_BAR; PG8_SCHED;
            PG8_LDA(At, 0, 1); PG8_STAGEB(PG8_SB(0, 0), b2); PG8_STAGEB(PG8_SB(0, 1), b2 + hstep); PG8_STAGEA(PG8_SA(0, 0), a2, PG8_AOFF(px, 0, 0), PG8_AOFF(px, 0, 1));
            PG8_WAIT_V(8); PG8_WAIT_L(0); PG8_BAR; PG8_MMA(1, 0, At, B0); PG8_MMA(1, 1, At, B1); PG8_BAR; PG8_SCHED;
            PG8_LDB(B0, 1, 0); PG8_LDB(B1, 1, 1); PG8_SCHED; PG8_LDA(At, 1, 0); PG8_STAGEA(PG8_SA(0, 1), a2, PG8_AOFF(px, 1, 0), PG8_AOFF(px, 1, 1));
            PG8_WAIT_V(8); PG8_WAIT_L(0); PG8_BAR; PG8_MMA(0, 0, At, B0); PG8_MMA(0, 1, At, B1); PG8_BAR; PG8_SCHED;
            PG8_LDA(At, 1, 1); PG8_STAGEB(PG8_SB(1, 0), b3); PG8_STAGEB(PG8_SB(1, 1), b3 + hstep); PG8_STAGEA(PG8_SA(1, 0), a3, PG8_AOFF(px, 0, 0), PG8_AOFF(px, 0, 1));
            PG8_WAIT_V(8); PG8_WAIT_L(0); PG8_BAR; PG8_MMA(1, 0, At, B0); PG8_MMA(1, 1, At, B1); PG8_BAR; PG8_SCHED;
        }
        if (wr == 0) PG8_BAR;
        bool keep = false;
        if constexpr (Epi::CHAIN) keep = E(acc, cur, wr, wc, fr, fq, (const LAS float*)(side + (ui % 3) * 512)); else E(acc, cur, wr, wc, fr, fq, (const LAS float*)(side + (ui % 3) * 512));
        if (!has_next) break;
        if (!keep) {
#pragma unroll
        for (int a = 0; a < 2; ++a)
#pragma unroll
            for (int b = 0; b < 2; ++b)
#pragma unroll
                for (int m = 0; m < 4; ++m)
#pragma unroll
                    for (int n = 0; n < 2; ++n) acc[a][b][m][n] = (f32x4){0.f, 0.f, 0.f, 0.f};
        }
        cur = nxt; cA = nA; cB = nB; ++ui;
        if (wr == 1) PG8_BAR;
    }
    PG8_WAIT_V(0);
    PG8_BAR;
#undef PG8_SA
#undef PG8_AOFF
#undef PG8_SB
#undef PG8_GLDS
#undef PG8_STAGEA
#undef PG8_STAGEB
#undef PG8_LDA
#undef PG8_LDB
#undef PG8_MMA
#undef PG8_WAIT_V
#undef PG8_WAIT_L
#undef PG8_WAIT_V8_UNLESS
#undef PG8_BAR
#undef PG8_SCHED
}

__device__ __forceinline__ void store8bf(bf16_t* p, const f32x4 v0, const f32x4 v1) {
    u32x4 w; w.x = cvt_pk_bf16(v0[0], v0[1]); w.y = cvt_pk_bf16(v0[2], v0[3]); w.z = cvt_pk_bf16(v1[0], v1[1]); w.w = cvt_pk_bf16(v1[2], v1[3]); *(u32x4*)p = w;
}
__device__ __forceinline__ void load8bf(const bf16_t* p, f32x4& v0, f32x4& v1) {
    const u32x4 w = *(const u32x4*)p;
    v0 = (f32x4){__uint_as_float(w.x << 16), __uint_as_float(w.x & 0xffff0000u), __uint_as_float(w.y << 16), __uint_as_float(w.y & 0xffff0000u)};
    v1 = (f32x4){__uint_as_float(w.z << 16), __uint_as_float(w.z & 0xffff0000u), __uint_as_float(w.w << 16), __uint_as_float(w.w & 0xffff0000u)};
}
__device__ __forceinline__ f32x2 lo2(const f32x4 v) { return (f32x2){v.x, v.y}; }
__device__ __forceinline__ f32x2 hi2(const f32x4 v) { return (f32x2){v.z, v.w}; }
__device__ __forceinline__ f32x2 sigmoid2(const f32x2 x) { const f32x2 t = x * -1.4426950408889634f; const f32x2 d = (f32x2){__builtin_amdgcn_exp2f(t.x), __builtin_amdgcn_exp2f(t.y)} + 1.0f; return (f32x2){__builtin_amdgcn_rcpf(d.x), __builtin_amdgcn_rcpf(d.y)}; }
__device__ __forceinline__ f32x2 swiglu2(const f32x2 g, const f32x2 u) {
    const f32x2 g_ = (f32x2){fminf(g.x, 7.0f), fminf(g.y, 7.0f)}; const f32x2 u_ = (f32x2){fminf(fmaxf(u.x, -7.0f), 7.0f), fminf(fmaxf(u.y, -7.0f), 7.0f)};
    const f32x2 t = g_ * (-1.702f * 1.4426950408889634f); const f32x2 d = (f32x2){__builtin_amdgcn_exp2f(t.x), __builtin_amdgcn_exp2f(t.y)} + 1.0f;
    const f32x2 p = g_ * (f32x2){__builtin_amdgcn_rcpf(d.x), __builtin_amdgcn_rcpf(d.y)}; return u_ * p + p; }
__device__ __forceinline__ void store8bf2(bf16_t* p, const f32x2 a, const f32x2 b, const f32x2 c, const f32x2 d) {
    u32x4 w; w.x = cvt_pk_bf16(a.x, a.y); w.y = cvt_pk_bf16(b.x, b.y); w.z = cvt_pk_bf16(c.x, c.y); w.w = cvt_pk_bf16(d.x, d.y); *(u32x4*)p = w; }
#define EPI_ROWS(ai, m) ((ai) * HALF + wr * 64 + (m) * 16 + fr)
#define EPI_COLS(bj) ((bj) * HALF + wc * 32 + 8 * fq)

struct EpiNone {
    static constexpr bool CHAIN = false;
    __device__ __forceinline__ void operator()(const f32x4 (&acc)[2][2][4][2], const Unit&, int, int, int, int, const LAS float*) const {
#pragma unroll
        for (int a = 0; a < 2; ++a)
#pragma unroll
            for (int b = 0; b < 2; ++b)
#pragma unroll
                for (int m = 0; m < 4; ++m)
#pragma unroll
                    for (int n = 0; n < 2; ++n) asm volatile("" :: "v"(acc[a][b][m][n]));
    }
};
struct EpiProbeStore {
    static constexpr bool CHAIN = false;
    bf16_t* dst;
    __device__ __forceinline__ void operator()(const f32x4 (&acc)[2][2][4][2], const Unit& u, int wr, int wc, int fr, int fq, const LAS float* side) const {
#pragma unroll
        for (int ai = 0; ai < 2; ++ai)
#pragma unroll
            for (int m = 0; m < 4; ++m) {
#if defined(PROBE_LOCAL)
                bf16_t* rowp = dst + (size_t)(blockIdx.x * 256 + EPI_ROWS(ai, m)) * 256;
#elif defined(PROBE_MIXED)
                bf16_t* rowp = (blockIdx.x & 3) ? dst + (size_t)(blockIdx.x * 256 + EPI_ROWS(ai, m)) * 256 : dst + (size_t)(u.pm * BM + EPI_ROWS(ai, m)) * 4096 + (u.pn & 15) * 256;
#elif defined(PROBE_WIDE)
                bf16_t* rowp = dst + (size_t)(u.pm * BM + EPI_ROWS(ai, m)) * 4096 + (u.pn & 15) * 256;
#else
                bf16_t* rowp = dst + (size_t)(u.pm * BM + EPI_ROWS(ai, m)) * 1024 + (u.pn & 3) * 256;
#endif
#pragma unroll
                for (int bj = 0; bj < 2; ++bj) store8bf(rowp + EPI_COLS(bj), acc[ai][bj][m][0], acc[ai][bj][m][1]); }
    }
};
struct EpiIn {
    static constexpr bool CHAIN = false;
    bf16_t *P0, *P1, *PHY, *PG; const float* bias;
    __device__ __forceinline__ void operator()(const f32x4 (&acc)[2][2][4][2], const Unit& u, int wr, int wc, int fr, int fq, const LAS float* side) const {
        const int seg = u.pn >> 2; bf16_t* dst; int ld, colt; int act = 0;
        if (seg == 0) { dst = P0; ld = 1024; colt = u.pn * 256; }
        else if (seg == 1) { dst = P1; ld = 1024; colt = u.pn * 256 - 1024; }
        else if (seg < 5) { dst = PHY; ld = 3072; colt = u.pn * 256 - 2048; }
        else { dst = PG; ld = 2048; colt = (u.pn - 20) * 128; act = 2; }
        f32x4 bv[2][2];
#pragma unroll
        for (int bj = 0; bj < 2; ++bj)
#pragma unroll
            for (int n = 0; n < 2; ++n) bv[bj][n] = *(const LAS f32x4*)(side + EPI_COLS(bj) + 4 * n);
        if (act == 2) {
#pragma unroll
            for (int ai = 0; ai < 2; ++ai)
#pragma unroll
                for (int m = 0; m < 4; ++m) { bf16_t* rowp = dst + (size_t)(u.pm * BM + EPI_ROWS(ai, m)) * ld + colt + wc * 32 + 8 * fq;
                    f32x2 rho[4], sh[4];
#pragma unroll
                    for (int n = 0; n < 2; ++n)
#pragma unroll
                        for (int hh = 0; hh < 2; ++hh) {
                            const f32x2 al = (hh ? hi2(acc[ai][0][m][n]) : lo2(acc[ai][0][m][n])) + (hh ? hi2(bv[0][n]) : lo2(bv[0][n]));
                            f32x2 ah = (hh ? hi2(acc[ai][1][m][n]) : lo2(acc[ai][1][m][n])) + (hh ? hi2(bv[1][n]) : lo2(bv[1][n]));
                            ah = (f32x2){fmaxf(ah.x, -80.0f), fmaxf(ah.y, -80.0f)};
                            const f32x2 tl = al * -1.4426950408889634f, th = ah * -1.4426950408889634f;
                            const f32x2 dl = (f32x2){__builtin_amdgcn_exp2f(tl.x), __builtin_amdgcn_exp2f(tl.y)} + 1.0f, dh = (f32x2){__builtin_amdgcn_exp2f(th.x), __builtin_amdgcn_exp2f(th.y)} + 1.0f;
                            sh[2 * n + hh] = (f32x2){__builtin_amdgcn_rcpf(dh.x), __builtin_amdgcn_rcpf(dh.y)};
                            rho[2 * n + hh] = dh * (f32x2){__builtin_amdgcn_rcpf(dl.x), __builtin_amdgcn_rcpf(dl.y)}; }
                    store8bf2(rowp, rho[0], rho[1], rho[2], rho[3]); store8bf2(rowp + 1024, sh[0], sh[1], sh[2], sh[3]); }
            return;
        }
#pragma unroll
        for (int ai = 0; ai < 2; ++ai)
#pragma unroll
            for (int m = 0; m < 4; ++m) { bf16_t* rowp = dst + (size_t)(u.pm * BM + EPI_ROWS(ai, m)) * ld + colt;
#pragma unroll
                for (int bj = 0; bj < 2; ++bj) { f32x2 a = lo2(acc[ai][bj][m][0]) + lo2(bv[bj][0]), b = hi2(acc[ai][bj][m][0]) + hi2(bv[bj][0]), c = lo2(acc[ai][bj][m][1]) + lo2(bv[bj][1]), d = hi2(acc[ai][bj][m][1]) + hi2(bv[bj][1]);
                    store8bf2(rowp + EPI_COLS(bj), a, b, c, d); } }
    }
};
struct EpiMix {
    static constexpr bool CHAIN = true;
    const bf16_t* PG; bf16_t* MIX;
    __device__ __forceinline__ bool operator()(f32x4 (&acc)[2][2][4][2], const Unit& u, int wr, int wc, int fr, int fq, const LAS float*) const {
#pragma unroll
        for (int ai = 0; ai < 2; ++ai)
#pragma unroll
            for (int m = 0; m < 4; ++m) { const size_t row = (size_t)(u.pm * BM + EPI_ROWS(ai, m));
#pragma unroll
                for (int bj = 0; bj < 2; ++bj) { const int col = u.pn * 256 + EPI_COLS(bj);
                    f32x4 h0, h1; load8bf(PG + row * 2048 + (u.e == 0 ? 0 : 1024) + col, h0, h1);
                    if (u.e == 0) { acc[ai][bj][m][0] *= h0; acc[ai][bj][m][1] *= h1; }
                    else store8bf(MIX + row * 1024 + col, h0 * acc[ai][bj][m][0], h1 * acc[ai][bj][m][1]); } }
        return u.e == 0;
    }
};
struct EpiH {
    static constexpr bool CHAIN = false;
    const float* x; bf16_t* HB;
    __device__ __forceinline__ void operator()(const f32x4 (&acc)[2][2][4][2], const Unit& u, int wr, int wc, int fr, int fq, const LAS float* side) const {
#pragma unroll
        for (int ai = 0; ai < 2; ++ai)
#pragma unroll
            for (int m = 0; m < 4; ++m) { const size_t row = (size_t)(u.pm * BM + EPI_ROWS(ai, m));
#pragma unroll
                for (int bj = 0; bj < 2; ++bj) { const size_t o = row * 1024 + u.pn * 256 + EPI_COLS(bj);
                    const f32x4 v0 = *(const f32x4*)(x + o) + acc[ai][bj][m][0], v1 = *(const f32x4*)(x + o + 4) + acc[ai][bj][m][1];
                    store8bf(HB + o, v0, v1); } }
    }
};
struct EpiGU {
    static constexpr bool CHAIN = false;
    const float* bgu; const float* ROWRS; bf16_t* ACT;
    __device__ __forceinline__ void operator()(const f32x4 (&acc)[2][2][4][2], const Unit& u, int wr, int wc, int fr, int fq, const LAS float* side) const {
        const int colp = u.pn * 128 + wc * 32 + 8 * fq;
        f32x4 bg[2], bu[2];
#pragma unroll
        for (int n = 0; n < 2; ++n) { bg[n] = *(const LAS f32x4*)(side + wc * 32 + 8 * fq + 4 * n); bu[n] = *(const LAS f32x4*)(side + 128 + wc * 32 + 8 * fq + 4 * n); }
#pragma unroll
        for (int ai = 0; ai < 2; ++ai)
#pragma unroll
            for (int m = 0; m < 4; ++m) { const size_t row = (size_t)u.gm * BM + EPI_ROWS(ai, m); const float rs = side[256 + EPI_ROWS(ai, m)];
                f32x2 o[4];
#pragma unroll
                for (int n = 0; n < 2; ++n) {
                    o[2 * n] = swiglu2(lo2(acc[ai][0][m][n]) * rs + lo2(bg[n]), lo2(acc[ai][1][m][n]) * rs + lo2(bu[n]));
                    o[2 * n + 1] = swiglu2(hi2(acc[ai][0][m][n]) * rs + hi2(bg[n]), hi2(acc[ai][1][m][n]) * rs + hi2(bu[n])); }
                store8bf2(ACT + row * 1024 + colp, o[0], o[1], o[2], o[3]); }
    }
};
struct EpiDN {
    static constexpr bool CHAIN = false;
    const float* bdn; const float* ROWGATE; bf16_t* YS;
    __device__ __forceinline__ void operator()(const f32x4 (&acc)[2][2][4][2], const Unit& u, int wr, int wc, int fr, int fq, const LAS float* side) const {
        f32x4 bv[2][2];
#pragma unroll
        for (int bj = 0; bj < 2; ++bj)
#pragma unroll
            for (int n = 0; n < 2; ++n) bv[bj][n] = *(const LAS f32x4*)(side + EPI_COLS(bj) + 4 * n);
#pragma unroll
        for (int ai = 0; ai < 2; ++ai)
#pragma unroll
            for (int m = 0; m < 4; ++m) { const size_t row = (size_t)u.gm * BM + EPI_ROWS(ai, m); const float gt = side[256 + EPI_ROWS(ai, m)];
#pragma unroll
                for (int bj = 0; bj < 2; ++bj) {
                    const f32x2 a = (lo2(acc[ai][bj][m][0]) + lo2(bv[bj][0])) * gt, b = (hi2(acc[ai][bj][m][0]) + hi2(bv[bj][0])) * gt, c = (lo2(acc[ai][bj][m][1]) + lo2(bv[bj][1])) * gt, d = (hi2(acc[ai][bj][m][1]) + hi2(bv[bj][1])) * gt;
#ifdef YS_FP8
                    int w0 = __builtin_amdgcn_cvt_pk_fp8_f32(a.x, a.y, 0, false); w0 = __builtin_amdgcn_cvt_pk_fp8_f32(b.x, b.y, w0, true);
                    int w1 = __builtin_amdgcn_cvt_pk_fp8_f32(c.x, c.y, 0, false); w1 = __builtin_amdgcn_cvt_pk_fp8_f32(d.x, d.y, w1, true);
                    *(u32x2*)((unsigned char*)YS + row * 1024 + u.pn * 256 + EPI_COLS(bj)) = (u32x2){(unsigned)w0, (unsigned)w1};
#else
                    store8bf2(YS + row * 1024 + u.pn * 256 + EPI_COLS(bj), a, b, c, d);
#endif
                } }
    }
};

template <int NS> struct SchedDenseT {
    static constexpr int NSIDE = NS; const float* bias;
    __device__ __forceinline__ const float* side_addr(const Unit& u, int, int idx) const {
        const int p = u.pn - 20; return p < 0 ? bias + u.pn * 256 + idx : bias + (idx < 128 ? 5120 + 128 * p + idx : 6144 + 128 * p + (idx - 128)); }
    DenseOrder O; const char* A; const char* B;
    __device__ __forceinline__ bool next(int i, Unit& u) const { int pm, pn; if (!O.tile(i, pm, pn)) return false; u.pm = pm; u.pn = pn; u.e = 0; u.gm = pm;
        u.A = A + (size_t)pm * (BM * KD * 2); u.B = B + (size_t)pn * (BM * KD * 2); return true; }
    static constexpr const unsigned* ROWTOK = nullptr; __device__ __forceinline__ int ROWTOK_row(const Unit&, int) const { return 0; } __device__ __forceinline__ size_t rowoff(const Unit&) const { return 0; }
};
struct SchedDenseProbe {
    static constexpr int NSIDE = 0; __device__ __forceinline__ const float* side_addr(const Unit&, int, int) const { return nullptr; }
    DenseOrder O; const char* A; const char* B;
    __device__ __forceinline__ bool next(int i, Unit& u) const { int pm, pn; if (!O.tile(i, pm, pn)) return false; u.pm = pm; u.pn = pn; u.e = 0; u.gm = pm;
        u.A = A + (size_t)(pm & 1) * (BM * KD * 2); u.B = B + (size_t)(pn & 1) * (BM * KD * 2); return true; }
    static constexpr const unsigned* ROWTOK = nullptr; __device__ __forceinline__ int ROWTOK_row(const Unit&, int) const { return 0; } __device__ __forceinline__ size_t rowoff(const Unit&) const { return 0; }
};
struct SchedMix {
    static constexpr int NSIDE = 0; __device__ __forceinline__ const float* side_addr(const Unit&, int, int) const { return nullptr; }
    DenseOrder O; const char* A0; const char* A1; const char* B0; const char* B1;
    __device__ __forceinline__ bool next(int i, Unit& u) const { int pm, pn; if (!O.tile(i >> 1, pm, pn)) return false; const int w = i & 1; u.pm = pm; u.pn = pn; u.e = w; u.gm = pm;
        u.A = (w ? A1 : A0) + (size_t)pm * (BM * KD * 2); u.B = (w ? B1 : B0) + (size_t)pn * (BM * KD * 2); return true; }
    static constexpr const unsigned* ROWTOK = nullptr; __device__ __forceinline__ int ROWTOK_row(const Unit&, int) const { return 0; } __device__ __forceinline__ size_t rowoff(const Unit&) const { return 0; }
};
template <int NT, bool GATHER> struct SchedMoE {
    static constexpr int NSIDE = 2; const float* sbias; const float* srow;
    __device__ __forceinline__ const float* side_addr(const Unit& u, int k, int idx) const {
        if (k == 1) return srow + (size_t)u.e * T + u.pm + idx;
        return NT == 8 ? sbias + u.e * 2048 + (idx < 128 ? 128 * u.pn + idx : 1024 + 128 * u.pn + idx - 128) : sbias + u.e * 1024 + 256 * u.pn + idx; }
    const LAS int* ptile; int G, c; const char* A; const char* B; size_t bstride  ; const int* ROWTOK;
    __device__ __forceinline__ bool next(int i, Unit& u) const {
        const int ngm = __builtin_amdgcn_readfirstlane(ptile[32]);
        int gm, pn;
        if (G == 256) {
            const int x = c & 7, y = c >> 3; gm = i * (256 / NT) + x * (32 / NT) + y / NT; pn = y % NT;
#ifdef LAST_SPREAD
            if ((i + 1) * (256 / NT) > ngm) gm = i * (256 / NT) + (y / NT) * 8 + x;
#endif
            if (gm >= ngm) return false;
#ifdef DN_REVERSE
            if (NT == 4) gm = ngm - 1 - gm;
#endif
        } else { const long Lx = (long)i * G + c; if (Lx >= (long)ngm * NT) return false; gm = (int)(Lx / NT); pn = (int)(Lx % NT); }
        int e = 0;
#pragma unroll 1
        for (int q = 1; q < 32; ++q) e += (__builtin_amdgcn_readfirstlane(ptile[q]) <= gm) ? 1 : 0;
        u.pm = (gm - __builtin_amdgcn_readfirstlane(ptile[e])) * BM; u.gm = gm; u.pn = pn; u.e = e;
        u.A = GATHER ? A : A + (size_t)gm * (BM * KD * 2); u.B = B + (size_t)e * bstride + (size_t)pn * (BM * KD * 2); return true; }
    __device__ __forceinline__ int ROWTOK_row(const Unit& u, int r) const { return GATHER ? ROWTOK[(size_t)u.e * T + u.pm + r] : 0; }
    __device__ __forceinline__ size_t rowoff(const Unit& u) const { return (size_t)u.e * T + u.pm; }
};
}
struct Args { const float* in[33]; float* out; unsigned char* ws; int ph_lo, ph_hi, li, pad; };
#define LDS_WAIT() asm volatile("s_waitcnt lgkmcnt(0)" ::: "memory")

struct Frame {
    LAS unsigned char* lds; int tid, lane, wave, G, bid; const float* const* in; float* out; unsigned char* ws;
};

#ifndef DUPMASK
#define DUPMASK 0
#endif
#define REP(bit) for (int rep_ = 0; rep_ < (((DUPMASK >> (bit)) & 1) ? 2 : 1); ++rep_)

#define XB_TMO      128
#define XB_XCNT(j)  (256  + 64 * (j))
#define XB_XSUB(j)  (1280 + 64 * (j))
#define XB_XGEN(j)  (2304 + 64 * (j))
#define XB_TOP      3328
#define XB_TOPGEN   3392
#define XCD_BAR_WORDS 3456
#define XB_SPIN_CAP (1u << 18)

__device__ __forceinline__ unsigned xb_ld(unsigned* p)              { return __hip_atomic_load(p, __ATOMIC_RELAXED, __HIP_MEMORY_SCOPE_AGENT); }
__device__ __forceinline__ unsigned xb_add(unsigned* p, unsigned v) { return __hip_atomic_fetch_add(p, v, __ATOMIC_RELAXED, __HIP_MEMORY_SCOPE_AGENT); }
__device__ __forceinline__ unsigned xb_xcc_id() { return (unsigned)__builtin_amdgcn_s_getreg((3 << 11) | 20) & 0xFu; }
#define XB_SPIN(cond, bar) do { unsigned _sp = 0; while (cond) { __builtin_amdgcn_s_sleep(1); \
    if ((++_sp & 255u) == 0u) { if (xb_ld(&(bar)[XB_TMO])) break; if (_sp > XB_SPIN_CAP) { atomicAdd(&(bar)[XB_TMO], 1u); break; } } } } while (0)

struct XcdBarrier {
    unsigned* bar; unsigned x;
    volatile LAS unsigned* st;
};

__device__ __forceinline__ XcdBarrier xcd_barrier_post(unsigned* bar, volatile LAS unsigned* st) {
    XcdBarrier b; b.bar = bar; b.x = xb_xcc_id(); b.st = st;
    if (threadIdx.x == 0) (void)xb_add(&bar[XB_XCNT(b.x)], 1u);
    return b;
}
__device__ __forceinline__ void xcd_barrier_complete(unsigned* bar, unsigned x, unsigned& nloc, unsigned& nx) {
    const unsigned G = gridDim.x * gridDim.y * gridDim.z;
    unsigned sum, cnt, mine, sp = 0u;
    for (;;) {
        sum = 0u; cnt = 0u; mine = 0u;
#pragma unroll
        for (unsigned j = 0; j < 16; ++j) { const unsigned c = xb_ld(&bar[XB_XCNT(j)]); sum += c; cnt += (c > 0u) ? 1u : 0u; mine = (j == x) ? c : mine; }
        if (sum == G) break;
        __builtin_amdgcn_s_sleep(1);
        if ((++sp & 255u) == 0u) { if (xb_ld(&bar[XB_TMO])) break; if (sp > XB_SPIN_CAP) { atomicAdd(&bar[XB_TMO], 1u); break; } }
    }
    nloc = mine > 0u ? mine : 1u; nx = cnt > 0u ? cnt : 1u;
}

__device__ __forceinline__ void xcd_barrier(const XcdBarrier& b) {
    asm volatile("s_waitcnt vmcnt(0)" ::: "memory");
    __syncthreads();
    if (threadIdx.x == 0) {
        unsigned* bar = b.bar;
        __builtin_amdgcn_s_waitcnt(0);
        unsigned nloc = b.st[0], nx = b.st[1];
        if (nloc == 0u) { xcd_barrier_complete(bar, b.x, nloc, nx); b.st[0] = nloc; b.st[1] = nx; }
        const unsigned old = xb_add(&bar[XB_XSUB(b.x)], 1u);
        const unsigned gen = old / nloc;
        if (old + 1u == (gen + 1u) * nloc) {
            __builtin_amdgcn_fence(__ATOMIC_RELEASE, "agent");
            asm volatile("s_waitcnt vmcnt(0)" ::: "memory");
            const unsigned og = xb_add(&bar[XB_TOP], 1u);
            const unsigned tg = og / nx;
            if (og + 1u == (tg + 1u) * nx) xb_add(&bar[XB_TOPGEN], 1u);
            else XB_SPIN(xb_ld(&bar[XB_TOPGEN]) == tg, bar);
            __builtin_amdgcn_fence(__ATOMIC_ACQUIRE, "agent");
            xb_add(&bar[XB_XGEN(b.x)], 1u);
            asm volatile("s_waitcnt vmcnt(0)" ::: "memory");
        } else {
            XB_SPIN(xb_ld(&bar[XB_XGEN(b.x)]) == gen, bar);
            __builtin_amdgcn_fence(__ATOMIC_ACQUIRE, "agent");
            asm volatile("s_waitcnt vmcnt(0)" ::: "memory");
        }
    }
    __syncthreads();
}


__device__ __forceinline__ void stagger_delay(int cls, int ticks_per_class) {
    if (cls > 0) { const unsigned long long t0 = __builtin_amdgcn_s_memrealtime(); const unsigned long long want = (unsigned long long)(cls * ticks_per_class);
        while (__builtin_amdgcn_s_memrealtime() - t0 < want) __builtin_amdgcn_s_sleep(32); }
}
namespace hy {
constexpr int TW128_OFF = MISC_OFF + 1024, TWT_OFF = MISC_OFF + 2048;

__host__ __device__ constexpr float twc16(int m) { return m == 0 ? 1.f : m == 1 ? 0.92387953251128674f : m == 2 ? 0.70710678118654752f : m == 3 ? 0.38268343236508977f : m == 4 ? 0.f : m == 5 ? -0.38268343236508977f : m == 6 ? -0.70710678118654752f : -0.92387953251128674f; }
__host__ __device__ constexpr float tws16(int m) { return m == 0 ? 0.f : m == 1 ? 0.38268343236508977f : m == 2 ? 0.70710678118654752f : m == 3 ? 0.92387953251128674f : m == 4 ? 1.f : m == 5 ? 0.92387953251128674f : m == 6 ? 0.70710678118654752f : 0.38268343236508977f; }
template <int N> __host__ __device__ constexpr int brev(int i) { int r = 0; for (int b = 1, c = N >> 1; b < N; b <<= 1, c >>= 1) if (i & b) r |= c; return r; }

typedef f32x2 P2;
template <int N, bool INV> __device__ __forceinline__ void fft_reg(P2 (&xr)[N], P2 (&xi)[N]) {
#pragma unroll
    for (int len = N; len >= 2; len >>= 1) {
        const int half = len >> 1;
#pragma unroll
        for (int start = 0; start < N; start += len) {
#pragma unroll
            for (int j = 0; j < half; ++j) {
                const int i0 = start + j, i1 = i0 + half;
                const P2 ar = xr[i0], ai = xi[i0], br = xr[i1], bi = xi[i1];
                xr[i0] = ar + br; xi[i0] = ai + bi;
                const P2 tr = ar - br, ti = ai - bi;
                const int m = j * (16 / len);
                if (m == 0) { xr[i1] = tr; xi[i1] = ti; }
                else if (m == 4) { if (INV) { xr[i1] = -ti; xi[i1] = tr; } else { xr[i1] = ti; xi[i1] = -tr; } }
                else { const float c = twc16(m), s = INV ? tws16(m) : -tws16(m); xr[i1] = tr * c - ti * s; xi[i1] = tr * s + ti * c; }
            }
        }
    }
}
__device__ __forceinline__ unsigned pkh(float a, float b) { return __builtin_bit_cast(unsigned, __builtin_amdgcn_cvt_pkrtz(a, b)); }
__device__ __forceinline__ u32x2 pkc(const P2 re, const P2 im) { u32x2 r; r.x = pkh(re.x, re.y); r.y = pkh(im.x, im.y); return r; }
__device__ __forceinline__ float h2f_lo(unsigned u) { return (float)__builtin_bit_cast(_Float16, (unsigned short)(u & 0xffffu)); }
__device__ __forceinline__ float h2f_hi(unsigned u) { return (float)__builtin_bit_cast(_Float16, (unsigned short)(u >> 16)); }
__device__ __forceinline__ P2 unpk2(unsigned u) { return (P2){h2f_lo(u), h2f_hi(u)}; }
__device__ __forceinline__ P2 bf2p(unsigned u) { return (P2){__uint_as_float(u << 16), __uint_as_float(u & 0xffff0000u)}; }
__device__ __forceinline__ void cmul(P2& xr, P2& xi, float c, float s) { const P2 r = xr * c - xi * s, i = xr * s + xi * c; xr = r; xi = i; }

__device__ __forceinline__ void init_tw128(Frame& F) {
    __syncthreads();
    if (F.tid < 128) { float s, c; sincospif((float)F.tid * (1.0f / 64.0f), &s, &c); ((LAS f32x2*)(F.lds + TW128_OFF))[F.tid] = (f32x2){c, s}; }
    __syncthreads();
}
__device__ __forceinline__ void tile_tw(Frame& F, int a, bool inv) {
    if (F.tid < 128) { const int m = (a * F.tid) & (L2X - 1); float s, c; sincospif((float)m * (1.0f / 8192.0f), &s, &c); ((LAS f32x2*)(F.lds + TWT_OFF))[F.tid] = (f32x2){c, inv ? s : -s}; }
}
template <bool INV> __device__ __forceinline__ void stage1(Frame& F, P2 (&xr)[16], P2 (&xi)[16], int s) {
    fft_reg<16, INV>(xr, xi);
    const LAS f32x2* tw = (const LAS f32x2*)(F.lds + TW128_OFF); LAS f32x4* tile = (LAS f32x4*)F.lds;
#pragma unroll
    for (int q = 0; q < 16; ++q) { const int p = brev<16>(q); const f32x2 w = tw[s * q]; const float c = w.x, sn = INV ? w.y : -w.y;
        P2 a = xr[p], b = xi[p]; cmul(a, b, c, sn);
        tile[(s * 16 + q) * 64 + F.lane] = (f32x4){a.x, a.y, b.x, b.y}; }
}
__device__ __forceinline__ void stage2_read(Frame& F, P2 (&xr)[8], P2 (&xi)[8], int qq) {
    const LAS f32x4* tile = (const LAS f32x4*)F.lds;
#pragma unroll
    for (int s = 0; s < 8; ++s) { const f32x4 v = tile[(s * 16 + qq) * 64 + F.lane]; xr[s] = (P2){v.x, v.y}; xi[s] = (P2){v.z, v.w}; }
}
__device__ __forceinline__ void hyq2(const bf16_t* __restrict__ PHY, size_t row, int tl, int col, const float (&w)[3][2], const float (&b)[2], float& q0, float& q1) {
    q0 = b[0]; q1 = b[1];
#pragma unroll
    for (int k = 0; k < 3; ++k) { const int tt = tl + k - 1; const bool ok = (tt >= 0) && (tt < L);
        const unsigned u = ok ? *(const unsigned*)(PHY + (row + k - 1) * 3072 + col) : 0u;
        q0 += w[k][0] * __uint_as_float(u << 16); q1 += w[k][1] * __uint_as_float(u & 0xffff0000u); }
}
struct ConvW { float w[3][3][2]; float b[3][2]; };
__device__ __forceinline__ void load_convw(ConvW& W, const float* __restrict__ cw, const float* __restrict__ cb, int c0) {
#pragma unroll
    for (int seg = 0; seg < 3; ++seg) {
#pragma unroll
        for (int k = 0; k < 3; ++k) { const f32x2 v = *(const f32x2*)(cw + k * 3072 + seg * 1024 + c0); W.w[seg][k][0] = v.x; W.w[seg][k][1] = v.y; }
        const f32x2 v = *(const f32x2*)(cb + seg * 1024 + c0); W.b[seg][0] = v.x; W.b[seg][1] = v.y; }
}


__device__ __forceinline__ void bf8_to_f(const u32x4 u, float (&f)[8]) {
    f[0] = __uint_as_float(u.x << 16); f[1] = __uint_as_float(u.x & 0xffff0000u); f[2] = __uint_as_float(u.y << 16); f[3] = __uint_as_float(u.y & 0xffff0000u);
    f[4] = __uint_as_float(u.z << 16); f[5] = __uint_as_float(u.z & 0xffff0000u); f[6] = __uint_as_float(u.w << 16); f[7] = __uint_as_float(u.w & 0xffff0000u);
}
__device__ __forceinline__ void prepass(Frame& F) {
    const bf16_t* PHY = (const bf16_t*)(F.ws + WS_PHY); bf16_t* Z16 = (bf16_t*)(F.ws + WS_Z16); bf16_t* X1Q = (bf16_t*)(F.ws + WS_YHY); const float* cw = F.in[12]; const float* cb = F.in[13];
    const int gw = F.bid * NWAVES + F.wave, NGW = F.G * NWAVES;
#pragma unroll 1
    for (int item = gw; item < (T / 16) * 2; item += NGW) {
        const int half = item & 1, row0 = (item >> 1) * 16, tl0 = row0 & (L - 1), c0 = half * 512 + 8 * F.lane;
        float w[3][3][8], bs[3][8];
#pragma unroll
        for (int seg = 0; seg < 3; ++seg) {
#pragma unroll
            for (int k = 0; k < 3; ++k) { const f32x4 a = *(const f32x4*)(cw + k * 3072 + seg * 1024 + c0), b = *(const f32x4*)(cw + k * 3072 + seg * 1024 + c0 + 4);
                w[seg][k][0] = a.x; w[seg][k][1] = a.y; w[seg][k][2] = a.z; w[seg][k][3] = a.w; w[seg][k][4] = b.x; w[seg][k][5] = b.y; w[seg][k][6] = b.z; w[seg][k][7] = b.w; }
            const f32x4 a = *(const f32x4*)(cb + seg * 1024 + c0), b = *(const f32x4*)(cb + seg * 1024 + c0 + 4);
            bs[seg][0] = a.x; bs[seg][1] = a.y; bs[seg][2] = a.z; bs[seg][3] = a.w; bs[seg][4] = b.x; bs[seg][5] = b.y; bs[seg][6] = b.z; bs[seg][7] = b.w; }
        const u32x4 zero4 = (u32x4){0u, 0u, 0u, 0u};
        u32x4 prev[3], cur[3];
#pragma unroll
        for (int seg = 0; seg < 3; ++seg) { prev[seg] = tl0 > 0 ? *(const u32x4*)(PHY + (size_t)(row0 - 1) * 3072 + seg * 1024 + c0) : zero4; cur[seg] = *(const u32x4*)(PHY + (size_t)row0 * 3072 + seg * 1024 + c0); }
#pragma unroll 1
        for (int sub = 0; sub < 4; ++sub) {
            u32x4 nx[4][3];
#pragma unroll
            for (int r = 0; r < 4; ++r)
#pragma unroll
                for (int seg = 0; seg < 3; ++seg) { const int tn = tl0 + sub * 4 + r + 1; nx[r][seg] = tn < L ? *(const u32x4*)(PHY + (size_t)(row0 + sub * 4 + r + 1) * 3072 + seg * 1024 + c0) : zero4; }
#pragma unroll
            for (int r = 0; r < 4; ++r) {
                float q[3][8];
#pragma unroll
                for (int seg = 0; seg < 3; ++seg) { float a[8], b[8], c[8]; bf8_to_f(prev[seg], a); bf8_to_f(cur[seg], b); bf8_to_f(nx[r][seg], c);
#pragma unroll
                    for (int e = 0; e < 8; ++e) q[seg][e] = bs[seg][e] + w[seg][0][e] * a[e] + w[seg][1][e] * b[e] + w[seg][2][e] * c[e];
                    prev[seg] = cur[seg]; cur[seg] = nx[r][seg]; }
                const size_t o = (size_t)(row0 + sub * 4 + r) * 1024 + c0;
                u32x4 zo, xo;
                zo.x = pk2(q[2][0] * q[0][0], q[2][1] * q[0][1]); zo.y = pk2(q[2][2] * q[0][2], q[2][3] * q[0][3]); zo.z = pk2(q[2][4] * q[0][4], q[2][5] * q[0][5]); zo.w = pk2(q[2][6] * q[0][6], q[2][7] * q[0][7]);
                xo.x = pk2(q[1][0], q[1][1]); xo.y = pk2(q[1][2], q[1][3]); xo.z = pk2(q[1][4], q[1][5]); xo.w = pk2(q[1][6], q[1][7]);
                *(u32x4*)(Z16 + o) = zo; *(u32x4*)(X1Q + o) = xo;
            }
        }
    }
}

__device__ __forceinline__ void prep_w4frag(Frame& F) {
    const float* w4 = F.in[20]; u32x4* WF4 = (u32x4*)(F.ws + WS_WF4);
    for (int idx = F.bid * NTHREADS + F.tid; idx < 2 * 64 * 2 * 64; idx += F.G * NTHREADS) {
        const int lane = idx & 63, s = (idx >> 6) & 1, cb = (idx >> 7) & 63, dir = idx >> 13; const int col = dir * 1024 + 16 * cb + (lane & 15), k0 = 32 * s + 8 * (lane >> 4);
        u32x4 o; o.x = pk2(w4[(k0 + 0) * 2048 + col], w4[(k0 + 1) * 2048 + col]); o.y = pk2(w4[(k0 + 2) * 2048 + col], w4[(k0 + 3) * 2048 + col]);
        o.z = pk2(w4[(k0 + 4) * 2048 + col], w4[(k0 + 5) * 2048 + col]); o.w = pk2(w4[(k0 + 6) * 2048 + col], w4[(k0 + 7) * 2048 + col]);
        WF4[idx] = o; }
}
__device__ __forceinline__ void fa_load(const float* __restrict__ w4, int c0, int bt, f32x2 (&wf)[16], f32x2 (&wb)[16]) {
#pragma unroll
    for (int e = 0; e < 16; ++e) { wf[e] = *(const f32x2*)(w4 + (16 * bt + e) * 2048 + c0); wb[e] = *(const f32x2*)(w4 + (16 * bt + e) * 2048 + 1024 + c0); }
}
__device__ __forceinline__ void fa_compute(const LAS f32x4* hrow, int bt, const f32x2 (&wf)[16], const f32x2 (&wb)[16], float (&r0)[16], float (&r1)[16], float& l0, float& l1, bool lag0) {
#pragma unroll
    for (int e4 = 0; e4 < 4; ++e4) { const int u4 = 4 * bt + e4; __builtin_amdgcn_sched_barrier(0);
#pragma unroll
        for (int j = 0; j < 16; ++j) { const f32x4 hv = hrow[(8 * j) * 16 + u4];
#pragma unroll
            for (int e = 0; e < 4; ++e) { r0[j] += hv[e] * (j < 8 ? wf[4 * e4 + e].x : wb[4 * e4 + e].x); r1[j] += hv[e] * (j < 8 ? wf[4 * e4 + e].y : wb[4 * e4 + e].y); } }
        if (lag0) { const f32x4 hv = hrow[u4];
#pragma unroll
            for (int e = 0; e < 4; ++e) { l0 += hv[e] * wb[4 * e4 + e].x; l1 += hv[e] * wb[4 * e4 + e].y; } } }
}
template <bool DRY = false> __device__ __forceinline__ void filter_pass_a(Frame& F, int k_lo = 0, int k_hi = 1 << 20) {
    const float* HH3 = (const float*)(F.ws + WS_HH3); const float* w4 = F.in[20]; float* NORM = (float*)(F.ws + WS_NORMP); u32x2* YK = (u32x2*)(F.ws + WS_KF);
    const int s = F.wave; const LAS f32x2* twt = (const LAS f32x2*)(F.lds + TWT_OFF);
    for (int kk = k_lo, tl = F.bid + k_lo * F.G; kk < k_hi && tl < 128 * 8; ++kk, tl += F.G) {
        const int n1 = tl >> 3, ct = tl & 7, c0 = ct * 128 + 2 * F.lane;
        tile_tw(F, n1, false);
        { const int rw = F.tid >> 2, part = F.tid & 3; const int n = n1 + 128 * rw; const int t = n < L ? n : ((2 * L - n) & (L - 1));
          const f32x4* src = (const f32x4*)(HH3 + t * 64 + part * 16); LAS f32x4* dst = (LAS f32x4*)(F.lds + rw * 256 + part * 64);
          const f32x4 a = src[0], b = src[1], c = src[2], d = src[3]; dst[0] = a; dst[1] = b; dst[2] = c; dst[3] = d; }
        __syncthreads();
        P2 xr[16], xi[16]; P2 lag0 = (P2){0.f, 0.f};
        const P2 da = (P2){hy_delta_abs(c0), hy_delta_abs(c0 + 1)};
        { const u32x4* WF4 = (const u32x4*)(F.ws + WS_WF4); const int cb = ct * 8 + s, jl = F.lane & 15, ql = F.lane >> 4;
          bf16x8 bfr[2][2];
#pragma unroll
          for (int dir = 0; dir < 2; ++dir)
#pragma unroll
              for (int ks = 0; ks < 2; ++ks) bfr[dir][ks] = __builtin_bit_cast(bf16x8, WF4[(((dir * 64 + cb) * 2 + ks) * 64) + F.lane]);
          LAS float* kt = (LAS float*)(F.lds + 32768);
#pragma unroll
          for (int m = 0; m < 8; ++m) {
              bf16x8 afr[2];
#pragma unroll
              for (int ks = 0; ks < 2; ++ks) { const LAS f32x4* hp = (const LAS f32x4*)(F.lds + (16 * m + jl) * 256 + (32 * ks + 8 * ql) * 4); const f32x4 x0 = hp[0], x1 = hp[1];
                  u32x4 pk; pk.x = pk2(x0.x, x0.y); pk.y = pk2(x0.z, x0.w); pk.z = pk2(x1.x, x1.y); pk.w = pk2(x1.z, x1.w); afr[ks] = __builtin_bit_cast(bf16x8, pk); }
              f32x4 d = (f32x4){0.f, 0.f, 0.f, 0.f};
              d = __builtin_amdgcn_mfma_f32_16x16x32_bf16(afr[0], bfr[m >> 2][0], d, 0, 0, 0); d = __builtin_amdgcn_mfma_f32_16x16x32_bf16(afr[1], bfr[m >> 2][1], d, 0, 0, 0);
#pragma unroll
              for (int r = 0; r < 4; ++r) kt[(16 * m + 4 * ql + r) * 132 + 16 * s + jl] = d[r]; }
          if (n1 == 0 && s == 0) { const LAS float* h0 = (const LAS float*)F.lds;
#pragma unroll 4
              for (int u = 0; u < 64; ++u) { const f32x2 wb = *(const f32x2*)(w4 + u * 2048 + 1024 + c0); lag0 += h0[u] * wb; } }
          __syncthreads();
#pragma unroll
          for (int j = 0; j < 16; ++j) xr[j] = *(const LAS f32x2*)(kt + (s + 8 * j) * 132 + 2 * F.lane);
        }
        __syncthreads();
        P2 na = (P2){0.f, 0.f};
#pragma unroll
        for (int j = 0; j < 16; ++j) { const int n = n1 + 128 * (s + 8 * j); const int t = j < 8 ? n : ((2 * L - n) & (L - 1)); const float tt = (float)t * (1.0f / (float)(L - 1));
            P2 v = xr[j] * (P2){fexp(-tt * da.x), fexp(-tt * da.y)};
            if (n == L) v = (P2){0.f, 0.f};
            if (j == 0) v += lag0;
            xr[j] = v; xi[j] = (P2){0.f, 0.f}; na += (P2){fabsf(v.x), fabsf(v.y)}; }
        { LAS f32x2* nred = (LAS f32x2*)(F.lds + MISC_OFF + 12288); nred[s * 64 + F.lane] = na; }
        stage1<false>(F, xr, xi, s);
        __syncthreads();
        if (s == 0) { const LAS f32x2* nred = (const LAS f32x2*)(F.lds + MISC_OFF + 12288); f32x2 a = nred[F.lane];
#pragma unroll
            for (int w = 1; w < 8; ++w) { const f32x2 b = nred[w * 64 + F.lane]; a.x += b.x; a.y += b.y; }
            if (!DRY) *(f32x2*)(NORM + (size_t)n1 * 1024 + c0) = a; else asm volatile("" :: "v"(a)); }
#pragma unroll
        for (int h = 0; h < 2; ++h) { const int qq = s + 8 * h; P2 a[8], b[8];
            stage2_read(F, a, b, qq); fft_reg<8, false>(a, b);
#pragma unroll
            for (int r = 0; r < 8; ++r) { const int p = brev<8>(r), k2 = qq + 16 * r; const f32x2 w = twt[k2];
                P2 x = a[p], y = b[p]; cmul(x, y, w.x, w.y);
                if (!DRY) YK[((size_t)k2 * 128 + n1) * 512 + (c0 >> 1)] = pkc(x, y); else asm volatile("" :: "v"(x), "v"(y)); } }
        __syncthreads();
    }
}
template <bool DRY = false> __device__ __forceinline__ void filter_pass_b(Frame& F) {
    const float* NORM = (const float*)(F.ws + WS_NORMP); u32x2* KF = (u32x2*)(F.ws + WS_KF); const int s = F.wave;
    for (int tl = F.bid; tl < 128 * 8; tl += F.G) {
        const int k2 = tl >> 3, ct = tl & 7, c0 = ct * 128 + 2 * F.lane; const size_t base = (size_t)k2 * 128 * 512 + (c0 >> 1);
        { LAS float* nsum = (LAS float*)(F.lds + MISC_OFF + 12288); const int ch = F.tid & 127, qt = F.tid >> 7; float a = 0.f;
#pragma unroll 8
          for (int i = 0; i < 32; ++i) a += NORM[(size_t)(qt * 32 + i) * 1024 + ct * 128 + ch];
          __syncthreads(); nsum[qt * 128 + ch] = a; __syncthreads(); }
        P2 sc;
        { const LAS float* nsum = (const LAS float*)(F.lds + MISC_OFF + 12288); const int ch = 2 * F.lane;
          sc.x = 1.0f / ((nsum[ch] + nsum[128 + ch]) + (nsum[256 + ch] + nsum[384 + ch])); sc.y = 1.0f / ((nsum[ch + 1] + nsum[128 + ch + 1]) + (nsum[256 + ch + 1] + nsum[384 + ch + 1])); }
        P2 xr[16], xi[16];
#pragma unroll
        for (int j = 0; j < 16; ++j) { const u32x2 u = KF[base + (size_t)(s + 8 * j) * 512]; xr[j] = unpk2(u.x); xi[j] = unpk2(u.y); }
        stage1<false>(F, xr, xi, s);
        __syncthreads();
#pragma unroll
        for (int h = 0; h < 2; ++h) { const int qq = s + 8 * h; P2 a[8], b[8];
            stage2_read(F, a, b, qq); fft_reg<8, false>(a, b);
#pragma unroll
            for (int r = 0; r < 8; ++r) { const int p = brev<8>(r), k1 = qq + 16 * r;
                const u32x2 o_ = pkc(a[p] * sc, b[p] * sc); if (!DRY) KF[base + (size_t)k1 * 512] = o_; else asm volatile("" :: "v"(o_)); } }
        __syncthreads();
    }
}
__device__ __forceinline__ void data_pass_a(Frame& F) {
    const bf16_t* Z16 = (const bf16_t*)(F.ws + WS_Z16); u32x2* YZ = (u32x2*)(F.ws + WS_YZ); const int s = F.wave; const LAS f32x2* twt = (const LAS f32x2*)(F.lds + TWT_OFF);
    unsigned zn[16];
    auto zload = [&](int tl, unsigned (&z)[16]) { const int ct = tl & 7, n1 = (tl >> 3) & 127, p = tl >> 10, c0 = ct * 128 + 2 * F.lane;
#pragma unroll
        for (int j = 0; j < 8; ++j) { const int t = n1 + 128 * (s + 8 * j);
            z[2 * j] = *(const unsigned*)(Z16 + ((size_t)(2 * p) * L + t) * 1024 + c0); z[2 * j + 1] = *(const unsigned*)(Z16 + ((size_t)(2 * p + 1) * L + t) * 1024 + c0); } };
    if (F.bid < 2 * 128 * 8) zload(F.bid, zn);
    for (int tl = F.bid; tl < 2 * 128 * 8; tl += F.G) {
        const int ct = tl & 7, n1 = (tl >> 3) & 127, p = tl >> 10, c0 = ct * 128 + 2 * F.lane;
        tile_tw(F, n1, false);
        P2 xr[16], xi[16];
#pragma unroll
        for (int j = 0; j < 8; ++j) { xr[j] = bf2p(zn[2 * j]); xi[j] = bf2p(zn[2 * j + 1]); }
        if (tl + F.G < 2 * 128 * 8) zload(tl + F.G, zn);
#pragma unroll
        for (int j = 8; j < 16; ++j) { xr[j] = (P2){0.f, 0.f}; xi[j] = (P2){0.f, 0.f}; }
        stage1<false>(F, xr, xi, s);
        __syncthreads();
#pragma unroll
        for (int h = 0; h < 2; ++h) { const int qq = s + 8 * h; P2 a[8], b[8];
            stage2_read(F, a, b, qq); fft_reg<8, false>(a, b);
#pragma unroll
            for (int r = 0; r < 8; ++r) { const int pp = brev<8>(r), k2 = qq + 16 * r; const f32x2 w = twt[k2];
                P2 x = a[pp], y = b[pp]; cmul(x, y, w.x, w.y);
                YZ[(((size_t)p * 128 + k2) * 128 + n1) * 512 + (c0 >> 1)] = pkc(x, y); } }
        __syncthreads();
    }
}
template <bool DRY = false> __device__ __forceinline__ void data_pass_b(Frame& F) {
    u32x2* YZ = (u32x2*)(F.ws + WS_YZ); const u32x2* KF = (const u32x2*)(F.ws + WS_KF); const int s = F.wave;
    const LAS f32x2* twt = (const LAS f32x2*)(F.lds + TWT_OFF); const LAS f32x2* tw = (const LAS f32x2*)(F.lds + TW128_OFF); LAS f32x4* tile = (LAS f32x4*)F.lds;
    int* qctr = (int*)(F.ws + WS_CTL) + 128 + (DRY ? 1 : 0); LAS int* qslot = (LAS int*)(F.lds + MISC_OFF + 768);
    for (;;) {
        __syncthreads();
        if (F.tid == 0) *qslot = atomicAdd(qctr, 1);
        __syncthreads();
        const int tl = *qslot; if (tl >= 128 * 8) break;
        const int k2 = tl >> 3, ct = tl & 7, c0 = ct * 128 + 2 * F.lane; const size_t kbase = (size_t)k2 * 128 * 512 + (c0 >> 1);
        tile_tw(F, k2, true);
#pragma unroll 1
        for (int p = 0; p < 2; ++p) {
            const size_t base = ((size_t)p * 128 + k2) * 128 * 512 + (c0 >> 1);
            u32x2 kfp[2][8];
#pragma unroll
            for (int h = 0; h < 2; ++h)
#pragma unroll
                for (int r = 0; r < 8; ++r) kfp[h][r] = KF[kbase + (size_t)(s + 8 * h + 16 * r) * 512];
            { P2 xr[16], xi[16];
#pragma unroll
              for (int j = 0; j < 16; ++j) { const u32x2 u = YZ[base + (size_t)(s + 8 * j) * 512]; xr[j] = unpk2(u.x); xi[j] = unpk2(u.y); }
              stage1<false>(F, xr, xi, s); }
            __syncthreads();
#pragma unroll
            for (int h = 0; h < 2; ++h) { const int qq = s + 8 * h; P2 a[8], b[8], gr[8], gi[8];
                if (h == 1) __builtin_amdgcn_sched_barrier(0);
                stage2_read(F, a, b, qq); fft_reg<8, false>(a, b);
#pragma unroll
                for (int r = 0; r < 8; ++r) { const int pp = brev<8>(r); const P2 kr = unpk2(kfp[h][r].x), ki = unpk2(kfp[h][r].y);
                    gr[r] = a[pp] * kr - b[pp] * ki; gi[r] = a[pp] * ki + b[pp] * kr; }
                fft_reg<8, true>(gr, gi);
#pragma unroll
                for (int bq = 0; bq < 8; ++bq) { const int pp = brev<8>(bq); const f32x2 w = tw[bq * qq];
                    P2 x = gr[pp], y = gi[pp]; cmul(x, y, w.x, w.y);
                    tile[(bq * 16 + qq) * 64 + F.lane] = (f32x4){x.x, x.y, y.x, y.y}; } }
            __syncthreads();
            { P2 xr[16], xi[16];
#pragma unroll
              for (int q = 0; q < 16; ++q) { const f32x4 v = tile[(s * 16 + q) * 64 + F.lane]; xr[q] = (P2){v.x, v.y}; xi[q] = (P2){v.z, v.w}; }
              fft_reg<16, true>(xr, xi);
#pragma unroll
              for (int a = 0; a < 16; ++a) { const int pp = brev<16>(a), m2 = s + 8 * a; const f32x2 w = twt[m2];
                  P2 x = xr[pp], y = xi[pp]; cmul(x, y, w.x, w.y);
                  if (!DRY) YZ[base + (size_t)m2 * 512] = pkc(x, y); else asm volatile("" :: "v"(x), "v"(y)); } }
            __syncthreads();
        }
    }
}
template <bool DRY = false> __device__ __forceinline__ void data_pass_c(Frame& F) {
    const bf16_t* Z16 = (const bf16_t*)(F.ws + WS_Z16); const u32x2* YZ = (const u32x2*)(F.ws + WS_YZ); bf16_t* YHY = (bf16_t*)(F.ws + WS_YHY); const float* hbias = F.in[22]; const int s = F.wave;
    u32x2 yzn[16];
    auto yzload = [&](int tl, u32x2 (&y)[16]) { const int ct = tl & 7, m2 = (tl >> 3) & 127, p = tl >> 10, c0 = ct * 128 + 2 * F.lane;
#pragma unroll
        for (int j = 0; j < 16; ++j) y[j] = YZ[(((size_t)p * 128 + (s + 8 * j)) * 128 + m2) * 512 + (c0 >> 1)]; };
    if (F.bid < 2 * 128 * 8) yzload(F.bid, yzn);
    for (int tl = F.bid; tl < 2 * 128 * 8; tl += F.G) {
        const int ct = tl & 7, m2 = (tl >> 3) & 127, p = tl >> 10, c0 = ct * 128 + 2 * F.lane;
        unsigned uzp[2][4][2], uxp[2][4][2];
#pragma unroll
        for (int h = 0; h < 2; ++h)
#pragma unroll
            for (int r = 0; r < 4; ++r)
#pragma unroll
                for (int bb = 0; bb < 2; ++bb) { const size_t row = (size_t)(2 * p + bb) * L + 128 * (s + 8 * h + 16 * r) + m2;
                    uzp[h][r][bb] = *(const unsigned*)(Z16 + row * 1024 + c0); uxp[h][r][bb] = *(const unsigned*)(YHY + row * 1024 + c0); }
        { P2 xr[16], xi[16];
#pragma unroll
          for (int j = 0; j < 16; ++j) { xr[j] = unpk2(yzn[j].x); xi[j] = unpk2(yzn[j].y); }
          if (tl + F.G < 2 * 128 * 8) yzload(tl + F.G, yzn);
          stage1<true>(F, xr, xi, s); }
        __syncthreads();
        const P2 hb = *(const f32x2*)(hbias + c0);
#pragma unroll
        for (int h = 0; h < 2; ++h) { const int qq = s + 8 * h; P2 a[8], b[8];
            stage2_read(F, a, b, qq); fft_reg<8, true>(a, b);
#pragma unroll
            for (int r = 0; r < 4; ++r) { const int pp = brev<8>(r), t = 128 * (qq + 16 * r) + m2;
#pragma unroll
                for (int bb = 0; bb < 2; ++bb) { const size_t row = (size_t)(2 * p + bb) * L + t;
                    const P2 z = bf2p(uzp[h][r][bb]), x1 = bf2p(uxp[h][r][bb]);
                    const P2 cv = (bb == 0 ? a[pp] : b[pp]) * (1.0f / (float)L2X);
                    const P2 y = x1 * (cv + hb * z);
                    if (!DRY) *(unsigned*)(YHY + row * 1024 + c0) = pk2(y.x, y.y); else asm volatile("" :: "v"(y)); } } }
        __syncthreads();
    }
}
}
namespace lru {
__device__ __forceinline__ f32x2 sig2(const f32x2 x) { const f32x2 t = x * -1.4426950408889634f; const f32x2 d = (f32x2){__builtin_amdgcn_exp2f(t.x), __builtin_amdgcn_exp2f(t.y)} + 1.0f; return (f32x2){__builtin_amdgcn_rcpf(d.x), __builtin_amdgcn_rcpf(d.y)}; }
constexpr int TC = 64, NCH = L / TC, MB = TC / 16;

__device__ __forceinline__ void prep_wfrag(Frame& F) {
    const float* wa = F.in[6]; const float* wi = F.in[8]; u32x4* WF = (u32x4*)(F.ws + WS_WLRUF);
    for (int idx = F.bid * NTHREADS + F.tid; idx < 2 * 16 * 2 * 4 * 2 * 64; idx += F.G * NTHREADS) {
        const int lane = idx & 63, s = (idx >> 6) & 1, n = (idx >> 7) & 3, mat = (idx >> 9) & 1, h = (idx >> 10) & 15, dir = idx >> 14;
        const float* W = (mat == 0 ? wa : wi) + ((size_t)(dir * 16 + h) * 64) * 64; const int jo = 16 * n + (lane & 15), i0 = 32 * s + 8 * (lane >> 4);
        u32x4 o; o.x = pk2(W[(i0 + 0) * 64 + jo], W[(i0 + 1) * 64 + jo]); o.y = pk2(W[(i0 + 2) * 64 + jo], W[(i0 + 3) * 64 + jo]);
        o.z = pk2(W[(i0 + 4) * 64 + jo], W[(i0 + 5) * 64 + jo]); o.w = pk2(W[(i0 + 6) * 64 + jo], W[(i0 + 7) * 64 + jo]);
        WF[idx] = o;
    }
}

__device__ __forceinline__ void load_rows(const bf16_t* __restrict__ P0, int b, int t0, int m, int h, int j, int q, u32x4 (&pv)[2][4]) {
#pragma unroll
    for (int s = 0; s < 2; ++s)
#pragma unroll
        for (int tap = 0; tap < 4; ++tap) { const int tl = t0 + 16 * m + j + tap - 2; const bool ok = (tl >= 0) && (tl < L);
            const size_t off = ok ? (WS_P0 - WS_CTL - 8192) + (((size_t)b * L + tl) * 1024 + 64 * h + 32 * s + 8 * q) * 2 : (size_t)0;
            pv[s][tap] = *(const u32x4*)((const char*)P0 + off); }
}
__device__ __forceinline__ void stage1(Frame& F) {
    const bf16_t* P0 = (const bf16_t*)(F.ws + WS_CTL + 8192);
    const float* cw = F.in[4]; const float* cb = F.in[5]; const float* ba = F.in[7]; const float* bi = F.in[9]; const float* lam = F.in[10];
    const u32x4* WF = (const u32x4*)(F.ws + WS_WLRUF); f32x2* SUMM = (f32x2*)(F.ws + WS_SUMM);
    u32x2* HS = (u32x2*)(F.ws + WS_HS); u32x2* AF = (u32x2*)(F.ws + WS_AF); u32x2* AB = (u32x2*)(F.ws + WS_AB);
    LAS float* cwl = (LAS float*)(F.lds + MISC_OFF + 4096);
    LAS unsigned* hfl = (LAS unsigned*)(F.lds + F.wave * 8192) + F.lane;
    const LAS u32x4* wl = (const LAS u32x4*)(F.lds + 65536) + F.lane;
    asm volatile("" : "+v"(wl)); asm volatile("" : "+v"(hfl));
    const int lane = F.lane, j = lane & 15, q = lane >> 4;
    bf16x8 idf[2];
#pragma unroll
    for (int par = 0; par < 2; ++par) { const int kp = 16 * par + j;
#pragma unroll
        for (int jj = 0; jj < 8; ++jj) idf[par][jj] = (short)((q == (kp >> 3) && jj == (kp & 7)) ? 0x3F80 : 0); }
#pragma unroll 1
    for (int bix = F.bid; bix < NB * 16 * (NCH / 8); bix += F.G) {
        const int h = (bix >> 4) & 15, b = bix >> 8, chunk = (bix & 15) * 8 + F.wave; const int t0 = chunk * TC; const int task = ((b * NCH + chunk) << 4) + h;
        __syncthreads();
        if (F.tid < 320) cwl[F.tid] = F.tid < 256 ? cw[(F.tid >> 6) * 1024 + 64 * h + (F.tid & 63)] : cb[64 * h + (F.tid & 63)];
#pragma unroll
        for (int i = 0; i < 4; ++i) { const int e = F.tid + 512 * i; const int dir_ = e >> 10, rest = e & 1023;
            ((LAS u32x4*)(F.lds + 65536))[e] = WF[((size_t)(dir_ * 16 + h) * 16) * 64 + rest]; }
        __syncthreads();
#pragma unroll
        for (int dir = 0; dir < 2; ++dir) {
            float bac[4], bic[4], spc[4], cst[4], arun[4];
#pragma unroll
            for (int n = 0; n < 4; ++n) { const int c = 64 * h + 16 * n + j; bac[n] = ba[dir * 1024 + c]; bic[n] = bi[dir * 1024 + c]; spc[n] = -8.0f * 1.4426950408889634f * log1pf(expf(-lam[dir * 1024 + c])); cst[n] = 0.f; arun[n] = 1.f; }
            u32x4 pvn[2][4];
            load_rows(P0, b, t0, dir == 0 ? 0 : MB - 1, h, j, q, pvn);
#pragma unroll 1
            for (int mm = 0; mm < MB; ++mm) {
                const int m = dir == 0 ? mm : MB - 1 - mm;
                bf16x8 afr[2];
#pragma unroll
                for (int s = 0; s < 2; ++s) { const int chb = 32 * s + 8 * q; f32x2 xp[4];
                    { const f32x4 b0 = *(const LAS f32x4*)(cwl + 256 + chb), b1 = *(const LAS f32x4*)(cwl + 256 + chb + 4);
                      xp[0] = (f32x2){b0.x, b0.y}; xp[1] = (f32x2){b0.z, b0.w}; xp[2] = (f32x2){b1.x, b1.y}; xp[3] = (f32x2){b1.z, b1.w}; }
#pragma unroll
                    for (int tap = 0; tap < 4; ++tap) { const u32x4 pq = pvn[s][tap];
                        const f32x4 w0 = *(const LAS f32x4*)(cwl + tap * 64 + chb), w1 = *(const LAS f32x4*)(cwl + tap * 64 + chb + 4);
                        xp[0] += (f32x2){w0.x, w0.y} * (f32x2){__uint_as_float(pq.x << 16), __uint_as_float(pq.x & 0xffff0000u)}; xp[1] += (f32x2){w0.z, w0.w} * (f32x2){__uint_as_float(pq.y << 16), __uint_as_float(pq.y & 0xffff0000u)};
                        xp[2] += (f32x2){w1.x, w1.y} * (f32x2){__uint_as_float(pq.z << 16), __uint_as_float(pq.z & 0xffff0000u)}; xp[3] += (f32x2){w1.z, w1.w} * (f32x2){__uint_as_float(pq.w << 16), __uint_as_float(pq.w & 0xffff0000u)}; }
                    u32x4 pk; pk.x = pk2(xp[0].x, xp[0].y); pk.y = pk2(xp[1].x, xp[1].y); pk.z = pk2(xp[2].x, xp[2].y); pk.w = pk2(xp[3].x, xp[3].y); afr[s] = __builtin_bit_cast(bf16x8, pk); }
                __builtin_amdgcn_sched_barrier(0);
                if (mm + 1 < MB) load_rows(P0, b, t0, dir == 0 ? m + 1 : m - 1, h, j, q, pvn);
                f32x4 dx[4], da[4], di[4];
#pragma unroll
                for (int n = 0; n < 4; ++n) { const f32x4 z4 = (f32x4){0.f, 0.f, 0.f, 0.f};
                    dx[n] = __builtin_amdgcn_mfma_f32_16x16x32_bf16(afr[n >> 1], idf[n & 1], z4, 0, 0, 0);
                    const bf16x8 wa0 = __builtin_bit_cast(bf16x8, wl[(((dir * 2 + 0) * 4 + n) * 2 + 0) * 64]), wa1 = __builtin_bit_cast(bf16x8, wl[(((dir * 2 + 0) * 4 + n) * 2 + 1) * 64]);
                    const bf16x8 wi0 = __builtin_bit_cast(bf16x8, wl[(((dir * 2 + 1) * 4 + n) * 2 + 0) * 64]), wi1 = __builtin_bit_cast(bf16x8, wl[(((dir * 2 + 1) * 4 + n) * 2 + 1) * 64]);
                    da[n] = __builtin_amdgcn_mfma_f32_16x16x32_bf16(afr[0], wa0, z4, 0, 0, 0); da[n] = __builtin_amdgcn_mfma_f32_16x16x32_bf16(afr[1], wa1, da[n], 0, 0, 0);
                    di[n] = __builtin_amdgcn_mfma_f32_16x16x32_bf16(afr[0], wi0, z4, 0, 0, 0); di[n] = __builtin_amdgcn_mfma_f32_16x16x32_bf16(afr[1], wi1, di[n], 0, 0, 0); }
                float P[4][4], S[4][4], PT[4], ST[4];
#pragma unroll
                for (int n = 0; n < 4; ++n) { float av[4], bv[4];
#pragma unroll
                    for (int hp = 0; hp < 2; ++hp) {
                        const f32x2 rg = sig2((f32x2){da[n][2 * hp], da[n][2 * hp + 1]} + bac[n]), ig = sig2((f32x2){di[n][2 * hp], di[n][2 * hp + 1]} + bic[n]);
                        const f32x2 tq = rg * spc[n];
                        const f32x2 a = (f32x2){__builtin_amdgcn_exp2f(tq.x), __builtin_amdgcn_exp2f(tq.y)};
                        const f32x2 w = 1.0f - a * a;
                        const f32x2 mult = (f32x2){__builtin_amdgcn_sqrtf(fmaxf(w.x, 0.f)), __builtin_amdgcn_sqrtf(fmaxf(w.y, 0.f))};
                        const f32x2 bq = mult * (ig * (f32x2){dx[n][2 * hp], dx[n][2 * hp + 1]});
                        av[2 * hp] = a.x; av[2 * hp + 1] = a.y; bv[2 * hp] = bq.x; bv[2 * hp + 1] = bq.y; }
                    if (dir == 0) { P[n][0] = av[0]; S[n][0] = bv[0];
#pragma unroll
                        for (int r = 1; r < 4; ++r) { P[n][r] = P[n][r - 1] * av[r]; S[n][r] = av[r] * S[n][r - 1] + bv[r]; } }
                    else { P[n][3] = av[3]; S[n][3] = bv[3];
#pragma unroll
                        for (int r = 2; r >= 0; --r) { P[n][r] = P[n][r + 1] * av[r]; S[n][r] = av[r] * S[n][r + 1] + bv[r]; } }
                    PT[n] = dir == 0 ? P[n][3] : P[n][0]; ST[n] = dir == 0 ? S[n][3] : S[n][0]; }
                float pt[4][4], st[4][4];
#pragma unroll
                for (int n = 0; n < 4; ++n)
#pragma unroll
                    for (int g = 0; g < 4; ++g) { pt[n][g] = __shfl(PT[n], j + 16 * g); st[n][g] = __shfl(ST[n], j + 16 * g); }
#pragma unroll
                for (int n = 0; n < 4; ++n) {
                    float C = cst[n], A = arun[n], Cq = 0.f, Aq = 1.f;
#pragma unroll
                    for (int gg = 0; gg < 4; ++gg) { const int g = dir == 0 ? gg : 3 - gg; if (g == q) { Cq = C; Aq = A; } C = pt[n][g] * C + st[n][g]; A *= pt[n][g]; }
                    cst[n] = C; arun[n] = A;
                    float hl[4], ac[4];
#pragma unroll
                    for (int hp = 0; hp < 2; ++hp) { const f32x2 pp = (f32x2){P[n][2 * hp], P[n][2 * hp + 1]}; const f32x2 hq = (f32x2){S[n][2 * hp], S[n][2 * hp + 1]} + pp * Cq, aq = pp * Aq;
                        hl[2 * hp] = hq.x; hl[2 * hp + 1] = hq.y; ac[2 * hp] = aq.x; ac[2 * hp + 1] = aq.y; }
                    const size_t fo = ((size_t)(task * MB + m) * 4 + n) * 64 + lane;
                    if (dir == 0) {
                        hfl[((m * 4 + n) * 2 + 0) * 64] = pk2(hl[0], hl[1]); hfl[((m * 4 + n) * 2 + 1) * 64] = pk2(hl[2], hl[3]);
                        AF[fo] = (u32x2){pk2(ac[0], ac[1]), pk2(ac[2], ac[3])};
                    } else {
                        { const unsigned u0 = hfl[((m * 4 + n) * 2 + 0) * 64], u1 = hfl[((m * 4 + n) * 2 + 1) * 64];
                          hl[0] += __uint_as_float(u0 << 16); hl[1] += __uint_as_float(u0 & 0xffff0000u); hl[2] += __uint_as_float(u1 << 16); hl[3] += __uint_as_float(u1 & 0xffff0000u); }
                        HS[fo] = (u32x2){pk2(hl[0], hl[1]), pk2(hl[2], hl[3])}; AB[fo] = (u32x2){pk2(ac[0], ac[1]), pk2(ac[2], ac[3])};
                    }
                }
            }
            if (q == 0) {
#pragma unroll
                for (int n = 0; n < 4; ++n) SUMM[((size_t)(dir * NB + b) * NCH + chunk) * 1024 + 64 * h + 16 * n + j] = (f32x2){arun[n], cst[n]};
            }
        }
    }
}
__device__ __forceinline__ void stage2(Frame& F) {
    const bf16_t* P1 = (const bf16_t*)(F.ws + WS_P1); bf16_t* YLRU = (bf16_t*)(F.ws + WS_YLRU); const float* CARRY = (const float*)(F.ws + WS_CARRY);
    const u32x2* HS = (const u32x2*)(F.ws + WS_HS); const u32x2* AF = (const u32x2*)(F.ws + WS_AF); const u32x2* AB = (const u32x2*)(F.ws + WS_AB);
    LAS float* buf = (LAS float*)(F.lds + F.wave * 8192);
    const int lane = F.lane, j = lane & 15, q = lane >> 4, tk = lane >> 2, cg = lane & 3;
    const int gw = F.bid * NWAVES + F.wave, NGW = F.G * NWAVES;
    struct In { u32x2 hs[4], af[4], ab[4]; float cf[4], cbk[4]; u32x4 g0, g1; };
    auto issue = [&](int item, In& I) {
        const int m = item & (MB - 1), task = item >> 2, h = task & 15, chunk = (task >> 4) & (NCH - 1), b = task >> 11;
#pragma unroll
        for (int n = 0; n < 4; ++n) { const size_t fo = ((size_t)item * 4 + n) * 64 + lane; I.hs[n] = HS[fo]; I.af[n] = AF[fo]; I.ab[n] = AB[fo];
            const int c = 64 * h + 16 * n + j; I.cf[n] = CARRY[((size_t)(0 * NB + b) * NCH + chunk) * 1024 + c]; I.cbk[n] = CARRY[((size_t)(1 * NB + b) * NCH + chunk) * 1024 + c]; }
        const size_t o = ((size_t)b * L + chunk * TC + 16 * m + tk) * 1024 + 64 * h + 16 * cg;
        I.g0 = *(const u32x4*)(P1 + o); I.g1 = *(const u32x4*)(P1 + o + 8); };
    auto finish = [&](int item, const In& I) {
        const int m = item & (MB - 1), task = item >> 2, h = task & 15, chunk = (task >> 4) & (NCH - 1), b = task >> 11;
#pragma unroll
        for (int n = 0; n < 4; ++n) {
            const float h0 = __uint_as_float(I.hs[n].x << 16) + __uint_as_float(I.af[n].x << 16) * I.cf[n] + __uint_as_float(I.ab[n].x << 16) * I.cbk[n];
            const float h1 = __uint_as_float(I.hs[n].x & 0xffff0000u) + __uint_as_float(I.af[n].x & 0xffff0000u) * I.cf[n] + __uint_as_float(I.ab[n].x & 0xffff0000u) * I.cbk[n];
            const float h2 = __uint_as_float(I.hs[n].y << 16) + __uint_as_float(I.af[n].y << 16) * I.cf[n] + __uint_as_float(I.ab[n].y << 16) * I.cbk[n];
            const float h3 = __uint_as_float(I.hs[n].y & 0xffff0000u) + __uint_as_float(I.af[n].y & 0xffff0000u) * I.cf[n] + __uint_as_float(I.ab[n].y & 0xffff0000u) * I.cbk[n];
            buf[(4 * q + 0) * 68 + 16 * n + j] = h0; buf[(4 * q + 1) * 68 + 16 * n + j] = h1; buf[(4 * q + 2) * 68 + 16 * n + j] = h2; buf[(4 * q + 3) * 68 + 16 * n + j] = h3;
        }
        LDS_WAIT();
        const size_t o = ((size_t)b * L + chunk * TC + 16 * m + tk) * 1024 + 64 * h + 16 * cg;
        const LAS f32x4* br = (const LAS f32x4*)(buf + tk * 68 + 16 * cg);
        const f32x4 v0 = br[0], v1 = br[1], v2 = br[2], v3 = br[3];
        float gg[16];
        { const unsigned w[8] = {I.g0.x, I.g0.y, I.g0.z, I.g0.w, I.g1.x, I.g1.y, I.g1.z, I.g1.w};
#pragma unroll
          for (int i = 0; i < 8; ++i) { gg[2 * i] = gelu_tanh(__uint_as_float(w[i] << 16)); gg[2 * i + 1] = gelu_tanh(__uint_as_float(w[i] & 0xffff0000u)); } }
        u32x4 y0, y1;
        y0.x = pk2(v0.x * gg[0], v0.y * gg[1]); y0.y = pk2(v0.z * gg[2], v0.w * gg[3]); y0.z = pk2(v1.x * gg[4], v1.y * gg[5]); y0.w = pk2(v1.z * gg[6], v1.w * gg[7]);
        y1.x = pk2(v2.x * gg[8], v2.y * gg[9]); y1.y = pk2(v2.z * gg[10], v2.w * gg[11]); y1.z = pk2(v3.x * gg[12], v3.y * gg[13]); y1.w = pk2(v3.z * gg[14], v3.w * gg[15]);
        *(u32x4*)(YLRU + o) = y0; *(u32x4*)(YLRU + o + 8) = y1;
        LDS_WAIT(); };
    constexpr int NIT = NB * NCH * 16 * MB;
    In A, B; int item = gw;
    if (item < NIT) issue(item, A);
#pragma unroll 1
    for (; item < NIT; item += 2 * NGW) {
        if (item + NGW < NIT) issue(item + NGW, B);
        finish(item, A);
        if (item + NGW >= NIT) break;
        if (item + 2 * NGW < NIT) issue(item + 2 * NGW, A);
        finish(item + NGW, B);
    }
}
__device__ __forceinline__ void carry(Frame& F) {
    const f32x2* SUMM = (const f32x2*)(F.ws + WS_SUMM); float* CARRY = (float*)(F.ws + WS_CARRY);
    for (int idx = F.bid * NTHREADS + F.tid; idx < 2 * NB * 1024; idx += F.G * NTHREADS) {
        const int c = idx & 1023, db = idx >> 10, dir = db >> 2; const size_t base = (size_t)db * NCH * 1024 + c;
        float C = 0.f;
#pragma unroll 1
        for (int k0 = 0; k0 < NCH; k0 += 16) {
            f32x2 v[16];
#pragma unroll
            for (int i = 0; i < 16; ++i) { const int k = dir == 0 ? (k0 + i) : (NCH - 1 - k0 - i); v[i] = SUMM[base + (size_t)k * 1024]; }
#pragma unroll
            for (int i = 0; i < 16; ++i) { const int k = dir == 0 ? (k0 + i) : (NCH - 1 - k0 - i); CARRY[base + (size_t)k * 1024] = C; C = v[i].x * C + v[i].y; }
        }
    }
}
}
__device__ __forceinline__ void transpose_item(const float* __restrict__ W, int ldw, int k0, int n0, bf16_t* __restrict__ WT, size_t orow0, const float* __restrict__ kscale, LAS float* scr, int lane) {
    const int r8 = lane >> 3, c4 = (lane & 7) * 4;
#pragma unroll
    for (int i = 0; i < 8; ++i) { const int kk = 8 * i + r8; f32x4 v = *(const f32x4*)(W + (size_t)(k0 + kk) * ldw + n0 + c4);
        if (kscale) { const float s = kscale[k0 + kk]; v = v * s; }
        scr[kk * 33 + c4 + 0] = v.x; scr[kk * 33 + c4 + 1] = v.y; scr[kk * 33 + c4 + 2] = v.z; scr[kk * 33 + c4 + 3] = v.w; }
    LDS_WAIT();
    const int c = lane & 7;
#pragma unroll
    for (int j = 0; j < 4; ++j) { const int n = (lane >> 3) + 8 * j; const LAS float* s = scr + (8 * c) * 33 + n;
        u32x4 o; o.x = pk2(s[0 * 33], s[1 * 33]); o.y = pk2(s[2 * 33], s[3 * 33]); o.z = pk2(s[4 * 33], s[5 * 33]); o.w = pk2(s[6 * 33], s[7 * 33]);
        *(u32x4*)(WT + (orow0 + n) * 1024 + k0 + 8 * c) = o; }
    LDS_WAIT();
}

__device__ __forceinline__ void phase_prep(Frame& F) {
    LAS float* scr = (LAS float*)(F.lds + F.wave * 16384);
    const int gw = F.bid * NWAVES + F.wave, NGW = F.G * NWAVES;
    constexpr int I_IN = (1024 / 64) * (NIN / 32), I_SQ = (1024 / 64) * (1024 / 32);
    for (int it = gw; it < I_IN + 3 * I_SQ; it += NGW) {
        int r = it; const float* W; int N; bf16_t* WT;
        if (r < I_IN) { W = F.in[2]; N = NIN; WT = (bf16_t*)(F.ws + WS_WIN); }
        else { r -= I_IN; const int q = r / I_SQ; r -= q * I_SQ; N = 1024; W = q == 0 ? F.in[11] : q == 1 ? F.in[23] : F.in[24]; WT = (bf16_t*)(F.ws + (q == 0 ? WS_WLRU : q == 1 ? WS_WHY : WS_WOUT)); }
        const int nblk = N / 32, kb = r / nblk, nb = r % nblk;
        int orow = 32 * nb;
        if (N == NIN && orow >= 5120) { const int which = (orow - 5120) >> 10, cc = (orow - 5120) & 1023; orow = 5120 + 256 * (cc >> 7) + 128 * which + (cc & 127); }
        transpose_item(W, N, 64 * kb, 32 * nb, WT, (size_t)orow, nullptr, scr, F.lane);
    }
    { const float* x = F.in[0]; const float* g = F.in[1]; bf16_t* U = (bf16_t*)(F.ws + WS_U);
      f32x4 gg[4];
#pragma unroll
      for (int j = 0; j < 4; ++j) gg[j] = ((const f32x4*)g)[F.lane + 64 * j];
      auto ld = [&](int row, f32x4 (&v)[4]) { const f32x4* xr = (const f32x4*)(x + (size_t)row * D) + F.lane;
#pragma unroll
          for (int j = 0; j < 4; ++j) v[j] = xr[64 * j]; };
      auto fin = [&](int row, const f32x4 (&v)[4]) { float s = 0.f;
#pragma unroll
          for (int j = 0; j < 4; ++j) s += v[j].x * v[j].x + v[j].y * v[j].y + v[j].z * v[j].z + v[j].w * v[j].w;
          const float rstd = rsqrtf(wave_sum(s) * (1.0f / D) + EPS);
#pragma unroll
          for (int j = 0; j < 4; ++j) { u32x2 w; w.x = pk2(v[j].x * rstd * gg[j].x, v[j].y * rstd * gg[j].y); w.y = pk2(v[j].z * rstd * gg[j].z, v[j].w * rstd * gg[j].w);
              ((u32x2*)(U + (size_t)row * D))[F.lane + 64 * j] = w; } };
      f32x4 va[4], vb[4], vc[4]; int row = gw;
      if (row < T) ld(row, va);
      if (row + NGW < T) ld(row + NGW, vb);
#pragma unroll 1
      for (; row < T; row += 3 * NGW) {
          if (row + 2 * NGW < T) ld(row + 2 * NGW, vc);
          fin(row, va);
          if (row + NGW >= T) break;
          if (row + 3 * NGW < T) ld(row + 3 * NGW, va);
          fin(row + NGW, vb);
          if (row + 2 * NGW >= T) break;
          if (row + 4 * NGW < T) ld(row + 4 * NGW, vb);
          fin(row + 2 * NGW, vc);
      } }
    { const float *w1 = F.in[14], *b1 = F.in[15], *w2 = F.in[16], *b2 = F.in[17], *w3 = F.in[18], *b3 = F.in[19], *freq = F.in[21]; float* HH3 = (float*)(F.ws + WS_HH3);
      LAS float* feat = scr; LAS float* h1 = scr + 64; LAS float* h2 = scr + 128; const int u = F.lane; const float fr = freq[u];
#pragma unroll 1
      for (int t = gw; t < L; t += NGW) {
        asm volatile("" ::: "memory");
        if (u < HYEMB) { float f; if (u == 0) f = (float)t / (float)(L - 1);
            else { const int j = (u - 1) & 15; const float band = 1e-4f + (float)j * ((15.0f - 1e-4f) / 15.0f); const float arg = (6.283185307179586f * (float)t / (float)L) * band; f = (u <= 16) ? cosf(arg) : -sinf(arg); }
            feat[u] = f; }
        LDS_WAIT();
        float s = b1[u];
#pragma unroll 1
        for (int f = 0; f < HYEMB; ++f) s += feat[f] * w1[f * 64 + u];
        h1[u] = sinf(fr * s); LDS_WAIT();
        s = b2[u];
#pragma unroll 4
        for (int f = 0; f < 64; ++f) s += h1[f] * w2[f * 64 + u];
        h2[u] = sinf(fr * s); LDS_WAIT();
        s = b3[u];
#pragma unroll 4
        for (int f = 0; f < 64; ++f) s += h2[f] * w3[f * 64 + u];
        HH3[t * 64 + u] = sinf(fr * s); LDS_WAIT(); } }
    lru::prep_wfrag(F); hy::prep_w4frag(F);
    { u32x4* WRGF = (u32x4*)(F.ws + WS_WRG); const float* g = F.in[25]; const float* wr = F.in[26];
      for (int idx = F.bid * NTHREADS + F.tid; idx < 32 * 2 * 2 * 64; idx += F.G * NTHREADS) {
          const int lane = idx & 63, part = (idx >> 6) & 1, tile = (idx >> 7) & 1, s = idx >> 8; const int e = 16 * tile + (lane & 15), k0 = 32 * s + 8 * (lane >> 4);
          float w[8];
#pragma unroll
          for (int jj = 0; jj < 8; ++jj) { const float v = g[k0 + jj] * wr[(k0 + jj) * 32 + e]; const float hi = __uint_as_float(pk2(v, v) << 16); w[jj] = part == 0 ? hi : v - hi; }
          u32x4 o; o.x = pk2(w[0], w[1]); o.y = pk2(w[2], w[3]); o.z = pk2(w[4], w[5]); o.w = pk2(w[6], w[7]); WRGF[idx] = o; } }
}

template <int KIND, bool DYN> __device__ __forceinline__ void convert_weights(Frame& F, int rank, int nranks, int rnd_lo = 0, int rnd_hi = 1 << 20) {
    LAS float* scr = (LAS float*)(F.lds + F.wave * 16384);
    const int gw = rank * NWAVES + F.wave, NGW = nranks * NWAVES;
    constexpr int IPE = KIND == 0 ? (1024 / 64) * (2048 / 32) : (1024 / 64) * (1024 / 32), TOTAL_ALL = NE * IPE;
    const int TOTAL = (long)rnd_hi * NGW < (long)TOTAL_ALL ? rnd_hi * NGW : TOTAL_ALL;
    int* ctr = (int*)(F.ws + WS_CTL) + 130;
    auto claim = [&]() { int v = 0; if (DYN && F.lane == 0) v = atomicAdd(ctr, 1); return v; };
    const float* Wc = nullptr; bf16_t* WTc = nullptr; size_t orowc = 0; int k0c = 0; f32x4 vc[8];
    auto decode_load = [&](int it, const float*& W, bf16_t*& WT, size_t& orow, int& k0, f32x4 (&v)[8]) {
        const int e = it / IPE, r = it - e * IPE; int ldw, n0;
        if (KIND == 0) { const int kb = r / 64, nb = r % 64; n0 = 32 * nb; const int which = n0 >> 10, pn = (n0 & 1023) >> 7, j0 = n0 & 127;
            W = F.in[28] + (size_t)e * 1024 * 2048; ldw = 2048; k0 = 64 * kb; WT = (bf16_t*)(F.ws + WS_WGU); orow = (size_t)e * 2048 + 256 * pn + 128 * which + j0; }
        else { const int kb = r / 32, nb = r % 32; n0 = 32 * nb;
            W = F.in[30] + (size_t)e * 1024 * 1024; ldw = 1024; k0 = 64 * kb; WT = (bf16_t*)(F.ws + WS_WDN); orow = (size_t)e * 1024 + 32 * nb; }
        const int r8 = F.lane >> 3, c4 = (F.lane & 7) * 4;
#pragma unroll
        for (int i = 0; i < 8; ++i) { const int kk = 8 * i + r8; v[i] = *(const f32x4*)(W + (size_t)(k0 + kk) * ldw + n0 + c4); if (KIND == 0) v[i] = v[i] * F.in[25][k0 + kk]; }
    };
    int it, itn, raw2 = 0;
    if (DYN) { const int r0 = claim(), r1 = claim(); raw2 = claim(); it = __builtin_amdgcn_readfirstlane(r0); itn = __builtin_amdgcn_readfirstlane(r1); }
    else { it = rnd_lo * NGW + gw; itn = it + NGW; }
    if (it < TOTAL) decode_load(it, Wc, WTc, orowc, k0c, vc);
#pragma unroll 1
    while (it < TOTAL) {
        const float* Wn = nullptr; bf16_t* WTn = nullptr; size_t orown = 0; int k0n = 0; f32x4 vn[8];
        const bool more = itn < TOTAL;
        if (more) decode_load(itn, Wn, WTn, orown, k0n, vn);
        { const int r8 = F.lane >> 3, c4 = (F.lane & 7) * 4;
#pragma unroll
          for (int i = 0; i < 8; ++i) { const int kk = 8 * i + r8; scr[kk * 33 + c4 + 0] = vc[i].x; scr[kk * 33 + c4 + 1] = vc[i].y; scr[kk * 33 + c4 + 2] = vc[i].z; scr[kk * 33 + c4 + 3] = vc[i].w; }
          LDS_WAIT();
          const int c = F.lane & 7;
#pragma unroll
          for (int j = 0; j < 4; ++j) { const int n = (F.lane >> 3) + 8 * j; const LAS float* s = scr + (8 * c) * 33 + n;
              u32x4 o; o.x = pk2(s[0 * 33], s[1 * 33]); o.y = pk2(s[2 * 33], s[3 * 33]); o.z = pk2(s[4 * 33], s[5 * 33]); o.w = pk2(s[6 * 33], s[7 * 33]);
              *(u32x4*)(WTc + (orowc + n) * 1024 + k0c + 8 * c) = o; }
          LDS_WAIT(); }
        if (more) { Wc = Wn; WTc = WTn; orowc = orown; k0c = k0n;
#pragma unroll
            for (int i = 0; i < 8; ++i) vc[i] = vn[i]; }
        it = itn;
        if (DYN) { itn = __builtin_amdgcn_readfirstlane(raw2); raw2 = claim(); } else itn += NGW;
    }
}
__device__ __forceinline__ void phase_router_a(Frame& F) {
#ifdef MIXDESYNC
    convert_weights<0, false>(F, F.bid, F.G, 2 * MIXDESYNC); convert_weights<1, false>(F, F.bid, F.G);
#else
    REP(11) { convert_weights<0, false>(F, F.bid, F.G); convert_weights<1, false>(F, F.bid, F.G); }
#endif
    __syncthreads();
    { const f32x4* src = (const f32x4*)(F.ws + WS_WRG); LAS f32x4* dst = (LAS f32x4*)F.lds;
      for (int i = F.tid; i < 32 * 2 * 2 * 64; i += NTHREADS) dst[i] = src[i]; }
    LAS int* hist = (LAS int*)(F.lds + MISC_OFF);
    if (F.tid < 32) hist[F.tid] = 0;
    __syncthreads();
    const LAS u32x4* wl = (const LAS u32x4*)F.lds + F.lane;
    const bf16_t* HB = (const bf16_t*)(F.ws + WS_HN); const float* br = F.in[27];
    int* EROWTOK = (int*)(F.ws + WS_EROWTOK); float* EROWRS = (float*)(F.ws + WS_EROWRS); float* EROWGATE = (float*)(F.ws + WS_EROWGATE); int* TOKCODE = (int*)(F.ws + WS_TOKROW); LAS int* base = hist + 32;
    for (int g0 = 0; g0 < T / 16; g0 += F.G * NWAVES) {
        const int grp = g0 + F.bid * NWAVES + F.wave; const bool act = grp < T / 16;
        int te_[4] = {0, 0, 0, 0}, lr_[4] = {0, 0, 0, 0}; float gt_[4] = {0.f, 0.f, 0.f, 0.f}, rs_ = 0.f;
        const int n = F.lane & 15, g = F.lane >> 4; const int t = grp * 16 + n;
        if (act) {
        const u32x4* hp = (const u32x4*)(HB + (size_t)t * D + 8 * g);
        f32x4 acc[2] = {(f32x4){0.f, 0.f, 0.f, 0.f}, (f32x4){0.f, 0.f, 0.f, 0.f}}; f32x2 ss2 = (f32x2){0.f, 0.f};
        u32x4 hb[8];
#pragma unroll
        for (int u = 0; u < 8; ++u) hb[u] = hp[u * 4];
#pragma unroll 1
        for (int s0 = 0; s0 < 32; s0 += 8) {
#pragma unroll
            for (int u = 0; u < 8; ++u) { const int s = s0 + u; const u32x4 cur = hb[u];
                if (s0 + 8 < 32) hb[u] = hp[(s + 8) * 4];
                const bf16x8 bfr = __builtin_bit_cast(bf16x8, cur);
#pragma unroll
                for (int tile = 0; tile < 2; ++tile) {
                    acc[tile] = __builtin_amdgcn_mfma_f32_16x16x32_bf16(__builtin_bit_cast(bf16x8, wl[((s * 2 + tile) * 2 + 0) * 64]), bfr, acc[tile], 0, 0, 0);
                    acc[tile] = __builtin_amdgcn_mfma_f32_16x16x32_bf16(__builtin_bit_cast(bf16x8, wl[((s * 2 + tile) * 2 + 1) * 64]), bfr, acc[tile], 0, 0, 0); }
                const f32x2 a = (f32x2){__uint_as_float(cur.x << 16), __uint_as_float(cur.x & 0xffff0000u)}, b = (f32x2){__uint_as_float(cur.y << 16), __uint_as_float(cur.y & 0xffff0000u)};
                const f32x2 c = (f32x2){__uint_as_float(cur.z << 16), __uint_as_float(cur.z & 0xffff0000u)}, d = (f32x2){__uint_as_float(cur.w << 16), __uint_as_float(cur.w & 0xffff0000u)};
                ss2 += a * a; ss2 += b * b; ss2 += c * c; ss2 += d * d; }
        }
        float ss = ss2.x + ss2.y; ss += __shfl_xor(ss, 16); ss += __shfl_xor(ss, 32);
        const float rstd = rsqrtf(ss * (1.0f / D) + EPS);
        float v[8];
#pragma unroll
        for (int q = 0; q < 8; ++q) v[q] = acc[q >> 2][q & 3] * rstd + br[16 * (q >> 2) + 4 * g + (q & 3)];
        float tv[4]; int te[4];
#pragma unroll
        for (int k = 0; k < 4; ++k) {
            float mx = -3.0e38f; int mi = 0;
#pragma unroll
            for (int q = 0; q < 8; ++q) { const int ex = 16 * (q >> 2) + 4 * g + (q & 3); if (v[q] > mx) { mx = v[q]; mi = ex; } }
#pragma unroll
            for (int o = 16; o <= 32; o <<= 1) { const float om = __shfl_xor(mx, o); const int oi = __shfl_xor(mi, o); if (om > mx || (om == mx && oi < mi)) { mx = om; mi = oi; } }
            tv[k] = mx; te[k] = mi;
#pragma unroll
            for (int q = 0; q < 8; ++q) { const int ex = 16 * (q >> 2) + 4 * g + (q & 3); if (ex == mi) v[q] = -3.0e38f; }
        }
        const float e1 = __expf(tv[1] - tv[0]), e2 = __expf(tv[2] - tv[0]), e3 = __expf(tv[3] - tv[0]); const float inv = 1.0f / (1.0f + e1 + e2 + e3);
        if (g == 0) {
            gt_[0] = inv; gt_[1] = e1 * inv; gt_[2] = e2 * inv; gt_[3] = e3 * inv; rs_ = rstd;
#pragma unroll
            for (int k = 0; k < 4; ++k) { te_[k] = te[k]; lr_[k] = atomicAdd((int*)&hist[te[k]], 1); }
        }
        }
        __syncthreads();
        if (F.tid < 32) base[F.tid] = hist[F.tid] != 0 ? atomicAdd((int*)(F.ws + WS_CTL) + F.tid, hist[F.tid]) : 0;
        __syncthreads();
        if (act && g == 0) { int code[4];
#pragma unroll
            for (int k = 0; k < 4; ++k) { const int e = te_[k], pos = base[e] + lr_[k]; const size_t o = (size_t)e * T + pos;
                EROWTOK[o] = t; EROWRS[o] = rs_; EROWGATE[o] = gt_[k]; code[k] = (e << 15) | pos; }
            *(int4*)(TOKCODE + t * 4) = make_int4(code[0], code[1], code[2], code[3]); }
        __syncthreads();
        if (F.tid < 32) hist[F.tid] = 0;
        __syncthreads();
    }
}
__device__ __forceinline__ const LAS int* build_ptile(Frame& F) {
    LAS int* pt = (LAS int*)(F.lds + MISC_OFF + 256);
    __syncthreads();
    if (F.tid == 0) { const int* cnt = (const int*)(F.ws + WS_CTL); int o = 0; for (int e = 0; e < 32; ++e) { pt[e] = o; o += (cnt[e] + 255) >> 8; } pt[32] = o; }
    __syncthreads();
    return pt;
}
__device__ __forceinline__ void phase_router_b(Frame& F) {
    const LAS int* pt = build_ptile(F);
    LAS int* hist = (LAS int*)(F.lds + MISC_OFF); LAS int* base = hist + 32;
    const int* TOPE = (const int*)(F.ws + WS_TOPE); const float* TOPG = (const float*)(F.ws + WS_TOPG); const float* TOKRS = (const float*)(F.ws + WS_TOKRS);
    int* ROWTOK = (int*)(F.ws + WS_ROWTOK); float* ROWGATE = (float*)(F.ws + WS_ROWGATE); float* ROWRS = (float*)(F.ws + WS_ROWRS); int* TOKROW = (int*)(F.ws + WS_TOKROW);
    int* cursor = (int*)(F.ws + WS_CTL) + 64; const int* cnt = (const int*)(F.ws + WS_CTL);
    for (int chunk = F.bid; chunk < T * 4 / NTHREADS; chunk += F.G) {
        __syncthreads();
        if (F.tid < 32) hist[F.tid] = 0;
        __syncthreads();
        const int idx = chunk * NTHREADS + F.tid; const int e = TOPE[idx]; const int lr = atomicAdd((int*)&hist[e], 1);
        __syncthreads();
        if (F.tid < 32) base[F.tid] = hist[F.tid] ? atomicAdd(cursor + F.tid, hist[F.tid]) : 0;
        __syncthreads();
        const int row = pt[e] * 256 + base[e] + lr;
        ROWTOK[row] = idx >> 2; ROWGATE[row] = TOPG[idx]; ROWRS[row] = TOKRS[idx >> 2]; TOKROW[idx] = row;
    }
    if (F.bid == 0) for (int e = F.wave; e < 32; e += NWAVES) { const int r0 = pt[e] * 256 + cnt[e], r1 = pt[e + 1] * 256; for (int r = r0 + F.lane; r < r1; r += 64) { ROWTOK[r] = 0; ROWGATE[r] = 0.f; ROWRS[r] = 0.f; } }
}
#ifdef YS_FP8
__device__ __forceinline__ void phase_final(Frame& F) {
    const int gw = F.bid * NWAVES + F.wave, NGW = F.G * NWAVES;
    float* out = F.out; const bf16_t* HB = (const bf16_t*)(F.ws + WS_HN); const unsigned char* YS8 = (const unsigned char*)(F.ws + WS_YS); const int* TOKROW = (const int*)(F.ws + WS_TOKROW); const float* g = F.in[32];
    const LAS int* pt = build_ptile(F);
    struct In { u32x4 h[2]; u32x2 y[4][2]; };
    auto issue = [&](int t, const int4 rows, In& I) {
#pragma unroll
        for (int j = 0; j < 2; ++j) I.h[j] = ((const u32x4*)(HB + (size_t)t * D))[F.lane + 64 * j];
#pragma unroll
        for (int k = 0; k < 4; ++k) { const int code = k == 0 ? rows.x : k == 1 ? rows.y : k == 2 ? rows.z : rows.w; const size_t row = (size_t)(pt[code >> 15] * 256 + (code & 32767));
#pragma unroll
            for (int j = 0; j < 2; ++j) I.y[k][j] = ((const u32x2*)(YS8 + row * D))[F.lane + 64 * j]; } };
    auto finish = [&](int t, const In& I) {
        float v[2][8]; float s = 0.f;
#pragma unroll
        for (int j = 0; j < 2; ++j) { const unsigned hw[4] = {I.h[j].x, I.h[j].y, I.h[j].z, I.h[j].w};
#pragma unroll
            for (int i = 0; i < 4; ++i) { v[j][2 * i] = __uint_as_float(hw[i] << 16); v[j][2 * i + 1] = __uint_as_float(hw[i] & 0xffff0000u); }
#pragma unroll
            for (int k = 0; k < 4; ++k) { const f32x2 a = __builtin_amdgcn_cvt_pk_f32_fp8((int)I.y[k][j].x, false), b = __builtin_amdgcn_cvt_pk_f32_fp8((int)I.y[k][j].x, true),
                                                      c = __builtin_amdgcn_cvt_pk_f32_fp8((int)I.y[k][j].y, false), d = __builtin_amdgcn_cvt_pk_f32_fp8((int)I.y[k][j].y, true);
                v[j][0] += a.x; v[j][1] += a.y; v[j][2] += b.x; v[j][3] += b.y; v[j][4] += c.x; v[j][5] += c.y; v[j][6] += d.x; v[j][7] += d.y; }
#pragma unroll
            for (int i = 0; i < 8; ++i) s += v[j][i] * v[j][i]; }
        const float rstd = rsqrtf(wave_sum(s) * (1.0f / D) + EPS);
#pragma unroll
        for (int j = 0; j < 2; ++j) { const f32x4 g0 = ((const f32x4*)g)[2 * (F.lane + 64 * j)], g1 = ((const f32x4*)g)[2 * (F.lane + 64 * j) + 1];
            f32x4* o = (f32x4*)(out + (size_t)t * D) + 2 * (F.lane + 64 * j);
            o[0] = (f32x4){v[j][0] * rstd * g0.x, v[j][1] * rstd * g0.y, v[j][2] * rstd * g0.z, v[j][3] * rstd * g0.w};
            o[1] = (f32x4){v[j][4] * rstd * g1.x, v[j][5] * rstd * g1.y, v[j][6] * rstd * g1.z, v[j][7] * rstd * g1.w}; } };
    int t = gw;
    int4 rowsA = make_int4(0, 0, 0, 0), rowsB = make_int4(0, 0, 0, 0); In dA, dB;
    if (t < T) rowsA = *(const int4*)(TOKROW + t * 4);
    if (t + NGW < T) rowsB = *(const int4*)(TOKROW + (t + NGW) * 4);
    if (t < T) issue(t, rowsA, dA);
#pragma unroll 1
    for (; t < T; t += 2 * NGW) {
        const int t1 = t + NGW, t2 = t + 2 * NGW, t3 = t + 3 * NGW;
        if (t2 < T) rowsA = *(const int4*)(TOKROW + t2 * 4);
        if (t1 < T) issue(t1, rowsB, dB);
        finish(t, dA);
        if (t1 >= T) break;
        if (t3 < T) rowsB = *(const int4*)(TOKROW + t3 * 4);
        if (t2 < T) issue(t2, rowsA, dA);
        finish(t1, dB);
    }
}
#else
__device__ __forceinline__ void phase_final(Frame& F) {
    const int gw = F.bid * NWAVES + F.wave, NGW = F.G * NWAVES;
    float* out = F.out; const bf16_t* HB = (const bf16_t*)(F.ws + WS_HN); const bf16_t* YS = (const bf16_t*)(F.ws + WS_YS); const int* TOKROW = (const int*)(F.ws + WS_TOKROW); const float* g = F.in[32];
    const LAS int* pt = build_ptile(F);
    auto issue = [&](int t, const int4 rows, u32x2 (&d)[5][4]) {
#pragma unroll
        for (int j = 0; j < 4; ++j) d[0][j] = ((const u32x2*)(HB + (size_t)t * D))[F.lane + 64 * j];
#pragma unroll
        for (int k = 0; k < 4; ++k) { const int code = k == 0 ? rows.x : k == 1 ? rows.y : k == 2 ? rows.z : rows.w; const size_t row = (size_t)(pt[code >> 15] * 256 + (code & 32767));
#pragma unroll
            for (int j = 0; j < 4; ++j) d[1 + k][j] = ((const u32x2*)(YS + row * D))[F.lane + 64 * j]; } };
    auto finish = [&](int t, const u32x2 (&d)[5][4]) {
        f32x4 v[4];
#pragma unroll
        for (int j = 0; j < 4; ++j) { v[j] = (f32x4){__uint_as_float(d[0][j].x << 16), __uint_as_float(d[0][j].x & 0xffff0000u), __uint_as_float(d[0][j].y << 16), __uint_as_float(d[0][j].y & 0xffff0000u)};
#pragma unroll
            for (int k = 1; k < 5; ++k) { const u32x2 w = d[k][j];
                v[j].x += __uint_as_float(w.x << 16); v[j].y += __uint_as_float(w.x & 0xffff0000u); v[j].z += __uint_as_float(w.y << 16); v[j].w += __uint_as_float(w.y & 0xffff0000u); } }
        float s = 0.f;
#pragma unroll
        for (int j = 0; j < 4; ++j) s += v[j].x * v[j].x + v[j].y * v[j].y + v[j].z * v[j].z + v[j].w * v[j].w;
        const float rstd = rsqrtf(wave_sum(s) * (1.0f / D) + EPS);
#pragma unroll
        for (int j = 0; j < 4; ++j) { const f32x4 gg = ((const f32x4*)g)[F.lane + 64 * j];
            ((f32x4*)(out + (size_t)t * D))[F.lane + 64 * j] = (f32x4){v[j].x * rstd * gg.x, v[j].y * rstd * gg.y, v[j].z * rstd * gg.z, v[j].w * rstd * gg.w}; } };
    int t = gw;
    int4 rowsA = make_int4(0, 0, 0, 0), rowsB = make_int4(0, 0, 0, 0); u32x2 dA[5][4], dB[5][4];
    if (t < T) rowsA = *(const int4*)(TOKROW + t * 4);
    if (t + NGW < T) rowsB = *(const int4*)(TOKROW + (t + NGW) * 4);
    if (t < T) issue(t, rowsA, dA);
#pragma unroll 1
    for (; t < T; t += 2 * NGW) {
        const int t1 = t + NGW, t2 = t + 2 * NGW, t3 = t + 3 * NGW;
        if (t2 < T) rowsA = *(const int4*)(TOKROW + t2 * 4);
        if (t1 < T) issue(t1, rowsB, dB);
        finish(t, dA);
        if (t1 >= T) break;
        if (t3 < T) rowsB = *(const int4*)(TOKROW + t3 * 4);
        if (t2 < T) issue(t2, rowsA, dA);
        finish(t1, dB);
    }
}

#endif
__global__ void __launch_bounds__(NTHREADS, 2) mega(Args args) {
    extern __shared__ __attribute__((aligned(16))) unsigned char lds_raw[];
    cg::grid_group grid = cg::this_grid();
    Frame F; F.lds = (LAS unsigned char*)lds_raw; F.tid = threadIdx.x; F.lane = F.tid & 63; F.wave = __builtin_amdgcn_readfirstlane(F.tid >> 6); F.G = gridDim.x; F.bid = blockIdx.x;
    F.in = args.in; F.out = args.out; F.ws = args.ws;
    const int lo = args.ph_lo, hi = args.ph_hi;
    if (F.tid < 2) ((LAS unsigned*)(F.lds + MISC_OFF + 512))[F.tid] = 0u;
    __syncthreads();
    (void)xcd_barrier_post((unsigned*)(args.ws + WS_CTL + 16384) + args.li * XCD_BAR_WORDS, (volatile LAS unsigned*)(F.lds + MISC_OFF + 512));
#ifndef STAG1
#define STAG1 650
#endif
#define IN(k) (lo <= (k) && (k) < hi)
#define FRESH() do { size_t z_ = 0; F.tid = threadIdx.x; asm volatile("" : "+s"(z_), "+v"(F.tid)); F.ws = args.ws + z_; F.lane = F.tid & 63; ws = F.ws; } while (0)
#ifdef PROBE_PHASE
#define TS(k) do { if (blockIdx.x == 0 && threadIdx.x == 0) ((unsigned long long*)(args.ws + WS_CTL + 2048))[k] = __builtin_amdgcn_s_memrealtime(); } while (0)
#else
#define TS(k) do {} while (0)
#endif
#define SEAM(k) do { if (IN(k) && IN((k) + 1)) { if (hi > 1000) grid.sync();   else { XcdBarrier xb_; xb_.bar = (unsigned*)(args.ws + WS_CTL + 16384) + args.li * XCD_BAR_WORDS; xb_.x = xb_xcc_id(); xb_.st = (volatile LAS unsigned*)(F.lds + MISC_OFF + 512); xcd_barrier(xb_); if ((DUPMASK >> 21) & 1) xcd_barrier(xb_); } } } while (0)
    unsigned char* ws = args.ws;
    if (IN(0)) { TS(0); FRESH(); REP(0) phase_prep(F); } SEAM(0);
    if (IN(1)) { TS(1); FRESH();
        pg8::SchedDenseT<1> S; S.bias = args.in[3]; S.O.init(T / 256, NIN / 256, F.G, F.bid); S.A = (const char*)(ws + WS_U); S.B = (const char*)(ws + WS_WIN);
        pg8::EpiIn E{(bf16_t*)(ws + WS_P0), (bf16_t*)(ws + WS_P1), (bf16_t*)(ws + WS_PHY), (bf16_t*)(ws + WS_PG), args.in[3]};
#ifdef DESYNC1
        const int nbefore_ = DESYNC1 == 2 ? (((F.bid >> 3) & 1) ? 0 : 4) : DESYNC1 == 4 ? ((F.bid >> 3) & 3) : DESYNC1 == 3 ? 2 * ((F.bid >> 3) & 1) + 1 : 0;
        if (nbefore_ > 0) { hy::init_tw128(F); hy::filter_pass_a<false>(F, 0, nbefore_); __syncthreads(); }
#endif
        pg8::gemm_phase<pg8::EpiIn, pg8::SchedDenseT<1>, false>(F.lds, S, E); if ((DUPMASK >> 1) & 1) { pg8::gemm_phase<pg8::EpiIn, pg8::SchedDenseT<1>, false>(F.lds, S, E); } if ((DUPMASK >> 13) & 1) { pg8::EpiProbeStore E1{(bf16_t*)(ws + WS_YZ)}; pg8::gemm_phase<pg8::EpiProbeStore, pg8::SchedDenseT<1>, false>(F.lds, S, E1); } if ((DUPMASK >> 12) & 1) { pg8::EpiNone E0; pg8::gemm_phase<pg8::EpiNone, pg8::SchedDenseT<1>, false>(F.lds, S, E0); }
        if ((DUPMASK >> 18) & 1) { pg8::EpiNone E0; pg8::SchedDenseProbe SP; SP.O = S.O; SP.A = S.A; SP.B = S.B; pg8::gemm_phase<pg8::EpiNone, pg8::SchedDenseProbe, false>(F.lds, SP, E0); }
#ifdef DESYNC1
        if (nbefore_ < 4) { __syncthreads(); hy::init_tw128(F); hy::filter_pass_a<false>(F, nbefore_); }
#else
        hy::init_tw128(F); if ((DUPMASK >> 14) & 1) hy::filter_pass_a<true>(F); hy::filter_pass_a<false>(F);
#endif
    } SEAM(1);
#ifdef P2_ALTERNATE
    if (IN(2)) { TS(2); FRESH();
        const bool rev_ = ((F.bid >> 3) & 1) != 0;
        if (!rev_) { lru::stage1(F); __syncthreads(); hy::init_tw128(F); hy::filter_pass_b<false>(F); hy::prepass(F); }
        else { hy::prepass(F); __syncthreads(); FRESH(); hy::init_tw128(F); hy::filter_pass_b<false>(F); __syncthreads(); FRESH(); lru::stage1(F); }
    } SEAM(2);
#else
    if (IN(2)) { TS(2); FRESH(); REP(4) lru::stage1(F); __syncthreads(); hy::init_tw128(F); if ((DUPMASK >> 15) & 1) hy::filter_pass_b<true>(F); hy::filter_pass_b<false>(F); REP(2) hy::prepass(F); } SEAM(2);
#endif
    if (IN(3)) { TS(3); FRESH(); hy::init_tw128(F); REP(3) hy::data_pass_a(F); } SEAM(3);
    if (IN(4)) { TS(4); FRESH(); REP(16) lru::carry(F); hy::init_tw128(F); if ((DUPMASK >> 17) & 1) hy::data_pass_b<true>(F); hy::data_pass_b<false>(F); } SEAM(4);
    if (IN(5)) { TS(5); FRESH(); hy::init_tw128(F); if ((DUPMASK >> 5) & 1) hy::data_pass_c<true>(F); hy::data_pass_c<false>(F); __syncthreads(); REP(6) lru::stage2(F); } SEAM(5);
    if (IN(6)) { TS(6); FRESH();
        pg8::SchedMix S; S.O.init(T / 256, D / 256, F.G, F.bid); S.A0 = (const char*)(ws + WS_YLRU); S.A1 = (const char*)(ws + WS_YHY); S.B0 = (const char*)(ws + WS_WLRU); S.B1 = (const char*)(ws + WS_WHY);
        pg8::EpiMix E{(const bf16_t*)(ws + WS_PG), (bf16_t*)(ws + WS_MIX)};
#ifdef MIXDESYNC
        const int cls_ = (F.bid >> 3) & 3; constexpr int RND_ = MIXDESYNC;
        if (cls_ > 0) { convert_weights<0, false>(F, F.bid, F.G, 0, RND_ * cls_ / 4); __syncthreads(); }
#endif
        pg8::gemm_phase<pg8::EpiMix, pg8::SchedMix, false>(F.lds, S, E); if ((DUPMASK >> 7) & 1) { pg8::gemm_phase<pg8::EpiMix, pg8::SchedMix, false>(F.lds, S, E); }
#ifdef MIXDESYNC
        __syncthreads(); convert_weights<0, false>(F, F.bid, F.G, RND_ * cls_ / 4, RND_);
#endif
    } SEAM(6);
    if (IN(7)) { TS(7); FRESH();
        pg8::SchedDenseT<0> S; S.bias = nullptr; S.O.init(T / 256, D / 256, F.G, F.bid); S.A = (const char*)(ws + WS_MIX); S.B = (const char*)(ws + WS_WOUT);
        pg8::EpiH E{args.in[0], (bf16_t*)(ws + WS_HN)};
        { u32x4* z = (u32x4*)(ws + WS_EROWTOK); const u32x4 z4 = (u32x4){0u, 0u, 0u, 0u};
          for (int i = F.bid * NTHREADS + F.tid; i < 3 * NE * T / 4; i += F.G * NTHREADS) z[i] = z4; }
#ifdef MIXDESYNC
        const int cls_ = (F.bid >> 3) & 3; constexpr int RND_ = MIXDESYNC; const int rrem_ = RND_;
        if (cls_ > 0) { convert_weights<0, false>(F, F.bid, F.G, RND_, RND_ + rrem_ * cls_ / 4); __syncthreads(); }
#endif
        pg8::gemm_phase<pg8::EpiH, pg8::SchedDenseT<0>, false>(F.lds, S, E); if ((DUPMASK >> 8) & 1) { pg8::gemm_phase<pg8::EpiH, pg8::SchedDenseT<0>, false>(F.lds, S, E); }
#ifdef MIXDESYNC
        __syncthreads(); convert_weights<0, false>(F, F.bid, F.G, RND_ + rrem_ * cls_ / 4, 2 * RND_);
#endif
    } SEAM(7);
    if (IN(8)) { TS(8); FRESH(); phase_router_a(F); } SEAM(8);
    if (IN(10)) { TS(10); FRESH();
        const LAS int* pt = build_ptile(F);
        pg8::SchedMoE<8, true> S{args.in[29], (const float*)(ws + WS_EROWRS), pt, F.G, F.bid, (const char*)(ws + WS_HN), (const char*)(ws + WS_WGU), (size_t)2048 * 1024 * 2, (const int*)(ws + WS_EROWTOK)};
        pg8::EpiGU E{args.in[29], (const float*)(ws + WS_ROWRS), (bf16_t*)(ws + WS_ACT)};
#ifdef DESYNC_GU
        { const int rounds_ = (pt[32] * 8 + F.G - 1) / F.G; pg8::Unit u_; if (!S.next(rounds_ - 1, u_)) stagger_delay(1, DESYNC_GU); }
#endif
        pg8::gemm_phase<pg8::EpiGU, pg8::SchedMoE<8, true>, true>(F.lds, S, E); if ((DUPMASK >> 9) & 1) { pg8::gemm_phase<pg8::EpiGU, pg8::SchedMoE<8, true>, true>(F.lds, S, E); }
        if ((DUPMASK >> 19) & 1) { pg8::EpiNone E0; pg8::gemm_phase<pg8::EpiNone, pg8::SchedMoE<8, true>, true>(F.lds, S, E0); }
    } SEAM(10);
    if (IN(11)) { TS(11); FRESH();
        const LAS int* pt = build_ptile(F);
        pg8::SchedMoE<4, false> S{args.in[31], (const float*)(ws + WS_EROWGATE), pt, F.G, F.bid, (const char*)(ws + WS_ACT), (const char*)(ws + WS_WDN), (size_t)1024 * 1024 * 2, nullptr};
        pg8::EpiDN E{args.in[31], (const float*)(ws + WS_ROWGATE), (bf16_t*)(ws + WS_YS)};
#ifdef DESYNC_DN
        { const int rounds_ = (pt[32] * 4 + F.G - 1) / F.G; pg8::Unit u_; if (!S.next(rounds_ - 1, u_)) stagger_delay(1, DESYNC_DN); }
#endif
        pg8::gemm_phase<pg8::EpiDN, pg8::SchedMoE<4, false>, false>(F.lds, S, E); if ((DUPMASK >> 10) & 1) { pg8::gemm_phase<pg8::EpiDN, pg8::SchedMoE<4, false>, false>(F.lds, S, E); }
        if ((DUPMASK >> 20) & 1) { pg8::EpiNone E0; pg8::gemm_phase<pg8::EpiNone, pg8::SchedMoE<4, false>, false>(F.lds, S, E0); }
    } SEAM(11);
    if (IN(12)) { TS(12); FRESH(); phase_final(F); }
#undef IN
#undef SEAM
}
static int g_grid = 0;
static void launch_mega(Args a, int lo, int hi, hipStream_t stream, int li = 0) {
    a.ph_lo = lo; a.ph_hi = hi; a.li = li; a.pad = 0; void* params[] = {&a};
    hipError_t e = hipLaunchCooperativeKernel((const void*)mega, dim3(g_grid), dim3(NTHREADS), params, LDS_BYTES, stream);
    if (e != hipSuccess) fprintf(stderr, "kernel_launch: cooperative launch [%d,%d) failed: %s (grid %d)\n", lo, hi, hipGetErrorString(e), g_grid);
}
extern "C" void kernel_launch(void* const* d_in, const int* in_sizes, int n_in, void* d_out, int out_size, void* d_ws, size_t ws_size, hipStream_t stream) {
    if (n_in != 33 || out_size != T * D || ws_size < WS_END) { fprintf(stderr, "kernel_launch: unexpected shapes n_in %d out %d ws %zu\n", n_in, out_size, ws_size); return; }
    if (g_grid == 0) {
        int dev = 0, cus = 0, per_cu = 0;
        (void)hipGetDevice(&dev); (void)hipDeviceGetAttribute(&cus, hipDeviceAttributeMultiprocessorCount, dev);
        if (hipFuncSetAttribute((const void*)mega, hipFuncAttributeMaxDynamicSharedMemorySize, LDS_BYTES) != hipSuccess) { fprintf(stderr, "kernel_launch: hipFuncSetAttribute failed\n"); g_grid = -1; return; }
        if (hipOccupancyMaxActiveBlocksPerMultiprocessor(&per_cu, (const void*)mega, NTHREADS, LDS_BYTES) != hipSuccess || per_cu < 1) { fprintf(stderr, "kernel_launch: occupancy query says %d\n", per_cu); g_grid = -1; return; }
        g_grid = cus;
    }
    if (g_grid < 0) return;
    const float* in[33]; for (int i = 0; i < 33; ++i) in[i] = (const float*)d_in[i];
    unsigned char* ws = (unsigned char*)d_ws; float* out = (float*)d_out;
    int* cnt = (int*)(ws + WS_CTL); float* NORM = (float*)(ws + WS_NORM); float* HH3 = (float*)(ws + WS_HH3);
    bf16_t* YLRU = (bf16_t*)(ws + WS_YLRU); bf16_t* HN = (bf16_t*)(ws + WS_HN); bf16_t* YHY = (bf16_t*)(ws + WS_YHY);
    bf16_t* PG = (bf16_t*)(ws + WS_PG); bf16_t* P0 = (bf16_t*)(ws + WS_P0); bf16_t* P1 = (bf16_t*)(ws + WS_P1); bf16_t* PHY = (bf16_t*)(ws + WS_PHY);
    bf16_t* MIX = (bf16_t*)(ws + WS_MIX); float* MIXF = (float*)(ws + WS_MIXF); bf16_t* ACT = (bf16_t*)(ws + WS_ACT); bf16_t* YS = (bf16_t*)(ws + WS_YS);
    float* XR = (float*)(ws + WS_XR); float* HF = (float*)(ws + WS_HF); float* KC = (float*)(ws + WS_KC);
    int* ROWTOK = (int*)(ws + WS_ROWTOK); float* ROWGATE = (float*)(ws + WS_ROWGATE); float* ROWRS = (float*)(ws + WS_ROWRS);
    (void)hipMemsetAsync(ws + WS_CTL, 0, CTL_BYTES, stream);
    Args a{}; for (int i = 0; i < 33; ++i) a.in[i] = in[i]; a.out = out; a.ws = ws;
    launch_mega(a, 0, 13, stream);
}
```

```cpp
#define DUPMASK 0x0
#define DESYNC1 4
#define DN_REVERSE 1
#define P2_ALTERNATE 1
#define YS_FP8 1
#define YZ_BF8 1
#include <hip/hip_runtime.h>
#include <hip/hip_cooperative_groups.h>
#include <cstdio>
#include <cstdint>
namespace cg = cooperative_groups;

typedef unsigned short bf16_t;
typedef float f32x4 __attribute__((ext_vector_type(4)));
typedef float f32x2 __attribute__((ext_vector_type(2)));
typedef unsigned u32x4 __attribute__((ext_vector_type(4)));
typedef unsigned u32x2 __attribute__((ext_vector_type(2)));
typedef short bf16x8 __attribute__((ext_vector_type(8)));

constexpr int T = 32768, D = 1024, L = 8192, NB = 4, NE = 32, TOPK = 4, NIN = 7168, L2X = 16384;
constexpr int HEADS = 16, HBLK = 64, HYFF = 64, HYEMB = 33;
constexpr int NPAD = T * TOPK + NE * 256;
constexpr float EPS = 1e-5f;

constexpr size_t MiB = 1u << 20;
constexpr size_t WS_CTL = 0;
constexpr size_t CTL_BYTES = 64 * 1024;
constexpr size_t WS_NORM = 4096;
constexpr size_t WS_HH3 = 2 * MiB;
constexpr size_t WS_WRG = 4 * MiB;
constexpr size_t WS_TOPE = 5 * MiB;
constexpr size_t WS_TOPG = 6 * MiB;
constexpr size_t WS_TOKRS = 7 * MiB;
constexpr size_t WS_ROWTOK = 8 * MiB;
constexpr size_t WS_ROWGATE = 9 * MiB;
constexpr size_t WS_ROWRS = 10 * MiB;
constexpr size_t WS_TOKROW = 11 * MiB;
constexpr size_t WS_WF4 = 14 * MiB;
constexpr size_t WS_NORMP = 15 * MiB;
constexpr size_t WS_EROWTOK = 164 * MiB, WS_EROWRS = 168 * MiB, WS_EROWGATE = 172 * MiB;
constexpr size_t WS_WLRUF = 13 * MiB;
constexpr size_t WS_SUMM = 996 * MiB;
constexpr size_t WS_CARRY = 1004 * MiB;
constexpr size_t WS_WIN = 16 * MiB;
constexpr size_t WS_WLRU = 30 * MiB, WS_WHY = 32 * MiB, WS_WOUT = 34 * MiB;
constexpr size_t WS_U = 36 * MiB;
constexpr size_t WS_Z16 = 36 * MiB, WS_HN = 36 * MiB;
constexpr size_t WS_YHY = 100 * MiB;
constexpr size_t WS_PG = 164 * MiB;
constexpr size_t WS_P0 = 292 * MiB;
constexpr size_t WS_P1 = 356 * MiB;
constexpr size_t WS_PHY = 420 * MiB;
constexpr size_t WS_MIX = 356 * MiB;
constexpr size_t WS_HS = 740 * MiB;
constexpr size_t WS_YLRU = 292 * MiB;
constexpr size_t WS_AF = 804 * MiB, WS_AB = 932 * MiB;
constexpr size_t WS_MIXF = 484 * MiB;
constexpr size_t WS_ACT = 292 * MiB;
constexpr size_t WS_R2 = 612 * MiB;
constexpr size_t WS_YZ = 612 * MiB;
constexpr size_t WS_KF = 868 * MiB;
constexpr size_t WS_WDN = 612 * MiB;
constexpr size_t WS_WGU = 676 * MiB;
constexpr size_t WS_YS = 676 * MiB;
constexpr size_t WS_XR = 612 * MiB;
constexpr size_t WS_HF = 740 * MiB;
constexpr size_t WS_KC = 868 * MiB;
constexpr size_t WS_END = 1024 * MiB;

__device__ __forceinline__ float bf2f(bf16_t b) { return __uint_as_float(((unsigned)b) << 16); }
__device__ __forceinline__ bf16_t f2bf(float f) { unsigned u = __float_as_uint(f); u += 0x7fffu + ((u >> 16) & 1u); return (bf16_t)(u >> 16); }
__device__ __forceinline__ unsigned pk2(float lo, float hi) { unsigned r; asm("v_cvt_pk_bf16_f32 %0, %1, %2" : "=v"(r) : "v"(lo), "v"(hi)); return r; }
__device__ __forceinline__ float fexp(float x) { return __builtin_amdgcn_exp2f(x * 1.4426950408889634f); }
__device__ __forceinline__ float sigmoidf_(float x) { return __builtin_amdgcn_rcpf(1.0f + fexp(-x)); }
__device__ __forceinline__ float gelu_tanh(float x) { const float u = 0.7978845608028654f * (x + 0.044715f * x * x * x); return x * sigmoidf_(2.0f * u); }
__device__ __forceinline__ float swiglu(float g, float u) { const float g_ = fminf(g, 7.0f); const float u_ = fminf(fmaxf(u, -7.0f), 7.0f); return (u_ + 1.0f) * (g_ * sigmoidf_(1.702f * g_)); }
__device__ __forceinline__ float wave_sum(float v) {
#pragma unroll
    for (int o = 1; o < 64; o <<= 1) v += __shfl_xor(v, o);
    return v;
}
__device__ __forceinline__ int expert_offpad(const int* cnt, int e) { int o = 0; for (int i = 0; i < e; ++i) o += (cnt[i] + 255) & ~255; return o; }
__device__ __forceinline__ float hy_delta_abs(int c) {
    const float lo = -4.605170185988091f / 1.5f, hi = -4.605170185988091f / 0.3f;
    return fabsf(lo + (hi - lo) * ((float)c / 1023.0f));
}
#define LAS __attribute__((address_space(3)))
constexpr int NWAVES = 8, NTHREADS = 512, LDS_BYTES = 147456, MISC_OFF = 131072;

namespace pg8 {
constexpr int BM = 256, BK = 64, HALF = 128, HTB = HALF * BK * 2, NXCD = 8, WGM = 8, KD = 1024;
__host__ __device__ __forceinline__ int lds_byte(int r, int c) { const int st = (r >> 4) * 2 + (c >> 5), rr = r & 15, cc = c & 31, ob = rr * 64 + cc * 2; return st * 1024 + (ob ^ (((ob >> 9) & 1) << 5)); }
__host__ __device__ __forceinline__ void stage_rc(int b, int& R, int& C) { const int st = b / 1024, sb = b % 1024, swz = sb ^ (((sb >> 9) & 1) << 5); R = (st >> 1) * 16 + swz / 64; C = (st & 1) * 32 + (swz % 64) / 2; }
__host__ __device__ __forceinline__ int perm32(int rho) { const int n = rho >> 4, i = rho & 15; return 8 * (i >> 2) + 4 * n + (i & 3); }

struct Unit { const char* A; const char* B; int pm, pn, e, gm; };

struct DenseOrder {
    int nM, nN, nwg, G, c;
    __device__ __forceinline__ void init(int nM_, int nN_, int G_, int c_) { nM = nM_; nN = nN_; nwg = nM * nN; G = G_; c = c_; }
    __device__ __forceinline__ bool tile(int i, int& pm, int& pn) const {
        const long Lx = (long)i * G + c; if (Lx >= nwg) return false;
        int wgid = (int)Lx; { const int q = nwg / NXCD, r = nwg % NXCD, xcd = wgid % NXCD, off = wgid / NXCD; wgid = (xcd < r ? xcd * (q + 1) : r * (q + 1) + (xcd - r) * q) + off; }
        const int nig = WGM * nN, gid = wgid / nig, fm = gid * WGM, gsz = (nM - fm) < WGM ? (nM - fm) : WGM;
        pm = fm + ((wgid % nig) % gsz); pn = (wgid % nig) / gsz; return true;
    }
};

__device__ __forceinline__ unsigned cvt_pk_bf16(float lo, float hi) { unsigned r; asm volatile("v_cvt_pk_bf16_f32 %0, %1, %2" : "=v"(r) : "v"(lo), "v"(hi)); return r; }

template <class Epi, class Sched, bool GATHER>
__device__ __forceinline__ void gemm_phase(LAS unsigned char* lds, const Sched& S, const Epi& E) {
    int tid_ = threadIdx.x; asm volatile("" : "+v"(tid_));
    const int tid = tid_, wid = __builtin_amdgcn_readfirstlane(tid >> 6), lane = tid & 63, wr = wid >> 2, wc = wid & 3, fr = lane & 15, fq = lane >> 4;
    constexpr int K = KD, nt = K / BK;
    int Rr[2], Cc[2]; unsigned voffB[2];
#pragma unroll
    for (int i = 0; i < 2; ++i) { int R, C; stage_rc(tid * 16 + i * 8192, R, C); Rr[i] = R; Cc[i] = C; const int Rb = (R & ~31) + perm32(R & 31); voffB[i] = (unsigned)(Rb * K + C) * 2u; }
    constexpr size_t kstep = (size_t)(BK * 2);
    constexpr size_t hstep = (size_t)HALF * K * 2;
    const unsigned ldsw = (unsigned)wid * 1024u;
    const int aoff = lds_byte(wr * 64 + fr, fq * 8), boff = lds_byte(wc * 32 + fr, fq * 8);
#define PG8_SA(b, h) (((b) * 2 + (h)) * HTB)
#define PG8_SB(b, h) ((4 + (b) * 2 + (h)) * HTB)
#define PG8_GLDS(gp, lp) __builtin_amdgcn_global_load_lds((const unsigned*)(gp), (LAS unsigned*)(lp), 16, 0, 0)
#define PG8_STAGEB(bufoff, gbase) do { PG8_GLDS((const char*)(gbase) + voffB[0], lds + (bufoff) + ldsw); PG8_GLDS((const char*)(gbase) + voffB[1], lds + (bufoff) + ldsw + 8192); } while (0)
#define PG8_STAGEA(bufoff, gbase, o0, o1) do { PG8_GLDS((const char*)(gbase) + (o0), lds + (bufoff) + ldsw); PG8_GLDS((const char*)(gbase) + (o1), lds + (bufoff) + ldsw + 8192); } while (0)
#define PG8_LDA(dst, b, h) do { _Pragma("unroll") for (int m = 0; m < 4; ++m) _Pragma("unroll") for (int k = 0; k < 2; ++k) dst[m][k] = *(const LAS bf16x8*)(lds + PG8_SA(b, h) + aoff + m * 2048 + k * 1024); } while (0)
#define PG8_LDB(dst, b, h) do { _Pragma("unroll") for (int n = 0; n < 2; ++n) _Pragma("unroll") for (int k = 0; k < 2; ++k) dst[n][k] = *(const LAS bf16x8*)(lds + PG8_SB(b, h) + boff + n * 2048 + k * 1024); } while (0)
#define PG8_MMA(ai, bj, At, Bt) do { __builtin_amdgcn_s_setprio(1); _Pragma("unroll") for (int m = 0; m < 4; ++m) _Pragma("unroll") for (int n = 0; n < 2; ++n) _Pragma("unroll") for (int k = 0; k < 2; ++k) \
        acc[ai][bj][m][n] = __builtin_amdgcn_mfma_f32_16x16x32_bf16(Bt[n][k], At[m][k], acc[ai][bj][m][n], 0, 0, 0); __builtin_amdgcn_s_setprio(0); } while (0)
#define PG8_WAIT_V(n) asm volatile("s_waitcnt vmcnt(" #n ")" ::: "memory")
#define PG8_WAIT_L(n) asm volatile("s_waitcnt lgkmcnt(" #n ")" ::: "memory")
#define PG8_WAIT_V8_UNLESS(flag) asm volatile("s_cmp_lg_u32 %0, 0\n\ts_cbranch_scc1 .Lskipw%=\n\ts_waitcnt vmcnt(8)\n.Lskipw%=:" :: "s"(flag) : "scc", "memory")
#define PG8_BAR __builtin_amdgcn_s_barrier()
#define PG8_SCHED __builtin_amdgcn_sched_barrier(0)
    Unit cur, nxt; int ui = 0;
    if (!S.next(0, cur)) return;
    LAS int* tokbuf = (LAS int*)(lds + MISC_OFF + 3072);
#define PG8_AOFF(par, h, i) (GATHER ? ((unsigned)tokbuf[(par) * 256 + (h) * HALF + Rr[i]] * (unsigned)(K * 2) + (unsigned)(Cc[i] * 2)) : ((unsigned)(Rr[i] * K + Cc[i]) * 2u + (unsigned)((h) * hstep)))
    LAS float* side = (LAS float*)(lds + MISC_OFF + 6144);
    if (GATHER || Sched::NSIDE > 0) {
        if (GATHER && tid < 256) tokbuf[tid] = S.ROWTOK_row(cur, tid);
        if (Sched::NSIDE > 0 && tid < 256 * Sched::NSIDE) side[tid] = *S.side_addr(cur, tid >> 8, tid & 255);
        asm volatile("s_waitcnt vmcnt(0) lgkmcnt(0)" ::: "memory"); __builtin_amdgcn_s_barrier(); }
    f32x4 acc[2][2][4][2];
#pragma unroll
    for (int a = 0; a < 2; ++a)
#pragma unroll
        for (int b = 0; b < 2; ++b)
#pragma unroll
            for (int m = 0; m < 4; ++m)
#pragma unroll
                for (int n = 0; n < 2; ++n) acc[a][b][m][n] = (f32x4){0.f, 0.f, 0.f, 0.f};
    bf16x8 At[4][2], B0[2][2], B1[2][2];
    const char* cA = cur.A; const char* cB = cur.B;
    PG8_STAGEB(PG8_SB(0, 0), cB); PG8_STAGEB(PG8_SB(0, 1), cB + hstep); PG8_STAGEA(PG8_SA(0, 0), cA, PG8_AOFF(0, 0, 0), PG8_AOFF(0, 0, 1)); PG8_STAGEA(PG8_SA(0, 1), cA, PG8_AOFF(0, 1, 0), PG8_AOFF(0, 1, 1));
    if (wr == 1) PG8_BAR;
    PG8_WAIT_V(2); PG8_BAR;
    PG8_STAGEB(PG8_SB(1, 0), cB + kstep); PG8_STAGEA(PG8_SA(1, 0), cA + kstep, PG8_AOFF(0, 0, 0), PG8_AOFF(0, 0, 1)); PG8_STAGEB(PG8_SB(1, 1), cB + hstep + kstep);
    PG8_WAIT_V(6); PG8_BAR;
    for (;;) {
        const bool has_next = S.next(ui + 1, nxt);
        const char* nA = has_next ? nxt.A : cA; const char* nB = has_next ? nxt.B : cB;
        const int pc = ui & 1, pn_ = has_next ? (pc ^ 1) : pc;
        if (Sched::NSIDE > 0 && has_next && wid < 4 * Sched::NSIDE) __builtin_amdgcn_global_load_lds((const unsigned*)S.side_addr(nxt, wid >> 2, (wid & 3) * 64 + lane), (LAS unsigned*)(side + ((ui + 1) % 3) * 512 + wid * 64), 4, 0, 0);
        if (GATHER && has_next && wid < 4) __builtin_amdgcn_global_load_lds((const unsigned*)(S.ROWTOK + S.rowoff(nxt) + wid * 64 + lane), (LAS unsigned*)(tokbuf + pn_ * 256 + wid * 64), 4, 0, 0);
        for (int t = 0; t < nt; t += 2) {
            const bool last = (t == nt - 2);
            const char* a1 = cA + (size_t)(t + 1) * kstep;
            const char* a2 = last ? nA : cA + (size_t)(t + 2) * kstep; const char* b2 = last ? nB : cB + (size_t)(t + 2) * kstep;
            const char* a3 = a2 + kstep; const char* b3 = b2 + kstep;
            const int px = last ? pn_ : pc;
            PG8_LDB(B0, 0, 0); PG8_LDB(B1, 0, 1); PG8_SCHED; PG8_LDA(At, 0, 0); PG8_STAGEA(PG8_SA(1, 1), a1, PG8_AOFF(pc, 1, 0), PG8_AOFF(pc, 1, 1));
            PG8_WAIT_V(8); PG8_WAIT_L(0); PG8_BAR; PG8_MMA(0, 0, At, B0); PG8_MMA(0, 1, At, B1); PG8_BAR; PG8_SCHED;
            PG8_LDA(At, 0, 1); PG8_STAGEB(PG8_SB(0, 0), b2); PG8_STAGEB(PG8_SB(0, 1), b2 + hstep); PG8_STAGEA(PG8_SA(0, 0), a2, PG8_AOFF(px, 0, 0), PG8_AOFF(px, 0, 1));
            PG8_WAIT_V(8); PG8_WAIT_L(0); PG8_BAR; PG8_MMA(1, 0, At, B0); PG8_MMA(1, 1, At, B1); PG8_BAR; PG8_SCHED;
            PG8_LDB(B0, 1, 0); PG8_LDB(B1, 1, 1); PG8_SCHED; PG8_LDA(At, 1, 0); PG8_STAGEA(PG8_SA(0, 1), a2, PG8_AOFF(px, 1, 0), PG8_AOFF(px, 1, 1));
            PG8_WAIT_V(8); PG8_WAIT_L(0); PG8_BAR; PG8_MMA(0, 0, At, B0); PG8_MMA(0, 1, At, B1); PG8_BAR; PG8_SCHED;
            PG8_LDA(At, 1, 1); PG8_STAGEB(PG8_SB(1, 0), b3); PG8_STAGEB(PG8_SB(1, 1), b3 + hstep); PG8_STAGEA(PG8_SA(1, 0), a3, PG8_AOFF(px, 0, 0), PG8_AOFF(px, 0, 1));
            PG8_WAIT_V(8); PG8_WAIT_L(0); PG8_BAR; PG8_MMA(1, 0, At, B0); PG8_MMA(1, 1, At, B1); PG8_BAR; PG8_SCHED;
        }
        if (wr == 0) PG8_BAR;
        bool keep = false;
        if constexpr (Epi::CHAIN) keep = E(acc, cur, wr, wc, fr, fq, (const LAS float*)(side + (ui % 3) * 512)); else E(acc, cur, wr, wc, fr, fq, (const LAS float*)(side + (ui % 3) * 512));
        if (!has_next) break;
        if (!keep) {
#pragma unroll
        for (int a = 0; a < 2; ++a)
#pragma unroll
            for (int b = 0; b < 2; ++b)
#pragma unroll
                for (int m = 0; m < 4; ++m)
#pragma unroll
                    for (int n = 0; n < 2; ++n) acc[a][b][m][n] = (f32x4){0.f, 0.f, 0.f, 0.f};
        }
        cur = nxt; cA = nA; cB = nB; ++ui;
        if (wr == 1) PG8_BAR;
    }
    PG8_WAIT_V(0);
    PG8_BAR;
#undef PG8_SA
#undef PG8_AOFF
#undef PG8_SB
#undef PG8_GLDS
#undef PG8_STAGEA
#undef PG8_STAGEB
#undef PG8_LDA
#undef PG8_LDB
#undef PG8_MMA
#undef PG8_WAIT_V
#undef PG8_WAIT_L
#undef PG8_WAIT_V8_UNLESS
#undef PG8_BAR
#undef PG8_SCHED
}

__device__ __forceinline__ void store8bf(bf16_t* p, const f32x4 v0, const f32x4 v1) {
    u32x4 w; w.x = cvt_pk_bf16(v0[0], v0[1]); w.y = cvt_pk_bf16(v0[2], v0[3]); w.z = cvt_pk_bf16(v1[0], v1[1]); w.w = cvt_pk_bf16(v1[2], v1[3]); *(u32x4*)p = w;
}
__device__ __forceinline__ void load8bf(const bf16_t* p, f32x4& v0, f32x4& v1) {
    const u32x4 w = *(const u32x4*)p;
    v0 = (f32x4){__uint_as_float(w.x << 16), __uint_as_float(w.x & 0xffff0000u), __uint_as_float(w.y << 16), __uint_as_float(w.y & 0xffff0000u)};
    v1 = (f32x4){__uint_as_float(w.z << 16), __uint_as_float(w.z & 0xffff0000u), __uint_as_float(w.w << 16), __uint_as_float(w.w & 0xffff0000u)};
}
__device__ __forceinline__ f32x2 lo2(const f32x4 v) { return (f32x2){v.x, v.y}; }
__device__ __forceinline__ f32x2 hi2(const f32x4 v) { return (f32x2){v.z, v.w}; }
__device__ __forceinline__ f32x2 sigmoid2(const f32x2 x) { const f32x2 t = x * -1.4426950408889634f; const f32x2 d = (f32x2){__builtin_amdgcn_exp2f(t.x), __builtin_amdgcn_exp2f(t.y)} + 1.0f; return (f32x2){__builtin_amdgcn_rcpf(d.x), __builtin_amdgcn_rcpf(d.y)}; }
__device__ __forceinline__ f32x2 swiglu2(const f32x2 g, const f32x2 u) {
    const f32x2 g_ = (f32x2){fminf(g.x, 7.0f), fminf(g.y, 7.0f)}; const f32x2 u_ = (f32x2){fminf(fmaxf(u.x, -7.0f), 7.0f), fminf(fmaxf(u.y, -7.0f), 7.0f)};
    const f32x2 t = g_ * (-1.702f * 1.4426950408889634f); const f32x2 d = (f32x2){__builtin_amdgcn_exp2f(t.x), __builtin_amdgcn_exp2f(t.y)} + 1.0f;
    const f32x2 p = g_ * (f32x2){__builtin_amdgcn_rcpf(d.x), __builtin_amdgcn_rcpf(d.y)}; return u_ * p + p; }
__device__ __forceinline__ void store8bf2(bf16_t* p, const f32x2 a, const f32x2 b, const f32x2 c, const f32x2 d) {
    u32x4 w; w.x = cvt_pk_bf16(a.x, a.y); w.y = cvt_pk_bf16(b.x, b.y); w.z = cvt_pk_bf16(c.x, c.y); w.w = cvt_pk_bf16(d.x, d.y); *(u32x4*)p = w; }
#define EPI_ROWS(ai, m) ((ai) * HALF + wr * 64 + (m) * 16 + fr)
#define EPI_COLS(bj) ((bj) * HALF + wc * 32 + 8 * fq)

struct EpiNone {
    static constexpr bool CHAIN = false;
    __device__ __forceinline__ void operator()(const f32x4 (&acc)[2][2][4][2], const Unit&, int, int, int, int, const LAS float*) const {
#pragma unroll
        for (int a = 0; a < 2; ++a)
#pragma unroll
            for (int b = 0; b < 2; ++b)
#pragma unroll
                for (int m = 0; m < 4; ++m)
#pragma unroll
                    for (int n = 0; n < 2; ++n) asm volatile("" :: "v"(acc[a][b][m][n]));
    }
};
struct EpiProbeStore {
    static constexpr bool CHAIN = false;
    bf16_t* dst;
    __device__ __forceinline__ void operator()(const f32x4 (&acc)[2][2][4][2], const Unit& u, int wr, int wc, int fr, int fq, const LAS float* side) const {
#pragma unroll
        for (int ai = 0; ai < 2; ++ai)
#pragma unroll
            for (int m = 0; m < 4; ++m) {
#if defined(PROBE_LOCAL)
                bf16_t* rowp = dst + (size_t)(blockIdx.x * 256 + EPI_ROWS(ai, m)) * 256;
#elif defined(PROBE_MIXED)
                bf16_t* rowp = (blockIdx.x & 3) ? dst + (size_t)(blockIdx.x * 256 + EPI_ROWS(ai, m)) * 256 : dst + (size_t)(u.pm * BM + EPI_ROWS(ai, m)) * 4096 + (u.pn & 15) * 256;
#elif defined(PROBE_WIDE)
                bf16_t* rowp = dst + (size_t)(u.pm * BM + EPI_ROWS(ai, m)) * 4096 + (u.pn & 15) * 256;
#else
                bf16_t* rowp = dst + (size_t)(u.pm * BM + EPI_ROWS(ai, m)) * 1024 + (u.pn & 3) * 256;
#endif
#pragma unroll
                for (int bj = 0; bj < 2; ++bj) store8bf(rowp + EPI_COLS(bj), acc[ai][bj][m][0], acc[ai][bj][m][1]); }
    }
};
struct EpiIn {
    static constexpr bool CHAIN = false;
    bf16_t *P0, *P1, *PHY, *PG; const float* bias;
    __device__ __forceinline__ void operator()(const f32x4 (&acc)[2][2][4][2], const Unit& u, int wr, int wc, int fr, int fq, const LAS float* side) const {
        const int seg = u.pn >> 2; bf16_t* dst; int ld, colt; int act = 0;
        if (seg == 0) { dst = P0; ld = 1024; colt = u.pn * 256; }
        else if (seg == 1) { dst = P1; ld = 1024; colt = u.pn * 256 - 1024; }
        else if (seg < 5) { dst = PHY; ld = 3072; colt = u.pn * 256 - 2048; }
        else { dst = PG; ld = 2048; colt = (u.pn - 20) * 128; act = 2; }
        f32x4 bv[2][2];
#pragma unroll
        for (int bj = 0; bj < 2; ++bj)
#pragma unroll
            for (int n = 0; n < 2; ++n) bv[bj][n] = *(const LAS f32x4*)(side + EPI_COLS(bj) + 4 * n);
        if (act == 2) {
#pragma unroll
            for (int ai = 0; ai < 2; ++ai)
#pragma unroll
                for (int m = 0; m < 4; ++m) { bf16_t* rowp = dst + (size_t)(u.pm * BM + EPI_ROWS(ai, m)) * ld + colt + wc * 32 + 8 * fq;
                    f32x2 rho[4], sh[4];
#pragma unroll
                    for (int n = 0; n < 2; ++n)
#pragma unroll
                        for (int hh = 0; hh < 2; ++hh) {
                            const f32x2 al = (hh ? hi2(acc[ai][0][m][n]) : lo2(acc[ai][0][m][n])) + (hh ? hi2(bv[0][n]) : lo2(bv[0][n]));
                            f32x2 ah = (hh ? hi2(acc[ai][1][m][n]) : lo2(acc[ai][1][m][n])) + (hh ? hi2(bv[1][n]) : lo2(bv[1][n]));
                            ah = (f32x2){fmaxf(ah.x, -80.0f), fmaxf(ah.y, -80.0f)};
                            const f32x2 tl = al * -1.4426950408889634f, th = ah * -1.4426950408889634f;
                            const f32x2 dl = (f32x2){__builtin_amdgcn_exp2f(tl.x), __builtin_amdgcn_exp2f(tl.y)} + 1.0f, dh = (f32x2){__builtin_amdgcn_exp2f(th.x), __builtin_amdgcn_exp2f(th.y)} + 1.0f;
                            sh[2 * n + hh] = (f32x2){__builtin_amdgcn_rcpf(dh.x), __builtin_amdgcn_rcpf(dh.y)};
                            rho[2 * n + hh] = dh * (f32x2){__builtin_amdgcn_rcpf(dl.x), __builtin_amdgcn_rcpf(dl.y)}; }
                    store8bf2(rowp, rho[0], rho[1], rho[2], rho[3]); store8bf2(rowp + 1024, sh[0], sh[1], sh[2], sh[3]); }
            return;
        }
#pragma unroll
        for (int ai = 0; ai < 2; ++ai)
#pragma unroll
            for (int m = 0; m < 4; ++m) { bf16_t* rowp = dst + (size_t)(u.pm * BM + EPI_ROWS(ai, m)) * ld + colt;
#pragma unroll
                for (int bj = 0; bj < 2; ++bj) { f32x2 a = lo2(acc[ai][bj][m][0]) + lo2(bv[bj][0]), b = hi2(acc[ai][bj][m][0]) + hi2(bv[bj][0]), c = lo2(acc[ai][bj][m][1]) + lo2(bv[bj][1]), d = hi2(acc[ai][bj][m][1]) + hi2(bv[bj][1]);
                    store8bf2(rowp + EPI_COLS(bj), a, b, c, d); } }
    }
};
struct EpiMix {
    static constexpr bool CHAIN = true;
    const bf16_t* PG; bf16_t* MIX;
    __device__ __forceinline__ bool operator()(f32x4 (&acc)[2][2][4][2], const Unit& u, int wr, int wc, int fr, int fq, const LAS float*) const {
#pragma unroll
        for (int ai = 0; ai < 2; ++ai)
#pragma unroll
            for (int m = 0; m < 4; ++m) { const size_t row = (size_t)(u.pm * BM + EPI_ROWS(ai, m));
#pragma unroll
                for (int bj = 0; bj < 2; ++bj) { const int col = u.pn * 256 + EPI_COLS(bj);
                    f32x4 h0, h1; load8bf(PG + row * 2048 + (u.e == 0 ? 0 : 1024) + col, h0, h1);
                    if (u.e == 0) { acc[ai][bj][m][0] *= h0; acc[ai][bj][m][1] *= h1; }
                    else store8bf(MIX + row * 1024 + col, h0 * acc[ai][bj][m][0], h1 * acc[ai][bj][m][1]); } }
        return u.e == 0;
    }
};
struct EpiH {
    static constexpr bool CHAIN = false;
    const float* x; bf16_t* HB;
    __device__ __forceinline__ void operator()(const f32x4 (&acc)[2][2][4][2], const Unit& u, int wr, int wc, int fr, int fq, const LAS float* side) const {
#pragma unroll
        for (int ai = 0; ai < 2; ++ai)
#pragma unroll
            for (int m = 0; m < 4; ++m) { const size_t row = (size_t)(u.pm * BM + EPI_ROWS(ai, m));
#pragma unroll
                for (int bj = 0; bj < 2; ++bj) { const size_t o = row * 1024 + u.pn * 256 + EPI_COLS(bj);
                    const f32x4 v0 = *(const f32x4*)(x + o) + acc[ai][bj][m][0], v1 = *(const f32x4*)(x + o + 4) + acc[ai][bj][m][1];
                    store8bf(HB + o, v0, v1); } }
    }
};
struct EpiGU {
    static constexpr bool CHAIN = false;
    const float* bgu; const float* ROWRS; bf16_t* ACT;
    __device__ __forceinline__ void operator()(const f32x4 (&acc)[2][2][4][2], const Unit& u, int wr, int wc, int fr, int fq, const LAS float* side) const {
        const int colp = u.pn * 128 + wc * 32 + 8 * fq;
        f32x4 bg[2], bu[2];
#pragma unroll
        for (int n = 0; n < 2; ++n) { bg[n] = *(const LAS f32x4*)(side + wc * 32 + 8 * fq + 4 * n); bu[n] = *(const LAS f32x4*)(side + 128 + wc * 32 + 8 * fq + 4 * n); }
#pragma unroll
        for (int ai = 0; ai < 2; ++ai)
#pragma unroll
            for (int m = 0; m < 4; ++m) { const size_t row = (size_t)u.gm * BM + EPI_ROWS(ai, m); const float rs = side[256 + EPI_ROWS(ai, m)];
                f32x2 o[4];
#pragma unroll
                for (int n = 0; n < 2; ++n) {
                    o[2 * n] = swiglu2(lo2(acc[ai][0][m][n]) * rs + lo2(bg[n]), lo2(acc[ai][1][m][n]) * rs + lo2(bu[n]));
                    o[2 * n + 1] = swiglu2(hi2(acc[ai][0][m][n]) * rs + hi2(bg[n]), hi2(acc[ai][1][m][n]) * rs + hi2(bu[n])); }
                store8bf2(ACT + row * 1024 + colp, o[0], o[1], o[2], o[3]); }
    }
};
struct EpiDN {
    static constexpr bool CHAIN = false;
    const float* bdn; const float* ROWGATE; bf16_t* YS;
    __device__ __forceinline__ void operator()(const f32x4 (&acc)[2][2][4][2], const Unit& u, int wr, int wc, int fr, int fq, const LAS float* side) const {
        f32x4 bv[2][2];
#pragma unroll
        for (int bj = 0; bj < 2; ++bj)
#pragma unroll
            for (int n = 0; n < 2; ++n) bv[bj][n] = *(const LAS f32x4*)(side + EPI_COLS(bj) + 4 * n);
#pragma unroll
        for (int ai = 0; ai < 2; ++ai)
#pragma unroll
            for (int m = 0; m < 4; ++m) { const size_t row = (size_t)u.gm * BM + EPI_ROWS(ai, m); const float gt = side[256 + EPI_ROWS(ai, m)];
#pragma unroll
                for (int bj = 0; bj < 2; ++bj) {
                    const f32x2 a = (lo2(acc[ai][bj][m][0]) + lo2(bv[bj][0])) * gt, b = (hi2(acc[ai][bj][m][0]) + hi2(bv[bj][0])) * gt, c = (lo2(acc[ai][bj][m][1]) + lo2(bv[bj][1])) * gt, d = (hi2(acc[ai][bj][m][1]) + hi2(bv[bj][1])) * gt;
#ifdef YS_FP8
                    int w0 = __builtin_amdgcn_cvt_pk_fp8_f32(a.x, a.y, 0, false); w0 = __builtin_amdgcn_cvt_pk_fp8_f32(b.x, b.y, w0, true);
                    int w1 = __builtin_amdgcn_cvt_pk_fp8_f32(c.x, c.y, 0, false); w1 = __builtin_amdgcn_cvt_pk_fp8_f32(d.x, d.y, w1, true);
                    *(u32x2*)((unsigned char*)YS + row * 1024 + u.pn * 256 + EPI_COLS(bj)) = (u32x2){(unsigned)w0, (unsigned)w1};
#else
                    store8bf2(YS + row * 1024 + u.pn * 256 + EPI_COLS(bj), a, b, c, d);
#endif
                } }
    }
};

template <int NS> struct SchedDenseT {
    static constexpr int NSIDE = NS; const float* bias;
    __device__ __forceinline__ const float* side_addr(const Unit& u, int, int idx) const {
        const int p = u.pn - 20; return p < 0 ? bias + u.pn * 256 + idx : bias + (idx < 128 ? 5120 + 128 * p + idx : 6144 + 128 * p + (idx - 128)); }
    DenseOrder O; const char* A; const char* B;
    __device__ __forceinline__ bool next(int i, Unit& u) const { int pm, pn; if (!O.tile(i, pm, pn)) return false; u.pm = pm; u.pn = pn; u.e = 0; u.gm = pm;
        u.A = A + (size_t)pm * (BM * KD * 2); u.B = B + (size_t)pn * (BM * KD * 2); return true; }
    static constexpr const unsigned* ROWTOK = nullptr; __device__ __forceinline__ int ROWTOK_row(const Unit&, int) const { return 0; } __device__ __forceinline__ size_t rowoff(const Unit&) const { return 0; }
};
struct SchedDenseProbe {
    static constexpr int NSIDE = 0; __device__ __forceinline__ const float* side_addr(const Unit&, int, int) const { return nullptr; }
    DenseOrder O; const char* A; const char* B;
    __device__ __forceinline__ bool next(int i, Unit& u) const { int pm, pn; if (!O.tile(i, pm, pn)) return false; u.pm = pm; u.pn = pn; u.e = 0; u.gm = pm;
        u.A = A + (size_t)(pm & 1) * (BM * KD * 2); u.B = B + (size_t)(pn & 1) * (BM * KD * 2); return true; }
    static constexpr const unsigned* ROWTOK = nullptr; __device__ __forceinline__ int ROWTOK_row(const Unit&, int) const { return 0; } __device__ __forceinline__ size_t rowoff(const Unit&) const { return 0; }
};
struct SchedMix {
    static constexpr int NSIDE = 0; __device__ __forceinline__ const float* side_addr(const Unit&, int, int) const { return nullptr; }
    DenseOrder O; const char* A0; const char* A1; const char* B0; const char* B1;
    __device__ __forceinline__ bool next(int i, Unit& u) const { int pm, pn; if (!O.tile(i >> 1, pm, pn)) return false; const int w = i & 1; u.pm = pm; u.pn = pn; u.e = w; u.gm = pm;
        u.A = (w ? A1 : A0) + (size_t)pm * (BM * KD * 2); u.B = (w ? B1 : B0) + (size_t)pn * (BM * KD * 2); return true; }
    static constexpr const unsigned* ROWTOK = nullptr; __device__ __forceinline__ int ROWTOK_row(const Unit&, int) const { return 0; } __device__ __forceinline__ size_t rowoff(const Unit&) const { return 0; }
};
template <int NT, bool GATHER> struct SchedMoE {
    static constexpr int NSIDE = 2; const float* sbias; const float* srow;
    __device__ __forceinline__ const float* side_addr(const Unit& u, int k, int idx) const {
        if (k == 1) return srow + (size_t)u.e * T + u.pm + idx;
        return NT == 8 ? sbias + u.e * 2048 + (idx < 128 ? 128 * u.pn + idx : 1024 + 128 * u.pn + idx - 128) : sbias + u.e * 1024 + 256 * u.pn + idx; }
    const LAS int* ptile; int G, c; const char* A; const char* B; size_t bstride  ; const int* ROWTOK;
    __device__ __forceinline__ bool next(int i, Unit& u) const {
        const int ngm = __builtin_amdgcn_readfirstlane(ptile[32]);
        int gm, pn;
        if (G == 256) {
            const int x = c & 7, y = c >> 3; gm = i * (256 / NT) + x * (32 / NT) + y / NT; pn = y % NT;
#ifdef LAST_SPREAD
            if ((i + 1) * (256 / NT) > ngm) gm = i * (256 / NT) + (y / NT) * 8 + x;
#endif
            if (gm >= ngm) return false;
#ifdef DN_REVERSE
            if (NT == 4) gm = ngm - 1 - gm;
#endif
        } else { const long Lx = (long)i * G + c; if (Lx >= (long)ngm * NT) return false; gm = (int)(Lx / NT); pn = (int)(Lx % NT); }
        int e = 0;
#pragma unroll 1
        for (int q = 1; q < 32; ++q) e += (__builtin_amdgcn_readfirstlane(ptile[q]) <= gm) ? 1 : 0;
        u.pm = (gm - __builtin_amdgcn_readfirstlane(ptile[e])) * BM; u.gm = gm; u.pn = pn; u.e = e;
        u.A = GATHER ? A : A + (size_t)gm * (BM * KD * 2); u.B = B + (size_t)e * bstride + (size_t)pn * (BM * KD * 2); return true; }
    __device__ __forceinline__ int ROWTOK_row(const Unit& u, int r) const { return GATHER ? ROWTOK[(size_t)u.e * T + u.pm + r] : 0; }
    __device__ __forceinline__ size_t rowoff(const Unit& u) const { return (size_t)u.e * T + u.pm; }
};
}
struct Args { const float* in[33]; float* out; unsigned char* ws; int ph_lo, ph_hi, li, pad; };
#define LDS_WAIT() asm volatile("s_waitcnt lgkmcnt(0)" ::: "memory")

struct Frame {
    LAS unsigned char* lds; int tid, lane, wave, G, bid; const float* const* in; float* out; unsigned char* ws;
};

#ifndef DUPMASK
#define DUPMASK 0
#endif
#define REP(bit) for (int rep_ = 0; rep_ < (((DUPMASK >> (bit)) & 1) ? 2 : 1); ++rep_)

#define XB_TMO      128
#define XB_XCNT(j)  (256  + 64 * (j))
#define XB_XSUB(j)  (1280 + 64 * (j))
#define XB_XGEN(j)  (2304 + 64 * (j))
#define XB_TOP      3328
#define XB_TOPGEN   3392
#define XCD_BAR_WORDS 3456
#define XB_SPIN_CAP (1u << 18)

__device__ __forceinline__ unsigned xb_ld(unsigned* p)              { return __hip_atomic_load(p, __ATOMIC_RELAXED, __HIP_MEMORY_SCOPE_AGENT); }
__device__ __forceinline__ unsigned xb_add(unsigned* p, unsigned v) { return __hip_atomic_fetch_add(p, v, __ATOMIC_RELAXED, __HIP_MEMORY_SCOPE_AGENT); }
__device__ __forceinline__ unsigned xb_xcc_id() { return (unsigned)__builtin_amdgcn_s_getreg((3 << 11) | 20) & 0xFu; }
#define XB_SPIN(cond, bar) do { unsigned _sp = 0; while (cond) { __builtin_amdgcn_s_sleep(1); \
    if ((++_sp & 255u) == 0u) { if (xb_ld(&(bar)[XB_TMO])) break; if (_sp > XB_SPIN_CAP) { atomicAdd(&(bar)[XB_TMO], 1u); break; } } } } while (0)

struct XcdBarrier {
    unsigned* bar; unsigned x;
    volatile LAS unsigned* st;
};

__device__ __forceinline__ XcdBarrier xcd_barrier_post(unsigned* bar, volatile LAS unsigned* st) {
    XcdBarrier b; b.bar = bar; b.x = xb_xcc_id(); b.st = st;
    if (threadIdx.x == 0) (void)xb_add(&bar[XB_XCNT(b.x)], 1u);
    return b;
}
__device__ __forceinline__ void xcd_barrier_complete(unsigned* bar, unsigned x, unsigned& nloc, unsigned& nx) {
    const unsigned G = gridDim.x * gridDim.y * gridDim.z;
    unsigned sum, cnt, mine, sp = 0u;
    for (;;) {
        sum = 0u; cnt = 0u; mine = 0u;
#pragma unroll
        for (unsigned j = 0; j < 16; ++j) { const unsigned c = xb_ld(&bar[XB_XCNT(j)]); sum += c; cnt += (c > 0u) ? 1u : 0u; mine = (j == x) ? c : mine; }
        if (sum == G) break;
        __builtin_amdgcn_s_sleep(1);
        if ((++sp & 255u) == 0u) { if (xb_ld(&bar[XB_TMO])) break; if (sp > XB_SPIN_CAP) { atomicAdd(&bar[XB_TMO], 1u); break; } }
    }
    nloc = mine > 0u ? mine : 1u; nx = cnt > 0u ? cnt : 1u;
}

__device__ __forceinline__ void xcd_barrier(const XcdBarrier& b) {
    asm volatile("s_waitcnt vmcnt(0)" ::: "memory");
    __syncthreads();
    if (threadIdx.x == 0) {
        unsigned* bar = b.bar;
        __builtin_amdgcn_s_waitcnt(0);
        unsigned nloc = b.st[0], nx = b.st[1];
        if (nloc == 0u) { xcd_barrier_complete(bar, b.x, nloc, nx); b.st[0] = nloc; b.st[1] = nx; }
        const unsigned old = xb_add(&bar[XB_XSUB(b.x)], 1u);
        const unsigned gen = old / nloc;
        if (old + 1u == (gen + 1u) * nloc) {
            __builtin_amdgcn_fence(__ATOMIC_RELEASE, "agent");
            asm volatile("s_waitcnt vmcnt(0)" ::: "memory");
            const unsigned og = xb_add(&bar[XB_TOP], 1u);
            const unsigned tg = og / nx;
            if (og + 1u == (tg + 1u) * nx) xb_add(&bar[XB_TOPGEN], 1u);
            else XB_SPIN(xb_ld(&bar[XB_TOPGEN]) == tg, bar);
            __builtin_amdgcn_fence(__ATOMIC_ACQUIRE, "agent");
            xb_add(&bar[XB_XGEN(b.x)], 1u);
            asm volatile("s_waitcnt vmcnt(0)" ::: "memory");
        } else {
            XB_SPIN(xb_ld(&bar[XB_XGEN(b.x)]) == gen, bar);
            __builtin_amdgcn_fence(__ATOMIC_ACQUIRE, "agent");
            asm volatile("s_waitcnt vmcnt(0)" ::: "memory");
        }
    }
    __syncthreads();
}


__device__ __forceinline__ void stagger_delay(int cls, int ticks_per_class) {
    if (cls > 0) { const unsigned long long t0 = __builtin_amdgcn_s_memrealtime(); const unsigned long long want = (unsigned long long)(cls * ticks_per_class);
        while (__builtin_amdgcn_s_memrealtime() - t0 < want) __builtin_amdgcn_s_sleep(32); }
}
namespace hy {
constexpr int TW128_OFF = MISC_OFF + 1024, TWT_OFF = MISC_OFF + 2048;

__host__ __device__ constexpr float twc16(int m) { return m == 0 ? 1.f : m == 1 ? 0.92387953251128674f : m == 2 ? 0.70710678118654752f : m == 3 ? 0.38268343236508977f : m == 4 ? 0.f : m == 5 ? -0.38268343236508977f : m == 6 ? -0.70710678118654752f : -0.92387953251128674f; }
__host__ __device__ constexpr float tws16(int m) { return m == 0 ? 0.f : m == 1 ? 0.38268343236508977f : m == 2 ? 0.70710678118654752f : m == 3 ? 0.92387953251128674f : m == 4 ? 1.f : m == 5 ? 0.92387953251128674f : m == 6 ? 0.70710678118654752f : 0.38268343236508977f; }
template <int N> __host__ __device__ constexpr int brev(int i) { int r = 0; for (int b = 1, c = N >> 1; b < N; b <<= 1, c >>= 1) if (i & b) r |= c; return r; }

typedef f32x2 P2;
template <int N, bool INV> __device__ __forceinline__ void fft_reg(P2 (&xr)[N], P2 (&xi)[N]) {
#pragma unroll
    for (int len = N; len >= 2; len >>= 1) {
        const int half = len >> 1;
#pragma unroll
        for (int start = 0; start < N; start += len) {
#pragma unroll
            for (int j = 0; j < half; ++j) {
                const int i0 = start + j, i1 = i0 + half;
                const P2 ar = xr[i0], ai = xi[i0], br = xr[i1], bi = xi[i1];
                xr[i0] = ar + br; xi[i0] = ai + bi;
                const P2 tr = ar - br, ti = ai - bi;
                const int m = j * (16 / len);
                if (m == 0) { xr[i1] = tr; xi[i1] = ti; }
                else if (m == 4) { if (INV) { xr[i1] = -ti; xi[i1] = tr; } else { xr[i1] = ti; xi[i1] = -tr; } }
                else { const float c = twc16(m), s = INV ? tws16(m) : -tws16(m); xr[i1] = tr * c - ti * s; xi[i1] = tr * s + ti * c; }
            }
        }
    }
}
__device__ __forceinline__ unsigned pkh(float a, float b) { return __builtin_bit_cast(unsigned, __builtin_amdgcn_cvt_pkrtz(a, b)); }
__device__ __forceinline__ u32x2 pkc(const P2 re, const P2 im) { u32x2 r; r.x = pkh(re.x, re.y); r.y = pkh(im.x, im.y); return r; }
__device__ __forceinline__ float h2f_lo(unsigned u) { return (float)__builtin_bit_cast(_Float16, (unsigned short)(u & 0xffffu)); }
__device__ __forceinline__ float h2f_hi(unsigned u) { return (float)__builtin_bit_cast(_Float16, (unsigned short)(u >> 16)); }
__device__ __forceinline__ P2 unpk2(unsigned u) { return (P2){h2f_lo(u), h2f_hi(u)}; }
#ifdef YZ_BF8
typedef unsigned yz_t;
__device__ __forceinline__ yz_t pkyz(const P2 re, const P2 im) { int v = __builtin_amdgcn_cvt_pk_bf8_f32(re.x, re.y, 0, false); v = __builtin_amdgcn_cvt_pk_bf8_f32(im.x, im.y, v, true); return (unsigned)v; }
__device__ __forceinline__ P2 yzre(const yz_t u) { return __builtin_amdgcn_cvt_pk_f32_bf8((int)u, false); }
__device__ __forceinline__ P2 yzim(const yz_t u) { return __builtin_amdgcn_cvt_pk_f32_bf8((int)u, true); }
constexpr float YZ_ZSCALE = 1.0f / 16.0f;
#else
typedef u32x2 yz_t;
__device__ __forceinline__ yz_t pkyz(const P2 re, const P2 im) { return pkc(re, im); }
__device__ __forceinline__ P2 yzre(const yz_t u) { return unpk2(u.x); }
__device__ __forceinline__ P2 yzim(const yz_t u) { return unpk2(u.y); }
constexpr float YZ_ZSCALE = 1.0f;
#endif
__device__ __forceinline__ P2 bf2p(unsigned u) { return (P2){__uint_as_float(u << 16), __uint_as_float(u & 0xffff0000u)}; }
__device__ __forceinline__ void cmul(P2& xr, P2& xi, float c, float s) { const P2 r = xr * c - xi * s, i = xr * s + xi * c; xr = r; xi = i; }

__device__ __forceinline__ void init_tw128(Frame& F) {
    __syncthreads();
    if (F.tid < 128) { float s, c; sincospif((float)F.tid * (1.0f / 64.0f), &s, &c); ((LAS f32x2*)(F.lds + TW128_OFF))[F.tid] = (f32x2){c, s}; }
    __syncthreads();
}
__device__ __forceinline__ void tile_tw(Frame& F, int a, bool inv) {
    if (F.tid < 128) { const int m = (a * F.tid) & (L2X - 1); float s, c; sincospif((float)m * (1.0f / 8192.0f), &s, &c); ((LAS f32x2*)(F.lds + TWT_OFF))[F.tid] = (f32x2){c, inv ? s : -s}; }
}
template <bool INV> __device__ __forceinline__ void stage1(Frame& F, P2 (&xr)[16], P2 (&xi)[16], int s) {
    fft_reg<16, INV>(xr, xi);
    const LAS f32x2* tw = (const LAS f32x2*)(F.lds + TW128_OFF); LAS f32x4* tile = (LAS f32x4*)F.lds;
#pragma unroll
    for (int q = 0; q < 16; ++q) { const int p = brev<16>(q); const f32x2 w = tw[s * q]; const float c = w.x, sn = INV ? w.y : -w.y;
        P2 a = xr[p], b = xi[p]; cmul(a, b, c, sn);
        tile[(s * 16 + q) * 64 + F.lane] = (f32x4){a.x, a.y, b.x, b.y}; }
}
__device__ __forceinline__ void stage2_read(Frame& F, P2 (&xr)[8], P2 (&xi)[8], int qq) {
    const LAS f32x4* tile = (const LAS f32x4*)F.lds;
#pragma unroll
    for (int s = 0; s < 8; ++s) { const f32x4 v = tile[(s * 16 + qq) * 64 + F.lane]; xr[s] = (P2){v.x, v.y}; xi[s] = (P2){v.z, v.w}; }
}
__device__ __forceinline__ void hyq2(const bf16_t* __restrict__ PHY, size_t row, int tl, int col, const float (&w)[3][2], const float (&b)[2], float& q0, float& q1) {
    q0 = b[0]; q1 = b[1];
#pragma unroll
    for (int k = 0; k < 3; ++k) { const int tt = tl + k - 1; const bool ok = (tt >= 0) && (tt < L);
        const unsigned u = ok ? *(const unsigned*)(PHY + (row + k - 1) * 3072 + col) : 0u;
        q0 += w[k][0] * __uint_as_float(u << 16); q1 += w[k][1] * __uint_as_float(u & 0xffff0000u); }
}
struct ConvW { float w[3][3][2]; float b[3][2]; };
__device__ __forceinline__ void load_convw(ConvW& W, const float* __restrict__ cw, const float* __restrict__ cb, int c0) {
#pragma unroll
    for (int seg = 0; seg < 3; ++seg) {
#pragma unroll
        for (int k = 0; k < 3; ++k) { const f32x2 v = *(const f32x2*)(cw + k * 3072 + seg * 1024 + c0); W.w[seg][k][0] = v.x; W.w[seg][k][1] = v.y; }
        const f32x2 v = *(const f32x2*)(cb + seg * 1024 + c0); W.b[seg][0] = v.x; W.b[seg][1] = v.y; }
}


__device__ __forceinline__ void bf8_to_f(const u32x4 u, float (&f)[8]) {
    f[0] = __uint_as_float(u.x << 16); f[1] = __uint_as_float(u.x & 0xffff0000u); f[2] = __uint_as_float(u.y << 16); f[3] = __uint_as_float(u.y & 0xffff0000u);
    f[4] = __uint_as_float(u.z << 16); f[5] = __uint_as_float(u.z & 0xffff0000u); f[6] = __uint_as_float(u.w << 16); f[7] = __uint_as_float(u.w & 0xffff0000u);
}
__device__ __forceinline__ void prepass(Frame& F) {
    const bf16_t* PHY = (const bf16_t*)(F.ws + WS_PHY); bf16_t* Z16 = (bf16_t*)(F.ws + WS_Z16); bf16_t* X1Q = (bf16_t*)(F.ws + WS_YHY); const float* cw = F.in[12]; const float* cb = F.in[13];
    const int gw = F.bid * NWAVES + F.wave, NGW = F.G * NWAVES;
#pragma unroll 1
    for (int item = gw; item < (T / 16) * 2; item += NGW) {
        const int half = item & 1, row0 = (item >> 1) * 16, tl0 = row0 & (L - 1), c0 = half * 512 + 8 * F.lane;
        float w[3][3][8], bs[3][8];
#pragma unroll
        for (int seg = 0; seg < 3; ++seg) {
#pragma unroll
            for (int k = 0; k < 3; ++k) { const f32x4 a = *(const f32x4*)(cw + k * 3072 + seg * 1024 + c0), b = *(const f32x4*)(cw + k * 3072 + seg * 1024 + c0 + 4);
                w[seg][k][0] = a.x; w[seg][k][1] = a.y; w[seg][k][2] = a.z; w[seg][k][3] = a.w; w[seg][k][4] = b.x; w[seg][k][5] = b.y; w[seg][k][6] = b.z; w[seg][k][7] = b.w; }
            const f32x4 a = *(const f32x4*)(cb + seg * 1024 + c0), b = *(const f32x4*)(cb + seg * 1024 + c0 + 4);
            bs[seg][0] = a.x; bs[seg][1] = a.y; bs[seg][2] = a.z; bs[seg][3] = a.w; bs[seg][4] = b.x; bs[seg][5] = b.y; bs[seg][6] = b.z; bs[seg][7] = b.w; }
        const u32x4 zero4 = (u32x4){0u, 0u, 0u, 0u};
        u32x4 prev[3], cur[3];
#pragma unroll
        for (int seg = 0; seg < 3; ++seg) { prev[seg] = tl0 > 0 ? *(const u32x4*)(PHY + (size_t)(row0 - 1) * 3072 + seg * 1024 + c0) : zero4; cur[seg] = *(const u32x4*)(PHY + (size_t)row0 * 3072 + seg * 1024 + c0); }
#pragma unroll 1
        for (int sub = 0; sub < 4; ++sub) {
            u32x4 nx[4][3];
#pragma unroll
            for (int r = 0; r < 4; ++r)
#pragma unroll
                for (int seg = 0; seg < 3; ++seg) { const int tn = tl0 + sub * 4 + r + 1; nx[r][seg] = tn < L ? *(const u32x4*)(PHY + (size_t)(row0 + sub * 4 + r + 1) * 3072 + seg * 1024 + c0) : zero4; }
#pragma unroll
            for (int r = 0; r < 4; ++r) {
                float q[3][8];
#pragma unroll
                for (int seg = 0; seg < 3; ++seg) { float a[8], b[8], c[8]; bf8_to_f(prev[seg], a); bf8_to_f(cur[seg], b); bf8_to_f(nx[r][seg], c);
#pragma unroll
                    for (int e = 0; e < 8; ++e) q[seg][e] = bs[seg][e] + w[seg][0][e] * a[e] + w[seg][1][e] * b[e] + w[seg][2][e] * c[e];
                    prev[seg] = cur[seg]; cur[seg] = nx[r][seg]; }
                const size_t o = (size_t)(row0 + sub * 4 + r) * 1024 + c0;
                u32x4 zo, xo;
                zo.x = pk2(q[2][0] * q[0][0], q[2][1] * q[0][1]); zo.y = pk2(q[2][2] * q[0][2], q[2][3] * q[0][3]); zo.z = pk2(q[2][4] * q[0][4], q[2][5] * q[0][5]); zo.w = pk2(q[2][6] * q[0][6], q[2][7] * q[0][7]);
                xo.x = pk2(q[1][0], q[1][1]); xo.y = pk2(q[1][2], q[1][3]); xo.z = pk2(q[1][4], q[1][5]); xo.w = pk2(q[1][6], q[1][7]);
                *(u32x4*)(Z16 + o) = zo; *(u32x4*)(X1Q + o) = xo;
            }
        }
    }
}

__device__ __forceinline__ void prep_w4frag(Frame& F) {
    const float* w4 = F.in[20]; u32x4* WF4 = (u32x4*)(F.ws + WS_WF4);
    for (int idx = F.bid * NTHREADS + F.tid; idx < 2 * 64 * 2 * 64; idx += F.G * NTHREADS) {
        const int lane = idx & 63, s = (idx >> 6) & 1, cb = (idx >> 7) & 63, dir = idx >> 13; const int col = dir * 1024 + 16 * cb + (lane & 15), k0 = 32 * s + 8 * (lane >> 4);
        u32x4 o; o.x = pk2(w4[(k0 + 0) * 2048 + col], w4[(k0 + 1) * 2048 + col]); o.y = pk2(w4[(k0 + 2) * 2048 + col], w4[(k0 + 3) * 2048 + col]);
        o.z = pk2(w4[(k0 + 4) * 2048 + col], w4[(k0 + 5) * 2048 + col]); o.w = pk2(w4[(k0 + 6) * 2048 + col], w4[(k0 + 7) * 2048 + col]);
        WF4[idx] = o; }
}
__device__ __forceinline__ void fa_load(const float* __restrict__ w4, int c0, int bt, f32x2 (&wf)[16], f32x2 (&wb)[16]) {
#pragma unroll
    for (int e = 0; e < 16; ++e) { wf[e] = *(const f32x2*)(w4 + (16 * bt + e) * 2048 + c0); wb[e] = *(const f32x2*)(w4 + (16 * bt + e) * 2048 + 1024 + c0); }
}
__device__ __forceinline__ void fa_compute(const LAS f32x4* hrow, int bt, const f32x2 (&wf)[16], const f32x2 (&wb)[16], float (&r0)[16], float (&r1)[16], float& l0, float& l1, bool lag0) {
#pragma unroll
    for (int e4 = 0; e4 < 4; ++e4) { const int u4 = 4 * bt + e4; __builtin_amdgcn_sched_barrier(0);
#pragma unroll
        for (int j = 0; j < 16; ++j) { const f32x4 hv = hrow[(8 * j) * 16 + u4];
#pragma unroll
            for (int e = 0; e < 4; ++e) { r0[j] += hv[e] * (j < 8 ? wf[4 * e4 + e].x : wb[4 * e4 + e].x); r1[j] += hv[e] * (j < 8 ? wf[4 * e4 + e].y : wb[4 * e4 + e].y); } }
        if (lag0) { const f32x4 hv = hrow[u4];
#pragma unroll
            for (int e = 0; e < 4; ++e) { l0 += hv[e] * wb[4 * e4 + e].x; l1 += hv[e] * wb[4 * e4 + e].y; } } }
}
template <bool DRY = false> __device__ __forceinline__ void filter_pass_a(Frame& F, int k_lo = 0, int k_hi = 1 << 20) {
    const float* HH3 = (const float*)(F.ws + WS_HH3); const float* w4 = F.in[20]; float* NORM = (float*)(F.ws + WS_NORMP); u32x2* YK = (u32x2*)(F.ws + WS_KF);
    const int s = F.wave; const LAS f32x2* twt = (const LAS f32x2*)(F.lds + TWT_OFF);
    for (int kk = k_lo, tl = F.bid + k_lo * F.G; kk < k_hi && tl < 128 * 8; ++kk, tl += F.G) {
        const int n1 = tl >> 3, ct = tl & 7, c0 = ct * 128 + 2 * F.lane;
        tile_tw(F, n1, false);
        { const int rw = F.tid >> 2, part = F.tid & 3; const int n = n1 + 128 * rw; const int t = n < L ? n : ((2 * L - n) & (L - 1));
          const f32x4* src = (const f32x4*)(HH3 + t * 64 + part * 16); LAS f32x4* dst = (LAS f32x4*)(F.lds + rw * 256 + part * 64);
          const f32x4 a = src[0], b = src[1], c = src[2], d = src[3]; dst[0] = a; dst[1] = b; dst[2] = c; dst[3] = d; }
        __syncthreads();
        P2 xr[16], xi[16]; P2 lag0 = (P2){0.f, 0.f};
        const P2 da = (P2){hy_delta_abs(c0), hy_delta_abs(c0 + 1)};
        { const u32x4* WF4 = (const u32x4*)(F.ws + WS_WF4); const int cb = ct * 8 + s, jl = F.lane & 15, ql = F.lane >> 4;
          bf16x8 bfr[2][2];
#pragma unroll
          for (int dir = 0; dir < 2; ++dir)
#pragma unroll
              for (int ks = 0; ks < 2; ++ks) bfr[dir][ks] = __builtin_bit_cast(bf16x8, WF4[(((dir * 64 + cb) * 2 + ks) * 64) + F.lane]);
          LAS float* kt = (LAS float*)(F.lds + 32768);
#pragma unroll
          for (int m = 0; m < 8; ++m) {
              bf16x8 afr[2];
#pragma unroll
              for (int ks = 0; ks < 2; ++ks) { const LAS f32x4* hp = (const LAS f32x4*)(F.lds + (16 * m + jl) * 256 + (32 * ks + 8 * ql) * 4); const f32x4 x0 = hp[0], x1 = hp[1];
                  u32x4 pk; pk.x = pk2(x0.x, x0.y); pk.y = pk2(x0.z, x0.w); pk.z = pk2(x1.x, x1.y); pk.w = pk2(x1.z, x1.w); afr[ks] = __builtin_bit_cast(bf16x8, pk); }
              f32x4 d = (f32x4){0.f, 0.f, 0.f, 0.f};
              d = __builtin_amdgcn_mfma_f32_16x16x32_bf16(afr[0], bfr[m >> 2][0], d, 0, 0, 0); d = __builtin_amdgcn_mfma_f32_16x16x32_bf16(afr[1], bfr[m >> 2][1], d, 0, 0, 0);
#pragma unroll
              for (int r = 0; r < 4; ++r) kt[(16 * m + 4 * ql + r) * 132 + 16 * s + jl] = d[r]; }
          if (n1 == 0 && s == 0) { const LAS float* h0 = (const LAS float*)F.lds;
#pragma unroll 4
              for (int u = 0; u < 64; ++u) { const f32x2 wb = *(const f32x2*)(w4 + u * 2048 + 1024 + c0); lag0 += h0[u] * wb; } }
          __syncthreads();
#pragma unroll
          for (int j = 0; j < 16; ++j) xr[j] = *(const LAS f32x2*)(kt + (s + 8 * j) * 132 + 2 * F.lane);
        }
        __syncthreads();
        P2 na = (P2){0.f, 0.f};
#pragma unroll
        for (int j = 0; j < 16; ++j) { const int n = n1 + 128 * (s + 8 * j); const int t = j < 8 ? n : ((2 * L - n) & (L - 1)); const float tt = (float)t * (1.0f / (float)(L - 1));
            P2 v = xr[j] * (P2){fexp(-tt * da.x), fexp(-tt * da.y)};
            if (n == L) v = (P2){0.f, 0.f};
            if (j == 0) v += lag0;
            xr[j] = v; xi[j] = (P2){0.f, 0.f}; na += (P2){fabsf(v.x), fabsf(v.y)}; }
        { LAS f32x2* nred = (LAS f32x2*)(F.lds + MISC_OFF + 12288); nred[s * 64 + F.lane] = na; }
        stage1<false>(F, xr, xi, s);
        __syncthreads();
        if (s == 0) { const LAS f32x2* nred = (const LAS f32x2*)(F.lds + MISC_OFF + 12288); f32x2 a = nred[F.lane];
#pragma unroll
            for (int w = 1; w < 8; ++w) { const f32x2 b = nred[w * 64 + F.lane]; a.x += b.x; a.y += b.y; }
            if (!DRY) *(f32x2*)(NORM + (size_t)n1 * 1024 + c0) = a; else asm volatile("" :: "v"(a)); }
#pragma unroll
        for (int h = 0; h < 2; ++h) { const int qq = s + 8 * h; P2 a[8], b[8];
            stage2_read(F, a, b, qq); fft_reg<8, false>(a, b);
#pragma unroll
            for (int r = 0; r < 8; ++r) { const int p = brev<8>(r), k2 = qq + 16 * r; const f32x2 w = twt[k2];
                P2 x = a[p], y = b[p]; cmul(x, y, w.x, w.y);
                if (!DRY) YK[((size_t)k2 * 128 + n1) * 512 + (c0 >> 1)] = pkc(x, y); else asm volatile("" :: "v"(x), "v"(y)); } }
        __syncthreads();
    }
}
template <bool DRY = false> __device__ __forceinline__ void filter_pass_b(Frame& F) {
    const float* NORM = (const float*)(F.ws + WS_NORMP); u32x2* KF = (u32x2*)(F.ws + WS_KF); const int s = F.wave;
    for (int tl = F.bid; tl < 128 * 8; tl += F.G) {
        const int k2 = tl >> 3, ct = tl & 7, c0 = ct * 128 + 2 * F.lane; const size_t base = (size_t)k2 * 128 * 512 + (c0 >> 1);
        { LAS float* nsum = (LAS float*)(F.lds + MISC_OFF + 12288); const int ch = F.tid & 127, qt = F.tid >> 7; float a = 0.f;
#pragma unroll 8
          for (int i = 0; i < 32; ++i) a += NORM[(size_t)(qt * 32 + i) * 1024 + ct * 128 + ch];
          __syncthreads(); nsum[qt * 128 + ch] = a; __syncthreads(); }
        P2 sc;
        { const LAS float* nsum = (const LAS float*)(F.lds + MISC_OFF + 12288); const int ch = 2 * F.lane;
          sc.x = 1.0f / ((nsum[ch] + nsum[128 + ch]) + (nsum[256 + ch] + nsum[384 + ch])); sc.y = 1.0f / ((nsum[ch + 1] + nsum[128 + ch + 1]) + (nsum[256 + ch + 1] + nsum[384 + ch + 1])); }
        P2 xr[16], xi[16];
#pragma unroll
        for (int j = 0; j < 16; ++j) { const u32x2 u = KF[base + (size_t)(s + 8 * j) * 512]; xr[j] = unpk2(u.x); xi[j] = unpk2(u.y); }
        stage1<false>(F, xr, xi, s);
        __syncthreads();
#pragma unroll
        for (int h = 0; h < 2; ++h) { const int qq = s + 8 * h; P2 a[8], b[8];
            stage2_read(F, a, b, qq); fft_reg<8, false>(a, b);
#pragma unroll
            for (int r = 0; r < 8; ++r) { const int p = brev<8>(r), k1 = qq + 16 * r;
                const u32x2 o_ = pkc(a[p] * sc, b[p] * sc); if (!DRY) KF[base + (size_t)k1 * 512] = o_; else asm volatile("" :: "v"(o_)); } }
        __syncthreads();
    }
}
__device__ __forceinline__ void data_pass_a(Frame& F) {
    const bf16_t* Z16 = (const bf16_t*)(F.ws + WS_Z16); yz_t* YZ = (yz_t*)(F.ws + WS_YZ); const int s = F.wave; const LAS f32x2* twt = (const LAS f32x2*)(F.lds + TWT_OFF);
    unsigned zn[16];
    auto zload = [&](int tl, unsigned (&z)[16]) { const int ct = tl & 7, n1 = (tl >> 3) & 127, p = tl >> 10, c0 = ct * 128 + 2 * F.lane;
#pragma unroll
        for (int j = 0; j < 8; ++j) { const int t = n1 + 128 * (s + 8 * j);
            z[2 * j] = *(const unsigned*)(Z16 + ((size_t)(2 * p) * L + t) * 1024 + c0); z[2 * j + 1] = *(const unsigned*)(Z16 + ((size_t)(2 * p + 1) * L + t) * 1024 + c0); } };
    if (F.bid < 2 * 128 * 8) zload(F.bid, zn);
    for (int tl = F.bid; tl < 2 * 128 * 8; tl += F.G) {
        const int ct = tl & 7, n1 = (tl >> 3) & 127, p = tl >> 10, c0 = ct * 128 + 2 * F.lane;
        tile_tw(F, n1, false);
        P2 xr[16], xi[16];
#pragma unroll
        for (int j = 0; j < 8; ++j) { xr[j] = bf2p(zn[2 * j]); xi[j] = bf2p(zn[2 * j + 1]); }
        if (tl + F.G < 2 * 128 * 8) zload(tl + F.G, zn);
#pragma unroll
        for (int j = 8; j < 16; ++j) { xr[j] = (P2){0.f, 0.f}; xi[j] = (P2){0.f, 0.f}; }
        stage1<false>(F, xr, xi, s);
        __syncthreads();
#pragma unroll
        for (int h = 0; h < 2; ++h) { const int qq = s + 8 * h; P2 a[8], b[8];
            stage2_read(F, a, b, qq); fft_reg<8, false>(a, b);
#pragma unroll
            for (int r = 0; r < 8; ++r) { const int pp = brev<8>(r), k2 = qq + 16 * r; const f32x2 w = twt[k2];
                P2 x = a[pp], y = b[pp]; cmul(x, y, w.x, w.y);
                YZ[(((size_t)p * 128 + k2) * 128 + n1) * 512 + (c0 >> 1)] = pkyz(x, y); } }
        __syncthreads();
    }
}
template <bool DRY = false> __device__ __forceinline__ void data_pass_b(Frame& F) {
    yz_t* YZ = (yz_t*)(F.ws + WS_YZ); const u32x2* KF = (const u32x2*)(F.ws + WS_KF); const int s = F.wave;
    const LAS f32x2* twt = (const LAS f32x2*)(F.lds + TWT_OFF); const LAS f32x2* tw = (const LAS f32x2*)(F.lds + TW128_OFF); LAS f32x4* tile = (LAS f32x4*)F.lds;
    int* qctr = (int*)(F.ws + WS_CTL) + 128 + (DRY ? 1 : 0); LAS int* qslot = (LAS int*)(F.lds + MISC_OFF + 768);
    for (;;) {
        __syncthreads();
        if (F.tid == 0) *qslot = atomicAdd(qctr, 1);
        __syncthreads();
        const int tl = *qslot; if (tl >= 128 * 8) break;
        const int k2 = tl >> 3, ct = tl & 7, c0 = ct * 128 + 2 * F.lane; const size_t kbase = (size_t)k2 * 128 * 512 + (c0 >> 1);
        tile_tw(F, k2, true);
#pragma unroll 1
        for (int p = 0; p < 2; ++p) {
            const size_t base = ((size_t)p * 128 + k2) * 128 * 512 + (c0 >> 1);
            u32x2 kfp[2][8];
#pragma unroll
            for (int h = 0; h < 2; ++h)
#pragma unroll
                for (int r = 0; r < 8; ++r) kfp[h][r] = KF[kbase + (size_t)(s + 8 * h + 16 * r) * 512];
            { P2 xr[16], xi[16];
#pragma unroll
              for (int j = 0; j < 16; ++j) { const yz_t u = YZ[base + (size_t)(s + 8 * j) * 512]; xr[j] = yzre(u); xi[j] = yzim(u); }
              stage1<false>(F, xr, xi, s); }
            __syncthreads();
#pragma unroll
            for (int h = 0; h < 2; ++h) { const int qq = s + 8 * h; P2 a[8], b[8], gr[8], gi[8];
                if (h == 1) __builtin_amdgcn_sched_barrier(0);
                stage2_read(F, a, b, qq); fft_reg<8, false>(a, b);
#pragma unroll
                for (int r = 0; r < 8; ++r) { const int pp = brev<8>(r); const P2 kr = unpk2(kfp[h][r].x), ki = unpk2(kfp[h][r].y);
                    gr[r] = a[pp] * kr - b[pp] * ki; gi[r] = a[pp] * ki + b[pp] * kr; }
                fft_reg<8, true>(gr, gi);
#pragma unroll
                for (int bq = 0; bq < 8; ++bq) { const int pp = brev<8>(bq); const f32x2 w = tw[bq * qq];
                    P2 x = gr[pp], y = gi[pp]; cmul(x, y, w.x, w.y);
                    tile[(bq * 16 + qq) * 64 + F.lane] = (f32x4){x.x, x.y, y.x, y.y}; } }
            __syncthreads();
            { P2 xr[16], xi[16];
#pragma unroll
              for (int q = 0; q < 16; ++q) { const f32x4 v = tile[(s * 16 + q) * 64 + F.lane]; xr[q] = (P2){v.x, v.y}; xi[q] = (P2){v.z, v.w}; }
              fft_reg<16, true>(xr, xi);
#pragma unroll
              for (int a = 0; a < 16; ++a) { const int pp = brev<16>(a), m2 = s + 8 * a; const f32x2 w = twt[m2];
                  P2 x = xr[pp], y = xi[pp]; cmul(x, y, w.x, w.y);
                  if (!DRY) YZ[base + (size_t)m2 * 512] = pkyz(x * YZ_ZSCALE, y * YZ_ZSCALE); else asm volatile("" :: "v"(x), "v"(y)); } }
            __syncthreads();
        }
    }
}
template <bool DRY = false> __device__ __forceinline__ void data_pass_c(Frame& F) {
    const bf16_t* Z16 = (const bf16_t*)(F.ws + WS_Z16); const yz_t* YZ = (const yz_t*)(F.ws + WS_YZ); bf16_t* YHY = (bf16_t*)(F.ws + WS_YHY); const float* hbias = F.in[22]; const int s = F.wave;
    yz_t yzn[16];
    auto yzload = [&](int tl, yz_t (&y)[16]) { const int ct = tl & 7, m2 = (tl >> 3) & 127, p = tl >> 10, c0 = ct * 128 + 2 * F.lane;
#pragma unroll
        for (int j = 0; j < 16; ++j) y[j] = YZ[(((size_t)p * 128 + (s + 8 * j)) * 128 + m2) * 512 + (c0 >> 1)]; };
    if (F.bid < 2 * 128 * 8) yzload(F.bid, yzn);
    for (int tl = F.bid; tl < 2 * 128 * 8; tl += F.G) {
        const int ct = tl & 7, m2 = (tl >> 3) & 127, p = tl >> 10, c0 = ct * 128 + 2 * F.lane;
        unsigned uzp[2][4][2], uxp[2][4][2];
#pragma unroll
        for (int h = 0; h < 2; ++h)
#pragma unroll
            for (int r = 0; r < 4; ++r)
#pragma unroll
                for (int bb = 0; bb < 2; ++bb) { const size_t row = (size_t)(2 * p + bb) * L + 128 * (s + 8 * h + 16 * r) + m2;
                    uzp[h][r][bb] = *(const unsigned*)(Z16 + row * 1024 + c0); uxp[h][r][bb] = *(const unsigned*)(YHY + row * 1024 + c0); }
        { P2 xr[16], xi[16];
#pragma unroll
          for (int j = 0; j < 16; ++j) { xr[j] = yzre(yzn[j]); xi[j] = yzim(yzn[j]); }
          if (tl + F.G < 2 * 128 * 8) yzload(tl + F.G, yzn);
          stage1<true>(F, xr, xi, s); }
        __syncthreads();
        const P2 hb = *(const f32x2*)(hbias + c0);
#pragma unroll
        for (int h = 0; h < 2; ++h) { const int qq = s + 8 * h; P2 a[8], b[8];
            stage2_read(F, a, b, qq); fft_reg<8, true>(a, b);
#pragma unroll
            for (int r = 0; r < 4; ++r) { const int pp = brev<8>(r), t = 128 * (qq + 16 * r) + m2;
#pragma unroll
                for (int bb = 0; bb < 2; ++bb) { const size_t row = (size_t)(2 * p + bb) * L + t;
                    const P2 z = bf2p(uzp[h][r][bb]), x1 = bf2p(uxp[h][r][bb]);
                    const P2 cv = (bb == 0 ? a[pp] : b[pp]) * (1.0f / ((float)L2X * YZ_ZSCALE));
                    const P2 y = x1 * (cv + hb * z);
                    if (!DRY) *(unsigned*)(YHY + row * 1024 + c0) = pk2(y.x, y.y); else asm volatile("" :: "v"(y)); } } }
        __syncthreads();
    }
}
}
namespace lru {
__device__ __forceinline__ f32x2 sig2(const f32x2 x) { const f32x2 t = x * -1.4426950408889634f; const f32x2 d = (f32x2){__builtin_amdgcn_exp2f(t.x), __builtin_amdgcn_exp2f(t.y)} + 1.0f; return (f32x2){__builtin_amdgcn_rcpf(d.x), __builtin_amdgcn_rcpf(d.y)}; }
constexpr int TC = 64, NCH = L / TC, MB = TC / 16;

__device__ __forceinline__ void prep_wfrag(Frame& F) {
    const float* wa = F.in[6]; const float* wi = F.in[8]; u32x4* WF = (u32x4*)(F.ws + WS_WLRUF);
    for (int idx = F.bid * NTHREADS + F.tid; idx < 2 * 16 * 2 * 4 * 2 * 64; idx += F.G * NTHREADS) {
        const int lane = idx & 63, s = (idx >> 6) & 1, n = (idx >> 7) & 3, mat = (idx >> 9) & 1, h = (idx >> 10) & 15, dir = idx >> 14;
        const float* W = (mat == 0 ? wa : wi) + ((size_t)(dir * 16 + h) * 64) * 64; const int jo = 16 * n + (lane & 15), i0 = 32 * s + 8 * (lane >> 4);
        u32x4 o; o.x = pk2(W[(i0 + 0) * 64 + jo], W[(i0 + 1) * 64 + jo]); o.y = pk2(W[(i0 + 2) * 64 + jo], W[(i0 + 3) * 64 + jo]);
        o.z = pk2(W[(i0 + 4) * 64 + jo], W[(i0 + 5) * 64 + jo]); o.w = pk2(W[(i0 + 6) * 64 + jo], W[(i0 + 7) * 64 + jo]);
        WF[idx] = o;
    }
}

__device__ __forceinline__ void load_rows(const bf16_t* __restrict__ P0, int b, int t0, int m, int h, int j, int q, u32x4 (&pv)[2][4]) {
#pragma unroll
    for (int s = 0; s < 2; ++s)
#pragma unroll
        for (int tap = 0; tap < 4; ++tap) { const int tl = t0 + 16 * m + j + tap - 2; const bool ok = (tl >= 0) && (tl < L);
            const size_t off = ok ? (WS_P0 - WS_CTL - 8192) + (((size_t)b * L + tl) * 1024 + 64 * h + 32 * s + 8 * q) * 2 : (size_t)0;
            pv[s][tap] = *(const u32x4*)((const char*)P0 + off); }
}
__device__ __forceinline__ void stage1(Frame& F) {
    const bf16_t* P0 = (const bf16_t*)(F.ws + WS_CTL + 8192);
    const float* cw = F.in[4]; const float* cb = F.in[5]; const float* ba = F.in[7]; const float* bi = F.in[9]; const float* lam = F.in[10];
    const u32x4* WF = (const u32x4*)(F.ws + WS_WLRUF); f32x2* SUMM = (f32x2*)(F.ws + WS_SUMM);
    u32x2* HS = (u32x2*)(F.ws + WS_HS); u32x2* AF = (u32x2*)(F.ws + WS_AF); u32x2* AB = (u32x2*)(F.ws + WS_AB);
    LAS float* cwl = (LAS float*)(F.lds + MISC_OFF + 4096);
    LAS unsigned* hfl = (LAS unsigned*)(F.lds + F.wave * 8192) + F.lane;
    const LAS u32x4* wl = (const LAS u32x4*)(F.lds + 65536) + F.lane;
    asm volatile("" : "+v"(wl)); asm volatile("" : "+v"(hfl));
    const int lane = F.lane, j = lane & 15, q = lane >> 4;
    bf16x8 idf[2];
#pragma unroll
    for (int par = 0; par < 2; ++par) { const int kp = 16 * par + j;
#pragma unroll
        for (int jj = 0; jj < 8; ++jj) idf[par][jj] = (short)((q == (kp >> 3) && jj == (kp & 7)) ? 0x3F80 : 0); }
#pragma unroll 1
    for (int bix = F.bid; bix < NB * 16 * (NCH / 8); bix += F.G) {
        const int h = (bix >> 4) & 15, b = bix >> 8, chunk = (bix & 15) * 8 + F.wave; const int t0 = chunk * TC; const int task = ((b * NCH + chunk) << 4) + h;
        __syncthreads();
        if (F.tid < 320) cwl[F.tid] = F.tid < 256 ? cw[(F.tid >> 6) * 1024 + 64 * h + (F.tid & 63)] : cb[64 * h + (F.tid & 63)];
#pragma unroll
        for (int i = 0; i < 4; ++i) { const int e = F.tid + 512 * i; const int dir_ = e >> 10, rest = e & 1023;
            ((LAS u32x4*)(F.lds + 65536))[e] = WF[((size_t)(dir_ * 16 + h) * 16) * 64 + rest]; }
        __syncthreads();
#pragma unroll
        for (int dir = 0; dir < 2; ++dir) {
            float bac[4], bic[4], spc[4], cst[4], arun[4];
#pragma unroll
            for (int n = 0; n < 4; ++n) { const int c = 64 * h + 16 * n + j; bac[n] = ba[dir * 1024 + c]; bic[n] = bi[dir * 1024 + c]; spc[n] = -8.0f * 1.4426950408889634f * log1pf(expf(-lam[dir * 1024 + c])); cst[n] = 0.f; arun[n] = 1.f; }
            u32x4 pvn[2][4];
            load_rows(P0, b, t0, dir == 0 ? 0 : MB - 1, h, j, q, pvn);
#pragma unroll 1
            for (int mm = 0; mm < MB; ++mm) {
                const int m = dir == 0 ? mm : MB - 1 - mm;
                bf16x8 afr[2];
#pragma unroll
                for (int s = 0; s < 2; ++s) { const int chb = 32 * s + 8 * q; f32x2 xp[4];
                    { const f32x4 b0 = *(const LAS f32x4*)(cwl + 256 + chb), b1 = *(const LAS f32x4*)(cwl + 256 + chb + 4);
                      xp[0] = (f32x2){b0.x, b0.y}; xp[1] = (f32x2){b0.z, b0.w}; xp[2] = (f32x2){b1.x, b1.y}; xp[3] = (f32x2){b1.z, b1.w}; }
#pragma unroll
                    for (int tap = 0; tap < 4; ++tap) { const u32x4 pq = pvn[s][tap];
                        const f32x4 w0 = *(const LAS f32x4*)(cwl + tap * 64 + chb), w1 = *(const LAS f32x4*)(cwl + tap * 64 + chb + 4);
                        xp[0] += (f32x2){w0.x, w0.y} * (f32x2){__uint_as_float(pq.x << 16), __uint_as_float(pq.x & 0xffff0000u)}; xp[1] += (f32x2){w0.z, w0.w} * (f32x2){__uint_as_float(pq.y << 16), __uint_as_float(pq.y & 0xffff0000u)};
                        xp[2] += (f32x2){w1.x, w1.y} * (f32x2){__uint_as_float(pq.z << 16), __uint_as_float(pq.z & 0xffff0000u)}; xp[3] += (f32x2){w1.z, w1.w} * (f32x2){__uint_as_float(pq.w << 16), __uint_as_float(pq.w & 0xffff0000u)}; }
                    u32x4 pk; pk.x = pk2(xp[0].x, xp[0].y); pk.y = pk2(xp[1].x, xp[1].y); pk.z = pk2(xp[2].x, xp[2].y); pk.w = pk2(xp[3].x, xp[3].y); afr[s] = __builtin_bit_cast(bf16x8, pk); }
                __builtin_amdgcn_sched_barrier(0);
                if (mm + 1 < MB) load_rows(P0, b, t0, dir == 0 ? m + 1 : m - 1, h, j, q, pvn);
                f32x4 dx[4], da[4], di[4];
#pragma unroll
                for (int n = 0; n < 4; ++n) { const f32x4 z4 = (f32x4){0.f, 0.f, 0.f, 0.f};
                    dx[n] = __builtin_amdgcn_mfma_f32_16x16x32_bf16(afr[n >> 1], idf[n & 1], z4, 0, 0, 0);
                    const bf16x8 wa0 = __builtin_bit_cast(bf16x8, wl[(((dir * 2 + 0) * 4 + n) * 2 + 0) * 64]), wa1 = __builtin_bit_cast(bf16x8, wl[(((dir * 2 + 0) * 4 + n) * 2 + 1) * 64]);
                    const bf16x8 wi0 = __builtin_bit_cast(bf16x8, wl[(((dir * 2 + 1) * 4 + n) * 2 + 0) * 64]), wi1 = __builtin_bit_cast(bf16x8, wl[(((dir * 2 + 1) * 4 + n) * 2 + 1) * 64]);
                    da[n] = __builtin_amdgcn_mfma_f32_16x16x32_bf16(afr[0], wa0, z4, 0, 0, 0); da[n] = __builtin_amdgcn_mfma_f32_16x16x32_bf16(afr[1], wa1, da[n], 0, 0, 0);
                    di[n] = __builtin_amdgcn_mfma_f32_16x16x32_bf16(afr[0], wi0, z4, 0, 0, 0); di[n] = __builtin_amdgcn_mfma_f32_16x16x32_bf16(afr[1], wi1, di[n], 0, 0, 0); }
                float P[4][4], S[4][4], PT[4], ST[4];
#pragma unroll
                for (int n = 0; n < 4; ++n) { float av[4], bv[4];
#pragma unroll
                    for (int hp = 0; hp < 2; ++hp) {
                        const f32x2 rg = sig2((f32x2){da[n][2 * hp], da[n][2 * hp + 1]} + bac[n]), ig = sig2((f32x2){di[n][2 * hp], di[n][2 * hp + 1]} + bic[n]);
                        const f32x2 tq = rg * spc[n];
                        const f32x2 a = (f32x2){__builtin_amdgcn_exp2f(tq.x), __builtin_amdgcn_exp2f(tq.y)};
                        const f32x2 w = 1.0f - a * a;
                        const f32x2 mult = (f32x2){__builtin_amdgcn_sqrtf(fmaxf(w.x, 0.f)), __builtin_amdgcn_sqrtf(fmaxf(w.y, 0.f))};
                        const f32x2 bq = mult * (ig * (f32x2){dx[n][2 * hp], dx[n][2 * hp + 1]});
                        av[2 * hp] = a.x; av[2 * hp + 1] = a.y; bv[2 * hp] = bq.x; bv[2 * hp + 1] = bq.y; }
                    if (dir == 0) { P[n][0] = av[0]; S[n][0] = bv[0];
#pragma unroll
                        for (int r = 1; r < 4; ++r) { P[n][r] = P[n][r - 1] * av[r]; S[n][r] = av[r] * S[n][r - 1] + bv[r]; } }
                    else { P[n][3] = av[3]; S[n][3] = bv[3];
#pragma unroll
                        for (int r = 2; r >= 0; --r) { P[n][r] = P[n][r + 1] * av[r]; S[n][r] = av[r] * S[n][r + 1] + bv[r]; } }
                    PT[n] = dir == 0 ? P[n][3] : P[n][0]; ST[n] = dir == 0 ? S[n][3] : S[n][0]; }
                float pt[4][4], st[4][4];
#pragma unroll
                for (int n = 0; n < 4; ++n)
#pragma unroll
                    for (int g = 0; g < 4; ++g) { pt[n][g] = __shfl(PT[n], j + 16 * g); st[n][g] = __shfl(ST[n], j + 16 * g); }
#pragma unroll
                for (int n = 0; n < 4; ++n) {
                    float C = cst[n], A = arun[n], Cq = 0.f, Aq = 1.f;
#pragma unroll
                    for (int gg = 0; gg < 4; ++gg) { const int g = dir == 0 ? gg : 3 - gg; if (g == q) { Cq = C; Aq = A; } C = pt[n][g] * C + st[n][g]; A *= pt[n][g]; }
                    cst[n] = C; arun[n] = A;
                    float hl[4], ac[4];
#pragma unroll
                    for (int hp = 0; hp < 2; ++hp) { const f32x2 pp = (f32x2){P[n][2 * hp], P[n][2 * hp + 1]}; const f32x2 hq = (f32x2){S[n][2 * hp], S[n][2 * hp + 1]} + pp * Cq, aq = pp * Aq;
                        hl[2 * hp] = hq.x; hl[2 * hp + 1] = hq.y; ac[2 * hp] = aq.x; ac[2 * hp + 1] = aq.y; }
                    const size_t fo = ((size_t)(task * MB + m) * 4 + n) * 64 + lane;
                    if (dir == 0) {
                        hfl[((m * 4 + n) * 2 + 0) * 64] = pk2(hl[0], hl[1]); hfl[((m * 4 + n) * 2 + 1) * 64] = pk2(hl[2], hl[3]);
                        AF[fo] = (u32x2){pk2(ac[0], ac[1]), pk2(ac[2], ac[3])};
                    } else {
                        { const unsigned u0 = hfl[((m * 4 + n) * 2 + 0) * 64], u1 = hfl[((m * 4 + n) * 2 + 1) * 64];
                          hl[0] += __uint_as_float(u0 << 16); hl[1] += __uint_as_float(u0 & 0xffff0000u); hl[2] += __uint_as_float(u1 << 16); hl[3] += __uint_as_float(u1 & 0xffff0000u); }
                        HS[fo] = (u32x2){pk2(hl[0], hl[1]), pk2(hl[2], hl[3])}; AB[fo] = (u32x2){pk2(ac[0], ac[1]), pk2(ac[2], ac[3])};
                    }
                }
            }
            if (q == 0) {
#pragma unroll
                for (int n = 0; n < 4; ++n) SUMM[((size_t)(dir * NB + b) * NCH + chunk) * 1024 + 64 * h + 16 * n + j] = (f32x2){arun[n], cst[n]};
            }
        }
    }
}
__device__ __forceinline__ void stage2(Frame& F) {
    const bf16_t* P1 = (const bf16_t*)(F.ws + WS_P1); bf16_t* YLRU = (bf16_t*)(F.ws + WS_YLRU); const float* CARRY = (const float*)(F.ws + WS_CARRY);
    const u32x2* HS = (const u32x2*)(F.ws + WS_HS); const u32x2* AF = (const u32x2*)(F.ws + WS_AF); const u32x2* AB = (const u32x2*)(F.ws + WS_AB);
    LAS float* buf = (LAS float*)(F.lds + F.wave * 8192);
    const int lane = F.lane, j = lane & 15, q = lane >> 4, tk = lane >> 2, cg = lane & 3;
    const int gw = F.bid * NWAVES + F.wave, NGW = F.G * NWAVES;
    struct In { u32x2 hs[4], af[4], ab[4]; float cf[4], cbk[4]; u32x4 g0, g1; };
    auto issue = [&](int item, In& I) {
        const int m = item & (MB - 1), task = item >> 2, h = task & 15, chunk = (task >> 4) & (NCH - 1), b = task >> 11;
#pragma unroll
        for (int n = 0; n < 4; ++n) { const size_t fo = ((size_t)item * 4 + n) * 64 + lane; I.hs[n] = HS[fo]; I.af[n] = AF[fo]; I.ab[n] = AB[fo];
            const int c = 64 * h + 16 * n + j; I.cf[n] = CARRY[((size_t)(0 * NB + b) * NCH + chunk) * 1024 + c]; I.cbk[n] = CARRY[((size_t)(1 * NB + b) * NCH + chunk) * 1024 + c]; }
        const size_t o = ((size_t)b * L + chunk * TC + 16 * m + tk) * 1024 + 64 * h + 16 * cg;
        I.g0 = *(const u32x4*)(P1 + o); I.g1 = *(const u32x4*)(P1 + o + 8); };
    auto finish = [&](int item, const In& I) {
        const int m = item & (MB - 1), task = item >> 2, h = task & 15, chunk = (task >> 4) & (NCH - 1), b = task >> 11;
#pragma unroll
        for (int n = 0; n < 4; ++n) {
            const float h0 = __uint_as_float(I.hs[n].x << 16) + __uint_as_float(I.af[n].x << 16) * I.cf[n] + __uint_as_float(I.ab[n].x << 16) * I.cbk[n];
            const float h1 = __uint_as_float(I.hs[n].x & 0xffff0000u) + __uint_as_float(I.af[n].x & 0xffff0000u) * I.cf[n] + __uint_as_float(I.ab[n].x & 0xffff0000u) * I.cbk[n];
            const float h2 = __uint_as_float(I.hs[n].y << 16) + __uint_as_float(I.af[n].y << 16) * I.cf[n] + __uint_as_float(I.ab[n].y << 16) * I.cbk[n];
            const float h3 = __uint_as_float(I.hs[n].y & 0xffff0000u) + __uint_as_float(I.af[n].y & 0xffff0000u) * I.cf[n] + __uint_as_float(I.ab[n].y & 0xffff0000u) * I.cbk[n];
            buf[(4 * q + 0) * 68 + 16 * n + j] = h0; buf[(4 * q + 1) * 68 + 16 * n + j] = h1; buf[(4 * q + 2) * 68 + 16 * n + j] = h2; buf[(4 * q + 3) * 68 + 16 * n + j] = h3;
        }
        LDS_WAIT();
        const size_t o = ((size_t)b * L + chunk * TC + 16 * m + tk) * 1024 + 64 * h + 16 * cg;
        const LAS f32x4* br = (const LAS f32x4*)(buf + tk * 68 + 16 * cg);
        const f32x4 v0 = br[0], v1 = br[1], v2 = br[2], v3 = br[3];
        float gg[16];
        { const unsigned w[8] = {I.g0.x, I.g0.y, I.g0.z, I.g0.w, I.g1.x, I.g1.y, I.g1.z, I.g1.w};
#pragma unroll
          for (int i = 0; i < 8; ++i) { gg[2 * i] = gelu_tanh(__uint_as_float(w[i] << 16)); gg[2 * i + 1] = gelu_tanh(__uint_as_float(w[i] & 0xffff0000u)); } }
        u32x4 y0, y1;
        y0.x = pk2(v0.x * gg[0], v0.y * gg[1]); y0.y = pk2(v0.z * gg[2], v0.w * gg[3]); y0.z = pk2(v1.x * gg[4], v1.y * gg[5]); y0.w = pk2(v1.z * gg[6], v1.w * gg[7]);
        y1.x = pk2(v2.x * gg[8], v2.y * gg[9]); y1.y = pk2(v2.z * gg[10], v2.w * gg[11]); y1.z = pk2(v3.x * gg[12], v3.y * gg[13]); y1.w = pk2(v3.z * gg[14], v3.w * gg[15]);
        *(u32x4*)(YLRU + o) = y0; *(u32x4*)(YLRU + o + 8) = y1;
        LDS_WAIT(); };
    constexpr int NIT = NB * NCH * 16 * MB;
    In A, B; int item = gw;
    if (item < NIT) issue(item, A);
#pragma unroll 1
    for (; item < NIT; item += 2 * NGW) {
        if (item + NGW < NIT) issue(item + NGW, B);
        finish(item, A);
        if (item + NGW >= NIT) break;
        if (item + 2 * NGW < NIT) issue(item + 2 * NGW, A);
        finish(item + NGW, B);
    }
}
__device__ __forceinline__ void carry(Frame& F) {
    const f32x2* SUMM = (const f32x2*)(F.ws + WS_SUMM); float* CARRY = (float*)(F.ws + WS_CARRY);
    for (int idx = F.bid * NTHREADS + F.tid; idx < 2 * NB * 1024; idx += F.G * NTHREADS) {
        const int c = idx & 1023, db = idx >> 10, dir = db >> 2; const size_t base = (size_t)db * NCH * 1024 + c;
        float C = 0.f;
#pragma unroll 1
        for (int k0 = 0; k0 < NCH; k0 += 16) {
            f32x2 v[16];
#pragma unroll
            for (int i = 0; i < 16; ++i) { const int k = dir == 0 ? (k0 + i) : (NCH - 1 - k0 - i); v[i] = SUMM[base + (size_t)k * 1024]; }
#pragma unroll
            for (int i = 0; i < 16; ++i) { const int k = dir == 0 ? (k0 + i) : (NCH - 1 - k0 - i); CARRY[base + (size_t)k * 1024] = C; C = v[i].x * C + v[i].y; }
        }
    }
}
}
__device__ __forceinline__ void transpose_item(const float* __restrict__ W, int ldw, int k0, int n0, bf16_t* __restrict__ WT, size_t orow0, const float* __restrict__ kscale, LAS float* scr, int lane) {
    const int r8 = lane >> 3, c4 = (lane & 7) * 4;
#pragma unroll
    for (int i = 0; i < 8; ++i) { const int kk = 8 * i + r8; f32x4 v = *(const f32x4*)(W + (size_t)(k0 + kk) * ldw + n0 + c4);
        if (kscale) { const float s = kscale[k0 + kk]; v = v * s; }
        scr[kk * 33 + c4 + 0] = v.x; scr[kk * 33 + c4 + 1] = v.y; scr[kk * 33 + c4 + 2] = v.z; scr[kk * 33 + c4 + 3] = v.w; }
    LDS_WAIT();
    const int c = lane & 7;
#pragma unroll
    for (int j = 0; j < 4; ++j) { const int n = (lane >> 3) + 8 * j; const LAS float* s = scr + (8 * c) * 33 + n;
        u32x4 o; o.x = pk2(s[0 * 33], s[1 * 33]); o.y = pk2(s[2 * 33], s[3 * 33]); o.z = pk2(s[4 * 33], s[5 * 33]); o.w = pk2(s[6 * 33], s[7 * 33]);
        *(u32x4*)(WT + (orow0 + n) * 1024 + k0 + 8 * c) = o; }
    LDS_WAIT();
}

__device__ __forceinline__ void phase_prep(Frame& F) {
    LAS float* scr = (LAS float*)(F.lds + F.wave * 16384);
    const int gw = F.bid * NWAVES + F.wave, NGW = F.G * NWAVES;
    constexpr int I_IN = (1024 / 64) * (NIN / 32), I_SQ = (1024 / 64) * (1024 / 32);
    for (int it = gw; it < I_IN + 3 * I_SQ; it += NGW) {
        int r = it; const float* W; int N; bf16_t* WT;
        if (r < I_IN) { W = F.in[2]; N = NIN; WT = (bf16_t*)(F.ws + WS_WIN); }
        else { r -= I_IN; const int q = r / I_SQ; r -= q * I_SQ; N = 1024; W = q == 0 ? F.in[11] : q == 1 ? F.in[23] : F.in[24]; WT = (bf16_t*)(F.ws + (q == 0 ? WS_WLRU : q == 1 ? WS_WHY : WS_WOUT)); }
        const int nblk = N / 32, kb = r / nblk, nb = r % nblk;
        int orow = 32 * nb;
        if (N == NIN && orow >= 5120) { const int which = (orow - 5120) >> 10, cc = (orow - 5120) & 1023; orow = 5120 + 256 * (cc >> 7) + 128 * which + (cc & 127); }
        transpose_item(W, N, 64 * kb, 32 * nb, WT, (size_t)orow, nullptr, scr, F.lane);
    }
    { const float* x = F.in[0]; const float* g = F.in[1]; bf16_t* U = (bf16_t*)(F.ws + WS_U);
      f32x4 gg[4];
#pragma unroll
      for (int j = 0; j < 4; ++j) gg[j] = ((const f32x4*)g)[F.lane + 64 * j];
      auto ld = [&](int row, f32x4 (&v)[4]) { const f32x4* xr = (const f32x4*)(x + (size_t)row * D) + F.lane;
#pragma unroll
          for (int j = 0; j < 4; ++j) v[j] = xr[64 * j]; };
      auto fin = [&](int row, const f32x4 (&v)[4]) { float s = 0.f;
#pragma unroll
          for (int j = 0; j < 4; ++j) s += v[j].x * v[j].x + v[j].y * v[j].y + v[j].z * v[j].z + v[j].w * v[j].w;
          const float rstd = rsqrtf(wave_sum(s) * (1.0f / D) + EPS);
#pragma unroll
          for (int j = 0; j < 4; ++j) { u32x2 w; w.x = pk2(v[j].x * rstd * gg[j].x, v[j].y * rstd * gg[j].y); w.y = pk2(v[j].z * rstd * gg[j].z, v[j].w * rstd * gg[j].w);
              ((u32x2*)(U + (size_t)row * D))[F.lane + 64 * j] = w; } };
      f32x4 va[4], vb[4], vc[4]; int row = gw;
      if (row < T) ld(row, va);
      if (row + NGW < T) ld(row + NGW, vb);
#pragma unroll 1
      for (; row < T; row += 3 * NGW) {
          if (row + 2 * NGW < T) ld(row + 2 * NGW, vc);
          fin(row, va);
          if (row + NGW >= T) break;
          if (row + 3 * NGW < T) ld(row + 3 * NGW, va);
          fin(row + NGW, vb);
          if (row + 2 * NGW >= T) break;
          if (row + 4 * NGW < T) ld(row + 4 * NGW, vb);
          fin(row + 2 * NGW, vc);
      } }
    { const float *w1 = F.in[14], *b1 = F.in[15], *w2 = F.in[16], *b2 = F.in[17], *w3 = F.in[18], *b3 = F.in[19], *freq = F.in[21]; float* HH3 = (float*)(F.ws + WS_HH3);
      LAS float* feat = scr; LAS float* h1 = scr + 64; LAS float* h2 = scr + 128; const int u = F.lane; const float fr = freq[u];
#pragma unroll 1
      for (int t = gw; t < L; t += NGW) {
        asm volatile("" ::: "memory");
        if (u < HYEMB) { float f; if (u == 0) f = (float)t / (float)(L - 1);
            else { const int j = (u - 1) & 15; const float band = 1e-4f + (float)j * ((15.0f - 1e-4f) / 15.0f); const float arg = (6.283185307179586f * (float)t / (float)L) * band; f = (u <= 16) ? cosf(arg) : -sinf(arg); }
            feat[u] = f; }
        LDS_WAIT();
        float s = b1[u];
#pragma unroll 1
        for (int f = 0; f < HYEMB; ++f) s += feat[f] * w1[f * 64 + u];
        h1[u] = sinf(fr * s); LDS_WAIT();
        s = b2[u];
#pragma unroll 4
        for (int f = 0; f < 64; ++f) s += h1[f] * w2[f * 64 + u];
        h2[u] = sinf(fr * s); LDS_WAIT();
        s = b3[u];
#pragma unroll 4
        for (int f = 0; f < 64; ++f) s += h2[f] * w3[f * 64 + u];
        HH3[t * 64 + u] = sinf(fr * s); LDS_WAIT(); } }
    lru::prep_wfrag(F); hy::prep_w4frag(F);
    { u32x4* WRGF = (u32x4*)(F.ws + WS_WRG); const float* g = F.in[25]; const float* wr = F.in[26];
      for (int idx = F.bid * NTHREADS + F.tid; idx < 32 * 2 * 2 * 64; idx += F.G * NTHREADS) {
          const int lane = idx & 63, part = (idx >> 6) & 1, tile = (idx >> 7) & 1, s = idx >> 8; const int e = 16 * tile + (lane & 15), k0 = 32 * s + 8 * (lane >> 4);
          float w[8];
#pragma unroll
          for (int jj = 0; jj < 8; ++jj) { const float v = g[k0 + jj] * wr[(k0 + jj) * 32 + e]; const float hi = __uint_as_float(pk2(v, v) << 16); w[jj] = part == 0 ? hi : v - hi; }
          u32x4 o; o.x = pk2(w[0], w[1]); o.y = pk2(w[2], w[3]); o.z = pk2(w[4], w[5]); o.w = pk2(w[6], w[7]); WRGF[idx] = o; } }
}

template <int KIND, bool DYN> __device__ __forceinline__ void convert_weights(Frame& F, int rank, int nranks, int rnd_lo = 0, int rnd_hi = 1 << 20) {
    LAS float* scr = (LAS float*)(F.lds + F.wave * 16384);
    const int gw = rank * NWAVES + F.wave, NGW = nranks * NWAVES;
    constexpr int IPE = KIND == 0 ? (1024 / 64) * (2048 / 32) : (1024 / 64) * (1024 / 32), TOTAL_ALL = NE * IPE;
    const int TOTAL = (long)rnd_hi * NGW < (long)TOTAL_ALL ? rnd_hi * NGW : TOTAL_ALL;
    int* ctr = (int*)(F.ws + WS_CTL) + 130;
    auto claim = [&]() { int v = 0; if (DYN && F.lane == 0) v = atomicAdd(ctr, 1); return v; };
    const float* Wc = nullptr; bf16_t* WTc = nullptr; size_t orowc = 0; int k0c = 0; f32x4 vc[8];
    auto decode_load = [&](int it, const float*& W, bf16_t*& WT, size_t& orow, int& k0, f32x4 (&v)[8]) {
        const int e = it / IPE, r = it - e * IPE; int ldw, n0;
        if (KIND == 0) { const int kb = r / 64, nb = r % 64; n0 = 32 * nb; const int which = n0 >> 10, pn = (n0 & 1023) >> 7, j0 = n0 & 127;
            W = F.in[28] + (size_t)e * 1024 * 2048; ldw = 2048; k0 = 64 * kb; WT = (bf16_t*)(F.ws + WS_WGU); orow = (size_t)e * 2048 + 256 * pn + 128 * which + j0; }
        else { const int kb = r / 32, nb = r % 32; n0 = 32 * nb;
            W = F.in[30] + (size_t)e * 1024 * 1024; ldw = 1024; k0 = 64 * kb; WT = (bf16_t*)(F.ws + WS_WDN); orow = (size_t)e * 1024 + 32 * nb; }
        const int r8 = F.lane >> 3, c4 = (F.lane & 7) * 4;
#pragma unroll
        for (int i = 0; i < 8; ++i) { const int kk = 8 * i + r8; v[i] = *(const f32x4*)(W + (size_t)(k0 + kk) * ldw + n0 + c4); if (KIND == 0) v[i] = v[i] * F.in[25][k0 + kk]; }
    };
    int it, itn, raw2 = 0;
    if (DYN) { const int r0 = claim(), r1 = claim(); raw2 = claim(); it = __builtin_amdgcn_readfirstlane(r0); itn = __builtin_amdgcn_readfirstlane(r1); }
    else { it = rnd_lo * NGW + gw; itn = it + NGW; }
    if (it < TOTAL) decode_load(it, Wc, WTc, orowc, k0c, vc);
#pragma unroll 1
    while (it < TOTAL) {
        const float* Wn = nullptr; bf16_t* WTn = nullptr; size_t orown = 0; int k0n = 0; f32x4 vn[8];
        const bool more = itn < TOTAL;
        if (more) decode_load(itn, Wn, WTn, orown, k0n, vn);
        { const int r8 = F.lane >> 3, c4 = (F.lane & 7) * 4;
#pragma unroll
          for (int i = 0; i < 8; ++i) { const int kk = 8 * i + r8; scr[kk * 33 + c4 + 0] = vc[i].x; scr[kk * 33 + c4 + 1] = vc[i].y; scr[kk * 33 + c4 + 2] = vc[i].z; scr[kk * 33 + c4 + 3] = vc[i].w; }
          LDS_WAIT();
          const int c = F.lane & 7;
#pragma unroll
          for (int j = 0; j < 4; ++j) { const int n = (F.lane >> 3) + 8 * j; const LAS float* s = scr + (8 * c) * 33 + n;
              u32x4 o; o.x = pk2(s[0 * 33], s[1 * 33]); o.y = pk2(s[2 * 33], s[3 * 33]); o.z = pk2(s[4 * 33], s[5 * 33]); o.w = pk2(s[6 * 33], s[7 * 33]);
              *(u32x4*)(WTc + (orowc + n) * 1024 + k0c + 8 * c) = o; }
          LDS_WAIT(); }
        if (more) { Wc = Wn; WTc = WTn; orowc = orown; k0c = k0n;
#pragma unroll
            for (int i = 0; i < 8; ++i) vc[i] = vn[i]; }
        it = itn;
        if (DYN) { itn = __builtin_amdgcn_readfirstlane(raw2); raw2 = claim(); } else itn += NGW;
    }
}
__device__ __forceinline__ void phase_router_a(Frame& F) {
#ifdef MIXDESYNC
    convert_weights<0, false>(F, F.bid, F.G, 2 * MIXDESYNC); convert_weights<1, false>(F, F.bid, F.G);
#else
    REP(11) { convert_weights<0, false>(F, F.bid, F.G); convert_weights<1, false>(F, F.bid, F.G); }
#endif
    __syncthreads();
    { const f32x4* src = (const f32x4*)(F.ws + WS_WRG); LAS f32x4* dst = (LAS f32x4*)F.lds;
      for (int i = F.tid; i < 32 * 2 * 2 * 64; i += NTHREADS) dst[i] = src[i]; }
    LAS int* hist = (LAS int*)(F.lds + MISC_OFF);
    if (F.tid < 32) hist[F.tid] = 0;
    __syncthreads();
    const LAS u32x4* wl = (const LAS u32x4*)F.lds + F.lane;
    const bf16_t* HB = (const bf16_t*)(F.ws + WS_HN); const float* br = F.in[27];
    int* EROWTOK = (int*)(F.ws + WS_EROWTOK); float* EROWRS = (float*)(F.ws + WS_EROWRS); float* EROWGATE = (float*)(F.ws + WS_EROWGATE); int* TOKCODE = (int*)(F.ws + WS_TOKROW); LAS int* base = hist + 32;
    for (int g0 = 0; g0 < T / 16; g0 += F.G * NWAVES) {
        const int grp = g0 + F.bid * NWAVES + F.wave; const bool act = grp < T / 16;
        int te_[4] = {0, 0, 0, 0}, lr_[4] = {0, 0, 0, 0}; float gt_[4] = {0.f, 0.f, 0.f, 0.f}, rs_ = 0.f;
        const int n = F.lane & 15, g = F.lane >> 4; const int t = grp * 16 + n;
        if (act) {
        const u32x4* hp = (const u32x4*)(HB + (size_t)t * D + 8 * g);
        f32x4 acc[2] = {(f32x4){0.f, 0.f, 0.f, 0.f}, (f32x4){0.f, 0.f, 0.f, 0.f}}; f32x2 ss2 = (f32x2){0.f, 0.f};
        u32x4 hb[8];
#pragma unroll
        for (int u = 0; u < 8; ++u) hb[u] = hp[u * 4];
#pragma unroll 1
        for (int s0 = 0; s0 < 32; s0 += 8) {
#pragma unroll
            for (int u = 0; u < 8; ++u) { const int s = s0 + u; const u32x4 cur = hb[u];
                if (s0 + 8 < 32) hb[u] = hp[(s + 8) * 4];
                const bf16x8 bfr = __builtin_bit_cast(bf16x8, cur);
#pragma unroll
                for (int tile = 0; tile < 2; ++tile) {
                    acc[tile] = __builtin_amdgcn_mfma_f32_16x16x32_bf16(__builtin_bit_cast(bf16x8, wl[((s * 2 + tile) * 2 + 0) * 64]), bfr, acc[tile], 0, 0, 0);
                    acc[tile] = __builtin_amdgcn_mfma_f32_16x16x32_bf16(__builtin_bit_cast(bf16x8, wl[((s * 2 + tile) * 2 + 1) * 64]), bfr, acc[tile], 0, 0, 0); }
                const f32x2 a = (f32x2){__uint_as_float(cur.x << 16), __uint_as_float(cur.x & 0xffff0000u)}, b = (f32x2){__uint_as_float(cur.y << 16), __uint_as_float(cur.y & 0xffff0000u)};
                const f32x2 c = (f32x2){__uint_as_float(cur.z << 16), __uint_as_float(cur.z & 0xffff0000u)}, d = (f32x2){__uint_as_float(cur.w << 16), __uint_as_float(cur.w & 0xffff0000u)};
                ss2 += a * a; ss2 += b * b; ss2 += c * c; ss2 += d * d; }
        }
        float ss = ss2.x + ss2.y; ss += __shfl_xor(ss, 16); ss += __shfl_xor(ss, 32);
        const float rstd = rsqrtf(ss * (1.0f / D) + EPS);
        float v[8];
#pragma unroll
        for (int q = 0; q < 8; ++q) v[q] = acc[q >> 2][q & 3] * rstd + br[16 * (q >> 2) + 4 * g + (q & 3)];
        float tv[4]; int te[4];
#pragma unroll
        for (int k = 0; k < 4; ++k) {
            float mx = -3.0e38f; int mi = 0;
#pragma unroll
            for (int q = 0; q < 8; ++q) { const int ex = 16 * (q >> 2) + 4 * g + (q & 3); if (v[q] > mx) { mx = v[q]; mi = ex; } }
#pragma unroll
            for (int o = 16; o <= 32; o <<= 1) { const float om = __shfl_xor(mx, o); const int oi = __shfl_xor(mi, o); if (om > mx || (om == mx && oi < mi)) { mx = om; mi = oi; } }
            tv[k] = mx; te[k] = mi;
#pragma unroll
            for (int q = 0; q < 8; ++q) { const int ex = 16 * (q >> 2) + 4 * g + (q & 3); if (ex == mi) v[q] = -3.0e38f; }
        }
        const float e1 = __expf(tv[1] - tv[0]), e2 = __expf(tv[2] - tv[0]), e3 = __expf(tv[3] - tv[0]); const float inv = 1.0f / (1.0f + e1 + e2 + e3);
        if (g == 0) {
            gt_[0] = inv; gt_[1] = e1 * inv; gt_[2] = e2 * inv; gt_[3] = e3 * inv; rs_ = rstd;
#pragma unroll
            for (int k = 0; k < 4; ++k) { te_[k] = te[k]; lr_[k] = atomicAdd((int*)&hist[te[k]], 1); }
        }
        }
        __syncthreads();
        if (F.tid < 32) base[F.tid] = hist[F.tid] != 0 ? atomicAdd((int*)(F.ws + WS_CTL) + F.tid, hist[F.tid]) : 0;
        __syncthreads();
        if (act && g == 0) { int code[4];
#pragma unroll
            for (int k = 0; k < 4; ++k) { const int e = te_[k], pos = base[e] + lr_[k]; const size_t o = (size_t)e * T + pos;
                EROWTOK[o] = t; EROWRS[o] = rs_; EROWGATE[o] = gt_[k]; code[k] = (e << 15) | pos; }
            *(int4*)(TOKCODE + t * 4) = make_int4(code[0], code[1], code[2], code[3]); }
        __syncthreads();
        if (F.tid < 32) hist[F.tid] = 0;
        __syncthreads();
    }
}
__device__ __forceinline__ const LAS int* build_ptile(Frame& F) {
    LAS int* pt = (LAS int*)(F.lds + MISC_OFF + 256);
    __syncthreads();
    if (F.tid == 0) { const int* cnt = (const int*)(F.ws + WS_CTL); int o = 0; for (int e = 0; e < 32; ++e) { pt[e] = o; o += (cnt[e] + 255) >> 8; } pt[32] = o; }
    __syncthreads();
    return pt;
}
__device__ __forceinline__ void phase_router_b(Frame& F) {
    const LAS int* pt = build_ptile(F);
    LAS int* hist = (LAS int*)(F.lds + MISC_OFF); LAS int* base = hist + 32;
    const int* TOPE = (const int*)(F.ws + WS_TOPE); const float* TOPG = (const float*)(F.ws + WS_TOPG); const float* TOKRS = (const float*)(F.ws + WS_TOKRS);
    int* ROWTOK = (int*)(F.ws + WS_ROWTOK); float* ROWGATE = (float*)(F.ws + WS_ROWGATE); float* ROWRS = (float*)(F.ws + WS_ROWRS); int* TOKROW = (int*)(F.ws + WS_TOKROW);
    int* cursor = (int*)(F.ws + WS_CTL) + 64; const int* cnt = (const int*)(F.ws + WS_CTL);
    for (int chunk = F.bid; chunk < T * 4 / NTHREADS; chunk += F.G) {
        __syncthreads();
        if (F.tid < 32) hist[F.tid] = 0;
        __syncthreads();
        const int idx = chunk * NTHREADS + F.tid; const int e = TOPE[idx]; const int lr = atomicAdd((int*)&hist[e], 1);
        __syncthreads();
        if (F.tid < 32) base[F.tid] = hist[F.tid] ? atomicAdd(cursor + F.tid, hist[F.tid]) : 0;
        __syncthreads();
        const int row = pt[e] * 256 + base[e] + lr;
        ROWTOK[row] = idx >> 2; ROWGATE[row] = TOPG[idx]; ROWRS[row] = TOKRS[idx >> 2]; TOKROW[idx] = row;
    }
    if (F.bid == 0) for (int e = F.wave; e < 32; e += NWAVES) { const int r0 = pt[e] * 256 + cnt[e], r1 = pt[e + 1] * 256; for (int r = r0 + F.lane; r < r1; r += 64) { ROWTOK[r] = 0; ROWGATE[r] = 0.f; ROWRS[r] = 0.f; } }
}
#ifdef YS_FP8
__device__ __forceinline__ void phase_final(Frame& F) {
    const int gw = F.bid * NWAVES + F.wave, NGW = F.G * NWAVES;
    float* out = F.out; const bf16_t* HB = (const bf16_t*)(F.ws + WS_HN); const unsigned char* YS8 = (const unsigned char*)(F.ws + WS_YS); const int* TOKROW = (const int*)(F.ws + WS_TOKROW); const float* g = F.in[32];
    const LAS int* pt = build_ptile(F);
    struct In { u32x4 h[2]; u32x2 y[4][2]; };
    auto issue = [&](int t, const int4 rows, In& I) {
#pragma unroll
        for (int j = 0; j < 2; ++j) I.h[j] = ((const u32x4*)(HB + (size_t)t * D))[F.lane + 64 * j];
#pragma unroll
        for (int k = 0; k < 4; ++k) { const int code = k == 0 ? rows.x : k == 1 ? rows.y : k == 2 ? rows.z : rows.w; const size_t row = (size_t)(pt[code >> 15] * 256 + (code & 32767));
#pragma unroll
            for (int j = 0; j < 2; ++j) I.y[k][j] = ((const u32x2*)(YS8 + row * D))[F.lane + 64 * j]; } };
    auto finish = [&](int t, const In& I) {
        float v[2][8]; float s = 0.f;
#pragma unroll
        for (int j = 0; j < 2; ++j) { const unsigned hw[4] = {I.h[j].x, I.h[j].y, I.h[j].z, I.h[j].w};
#pragma unroll
            for (int i = 0; i < 4; ++i) { v[j][2 * i] = __uint_as_float(hw[i] << 16); v[j][2 * i + 1] = __uint_as_float(hw[i] & 0xffff0000u); }
#pragma unroll
            for (int k = 0; k < 4; ++k) { const f32x2 a = __builtin_amdgcn_cvt_pk_f32_fp8((int)I.y[k][j].x, false), b = __builtin_amdgcn_cvt_pk_f32_fp8((int)I.y[k][j].x, true),
                                                      c = __builtin_amdgcn_cvt_pk_f32_fp8((int)I.y[k][j].y, false), d = __builtin_amdgcn_cvt_pk_f32_fp8((int)I.y[k][j].y, true);
                v[j][0] += a.x; v[j][1] += a.y; v[j][2] += b.x; v[j][3] += b.y; v[j][4] += c.x; v[j][5] += c.y; v[j][6] += d.x; v[j][7] += d.y; }
#pragma unroll
            for (int i = 0; i < 8; ++i) s += v[j][i] * v[j][i]; }
        const float rstd = rsqrtf(wave_sum(s) * (1.0f / D) + EPS);
#pragma unroll
        for (int j = 0; j < 2; ++j) { const f32x4 g0 = ((const f32x4*)g)[2 * (F.lane + 64 * j)], g1 = ((const f32x4*)g)[2 * (F.lane + 64 * j) + 1];
            f32x4* o = (f32x4*)(out + (size_t)t * D) + 2 * (F.lane + 64 * j);
            o[0] = (f32x4){v[j][0] * rstd * g0.x, v[j][1] * rstd * g0.y, v[j][2] * rstd * g0.z, v[j][3] * rstd * g0.w};
            o[1] = (f32x4){v[j][4] * rstd * g1.x, v[j][5] * rstd * g1.y, v[j][6] * rstd * g1.z, v[j][7] * rstd * g1.w}; } };
    int t = gw;
    int4 rowsA = make_int4(0, 0, 0, 0), rowsB = make_int4(0, 0, 0, 0); In dA, dB;
    if (t < T) rowsA = *(const int4*)(TOKROW + t * 4);
    if (t + NGW < T) rowsB = *(const int4*)(TOKROW + (t + NGW) * 4);
    if (t < T) issue(t, rowsA, dA);
#pragma unroll 1
    for (; t < T; t += 2 * NGW) {
        const int t1 = t + NGW, t2 = t + 2 * NGW, t3 = t + 3 * NGW;
        if (t2 < T) rowsA = *(const int4*)(TOKROW + t2 * 4);
        if (t1 < T) issue(t1, rowsB, dB);
        finish(t, dA);
        if (t1 >= T) break;
        if (t3 < T) rowsB = *(const int4*)(TOKROW + t3 * 4);
        if (t2 < T) issue(t2, rowsA, dA);
        finish(t1, dB);
    }
}
#else
__device__ __forceinline__ void phase_final(Frame& F) {
    const int gw = F.bid * NWAVES + F.wave, NGW = F.G * NWAVES;
    float* out = F.out; const bf16_t* HB = (const bf16_t*)(F.ws + WS_HN); const bf16_t* YS = (const bf16_t*)(F.ws + WS_YS); const int* TOKROW = (const int*)(F.ws + WS_TOKROW); const float* g = F.in[32];
    const LAS int* pt = build_ptile(F);
    auto issue = [&](int t, const int4 rows, u32x2 (&d)[5][4]) {
#pragma unroll
        for (int j = 0; j < 4; ++j) d[0][j] = ((const u32x2*)(HB + (size_t)t * D))[F.lane + 64 * j];
#pragma unroll
        for (int k = 0; k < 4; ++k) { const int code = k == 0 ? rows.x : k == 1 ? rows.y : k == 2 ? rows.z : rows.w; const size_t row = (size_t)(pt[code >> 15] * 256 + (code & 32767));
#pragma unroll
            for (int j = 0; j < 4; ++j) d[1 + k][j] = ((const u32x2*)(YS + row * D))[F.lane + 64 * j]; } };
    auto finish = [&](int t, const u32x2 (&d)[5][4]) {
        f32x4 v[4];
#pragma unroll
        for (int j = 0; j < 4; ++j) { v[j] = (f32x4){__uint_as_float(d[0][j].x << 16), __uint_as_float(d[0][j].x & 0xffff0000u), __uint_as_float(d[0][j].y << 16), __uint_as_float(d[0][j].y & 0xffff0000u)};
#pragma unroll
            for (int k = 1; k < 5; ++k) { const u32x2 w = d[k][j];
                v[j].x += __uint_as_float(w.x << 16); v[j].y += __uint_as_float(w.x & 0xffff0000u); v[j].z += __uint_as_float(w.y << 16); v[j].w += __uint_as_float(w.y & 0xffff0000u); } }
        float s = 0.f;
#pragma unroll
        for (int j = 0; j < 4; ++j) s += v[j].x * v[j].x + v[j].y * v[j].y + v[j].z * v[j].z + v[j].w * v[j].w;
        const float rstd = rsqrtf(wave_sum(s) * (1.0f / D) + EPS);
#pragma unroll
        for (int j = 0; j < 4; ++j) { const f32x4 gg = ((const f32x4*)g)[F.lane + 64 * j];
            ((f32x4*)(out + (size_t)t * D))[F.lane + 64 * j] = (f32x4){v[j].x * rstd * gg.x, v[j].y * rstd * gg.y, v[j].z * rstd * gg.z, v[j].w * rstd * gg.w}; } };
    int t = gw;
    int4 rowsA = make_int4(0, 0, 0, 0), rowsB = make_int4(0, 0, 0, 0); u32x2 dA[5][4], dB[5][4];
    if (t < T) rowsA = *(const int4*)(TOKROW + t * 4);
    if (t + NGW < T) rowsB = *(const int4*)(TOKROW + (t + NGW) * 4);
    if (t < T) issue(t, rowsA, dA);
#pragma unroll 1
    for (; t < T; t += 2 * NGW) {
        const int t1 = t + NGW, t2 = t + 2 * NGW, t3 = t + 3 * NGW;
        if (t2 < T) rowsA = *(const int4*)(TOKROW + t2 * 4);
        if (t1 < T) issue(t1, rowsB, dB);
        finish(t, dA);
        if (t1 >= T) break;
        if (t3 < T) rowsB = *(const int4*)(TOKROW + t3 * 4);
        if (t2 < T) issue(t2, rowsA, dA);
        finish(t1, dB);
    }
}

#endif
__global__ void __launch_bounds__(NTHREADS, 2) mega(Args args) {
    extern __shared__ __attribute__((aligned(16))) unsigned char lds_raw[];
    cg::grid_group grid = cg::this_grid();
    Frame F; F.lds = (LAS unsigned char*)lds_raw; F.tid = threadIdx.x; F.lane = F.tid & 63; F.wave = __builtin_amdgcn_readfirstlane(F.tid >> 6); F.G = gridDim.x; F.bid = blockIdx.x;
    F.in = args.in; F.out = args.out; F.ws = args.ws;
    const int lo = args.ph_lo, hi = args.ph_hi;
    if (F.tid < 2) ((LAS unsigned*)(F.lds + MISC_OFF + 512))[F.tid] = 0u;
    __syncthreads();
    (void)xcd_barrier_post((unsigned*)(args.ws + WS_CTL + 16384) + args.li * XCD_BAR_WORDS, (volatile LAS unsigned*)(F.lds + MISC_OFF + 512));
#ifndef STAG1
#define STAG1 650
#endif
#define IN(k) (lo <= (k) && (k) < hi)
#define FRESH() do { size_t z_ = 0; F.tid = threadIdx.x; asm volatile("" : "+s"(z_), "+v"(F.tid)); F.ws = args.ws + z_; F.lane = F.tid & 63; ws = F.ws; } while (0)
#ifdef PROBE_PHASE
#define TS(k) do { if (blockIdx.x == 0 && threadIdx.x == 0) ((unsigned long long*)(args.ws + WS_CTL + 2048))[k] = __builtin_amdgcn_s_memrealtime(); } while (0)
#else
#define TS(k) do {} while (0)
#endif
#define SEAM(k) do { if (IN(k) && IN((k) + 1)) { if (hi > 1000) grid.sync();   else { XcdBarrier xb_; xb_.bar = (unsigned*)(args.ws + WS_CTL + 16384) + args.li * XCD_BAR_WORDS; xb_.x = xb_xcc_id(); xb_.st = (volatile LAS unsigned*)(F.lds + MISC_OFF + 512); xcd_barrier(xb_); if ((DUPMASK >> 21) & 1) xcd_barrier(xb_); } } } while (0)
    unsigned char* ws = args.ws;
    if (IN(0)) { TS(0); FRESH(); REP(0) phase_prep(F); } SEAM(0);
    if (IN(1)) { TS(1); FRESH();
        pg8::SchedDenseT<1> S; S.bias = args.in[3]; S.O.init(T / 256, NIN / 256, F.G, F.bid); S.A = (const char*)(ws + WS_U); S.B = (const char*)(ws + WS_WIN);
        pg8::EpiIn E{(bf16_t*)(ws + WS_P0), (bf16_t*)(ws + WS_P1), (bf16_t*)(ws + WS_PHY), (bf16_t*)(ws + WS_PG), args.in[3]};
#ifdef DESYNC1
        const int nbefore_ = DESYNC1 == 2 ? (((F.bid >> 3) & 1) ? 0 : 4) : DESYNC1 == 4 ? ((F.bid >> 3) & 3) : DESYNC1 == 3 ? 2 * ((F.bid >> 3) & 1) + 1 : 0;
        if (nbefore_ > 0) { hy::init_tw128(F); hy::filter_pass_a<false>(F, 0, nbefore_); __syncthreads(); }
#endif
        pg8::gemm_phase<pg8::EpiIn, pg8::SchedDenseT<1>, false>(F.lds, S, E); if ((DUPMASK >> 1) & 1) { pg8::gemm_phase<pg8::EpiIn, pg8::SchedDenseT<1>, false>(F.lds, S, E); } if ((DUPMASK >> 13) & 1) { pg8::EpiProbeStore E1{(bf16_t*)(ws + WS_YZ)}; pg8::gemm_phase<pg8::EpiProbeStore, pg8::SchedDenseT<1>, false>(F.lds, S, E1); } if ((DUPMASK >> 12) & 1) { pg8::EpiNone E0; pg8::gemm_phase<pg8::EpiNone, pg8::SchedDenseT<1>, false>(F.lds, S, E0); }
        if ((DUPMASK >> 18) & 1) { pg8::EpiNone E0; pg8::SchedDenseProbe SP; SP.O = S.O; SP.A = S.A; SP.B = S.B; pg8::gemm_phase<pg8::EpiNone, pg8::SchedDenseProbe, false>(F.lds, SP, E0); }
#ifdef DESYNC1
        if (nbefore_ < 4) { __syncthreads(); hy::init_tw128(F); hy::filter_pass_a<false>(F, nbefore_); }
#else
        hy::init_tw128(F); if ((DUPMASK >> 14) & 1) hy::filter_pass_a<true>(F); hy::filter_pass_a<false>(F);
#endif
    } SEAM(1);
#ifdef P2_ALTERNATE
    if (IN(2)) { TS(2); FRESH();
        const bool rev_ = ((F.bid >> 3) & 1) != 0;
        if (!rev_) { lru::stage1(F); __syncthreads(); hy::init_tw128(F); hy::filter_pass_b<false>(F); hy::prepass(F); }
        else { hy::prepass(F); __syncthreads(); FRESH(); hy::init_tw128(F); hy::filter_pass_b<false>(F); __syncthreads(); FRESH(); lru::stage1(F); }
    } SEAM(2);
#else
    if (IN(2)) { TS(2); FRESH(); REP(4) lru::stage1(F); __syncthreads(); hy::init_tw128(F); if ((DUPMASK >> 15) & 1) hy::filter_pass_b<true>(F); hy::filter_pass_b<false>(F); REP(2) hy::prepass(F); } SEAM(2);
#endif
    if (IN(3)) { TS(3); FRESH(); hy::init_tw128(F); REP(3) hy::data_pass_a(F); } SEAM(3);
    if (IN(4)) { TS(4); FRESH(); REP(16) lru::carry(F); hy::init_tw128(F); if ((DUPMASK >> 17) & 1) hy::data_pass_b<true>(F); hy::data_pass_b<false>(F); } SEAM(4);
    if (IN(5)) { TS(5); FRESH(); hy::init_tw128(F); if ((DUPMASK >> 5) & 1) hy::data_pass_c<true>(F); hy::data_pass_c<false>(F); __syncthreads(); REP(6) lru::stage2(F); } SEAM(5);
    if (IN(6)) { TS(6); FRESH();
        pg8::SchedMix S; S.O.init(T / 256, D / 256, F.G, F.bid); S.A0 = (const char*)(ws + WS_YLRU); S.A1 = (const char*)(ws + WS_YHY); S.B0 = (const char*)(ws + WS_WLRU); S.B1 = (const char*)(ws + WS_WHY);
        pg8::EpiMix E{(const bf16_t*)(ws + WS_PG), (bf16_t*)(ws + WS_MIX)};
#ifdef MIXDESYNC
        const int cls_ = (F.bid >> 3) & 3; constexpr int RND_ = MIXDESYNC;
        if (cls_ > 0) { convert_weights<0, false>(F, F.bid, F.G, 0, RND_ * cls_ / 4); __syncthreads(); }
#endif
        pg8::gemm_phase<pg8::EpiMix, pg8::SchedMix, false>(F.lds, S, E); if ((DUPMASK >> 7) & 1) { pg8::gemm_phase<pg8::EpiMix, pg8::SchedMix, false>(F.lds, S, E); }
#ifdef MIXDESYNC
        __syncthreads(); convert_weights<0, false>(F, F.bid, F.G, RND_ * cls_ / 4, RND_);
#endif
    } SEAM(6);
    if (IN(7)) { TS(7); FRESH();
        pg8::SchedDenseT<0> S; S.bias = nullptr; S.O.init(T / 256, D / 256, F.G, F.bid); S.A = (const char*)(ws + WS_MIX); S.B = (const char*)(ws + WS_WOUT);
        pg8::EpiH E{args.in[0], (bf16_t*)(ws + WS_HN)};
        { u32x4* z = (u32x4*)(ws + WS_EROWTOK); const u32x4 z4 = (u32x4){0u, 0u, 0u, 0u};
          for (int i = F.bid * NTHREADS + F.tid; i < 3 * NE * T / 4; i += F.G * NTHREADS) z[i] = z4; }
#ifdef MIXDESYNC
        const int cls_ = (F.bid >> 3) & 3; constexpr int RND_ = MIXDESYNC; const int rrem_ = RND_;
        if (cls_ > 0) { convert_weights<0, false>(F, F.bid, F.G, RND_, RND_ + rrem_ * cls_ / 4); __syncthreads(); }
#endif
        pg8::gemm_phase<pg8::EpiH, pg8::SchedDenseT<0>, false>(F.lds, S, E); if ((DUPMASK >> 8) & 1) { pg8::gemm_phase<pg8::EpiH, pg8::SchedDenseT<0>, false>(F.lds, S, E); }
#ifdef MIXDESYNC
        __syncthreads(); convert_weights<0, false>(F, F.bid, F.G, RND_ + rrem_ * cls_ / 4, 2 * RND_);
#endif
    } SEAM(7);
    if (IN(8)) { TS(8); FRESH(); phase_router_a(F); } SEAM(8);
    if (IN(10)) { TS(10); FRESH();
        const LAS int* pt = build_ptile(F);
        pg8::SchedMoE<8, true> S{args.in[29], (const float*)(ws + WS_EROWRS), pt, F.G, F.bid, (const char*)(ws + WS_HN), (const char*)(ws + WS_WGU), (size_t)2048 * 1024 * 2, (const int*)(ws + WS_EROWTOK)};
        pg8::EpiGU E{args.in[29], (const float*)(ws + WS_ROWRS), (bf16_t*)(ws + WS_ACT)};
#ifdef DESYNC_GU
        { const int rounds_ = (pt[32] * 8 + F.G - 1) / F.G; pg8::Unit u_; if (!S.next(rounds_ - 1, u_)) stagger_delay(1, DESYNC_GU); }
#endif
        pg8::gemm_phase<pg8::EpiGU, pg8::SchedMoE<8, true>, true>(F.lds, S, E); if ((DUPMASK >> 9) & 1) { pg8::gemm_phase<pg8::EpiGU, pg8::SchedMoE<8, true>, true>(F.lds, S, E); }
        if ((DUPMASK >> 19) & 1) { pg8::EpiNone E0; pg8::gemm_phase<pg8::EpiNone, pg8::SchedMoE<8, true>, true>(F.lds, S, E0); }
    } SEAM(10);
    if (IN(11)) { TS(11); FRESH();
        const LAS int* pt = build_ptile(F);
        pg8::SchedMoE<4, false> S{args.in[31], (const float*)(ws + WS_EROWGATE), pt, F.G, F.bid, (const char*)(ws + WS_ACT), (const char*)(ws + WS_WDN), (size_t)1024 * 1024 * 2, nullptr};
        pg8::EpiDN E{args.in[31], (const float*)(ws + WS_ROWGATE), (bf16_t*)(ws + WS_YS)};
#ifdef DESYNC_DN
        { const int rounds_ = (pt[32] * 4 + F.G - 1) / F.G; pg8::Unit u_; if (!S.next(rounds_ - 1, u_)) stagger_delay(1, DESYNC_DN); }
#endif
        pg8::gemm_phase<pg8::EpiDN, pg8::SchedMoE<4, false>, false>(F.lds, S, E); if ((DUPMASK >> 10) & 1) { pg8::gemm_phase<pg8::EpiDN, pg8::SchedMoE<4, false>, false>(F.lds, S, E); }
        if ((DUPMASK >> 20) & 1) { pg8::EpiNone E0; pg8::gemm_phase<pg8::EpiNone, pg8::SchedMoE<4, false>, false>(F.lds, S, E0); }
    } SEAM(11);
    if (IN(12)) { TS(12); FRESH(); phase_final(F); }
#undef IN
#undef SEAM
}
static int g_grid = 0;
static void launch_mega(Args a, int lo, int hi, hipStream_t stream, int li = 0) {
    a.ph_lo = lo; a.ph_hi = hi; a.li = li; a.pad = 0; void* params[] = {&a};
    hipError_t e = hipLaunchCooperativeKernel((const void*)mega, dim3(g_grid), dim3(NTHREADS), params, LDS_BYTES, stream);
    if (e != hipSuccess) fprintf(stderr, "kernel_launch: cooperative launch [%d,%d) failed: %s (grid %d)\n", lo, hi, hipGetErrorString(e), g_grid);
}
extern "C" void kernel_launch(void* const* d_in, const int* in_sizes, int n_in, void* d_out, int out_size, void* d_ws, size_t ws_size, hipStream_t stream) {
    if (n_in != 33 || out_size != T * D || ws_size < WS_END) { fprintf(stderr, "kernel_launch: unexpected shapes n_in %d out %d ws %zu\n", n_in, out_size, ws_size); return; }
    if (g_grid == 0) {
        int dev = 0, cus = 0, per_cu = 0;
        (void)hipGetDevice(&dev); (void)hipDeviceGetAttribute(&cus, hipDeviceAttributeMultiprocessorCount, dev);
        if (hipFuncSetAttribute((const void*)mega, hipFuncAttributeMaxDynamicSharedMemorySize, LDS_BYTES) != hipSuccess) { fprintf(stderr, "kernel_launch: hipFuncSetAttribute failed\n"); g_grid = -1; return; }
        if (hipOccupancyMaxActiveBlocksPerMultiprocessor(&per_cu, (const void*)mega, NTHREADS, LDS_BYTES) != hipSuccess || per_cu < 1) { fprintf(stderr, "kernel_launch: occupancy query says %d\n", per_cu); g_grid = -1; return; }
        g_grid = cus;
    }
    if (g_grid < 0) return;
    const float* in[33]; for (int i = 0; i < 33; ++i) in[i] = (const float*)d_in[i];
    unsigned char* ws = (unsigned char*)d_ws; float* out = (float*)d_out;
    int* cnt = (int*)(ws + WS_CTL); float* NORM = (float*)(ws + WS_NORM); float* HH3 = (float*)(ws + WS_HH3);
    bf16_t* YLRU = (bf16_t*)(ws + WS_YLRU); bf16_t* HN = (bf16_t*)(ws + WS_HN); bf16_t* YHY = (bf16_t*)(ws + WS_YHY);
    bf16_t* PG = (bf16_t*)(ws + WS_PG); bf16_t* P0 = (bf16_t*)(ws + WS_P0); bf16_t* P1 = (bf16_t*)(ws + WS_P1); bf16_t* PHY = (bf16_t*)(ws + WS_PHY);
    bf16_t* MIX = (bf16_t*)(ws + WS_MIX); float* MIXF = (float*)(ws + WS_MIXF); bf16_t* ACT = (bf16_t*)(ws + WS_ACT); bf16_t* YS = (bf16_t*)(ws + WS_YS);
    float* XR = (float*)(ws + WS_XR); float* HF = (float*)(ws + WS_HF); float* KC = (float*)(ws + WS_KC);
    int* ROWTOK = (int*)(ws + WS_ROWTOK); float* ROWGATE = (float*)(ws + WS_ROWGATE); float* ROWRS = (float*)(ws + WS_ROWRS);
    (void)hipMemsetAsync(ws + WS_CTL, 0, CTL_BYTES, stream);
    Args a{}; for (int i = 0; i < 33; ++i) a.in[i] = in[i]; a.out = out; a.ws = ws;
    launch_mega(a, 0, 13, stream);
}
```

```cpp
#define DUPMASK 0x0
#define DESYNC1 4
#define DN_REVERSE 1
#define P2_ALTERNATE 1
#define YS_FP8 1
#define YZ_BF8 1
#define KF_BF8 1
#include <hip/hip_runtime.h>
#include <hip/hip_cooperative_groups.h>
#include <cstdio>
#include <cstdint>
namespace cg = cooperative_groups;

typedef unsigned short bf16_t;
typedef float f32x4 __attribute__((ext_vector_type(4)));
typedef float f32x2 __attribute__((ext_vector_type(2)));
typedef unsigned u32x4 __attribute__((ext_vector_type(4)));
typedef unsigned u32x2 __attribute__((ext_vector_type(2)));
typedef short bf16x8 __attribute__((ext_vector_type(8)));

constexpr int T = 32768, D = 1024, L = 8192, NB = 4, NE = 32, TOPK = 4, NIN = 7168, L2X = 16384;
constexpr int HEADS = 16, HBLK = 64, HYFF = 64, HYEMB = 33;
constexpr int NPAD = T * TOPK + NE * 256;
constexpr float EPS = 1e-5f;

constexpr size_t MiB = 1u << 20;
constexpr size_t WS_CTL = 0;
constexpr size_t CTL_BYTES = 64 * 1024;
constexpr size_t WS_NORM = 4096;
constexpr size_t WS_HH3 = 2 * MiB;
constexpr size_t WS_WRG = 4 * MiB;
constexpr size_t WS_TOPE = 5 * MiB;
constexpr size_t WS_TOPG = 6 * MiB;
constexpr size_t WS_TOKRS = 7 * MiB;
constexpr size_t WS_ROWTOK = 8 * MiB;
constexpr size_t WS_ROWGATE = 9 * MiB;
constexpr size_t WS_ROWRS = 10 * MiB;
constexpr size_t WS_TOKROW = 11 * MiB;
constexpr size_t WS_WF4 = 14 * MiB;
constexpr size_t WS_NORMP = 15 * MiB;
constexpr size_t WS_EROWTOK = 164 * MiB, WS_EROWRS = 168 * MiB, WS_EROWGATE = 172 * MiB;
constexpr size_t WS_WLRUF = 13 * MiB;
constexpr size_t WS_SUMM = 996 * MiB;
constexpr size_t WS_CARRY = 1004 * MiB;
constexpr size_t WS_WIN = 16 * MiB;
constexpr size_t WS_WLRU = 30 * MiB, WS_WHY = 32 * MiB, WS_WOUT = 34 * MiB;
constexpr size_t WS_U = 36 * MiB;
constexpr size_t WS_Z16 = 36 * MiB, WS_HN = 36 * MiB;
constexpr size_t WS_YHY = 100 * MiB;
constexpr size_t WS_PG = 164 * MiB;
constexpr size_t WS_P0 = 292 * MiB;
constexpr size_t WS_P1 = 356 * MiB;
constexpr size_t WS_PHY = 420 * MiB;
constexpr size_t WS_MIX = 356 * MiB;
constexpr size_t WS_HS = 740 * MiB;
constexpr size_t WS_YLRU = 292 * MiB;
constexpr size_t WS_AF = 804 * MiB, WS_AB = 932 * MiB;
constexpr size_t WS_MIXF = 484 * MiB;
constexpr size_t WS_ACT = 292 * MiB;
constexpr size_t WS_R2 = 612 * MiB;
constexpr size_t WS_YZ = 612 * MiB;
constexpr size_t WS_KF = 868 * MiB;
constexpr size_t WS_WDN = 612 * MiB;
constexpr size_t WS_WGU = 676 * MiB;
constexpr size_t WS_YS = 676 * MiB;
constexpr size_t WS_XR = 612 * MiB;
constexpr size_t WS_HF = 740 * MiB;
constexpr size_t WS_KC = 868 * MiB;
constexpr size_t WS_END = 1024 * MiB;

__device__ __forceinline__ float bf2f(bf16_t b) { return __uint_as_float(((unsigned)b) << 16); }
__device__ __forceinline__ bf16_t f2bf(float f) { unsigned u = __float_as_uint(f); u += 0x7fffu + ((u >> 16) & 1u); return (bf16_t)(u >> 16); }
__device__ __forceinline__ unsigned pk2(float lo, float hi) { unsigned r; asm("v_cvt_pk_bf16_f32 %0, %1, %2" : "=v"(r) : "v"(lo), "v"(hi)); return r; }
__device__ __forceinline__ float fexp(float x) { return __builtin_amdgcn_exp2f(x * 1.4426950408889634f); }
__device__ __forceinline__ float sigmoidf_(float x) { return __builtin_amdgcn_rcpf(1.0f + fexp(-x)); }
__device__ __forceinline__ float gelu_tanh(float x) { const float u = 0.7978845608028654f * (x + 0.044715f * x * x * x); return x * sigmoidf_(2.0f * u); }
__device__ __forceinline__ float swiglu(float g, float u) { const float g_ = fminf(g, 7.0f); const float u_ = fminf(fmaxf(u, -7.0f), 7.0f); return (u_ + 1.0f) * (g_ * sigmoidf_(1.702f * g_)); }
__device__ __forceinline__ float wave_sum(float v) {
#pragma unroll
    for (int o = 1; o < 64; o <<= 1) v += __shfl_xor(v, o);
    return v;
}
__device__ __forceinline__ int expert_offpad(const int* cnt, int e) { int o = 0; for (int i = 0; i < e; ++i) o += (cnt[i] + 255) & ~255; return o; }
__device__ __forceinline__ float hy_delta_abs(int c) {
    const float lo = -4.605170185988091f / 1.5f, hi = -4.605170185988091f / 0.3f;
    return fabsf(lo + (hi - lo) * ((float)c / 1023.0f));
}
#define LAS __attribute__((address_space(3)))
constexpr int NWAVES = 8, NTHREADS = 512, LDS_BYTES = 147456, MISC_OFF = 131072;

namespace pg8 {
constexpr int BM = 256, BK = 64, HALF = 128, HTB = HALF * BK * 2, NXCD = 8, WGM = 8, KD = 1024;
__host__ __device__ __forceinline__ int lds_byte(int r, int c) { const int st = (r >> 4) * 2 + (c >> 5), rr = r & 15, cc = c & 31, ob = rr * 64 + cc * 2; return st * 1024 + (ob ^ (((ob >> 9) & 1) << 5)); }
__host__ __device__ __forceinline__ void stage_rc(int b, int& R, int& C) { const int st = b / 1024, sb = b % 1024, swz = sb ^ (((sb >> 9) & 1) << 5); R = (st >> 1) * 16 + swz / 64; C = (st & 1) * 32 + (swz % 64) / 2; }
__host__ __device__ __forceinline__ int perm32(int rho) { const int n = rho >> 4, i = rho & 15; return 8 * (i >> 2) + 4 * n + (i & 3); }

struct Unit { const char* A; const char* B; int pm, pn, e, gm; };

struct DenseOrder {
    int nM, nN, nwg, G, c;
    __device__ __forceinline__ void init(int nM_, int nN_, int G_, int c_) { nM = nM_; nN = nN_; nwg = nM * nN; G = G_; c = c_; }
    __device__ __forceinline__ bool tile(int i, int& pm, int& pn) const {
        const long Lx = (long)i * G + c; if (Lx >= nwg) return false;
        int wgid = (int)Lx; { const int q = nwg / NXCD, r = nwg % NXCD, xcd = wgid % NXCD, off = wgid / NXCD; wgid = (xcd < r ? xcd * (q + 1) : r * (q + 1) + (xcd - r) * q) + off; }
        const int nig = WGM * nN, gid = wgid / nig, fm = gid * WGM, gsz = (nM - fm) < WGM ? (nM - fm) : WGM;
        pm = fm + ((wgid % nig) % gsz); pn = (wgid % nig) / gsz; return true;
    }
};

__device__ __forceinline__ unsigned cvt_pk_bf16(float lo, float hi) { unsigned r; asm volatile("v_cvt_pk_bf16_f32 %0, %1, %2" : "=v"(r) : "v"(lo), "v"(hi)); return r; }

template <class Epi, class Sched, bool GATHER>
__device__ __forceinline__ void gemm_phase(LAS unsigned char* lds, const Sched& S, const Epi& E) {
    int tid_ = threadIdx.x; asm volatile("" : "+v"(tid_));
    const int tid = tid_, wid = __builtin_amdgcn_readfirstlane(tid >> 6), lane = tid & 63, wr = wid >> 2, wc = wid & 3, fr = lane & 15, fq = lane >> 4;
    constexpr int K = KD, nt = K / BK;
    int Rr[2], Cc[2]; unsigned voffB[2];
#pragma unroll
    for (int i = 0; i < 2; ++i) { int R, C; stage_rc(tid * 16 + i * 8192, R, C); Rr[i] = R; Cc[i] = C; const int Rb = (R & ~31) + perm32(R & 31); voffB[i] = (unsigned)(Rb * K + C) * 2u; }
    constexpr size_t kstep = (size_t)(BK * 2);
    constexpr size_t hstep = (size_t)HALF * K * 2;
    const unsigned ldsw = (unsigned)wid * 1024u;
    const int aoff = lds_byte(wr * 64 + fr, fq * 8), boff = lds_byte(wc * 32 + fr, fq * 8);
#define PG8_SA(b, h) (((b) * 2 + (h)) * HTB)
#define PG8_SB(b, h) ((4 + (b) * 2 + (h)) * HTB)
#define PG8_GLDS(gp, lp) __builtin_amdgcn_global_load_lds((const unsigned*)(gp), (LAS unsigned*)(lp), 16, 0, 0)
#define PG8_STAGEB(bufoff, gbase) do { PG8_GLDS((const char*)(gbase) + voffB[0], lds + (bufoff) + ldsw); PG8_GLDS((const char*)(gbase) + voffB[1], lds + (bufoff) + ldsw + 8192); } while (0)
#define PG8_STAGEA(bufoff, gbase, o0, o1) do { PG8_GLDS((const char*)(gbase) + (o0), lds + (bufoff) + ldsw); PG8_GLDS((const char*)(gbase) + (o1), lds + (bufoff) + ldsw + 8192); } while (0)
#define PG8_LDA(dst, b, h) do { _Pragma("unroll") for (int m = 0; m < 4; ++m) _Pragma("unroll") for (int k = 0; k < 2; ++k) dst[m][k] = *(const LAS bf16x8*)(lds + PG8_SA(b, h) + aoff + m * 2048 + k * 1024); } while (0)
#define PG8_LDB(dst, b, h) do { _Pragma("unroll") for (int n = 0; n < 2; ++n) _Pragma("unroll") for (int k = 0; k < 2; ++k) dst[n][k] = *(const LAS bf16x8*)(lds + PG8_SB(b, h) + boff + n * 2048 + k * 1024); } while (0)
#define PG8_MMA(ai, bj, At, Bt) do { __builtin_amdgcn_s_setprio(1); _Pragma("unroll") for (int m = 0; m < 4; ++m) _Pragma("unroll") for (int n = 0; n < 2; ++n) _Pragma("unroll") for (int k = 0; k < 2; ++k) \
        acc[ai][bj][m][n] = __builtin_amdgcn_mfma_f32_16x16x32_bf16(Bt[n][k], At[m][k], acc[ai][bj][m][n], 0, 0, 0); __builtin_amdgcn_s_setprio(0); } while (0)
#define PG8_WAIT_V(n) asm volatile("s_waitcnt vmcnt(" #n ")" ::: "memory")
#define PG8_WAIT_L(n) asm volatile("s_waitcnt lgkmcnt(" #n ")" ::: "memory")
#define PG8_WAIT_V8_UNLESS(flag) asm volatile("s_cmp_lg_u32 %0, 0\n\ts_cbranch_scc1 .Lskipw%=\n\ts_waitcnt vmcnt(8)\n.Lskipw%=:" :: "s"(flag) : "scc", "memory")
#define PG8_BAR __builtin_amdgcn_s_barrier()
#define PG8_SCHED __builtin_amdgcn_sched_barrier(0)
    Unit cur, nxt; int ui = 0;
    if (!S.next(0, cur)) return;
    LAS int* tokbuf = (LAS int*)(lds + MISC_OFF + 3072);
#define PG8_AOFF(par, h, i) (GATHER ? ((unsigned)tokbuf[(par) * 256 + (h) * HALF + Rr[i]] * (unsigned)(K * 2) + (unsigned)(Cc[i] * 2)) : ((unsigned)(Rr[i] * K + Cc[i]) * 2u + (unsigned)((h) * hstep)))
    LAS float* side = (LAS float*)(lds + MISC_OFF + 6144);
    if (GATHER || Sched::NSIDE > 0) {
        if (GATHER && tid < 256) tokbuf[tid] = S.ROWTOK_row(cur, tid);
        if (Sched::NSIDE > 0 && tid < 256 * Sched::NSIDE) side[tid] = *S.side_addr(cur, tid >> 8, tid & 255);
        asm volatile("s_waitcnt vmcnt(0) lgkmcnt(0)" ::: "memory"); __builtin_amdgcn_s_barrier(); }
    f32x4 acc[2][2][4][2];
#pragma unroll
    for (int a = 0; a < 2; ++a)
#pragma unroll
        for (int b = 0; b < 2; ++b)
#pragma unroll
            for (int m = 0; m < 4; ++m)
#pragma unroll
                for (int n = 0; n < 2; ++n) acc[a][b][m][n] = (f32x4){0.f, 0.f, 0.f, 0.f};
    bf16x8 At[4][2], B0[2][2], B1[2][2];
    const char* cA = cur.A; const char* cB = cur.B;
    PG8_STAGEB(PG8_SB(0, 0), cB); PG8_STAGEB(PG8_SB(0, 1), cB + hstep); PG8_STAGEA(PG8_SA(0, 0), cA, PG8_AOFF(0, 0, 0), PG8_AOFF(0, 0, 1)); PG8_STAGEA(PG8_SA(0, 1), cA, PG8_AOFF(0, 1, 0), PG8_AOFF(0, 1, 1));
    if (wr == 1) PG8_BAR;
    PG8_WAIT_V(2); PG8_BAR;
    PG8_STAGEB(PG8_SB(1, 0), cB + kstep); PG8_STAGEA(PG8_SA(1, 0), cA + kstep, PG8_AOFF(0, 0, 0), PG8_AOFF(0, 0, 1)); PG8_STAGEB(PG8_SB(1, 1), cB + hstep + kstep);
    PG8_WAIT_V(6); PG8_BAR;
    for (;;) {
        const bool has_next = S.next(ui + 1, nxt);
        const char* nA = has_next ? nxt.A : cA; const char* nB = has_next ? nxt.B : cB;
        const int pc = ui & 1, pn_ = has_next ? (pc ^ 1) : pc;
        if (Sched::NSIDE > 0 && has_next && wid < 4 * Sched::NSIDE) __builtin_amdgcn_global_load_lds((const unsigned*)S.side_addr(nxt, wid >> 2, (wid & 3) * 64 + lane), (LAS unsigned*)(side + ((ui + 1) % 3) * 512 + wid * 64), 4, 0, 0);
        if (GATHER && has_next && wid < 4) __builtin_amdgcn_global_load_lds((const unsigned*)(S.ROWTOK + S.rowoff(nxt) + wid * 64 + lane), (LAS unsigned*)(tokbuf + pn_ * 256 + wid * 64), 4, 0, 0);
        for (int t = 0; t < nt; t += 2) {
            const bool last = (t == nt - 2);
            const char* a1 = cA + (size_t)(t + 1) * kstep;
            const char* a2 = last ? nA : cA + (size_t)(t + 2) * kstep; const char* b2 = last ? nB : cB + (size_t)(t + 2) * kstep;
            const char* a3 = a2 + kstep; const char* b3 = b2 + kstep;
            const int px = last ? pn_ : pc;
            PG8_LDB(B0, 0, 0); PG8_LDB(B1, 0, 1); PG8_SCHED; PG8_LDA(At, 0, 0); PG8_STAGEA(PG8_SA(1, 1), a1, PG8_AOFF(pc, 1, 0), PG8_AOFF(pc, 1, 1));
            PG8_WAIT_V(8); PG8_WAIT_L(0); PG8_BAR; PG8_MMA(0, 0, At, B0); PG8_MMA(0, 1, At, B1); PG8_BAR; PG8_SCHED;
            PG8_LDA(At, 0, 1); PG8_STAGEB(PG8_SB(0, 0), b2); PG8_STAGEB(PG8_SB(0, 1), b2 + hstep); PG8_STAGEA(PG8_SA(0, 0), a2, PG8_AOFF(px, 0, 0), PG8_AOFF(px, 0, 1));
            PG8_WAIT_V(8); PG8_WAIT_L(0); PG8_BAR; PG8_MMA(1, 0, At, B0); PG8_MMA(1, 1, At, B1); PG8_BAR; PG8_SCHED;
            PG8_LDB(B0, 1, 0); PG8_LDB(B1, 1, 1); PG8_SCHED; PG8_LDA(At, 1, 0); PG8_STAGEA(PG8_SA(0, 1), a2, PG8_AOFF(px, 1, 0), PG8_AOFF(px, 1, 1));
            PG8_WAIT_V(8); PG8_WAIT_L(0); PG8_BAR; PG8_MMA(0, 0, At, B0); PG8_MMA(0, 1, At, B1); PG8_BAR; PG8_SCHED;
            PG8_LDA(At, 1, 1); PG8_STAGEB(PG8_SB(1, 0), b3); PG8_STAGEB(PG8_SB(1, 1), b3 + hstep); PG8_STAGEA(PG8_SA(1, 0), a3, PG8_AOFF(px, 0, 0), PG8_AOFF(px, 0, 1));
            PG8_WAIT_V(8); PG8_WAIT_L(0); PG8_BAR; PG8_MMA(1, 0, At, B0); PG8_MMA(1, 1, At, B1); PG8_BAR; PG8_SCHED;
        }
        if (wr == 0) PG8_BAR;
        bool keep = false;
        if constexpr (Epi::CHAIN) keep = E(acc, cur, wr, wc, fr, fq, (const LAS float*)(side + (ui % 3) * 512)); else E(acc, cur, wr, wc, fr, fq, (const LAS float*)(side + (ui % 3) * 512));
        if (!has_next) break;
        if (!keep) {
#pragma unroll
        for (int a = 0; a < 2; ++a)
#pragma unroll
            for (int b = 0; b < 2; ++b)
#pragma unroll
                for (int m = 0; m < 4; ++m)
#pragma unroll
                    for (int n = 0; n < 2; ++n) acc[a][b][m][n] = (f32x4){0.f, 0.f, 0.f, 0.f};
        }
        cur = nxt; cA = nA; cB = nB; ++ui;
        if (wr == 1) PG8_BAR;
    }
    PG8_WAIT_V(0);
    PG8_BAR;
#undef PG8_SA
#undef PG8_AOFF
#undef PG8_SB
#undef PG8_GLDS
#undef PG8_STAGEA
#undef PG8_STAGEB
#undef PG8_LDA
#undef PG8_LDB
#undef PG8_MMA
#undef PG8_WAIT_V
#undef PG8_WAIT_L
#undef PG8_WAIT_V8_UNLESS
#undef PG8_BAR
#undef PG8_SCHED
}

__device__ __forceinline__ void store8bf(bf16_t* p, const f32x4 v0, const f32x4 v1) {
    u32x4 w; w.x = cvt_pk_bf16(v0[0], v0[1]); w.y = cvt_pk_bf16(v0[2], v0[3]); w.z = cvt_pk_bf16(v1[0], v1[1]); w.w = cvt_pk_bf16(v1[2], v1[3]); *(u32x4*)p = w;
}
__device__ __forceinline__ void load8bf(const bf16_t* p, f32x4& v0, f32x4& v1) {
    const u32x4 w = *(const u32x4*)p;
    v0 = (f32x4){__uint_as_float(w.x << 16), __uint_as_float(w.x & 0xffff0000u), __uint_as_float(w.y << 16), __uint_as_float(w.y & 0xffff0000u)};
    v1 = (f32x4){__uint_as_float(w.z << 16), __uint_as_float(w.z & 0xffff0000u), __uint_as_float(w.w << 16), __uint_as_float(w.w & 0xffff0000u)};
}
__device__ __forceinline__ f32x2 lo2(const f32x4 v) { return (f32x2){v.x, v.y}; }
__device__ __forceinline__ f32x2 hi2(const f32x4 v) { return (f32x2){v.z, v.w}; }
__device__ __forceinline__ f32x2 sigmoid2(const f32x2 x) { const f32x2 t = x * -1.4426950408889634f; const f32x2 d = (f32x2){__builtin_amdgcn_exp2f(t.x), __builtin_amdgcn_exp2f(t.y)} + 1.0f; return (f32x2){__builtin_amdgcn_rcpf(d.x), __builtin_amdgcn_rcpf(d.y)}; }
__device__ __forceinline__ f32x2 swiglu2(const f32x2 g, const f32x2 u) {
    const f32x2 g_ = (f32x2){fminf(g.x, 7.0f), fminf(g.y, 7.0f)}; const f32x2 u_ = (f32x2){fminf(fmaxf(u.x, -7.0f), 7.0f), fminf(fmaxf(u.y, -7.0f), 7.0f)};
    const f32x2 t = g_ * (-1.702f * 1.4426950408889634f); const f32x2 d = (f32x2){__builtin_amdgcn_exp2f(t.x), __builtin_amdgcn_exp2f(t.y)} + 1.0f;
    const f32x2 p = g_ * (f32x2){__builtin_amdgcn_rcpf(d.x), __builtin_amdgcn_rcpf(d.y)}; return u_ * p + p; }
__device__ __forceinline__ void store8bf2(bf16_t* p, const f32x2 a, const f32x2 b, const f32x2 c, const f32x2 d) {
    u32x4 w; w.x = cvt_pk_bf16(a.x, a.y); w.y = cvt_pk_bf16(b.x, b.y); w.z = cvt_pk_bf16(c.x, c.y); w.w = cvt_pk_bf16(d.x, d.y); *(u32x4*)p = w; }
#define EPI_ROWS(ai, m) ((ai) * HALF + wr * 64 + (m) * 16 + fr)
#define EPI_COLS(bj) ((bj) * HALF + wc * 32 + 8 * fq)

struct EpiNone {
    static constexpr bool CHAIN = false;
    __device__ __forceinline__ void operator()(const f32x4 (&acc)[2][2][4][2], const Unit&, int, int, int, int, const LAS float*) const {
#pragma unroll
        for (int a = 0; a < 2; ++a)
#pragma unroll
            for (int b = 0; b < 2; ++b)
#pragma unroll
                for (int m = 0; m < 4; ++m)
#pragma unroll
                    for (int n = 0; n < 2; ++n) asm volatile("" :: "v"(acc[a][b][m][n]));
    }
};
struct EpiProbeStore {
    static constexpr bool CHAIN = false;
    bf16_t* dst;
    __device__ __forceinline__ void operator()(const f32x4 (&acc)[2][2][4][2], const Unit& u, int wr, int wc, int fr, int fq, const LAS float* side) const {
#pragma unroll
        for (int ai = 0; ai < 2; ++ai)
#pragma unroll
            for (int m = 0; m < 4; ++m) {
#if defined(PROBE_LOCAL)
                bf16_t* rowp = dst + (size_t)(blockIdx.x * 256 + EPI_ROWS(ai, m)) * 256;
#elif defined(PROBE_MIXED)
                bf16_t* rowp = (blockIdx.x & 3) ? dst + (size_t)(blockIdx.x * 256 + EPI_ROWS(ai, m)) * 256 : dst + (size_t)(u.pm * BM + EPI_ROWS(ai, m)) * 4096 + (u.pn & 15) * 256;
#elif defined(PROBE_WIDE)
                bf16_t* rowp = dst + (size_t)(u.pm * BM + EPI_ROWS(ai, m)) * 4096 + (u.pn & 15) * 256;
#else
                bf16_t* rowp = dst + (size_t)(u.pm * BM + EPI_ROWS(ai, m)) * 1024 + (u.pn & 3) * 256;
#endif
#pragma unroll
                for (int bj = 0; bj < 2; ++bj) store8bf(rowp + EPI_COLS(bj), acc[ai][bj][m][0], acc[ai][bj][m][1]); }
    }
};
struct EpiIn {
    static constexpr bool CHAIN = false;
    bf16_t *P0, *P1, *PHY, *PG; const float* bias;
    __device__ __forceinline__ void operator()(const f32x4 (&acc)[2][2][4][2], const Unit& u, int wr, int wc, int fr, int fq, const LAS float* side) const {
        const int seg = u.pn >> 2; bf16_t* dst; int ld, colt; int act = 0;
        if (seg == 0) { dst = P0; ld = 1024; colt = u.pn * 256; }
        else if (seg == 1) { dst = P1; ld = 1024; colt = u.pn * 256 - 1024; }
        else if (seg < 5) { dst = PHY; ld = 3072; colt = u.pn * 256 - 2048; }
        else { dst = PG; ld = 2048; colt = (u.pn - 20) * 128; act = 2; }
        f32x4 bv[2][2];
#pragma unroll
        for (int bj = 0; bj < 2; ++bj)
#pragma unroll
            for (int n = 0; n < 2; ++n) bv[bj][n] = *(const LAS f32x4*)(side + EPI_COLS(bj) + 4 * n);
        if (act == 2) {
#pragma unroll
            for (int ai = 0; ai < 2; ++ai)
#pragma unroll
                for (int m = 0; m < 4; ++m) { bf16_t* rowp = dst + (size_t)(u.pm * BM + EPI_ROWS(ai, m)) * ld + colt + wc * 32 + 8 * fq;
                    f32x2 rho[4], sh[4];
#pragma unroll
                    for (int n = 0; n < 2; ++n)
#pragma unroll
                        for (int hh = 0; hh < 2; ++hh) {
                            const f32x2 al = (hh ? hi2(acc[ai][0][m][n]) : lo2(acc[ai][0][m][n])) + (hh ? hi2(bv[0][n]) : lo2(bv[0][n]));
                            f32x2 ah = (hh ? hi2(acc[ai][1][m][n]) : lo2(acc[ai][1][m][n])) + (hh ? hi2(bv[1][n]) : lo2(bv[1][n]));
                            ah = (f32x2){fmaxf(ah.x, -80.0f), fmaxf(ah.y, -80.0f)};
                            const f32x2 tl = al * -1.4426950408889634f, th = ah * -1.4426950408889634f;
                            const f32x2 dl = (f32x2){__builtin_amdgcn_exp2f(tl.x), __builtin_amdgcn_exp2f(tl.y)} + 1.0f, dh = (f32x2){__builtin_amdgcn_exp2f(th.x), __builtin_amdgcn_exp2f(th.y)} + 1.0f;
                            sh[2 * n + hh] = (f32x2){__builtin_amdgcn_rcpf(dh.x), __builtin_amdgcn_rcpf(dh.y)};
                            rho[2 * n + hh] = dh * (f32x2){__builtin_amdgcn_rcpf(dl.x), __builtin_amdgcn_rcpf(dl.y)}; }
                    store8bf2(rowp, rho[0], rho[1], rho[2], rho[3]); store8bf2(rowp + 1024, sh[0], sh[1], sh[2], sh[3]); }
            return;
        }
#pragma unroll
        for (int ai = 0; ai < 2; ++ai)
#pragma unroll
            for (int m = 0; m < 4; ++m) { bf16_t* rowp = dst + (size_t)(u.pm * BM + EPI_ROWS(ai, m)) * ld + colt;
#pragma unroll
                for (int bj = 0; bj < 2; ++bj) { f32x2 a = lo2(acc[ai][bj][m][0]) + lo2(bv[bj][0]), b = hi2(acc[ai][bj][m][0]) + hi2(bv[bj][0]), c = lo2(acc[ai][bj][m][1]) + lo2(bv[bj][1]), d = hi2(acc[ai][bj][m][1]) + hi2(bv[bj][1]);
                    store8bf2(rowp + EPI_COLS(bj), a, b, c, d); } }
    }
};
struct EpiMix {
    static constexpr bool CHAIN = true;
    const bf16_t* PG; bf16_t* MIX;
    __device__ __forceinline__ bool operator()(f32x4 (&acc)[2][2][4][2], const Unit& u, int wr, int wc, int fr, int fq, const LAS float*) const {
#pragma unroll
        for (int ai = 0; ai < 2; ++ai)
#pragma unroll
            for (int m = 0; m < 4; ++m) { const size_t row = (size_t)(u.pm * BM + EPI_ROWS(ai, m));
#pragma unroll
                for (int bj = 0; bj < 2; ++bj) { const int col = u.pn * 256 + EPI_COLS(bj);
                    f32x4 h0, h1; load8bf(PG + row * 2048 + (u.e == 0 ? 0 : 1024) + col, h0, h1);
                    if (u.e == 0) { acc[ai][bj][m][0] *= h0; acc[ai][bj][m][1] *= h1; }
                    else store8bf(MIX + row * 1024 + col, h0 * acc[ai][bj][m][0], h1 * acc[ai][bj][m][1]); } }
        return u.e == 0;
    }
};
struct EpiH {
    static constexpr bool CHAIN = false;
    const float* x; bf16_t* HB;
    __device__ __forceinline__ void operator()(const f32x4 (&acc)[2][2][4][2], const Unit& u, int wr, int wc, int fr, int fq, const LAS float* side) const {
#pragma unroll
        for (int ai = 0; ai < 2; ++ai)
#pragma unroll
            for (int m = 0; m < 4; ++m) { const size_t row = (size_t)(u.pm * BM + EPI_ROWS(ai, m));
#pragma unroll
                for (int bj = 0; bj < 2; ++bj) { const size_t o = row * 1024 + u.pn * 256 + EPI_COLS(bj);
                    const f32x4 v0 = *(const f32x4*)(x + o) + acc[ai][bj][m][0], v1 = *(const f32x4*)(x + o + 4) + acc[ai][bj][m][1];
                    store8bf(HB + o, v0, v1); } }
    }
};
struct EpiGU {
    static constexpr bool CHAIN = false;
    const float* bgu; const float* ROWRS; bf16_t* ACT;
    __device__ __forceinline__ void operator()(const f32x4 (&acc)[2][2][4][2], const Unit& u, int wr, int wc, int fr, int fq, const LAS float* side) const {
        const int colp = u.pn * 128 + wc * 32 + 8 * fq;
        f32x4 bg[2], bu[2];
#pragma unroll
        for (int n = 0; n < 2; ++n) { bg[n] = *(const LAS f32x4*)(side + wc * 32 + 8 * fq + 4 * n); bu[n] = *(const LAS f32x4*)(side + 128 + wc * 32 + 8 * fq + 4 * n); }
#pragma unroll
        for (int ai = 0; ai < 2; ++ai)
#pragma unroll
            for (int m = 0; m < 4; ++m) { const size_t row = (size_t)u.gm * BM + EPI_ROWS(ai, m); const float rs = side[256 + EPI_ROWS(ai, m)];
                f32x2 o[4];
#pragma unroll
                for (int n = 0; n < 2; ++n) {
                    o[2 * n] = swiglu2(lo2(acc[ai][0][m][n]) * rs + lo2(bg[n]), lo2(acc[ai][1][m][n]) * rs + lo2(bu[n]));
                    o[2 * n + 1] = swiglu2(hi2(acc[ai][0][m][n]) * rs + hi2(bg[n]), hi2(acc[ai][1][m][n]) * rs + hi2(bu[n])); }
                store8bf2(ACT + row * 1024 + colp, o[0], o[1], o[2], o[3]); }
    }
};
struct EpiDN {
    static constexpr bool CHAIN = false;
    const float* bdn; const float* ROWGATE; bf16_t* YS;
    __device__ __forceinline__ void operator()(const f32x4 (&acc)[2][2][4][2], const Unit& u, int wr, int wc, int fr, int fq, const LAS float* side) const {
        f32x4 bv[2][2];
#pragma unroll
        for (int bj = 0; bj < 2; ++bj)
#pragma unroll
            for (int n = 0; n < 2; ++n) bv[bj][n] = *(const LAS f32x4*)(side + EPI_COLS(bj) + 4 * n);
#pragma unroll
        for (int ai = 0; ai < 2; ++ai)
#pragma unroll
            for (int m = 0; m < 4; ++m) { const size_t row = (size_t)u.gm * BM + EPI_ROWS(ai, m); const float gt = side[256 + EPI_ROWS(ai, m)];
#pragma unroll
                for (int bj = 0; bj < 2; ++bj) {
                    const f32x2 a = (lo2(acc[ai][bj][m][0]) + lo2(bv[bj][0])) * gt, b = (hi2(acc[ai][bj][m][0]) + hi2(bv[bj][0])) * gt, c = (lo2(acc[ai][bj][m][1]) + lo2(bv[bj][1])) * gt, d = (hi2(acc[ai][bj][m][1]) + hi2(bv[bj][1])) * gt;
#ifdef YS_FP8
                    int w0 = __builtin_amdgcn_cvt_pk_fp8_f32(a.x, a.y, 0, false); w0 = __builtin_amdgcn_cvt_pk_fp8_f32(b.x, b.y, w0, true);
                    int w1 = __builtin_amdgcn_cvt_pk_fp8_f32(c.x, c.y, 0, false); w1 = __builtin_amdgcn_cvt_pk_fp8_f32(d.x, d.y, w1, true);
                    *(u32x2*)((unsigned char*)YS + row * 1024 + u.pn * 256 + EPI_COLS(bj)) = (u32x2){(unsigned)w0, (unsigned)w1};
#else
                    store8bf2(YS + row * 1024 + u.pn * 256 + EPI_COLS(bj), a, b, c, d);
#endif
                } }
    }
};

template <int NS> struct SchedDenseT {
    static constexpr int NSIDE = NS; const float* bias;
    __device__ __forceinline__ const float* side_addr(const Unit& u, int, int idx) const {
        const int p = u.pn - 20; return p < 0 ? bias + u.pn * 256 + idx : bias + (idx < 128 ? 5120 + 128 * p + idx : 6144 + 128 * p + (idx - 128)); }
    DenseOrder O; const char* A; const char* B;
    __device__ __forceinline__ bool next(int i, Unit& u) const { int pm, pn; if (!O.tile(i, pm, pn)) return false; u.pm = pm; u.pn = pn; u.e = 0; u.gm = pm;
        u.A = A + (size_t)pm * (BM * KD * 2); u.B = B + (size_t)pn * (BM * KD * 2); return true; }
    static constexpr const unsigned* ROWTOK = nullptr; __device__ __forceinline__ int ROWTOK_row(const Unit&, int) const { return 0; } __device__ __forceinline__ size_t rowoff(const Unit&) const { return 0; }
};
struct SchedDenseProbe {
    static constexpr int NSIDE = 0; __device__ __forceinline__ const float* side_addr(const Unit&, int, int) const { return nullptr; }
    DenseOrder O; const char* A; const char* B;
    __device__ __forceinline__ bool next(int i, Unit& u) const { int pm, pn; if (!O.tile(i, pm, pn)) return false; u.pm = pm; u.pn = pn; u.e = 0; u.gm = pm;
        u.A = A + (size_t)(pm & 1) * (BM * KD * 2); u.B = B + (size_t)(pn & 1) * (BM * KD * 2); return true; }
    static constexpr const unsigned* ROWTOK = nullptr; __device__ __forceinline__ int ROWTOK_row(const Unit&, int) const { return 0; } __device__ __forceinline__ size_t rowoff(const Unit&) const { return 0; }
};
struct SchedMix {
    static constexpr int NSIDE = 0; __device__ __forceinline__ const float* side_addr(const Unit&, int, int) const { return nullptr; }
    DenseOrder O; const char* A0; const char* A1; const char* B0; const char* B1;
    __device__ __forceinline__ bool next(int i, Unit& u) const { int pm, pn; if (!O.tile(i >> 1, pm, pn)) return false; const int w = i & 1; u.pm = pm; u.pn = pn; u.e = w; u.gm = pm;
        u.A = (w ? A1 : A0) + (size_t)pm * (BM * KD * 2); u.B = (w ? B1 : B0) + (size_t)pn * (BM * KD * 2); return true; }
    static constexpr const unsigned* ROWTOK = nullptr; __device__ __forceinline__ int ROWTOK_row(const Unit&, int) const { return 0; } __device__ __forceinline__ size_t rowoff(const Unit&) const { return 0; }
};
template <int NT, bool GATHER> struct SchedMoE {
    static constexpr int NSIDE = 2; const float* sbias; const float* srow;
    __device__ __forceinline__ const float* side_addr(const Unit& u, int k, int idx) const {
        if (k == 1) return srow + (size_t)u.e * T + u.pm + idx;
        return NT == 8 ? sbias + u.e * 2048 + (idx < 128 ? 128 * u.pn + idx : 1024 + 128 * u.pn + idx - 128) : sbias + u.e * 1024 + 256 * u.pn + idx; }
    const LAS int* ptile; int G, c; const char* A; const char* B; size_t bstride  ; const int* ROWTOK;
    __device__ __forceinline__ bool next(int i, Unit& u) const {
        const int ngm = __builtin_amdgcn_readfirstlane(ptile[32]);
        int gm, pn;
        if (G == 256) {
            const int x = c & 7, y = c >> 3; gm = i * (256 / NT) + x * (32 / NT) + y / NT; pn = y % NT;
#ifdef LAST_SPREAD
            if ((i + 1) * (256 / NT) > ngm) gm = i * (256 / NT) + (y / NT) * 8 + x;
#endif
            if (gm >= ngm) return false;
#ifdef DN_REVERSE
            if (NT == 4) gm = ngm - 1 - gm;
#endif
        } else { const long Lx = (long)i * G + c; if (Lx >= (long)ngm * NT) return false; gm = (int)(Lx / NT); pn = (int)(Lx % NT); }
        int e = 0;
#pragma unroll 1
        for (int q = 1; q < 32; ++q) e += (__builtin_amdgcn_readfirstlane(ptile[q]) <= gm) ? 1 : 0;
        u.pm = (gm - __builtin_amdgcn_readfirstlane(ptile[e])) * BM; u.gm = gm; u.pn = pn; u.e = e;
        u.A = GATHER ? A : A + (size_t)gm * (BM * KD * 2); u.B = B + (size_t)e * bstride + (size_t)pn * (BM * KD * 2); return true; }
    __device__ __forceinline__ int ROWTOK_row(const Unit& u, int r) const { return GATHER ? ROWTOK[(size_t)u.e * T + u.pm + r] : 0; }
    __device__ __forceinline__ size_t rowoff(const Unit& u) const { return (size_t)u.e * T + u.pm; }
};
}
struct Args { const float* in[33]; float* out; unsigned char* ws; int ph_lo, ph_hi, li, pad; };
#define LDS_WAIT() asm volatile("s_waitcnt lgkmcnt(0)" ::: "memory")

struct Frame {
    LAS unsigned char* lds; int tid, lane, wave, G, bid; const float* const* in; float* out; unsigned char* ws;
};

#ifndef DUPMASK
#define DUPMASK 0
#endif
#define REP(bit) for (int rep_ = 0; rep_ < (((DUPMASK >> (bit)) & 1) ? 2 : 1); ++rep_)

#define XB_TMO      128
#define XB_XCNT(j)  (256  + 64 * (j))
#define XB_XSUB(j)  (1280 + 64 * (j))
#define XB_XGEN(j)  (2304 + 64 * (j))
#define XB_TOP      3328
#define XB_TOPGEN   3392
#define XCD_BAR_WORDS 3456
#define XB_SPIN_CAP (1u << 18)

__device__ __forceinline__ unsigned xb_ld(unsigned* p)              { return __hip_atomic_load(p, __ATOMIC_RELAXED, __HIP_MEMORY_SCOPE_AGENT); }
__device__ __forceinline__ unsigned xb_add(unsigned* p, unsigned v) { return __hip_atomic_fetch_add(p, v, __ATOMIC_RELAXED, __HIP_MEMORY_SCOPE_AGENT); }
__device__ __forceinline__ unsigned xb_xcc_id() { return (unsigned)__builtin_amdgcn_s_getreg((3 << 11) | 20) & 0xFu; }
#define XB_SPIN(cond, bar) do { unsigned _sp = 0; while (cond) { __builtin_amdgcn_s_sleep(1); \
    if ((++_sp & 255u) == 0u) { if (xb_ld(&(bar)[XB_TMO])) break; if (_sp > XB_SPIN_CAP) { atomicAdd(&(bar)[XB_TMO], 1u); break; } } } } while (0)

struct XcdBarrier {
    unsigned* bar; unsigned x;
    volatile LAS unsigned* st;
};

__device__ __forceinline__ XcdBarrier xcd_barrier_post(unsigned* bar, volatile LAS unsigned* st) {
    XcdBarrier b; b.bar = bar; b.x = xb_xcc_id(); b.st = st;
    if (threadIdx.x == 0) (void)xb_add(&bar[XB_XCNT(b.x)], 1u);
    return b;
}
__device__ __forceinline__ void xcd_barrier_complete(unsigned* bar, unsigned x, unsigned& nloc, unsigned& nx) {
    const unsigned G = gridDim.x * gridDim.y * gridDim.z;
    unsigned sum, cnt, mine, sp = 0u;
    for (;;) {
        sum = 0u; cnt = 0u; mine = 0u;
#pragma unroll
        for (unsigned j = 0; j < 16; ++j) { const unsigned c = xb_ld(&bar[XB_XCNT(j)]); sum += c; cnt += (c > 0u) ? 1u : 0u; mine = (j == x) ? c : mine; }
        if (sum == G) break;
        __builtin_amdgcn_s_sleep(1);
        if ((++sp & 255u) == 0u) { if (xb_ld(&bar[XB_TMO])) break; if (sp > XB_SPIN_CAP) { atomicAdd(&bar[XB_TMO], 1u); break; } }
    }
    nloc = mine > 0u ? mine : 1u; nx = cnt > 0u ? cnt : 1u;
}

__device__ __forceinline__ void xcd_barrier(const XcdBarrier& b) {
    asm volatile("s_waitcnt vmcnt(0)" ::: "memory");
    __syncthreads();
    if (threadIdx.x == 0) {
        unsigned* bar = b.bar;
        __builtin_amdgcn_s_waitcnt(0);
        unsigned nloc = b.st[0], nx = b.st[1];
        if (nloc == 0u) { xcd_barrier_complete(bar, b.x, nloc, nx); b.st[0] = nloc; b.st[1] = nx; }
        const unsigned old = xb_add(&bar[XB_XSUB(b.x)], 1u);
        const unsigned gen = old / nloc;
        if (old + 1u == (gen + 1u) * nloc) {
            __builtin_amdgcn_fence(__ATOMIC_RELEASE, "agent");
            asm volatile("s_waitcnt vmcnt(0)" ::: "memory");
            const unsigned og = xb_add(&bar[XB_TOP], 1u);
            const unsigned tg = og / nx;
            if (og + 1u == (tg + 1u) * nx) xb_add(&bar[XB_TOPGEN], 1u);
            else XB_SPIN(xb_ld(&bar[XB_TOPGEN]) == tg, bar);
            __builtin_amdgcn_fence(__ATOMIC_ACQUIRE, "agent");
            xb_add(&bar[XB_XGEN(b.x)], 1u);
            asm volatile("s_waitcnt vmcnt(0)" ::: "memory");
        } else {
            XB_SPIN(xb_ld(&bar[XB_XGEN(b.x)]) == gen, bar);
            __builtin_amdgcn_fence(__ATOMIC_ACQUIRE, "agent");
            asm volatile("s_waitcnt vmcnt(0)" ::: "memory");
        }
    }
    __syncthreads();
}


__device__ __forceinline__ void stagger_delay(int cls, int ticks_per_class) {
    if (cls > 0) { const unsigned long long t0 = __builtin_amdgcn_s_memrealtime(); const unsigned long long want = (unsigned long long)(cls * ticks_per_class);
        while (__builtin_amdgcn_s_memrealtime() - t0 < want) __builtin_amdgcn_s_sleep(32); }
}
namespace hy {
constexpr int TW128_OFF = MISC_OFF + 1024, TWT_OFF = MISC_OFF + 2048;

__host__ __device__ constexpr float twc16(int m) { return m == 0 ? 1.f : m == 1 ? 0.92387953251128674f : m == 2 ? 0.70710678118654752f : m == 3 ? 0.38268343236508977f : m == 4 ? 0.f : m == 5 ? -0.38268343236508977f : m == 6 ? -0.70710678118654752f : -0.92387953251128674f; }
__host__ __device__ constexpr float tws16(int m) { return m == 0 ? 0.f : m == 1 ? 0.38268343236508977f : m == 2 ? 0.70710678118654752f : m == 3 ? 0.92387953251128674f : m == 4 ? 1.f : m == 5 ? 0.92387953251128674f : m == 6 ? 0.70710678118654752f : 0.38268343236508977f; }
template <int N> __host__ __device__ constexpr int brev(int i) { int r = 0; for (int b = 1, c = N >> 1; b < N; b <<= 1, c >>= 1) if (i & b) r |= c; return r; }

typedef f32x2 P2;
template <int N, bool INV> __device__ __forceinline__ void fft_reg(P2 (&xr)[N], P2 (&xi)[N]) {
#pragma unroll
    for (int len = N; len >= 2; len >>= 1) {
        const int half = len >> 1;
#pragma unroll
        for (int start = 0; start < N; start += len) {
#pragma unroll
            for (int j = 0; j < half; ++j) {
                const int i0 = start + j, i1 = i0 + half;
                const P2 ar = xr[i0], ai = xi[i0], br = xr[i1], bi = xi[i1];
                xr[i0] = ar + br; xi[i0] = ai + bi;
                const P2 tr = ar - br, ti = ai - bi;
                const int m = j * (16 / len);
                if (m == 0) { xr[i1] = tr; xi[i1] = ti; }
                else if (m == 4) { if (INV) { xr[i1] = -ti; xi[i1] = tr; } else { xr[i1] = ti; xi[i1] = -tr; } }
                else { const float c = twc16(m), s = INV ? tws16(m) : -tws16(m); xr[i1] = tr * c - ti * s; xi[i1] = tr * s + ti * c; }
            }
        }
    }
}
__device__ __forceinline__ unsigned pkh(float a, float b) { return __builtin_bit_cast(unsigned, __builtin_amdgcn_cvt_pkrtz(a, b)); }
__device__ __forceinline__ u32x2 pkc(const P2 re, const P2 im) { u32x2 r; r.x = pkh(re.x, re.y); r.y = pkh(im.x, im.y); return r; }
__device__ __forceinline__ float h2f_lo(unsigned u) { return (float)__builtin_bit_cast(_Float16, (unsigned short)(u & 0xffffu)); }
__device__ __forceinline__ float h2f_hi(unsigned u) { return (float)__builtin_bit_cast(_Float16, (unsigned short)(u >> 16)); }
__device__ __forceinline__ P2 unpk2(unsigned u) { return (P2){h2f_lo(u), h2f_hi(u)}; }
#ifdef YZ_BF8
typedef unsigned yz_t;
__device__ __forceinline__ yz_t pkyz(const P2 re, const P2 im) { int v = __builtin_amdgcn_cvt_pk_bf8_f32(re.x, re.y, 0, false); v = __builtin_amdgcn_cvt_pk_bf8_f32(im.x, im.y, v, true); return (unsigned)v; }
__device__ __forceinline__ P2 yzre(const yz_t u) { return __builtin_amdgcn_cvt_pk_f32_bf8((int)u, false); }
__device__ __forceinline__ P2 yzim(const yz_t u) { return __builtin_amdgcn_cvt_pk_f32_bf8((int)u, true); }
#ifdef KF_BF8
constexpr float KF_SCALE = 64.0f, YZ_ZSCALE = 1.0f / 1024.0f;
#else
constexpr float KF_SCALE = 1.0f, YZ_ZSCALE = 1.0f / 16.0f;
#endif
#else
typedef u32x2 yz_t;
__device__ __forceinline__ yz_t pkyz(const P2 re, const P2 im) { return pkc(re, im); }
__device__ __forceinline__ P2 yzre(const yz_t u) { return unpk2(u.x); }
__device__ __forceinline__ P2 yzim(const yz_t u) { return unpk2(u.y); }
constexpr float YZ_ZSCALE = 1.0f, KF_SCALE = 1.0f;
#endif
#ifdef KF_BF8
typedef yz_t kf_t;
#define KF_PK(re, im) pkyz(re, im)
#define KF_RE(u) yzre(u)
#define KF_IM(u) yzim(u)
#else
typedef u32x2 kf_t;
#define KF_PK(re, im) pkc(re, im)
#define KF_RE(u) unpk2((u).x)
#define KF_IM(u) unpk2((u).y)
#endif
__device__ __forceinline__ P2 bf2p(unsigned u) { return (P2){__uint_as_float(u << 16), __uint_as_float(u & 0xffff0000u)}; }
__device__ __forceinline__ void cmul(P2& xr, P2& xi, float c, float s) { const P2 r = xr * c - xi * s, i = xr * s + xi * c; xr = r; xi = i; }

__device__ __forceinline__ void init_tw128(Frame& F) {
    __syncthreads();
    if (F.tid < 128) { float s, c; sincospif((float)F.tid * (1.0f / 64.0f), &s, &c); ((LAS f32x2*)(F.lds + TW128_OFF))[F.tid] = (f32x2){c, s}; }
    __syncthreads();
}
__device__ __forceinline__ void tile_tw(Frame& F, int a, bool inv) {
    if (F.tid < 128) { const int m = (a * F.tid) & (L2X - 1); float s, c; sincospif((float)m * (1.0f / 8192.0f), &s, &c); ((LAS f32x2*)(F.lds + TWT_OFF))[F.tid] = (f32x2){c, inv ? s : -s}; }
}
template <bool INV> __device__ __forceinline__ void stage1(Frame& F, P2 (&xr)[16], P2 (&xi)[16], int s) {
    fft_reg<16, INV>(xr, xi);
    const LAS f32x2* tw = (const LAS f32x2*)(F.lds + TW128_OFF); LAS f32x4* tile = (LAS f32x4*)F.lds;
#pragma unroll
    for (int q = 0; q < 16; ++q) { const int p = brev<16>(q); const f32x2 w = tw[s * q]; const float c = w.x, sn = INV ? w.y : -w.y;
        P2 a = xr[p], b = xi[p]; cmul(a, b, c, sn);
        tile[(s * 16 + q) * 64 + F.lane] = (f32x4){a.x, a.y, b.x, b.y}; }
}
__device__ __forceinline__ void stage2_read(Frame& F, P2 (&xr)[8], P2 (&xi)[8], int qq) {
    const LAS f32x4* tile = (const LAS f32x4*)F.lds;
#pragma unroll
    for (int s = 0; s < 8; ++s) { const f32x4 v = tile[(s * 16 + qq) * 64 + F.lane]; xr[s] = (P2){v.x, v.y}; xi[s] = (P2){v.z, v.w}; }
}
__device__ __forceinline__ void hyq2(const bf16_t* __restrict__ PHY, size_t row, int tl, int col, const float (&w)[3][2], const float (&b)[2], float& q0, float& q1) {
    q0 = b[0]; q1 = b[1];
#pragma unroll
    for (int k = 0; k < 3; ++k) { const int tt = tl + k - 1; const bool ok = (tt >= 0) && (tt < L);
        const unsigned u = ok ? *(const unsigned*)(PHY + (row + k - 1) * 3072 + col) : 0u;
        q0 += w[k][0] * __uint_as_float(u << 16); q1 += w[k][1] * __uint_as_float(u & 0xffff0000u); }
}
struct ConvW { float w[3][3][2]; float b[3][2]; };
__device__ __forceinline__ void load_convw(ConvW& W, const float* __restrict__ cw, const float* __restrict__ cb, int c0) {
#pragma unroll
    for (int seg = 0; seg < 3; ++seg) {
#pragma unroll
        for (int k = 0; k < 3; ++k) { const f32x2 v = *(const f32x2*)(cw + k * 3072 + seg * 1024 + c0); W.w[seg][k][0] = v.x; W.w[seg][k][1] = v.y; }
        const f32x2 v = *(const f32x2*)(cb + seg * 1024 + c0); W.b[seg][0] = v.x; W.b[seg][1] = v.y; }
}


__device__ __forceinline__ void bf8_to_f(const u32x4 u, float (&f)[8]) {
    f[0] = __uint_as_float(u.x << 16); f[1] = __uint_as_float(u.x & 0xffff0000u); f[2] = __uint_as_float(u.y << 16); f[3] = __uint_as_float(u.y & 0xffff0000u);
    f[4] = __uint_as_float(u.z << 16); f[5] = __uint_as_float(u.z & 0xffff0000u); f[6] = __uint_as_float(u.w << 16); f[7] = __uint_as_float(u.w & 0xffff0000u);
}
__device__ __forceinline__ void prepass(Frame& F) {
    const bf16_t* PHY = (const bf16_t*)(F.ws + WS_PHY); bf16_t* Z16 = (bf16_t*)(F.ws + WS_Z16); bf16_t* X1Q = (bf16_t*)(F.ws + WS_YHY); const float* cw = F.in[12]; const float* cb = F.in[13];
    const int gw = F.bid * NWAVES + F.wave, NGW = F.G * NWAVES;
#pragma unroll 1
    for (int item = gw; item < (T / 16) * 2; item += NGW) {
        const int half = item & 1, row0 = (item >> 1) * 16, tl0 = row0 & (L - 1), c0 = half * 512 + 8 * F.lane;
        float w[3][3][8], bs[3][8];
#pragma unroll
        for (int seg = 0; seg < 3; ++seg) {
#pragma unroll
            for (int k = 0; k < 3; ++k) { const f32x4 a = *(const f32x4*)(cw + k * 3072 + seg * 1024 + c0), b = *(const f32x4*)(cw + k * 3072 + seg * 1024 + c0 + 4);
                w[seg][k][0] = a.x; w[seg][k][1] = a.y; w[seg][k][2] = a.z; w[seg][k][3] = a.w; w[seg][k][4] = b.x; w[seg][k][5] = b.y; w[seg][k][6] = b.z; w[seg][k][7] = b.w; }
            const f32x4 a = *(const f32x4*)(cb + seg * 1024 + c0), b = *(const f32x4*)(cb + seg * 1024 + c0 + 4);
            bs[seg][0] = a.x; bs[seg][1] = a.y; bs[seg][2] = a.z; bs[seg][3] = a.w; bs[seg][4] = b.x; bs[seg][5] = b.y; bs[seg][6] = b.z; bs[seg][7] = b.w; }
        const u32x4 zero4 = (u32x4){0u, 0u, 0u, 0u};
        u32x4 prev[3], cur[3];
#pragma unroll
        for (int seg = 0; seg < 3; ++seg) { prev[seg] = tl0 > 0 ? *(const u32x4*)(PHY + (size_t)(row0 - 1) * 3072 + seg * 1024 + c0) : zero4; cur[seg] = *(const u32x4*)(PHY + (size_t)row0 * 3072 + seg * 1024 + c0); }
#pragma unroll 1
        for (int sub = 0; sub < 4; ++sub) {
            u32x4 nx[4][3];
#pragma unroll
            for (int r = 0; r < 4; ++r)
#pragma unroll
                for (int seg = 0; seg < 3; ++seg) { const int tn = tl0 + sub * 4 + r + 1; nx[r][seg] = tn < L ? *(const u32x4*)(PHY + (size_t)(row0 + sub * 4 + r + 1) * 3072 + seg * 1024 + c0) : zero4; }
#pragma unroll
            for (int r = 0; r < 4; ++r) {
                float q[3][8];
#pragma unroll
                for (int seg = 0; seg < 3; ++seg) { float a[8], b[8], c[8]; bf8_to_f(prev[seg], a); bf8_to_f(cur[seg], b); bf8_to_f(nx[r][seg], c);
#pragma unroll
                    for (int e = 0; e < 8; ++e) q[seg][e] = bs[seg][e] + w[seg][0][e] * a[e] + w[seg][1][e] * b[e] + w[seg][2][e] * c[e];
                    prev[seg] = cur[seg]; cur[seg] = nx[r][seg]; }
                const size_t o = (size_t)(row0 + sub * 4 + r) * 1024 + c0;
                u32x4 zo, xo;
                zo.x = pk2(q[2][0] * q[0][0], q[2][1] * q[0][1]); zo.y = pk2(q[2][2] * q[0][2], q[2][3] * q[0][3]); zo.z = pk2(q[2][4] * q[0][4], q[2][5] * q[0][5]); zo.w = pk2(q[2][6] * q[0][6], q[2][7] * q[0][7]);
                xo.x = pk2(q[1][0], q[1][1]); xo.y = pk2(q[1][2], q[1][3]); xo.z = pk2(q[1][4], q[1][5]); xo.w = pk2(q[1][6], q[1][7]);
                *(u32x4*)(Z16 + o) = zo; *(u32x4*)(X1Q + o) = xo;
            }
        }
    }
}

__device__ __forceinline__ void prep_w4frag(Frame& F) {
    const float* w4 = F.in[20]; u32x4* WF4 = (u32x4*)(F.ws + WS_WF4);
    for (int idx = F.bid * NTHREADS + F.tid; idx < 2 * 64 * 2 * 64; idx += F.G * NTHREADS) {
        const int lane = idx & 63, s = (idx >> 6) & 1, cb = (idx >> 7) & 63, dir = idx >> 13; const int col = dir * 1024 + 16 * cb + (lane & 15), k0 = 32 * s + 8 * (lane >> 4);
        u32x4 o; o.x = pk2(w4[(k0 + 0) * 2048 + col], w4[(k0 + 1) * 2048 + col]); o.y = pk2(w4[(k0 + 2) * 2048 + col], w4[(k0 + 3) * 2048 + col]);
        o.z = pk2(w4[(k0 + 4) * 2048 + col], w4[(k0 + 5) * 2048 + col]); o.w = pk2(w4[(k0 + 6) * 2048 + col], w4[(k0 + 7) * 2048 + col]);
        WF4[idx] = o; }
}
__device__ __forceinline__ void fa_load(const float* __restrict__ w4, int c0, int bt, f32x2 (&wf)[16], f32x2 (&wb)[16]) {
#pragma unroll
    for (int e = 0; e < 16; ++e) { wf[e] = *(const f32x2*)(w4 + (16 * bt + e) * 2048 + c0); wb[e] = *(const f32x2*)(w4 + (16 * bt + e) * 2048 + 1024 + c0); }
}
__device__ __forceinline__ void fa_compute(const LAS f32x4* hrow, int bt, const f32x2 (&wf)[16], const f32x2 (&wb)[16], float (&r0)[16], float (&r1)[16], float& l0, float& l1, bool lag0) {
#pragma unroll
    for (int e4 = 0; e4 < 4; ++e4) { const int u4 = 4 * bt + e4; __builtin_amdgcn_sched_barrier(0);
#pragma unroll
        for (int j = 0; j < 16; ++j) { const f32x4 hv = hrow[(8 * j) * 16 + u4];
#pragma unroll
            for (int e = 0; e < 4; ++e) { r0[j] += hv[e] * (j < 8 ? wf[4 * e4 + e].x : wb[4 * e4 + e].x); r1[j] += hv[e] * (j < 8 ? wf[4 * e4 + e].y : wb[4 * e4 + e].y); } }
        if (lag0) { const f32x4 hv = hrow[u4];
#pragma unroll
            for (int e = 0; e < 4; ++e) { l0 += hv[e] * wb[4 * e4 + e].x; l1 += hv[e] * wb[4 * e4 + e].y; } } }
}
template <bool DRY = false> __device__ __forceinline__ void filter_pass_a(Frame& F, int k_lo = 0, int k_hi = 1 << 20) {
    const float* HH3 = (const float*)(F.ws + WS_HH3); const float* w4 = F.in[20]; float* NORM = (float*)(F.ws + WS_NORMP); kf_t* YK = (kf_t*)(F.ws + WS_KF);
    const int s = F.wave; const LAS f32x2* twt = (const LAS f32x2*)(F.lds + TWT_OFF);
    for (int kk = k_lo, tl = F.bid + k_lo * F.G; kk < k_hi && tl < 128 * 8; ++kk, tl += F.G) {
        const int n1 = tl >> 3, ct = tl & 7, c0 = ct * 128 + 2 * F.lane;
        tile_tw(F, n1, false);
        { const int rw = F.tid >> 2, part = F.tid & 3; const int n = n1 + 128 * rw; const int t = n < L ? n : ((2 * L - n) & (L - 1));
          const f32x4* src = (const f32x4*)(HH3 + t * 64 + part * 16); LAS f32x4* dst = (LAS f32x4*)(F.lds + rw * 256 + part * 64);
          const f32x4 a = src[0], b = src[1], c = src[2], d = src[3]; dst[0] = a; dst[1] = b; dst[2] = c; dst[3] = d; }
        __syncthreads();
        P2 xr[16], xi[16]; P2 lag0 = (P2){0.f, 0.f};
        const P2 da = (P2){hy_delta_abs(c0), hy_delta_abs(c0 + 1)};
        { const u32x4* WF4 = (const u32x4*)(F.ws + WS_WF4); const int cb = ct * 8 + s, jl = F.lane & 15, ql = F.lane >> 4;
          bf16x8 bfr[2][2];
#pragma unroll
          for (int dir = 0; dir < 2; ++dir)
#pragma unroll
              for (int ks = 0; ks < 2; ++ks) bfr[dir][ks] = __builtin_bit_cast(bf16x8, WF4[(((dir * 64 + cb) * 2 + ks) * 64) + F.lane]);
          LAS float* kt = (LAS float*)(F.lds + 32768);
#pragma unroll
          for (int m = 0; m < 8; ++m) {
              bf16x8 afr[2];
#pragma unroll
              for (int ks = 0; ks < 2; ++ks) { const LAS f32x4* hp = (const LAS f32x4*)(F.lds + (16 * m + jl) * 256 + (32 * ks + 8 * ql) * 4); const f32x4 x0 = hp[0], x1 = hp[1];
                  u32x4 pk; pk.x = pk2(x0.x, x0.y); pk.y = pk2(x0.z, x0.w); pk.z = pk2(x1.x, x1.y); pk.w = pk2(x1.z, x1.w); afr[ks] = __builtin_bit_cast(bf16x8, pk); }
              f32x4 d = (f32x4){0.f, 0.f, 0.f, 0.f};
              d = __builtin_amdgcn_mfma_f32_16x16x32_bf16(afr[0], bfr[m >> 2][0], d, 0, 0, 0); d = __builtin_amdgcn_mfma_f32_16x16x32_bf16(afr[1], bfr[m >> 2][1], d, 0, 0, 0);
#pragma unroll
              for (int r = 0; r < 4; ++r) kt[(16 * m + 4 * ql + r) * 132 + 16 * s + jl] = d[r]; }
          if (n1 == 0 && s == 0) { const LAS float* h0 = (const LAS float*)F.lds;
#pragma unroll 4
              for (int u = 0; u < 64; ++u) { const f32x2 wb = *(const f32x2*)(w4 + u * 2048 + 1024 + c0); lag0 += h0[u] * wb; } }
          __syncthreads();
#pragma unroll
          for (int j = 0; j < 16; ++j) xr[j] = *(const LAS f32x2*)(kt + (s + 8 * j) * 132 + 2 * F.lane);
        }
        __syncthreads();
        P2 na = (P2){0.f, 0.f};
#pragma unroll
        for (int j = 0; j < 16; ++j) { const int n = n1 + 128 * (s + 8 * j); const int t = j < 8 ? n : ((2 * L - n) & (L - 1)); const float tt = (float)t * (1.0f / (float)(L - 1));
            P2 v = xr[j] * (P2){fexp(-tt * da.x), fexp(-tt * da.y)};
            if (n == L) v = (P2){0.f, 0.f};
            if (j == 0) v += lag0;
            xr[j] = v; xi[j] = (P2){0.f, 0.f}; na += (P2){fabsf(v.x), fabsf(v.y)}; }
        { LAS f32x2* nred = (LAS f32x2*)(F.lds + MISC_OFF + 12288); nred[s * 64 + F.lane] = na; }
        stage1<false>(F, xr, xi, s);
        __syncthreads();
        if (s == 0) { const LAS f32x2* nred = (const LAS f32x2*)(F.lds + MISC_OFF + 12288); f32x2 a = nred[F.lane];
#pragma unroll
            for (int w = 1; w < 8; ++w) { const f32x2 b = nred[w * 64 + F.lane]; a.x += b.x; a.y += b.y; }
            if (!DRY) *(f32x2*)(NORM + (size_t)n1 * 1024 + c0) = a; else asm volatile("" :: "v"(a)); }
#pragma unroll
        for (int h = 0; h < 2; ++h) { const int qq = s + 8 * h; P2 a[8], b[8];
            stage2_read(F, a, b, qq); fft_reg<8, false>(a, b);
#pragma unroll
            for (int r = 0; r < 8; ++r) { const int p = brev<8>(r), k2 = qq + 16 * r; const f32x2 w = twt[k2];
                P2 x = a[p], y = b[p]; cmul(x, y, w.x, w.y);
                if (!DRY) YK[((size_t)k2 * 128 + n1) * 512 + (c0 >> 1)] = KF_PK(x, y); else asm volatile("" :: "v"(x), "v"(y)); } }
        __syncthreads();
    }
}
template <bool DRY = false> __device__ __forceinline__ void filter_pass_b(Frame& F) {
    const float* NORM = (const float*)(F.ws + WS_NORMP); kf_t* KF = (kf_t*)(F.ws + WS_KF); const int s = F.wave;
    for (int tl = F.bid; tl < 128 * 8; tl += F.G) {
        const int k2 = tl >> 3, ct = tl & 7, c0 = ct * 128 + 2 * F.lane; const size_t base = (size_t)k2 * 128 * 512 + (c0 >> 1);
        { LAS float* nsum = (LAS float*)(F.lds + MISC_OFF + 12288); const int ch = F.tid & 127, qt = F.tid >> 7; float a = 0.f;
#pragma unroll 8
          for (int i = 0; i < 32; ++i) a += NORM[(size_t)(qt * 32 + i) * 1024 + ct * 128 + ch];
          __syncthreads(); nsum[qt * 128 + ch] = a; __syncthreads(); }
        P2 sc;
        { const LAS float* nsum = (const LAS float*)(F.lds + MISC_OFF + 12288); const int ch = 2 * F.lane;
          sc.x = 1.0f / ((nsum[ch] + nsum[128 + ch]) + (nsum[256 + ch] + nsum[384 + ch])); sc.y = 1.0f / ((nsum[ch + 1] + nsum[128 + ch + 1]) + (nsum[256 + ch + 1] + nsum[384 + ch + 1])); }
        P2 xr[16], xi[16];
#pragma unroll
        for (int j = 0; j < 16; ++j) { const kf_t u = KF[base + (size_t)(s + 8 * j) * 512]; xr[j] = KF_RE(u); xi[j] = KF_IM(u); }
        stage1<false>(F, xr, xi, s);
        __syncthreads();
#pragma unroll
        for (int h = 0; h < 2; ++h) { const int qq = s + 8 * h; P2 a[8], b[8];
            stage2_read(F, a, b, qq); fft_reg<8, false>(a, b);
#pragma unroll
            for (int r = 0; r < 8; ++r) { const int p = brev<8>(r), k1 = qq + 16 * r;
                const kf_t o_ = KF_PK(a[p] * (sc * KF_SCALE), b[p] * (sc * KF_SCALE)); if (!DRY) KF[base + (size_t)k1 * 512] = o_; else asm volatile("" :: "v"(o_)); } }
        __syncthreads();
    }
}
__device__ __forceinline__ void data_pass_a(Frame& F) {
    const bf16_t* Z16 = (const bf16_t*)(F.ws + WS_Z16); yz_t* YZ = (yz_t*)(F.ws + WS_YZ); const int s = F.wave; const LAS f32x2* twt = (const LAS f32x2*)(F.lds + TWT_OFF);
    unsigned zn[16];
    auto zload = [&](int tl, unsigned (&z)[16]) { const int ct = tl & 7, n1 = (tl >> 3) & 127, p = tl >> 10, c0 = ct * 128 + 2 * F.lane;
#pragma unroll
        for (int j = 0; j < 8; ++j) { const int t = n1 + 128 * (s + 8 * j);
            z[2 * j] = *(const unsigned*)(Z16 + ((size_t)(2 * p) * L + t) * 1024 + c0); z[2 * j + 1] = *(const unsigned*)(Z16 + ((size_t)(2 * p + 1) * L + t) * 1024 + c0); } };
    if (F.bid < 2 * 128 * 8) zload(F.bid, zn);
    for (int tl = F.bid; tl < 2 * 128 * 8; tl += F.G) {
        const int ct = tl & 7, n1 = (tl >> 3) & 127, p = tl >> 10, c0 = ct * 128 + 2 * F.lane;
        tile_tw(F, n1, false);
        P2 xr[16], xi[16];
#pragma unroll
        for (int j = 0; j < 8; ++j) { xr[j] = bf2p(zn[2 * j]); xi[j] = bf2p(zn[2 * j + 1]); }
        if (tl + F.G < 2 * 128 * 8) zload(tl + F.G, zn);
#pragma unroll
        for (int j = 8; j < 16; ++j) { xr[j] = (P2){0.f, 0.f}; xi[j] = (P2){0.f, 0.f}; }
        stage1<false>(F, xr, xi, s);
        __syncthreads();
#pragma unroll
        for (int h = 0; h < 2; ++h) { const int qq = s + 8 * h; P2 a[8], b[8];
            stage2_read(F, a, b, qq); fft_reg<8, false>(a, b);
#pragma unroll
            for (int r = 0; r < 8; ++r) { const int pp = brev<8>(r), k2 = qq + 16 * r; const f32x2 w = twt[k2];
                P2 x = a[pp], y = b[pp]; cmul(x, y, w.x, w.y);
                YZ[(((size_t)p * 128 + k2) * 128 + n1) * 512 + (c0 >> 1)] = pkyz(x, y); } }
        __syncthreads();
    }
}
template <bool DRY = false> __device__ __forceinline__ void data_pass_b(Frame& F) {
    yz_t* YZ = (yz_t*)(F.ws + WS_YZ); const kf_t* KF = (const kf_t*)(F.ws + WS_KF); const int s = F.wave;
    const LAS f32x2* twt = (const LAS f32x2*)(F.lds + TWT_OFF); const LAS f32x2* tw = (const LAS f32x2*)(F.lds + TW128_OFF); LAS f32x4* tile = (LAS f32x4*)F.lds;
    int* qctr = (int*)(F.ws + WS_CTL) + 128 + (DRY ? 1 : 0); LAS int* qslot = (LAS int*)(F.lds + MISC_OFF + 768);
    for (;;) {
        __syncthreads();
        if (F.tid == 0) *qslot = atomicAdd(qctr, 1);
        __syncthreads();
        const int tl = *qslot; if (tl >= 128 * 8) break;
        const int k2 = tl >> 3, ct = tl & 7, c0 = ct * 128 + 2 * F.lane; const size_t kbase = (size_t)k2 * 128 * 512 + (c0 >> 1);
        tile_tw(F, k2, true);
#pragma unroll 1
        for (int p = 0; p < 2; ++p) {
            const size_t base = ((size_t)p * 128 + k2) * 128 * 512 + (c0 >> 1);
            kf_t kfp[2][8];
#pragma unroll
            for (int h = 0; h < 2; ++h)
#pragma unroll
                for (int r = 0; r < 8; ++r) kfp[h][r] = KF[kbase + (size_t)(s + 8 * h + 16 * r) * 512];
            { P2 xr[16], xi[16];
#pragma unroll
              for (int j = 0; j < 16; ++j) { const yz_t u = YZ[base + (size_t)(s + 8 * j) * 512]; xr[j] = yzre(u); xi[j] = yzim(u); }
              stage1<false>(F, xr, xi, s); }
            __syncthreads();
#pragma unroll
            for (int h = 0; h < 2; ++h) { const int qq = s + 8 * h; P2 a[8], b[8], gr[8], gi[8];
                if (h == 1) __builtin_amdgcn_sched_barrier(0);
                stage2_read(F, a, b, qq); fft_reg<8, false>(a, b);
#pragma unroll
                for (int r = 0; r < 8; ++r) { const int pp = brev<8>(r); const P2 kr = KF_RE(kfp[h][r]), ki = KF_IM(kfp[h][r]);
                    gr[r] = a[pp] * kr - b[pp] * ki; gi[r] = a[pp] * ki + b[pp] * kr; }
                fft_reg<8, true>(gr, gi);
#pragma unroll
                for (int bq = 0; bq < 8; ++bq) { const int pp = brev<8>(bq); const f32x2 w = tw[bq * qq];
                    P2 x = gr[pp], y = gi[pp]; cmul(x, y, w.x, w.y);
                    tile[(bq * 16 + qq) * 64 + F.lane] = (f32x4){x.x, x.y, y.x, y.y}; } }
            __syncthreads();
            { P2 xr[16], xi[16];
#pragma unroll
              for (int q = 0; q < 16; ++q) { const f32x4 v = tile[(s * 16 + q) * 64 + F.lane]; xr[q] = (P2){v.x, v.y}; xi[q] = (P2){v.z, v.w}; }
              fft_reg<16, true>(xr, xi);
#pragma unroll
              for (int a = 0; a < 16; ++a) { const int pp = brev<16>(a), m2 = s + 8 * a; const f32x2 w = twt[m2];
                  P2 x = xr[pp], y = xi[pp]; cmul(x, y, w.x, w.y);
                  if (!DRY) YZ[base + (size_t)m2 * 512] = pkyz(x * YZ_ZSCALE, y * YZ_ZSCALE); else asm volatile("" :: "v"(x), "v"(y)); } }
            __syncthreads();
        }
    }
}
template <bool DRY = false> __device__ __forceinline__ void data_pass_c(Frame& F) {
    const bf16_t* Z16 = (const bf16_t*)(F.ws + WS_Z16); const yz_t* YZ = (const yz_t*)(F.ws + WS_YZ); bf16_t* YHY = (bf16_t*)(F.ws + WS_YHY); const float* hbias = F.in[22]; const int s = F.wave;
    yz_t yzn[16];
    auto yzload = [&](int tl, yz_t (&y)[16]) { const int ct = tl & 7, m2 = (tl >> 3) & 127, p = tl >> 10, c0 = ct * 128 + 2 * F.lane;
#pragma unroll
        for (int j = 0; j < 16; ++j) y[j] = YZ[(((size_t)p * 128 + (s + 8 * j)) * 128 + m2) * 512 + (c0 >> 1)]; };
    if (F.bid < 2 * 128 * 8) yzload(F.bid, yzn);
    for (int tl = F.bid; tl < 2 * 128 * 8; tl += F.G) {
        const int ct = tl & 7, m2 = (tl >> 3) & 127, p = tl >> 10, c0 = ct * 128 + 2 * F.lane;
        unsigned uzp[2][4][2], uxp[2][4][2];
#pragma unroll
        for (int h = 0; h < 2; ++h)
#pragma unroll
            for (int r = 0; r < 4; ++r)
#pragma unroll
                for (int bb = 0; bb < 2; ++bb) { const size_t row = (size_t)(2 * p + bb) * L + 128 * (s + 8 * h + 16 * r) + m2;
                    uzp[h][r][bb] = *(const unsigned*)(Z16 + row * 1024 + c0); uxp[h][r][bb] = *(const unsigned*)(YHY + row * 1024 + c0); }
        { P2 xr[16], xi[16];
#pragma unroll
          for (int j = 0; j < 16; ++j) { xr[j] = yzre(yzn[j]); xi[j] = yzim(yzn[j]); }
          if (tl + F.G < 2 * 128 * 8) yzload(tl + F.G, yzn);
          stage1<true>(F, xr, xi, s); }
        __syncthreads();
        const P2 hb = *(const f32x2*)(hbias + c0);
#pragma unroll
        for (int h = 0; h < 2; ++h) { const int qq = s + 8 * h; P2 a[8], b[8];
            stage2_read(F, a, b, qq); fft_reg<8, true>(a, b);
#pragma unroll
            for (int r = 0; r < 4; ++r) { const int pp = brev<8>(r), t = 128 * (qq + 16 * r) + m2;
#pragma unroll
                for (int bb = 0; bb < 2; ++bb) { const size_t row = (size_t)(2 * p + bb) * L + t;
                    const P2 z = bf2p(uzp[h][r][bb]), x1 = bf2p(uxp[h][r][bb]);
                    const P2 cv = (bb == 0 ? a[pp] : b[pp]) * (1.0f / ((float)L2X * YZ_ZSCALE * KF_SCALE));
                    const P2 y = x1 * (cv + hb * z);
                    if (!DRY) *(unsigned*)(YHY + row * 1024 + c0) = pk2(y.x, y.y); else asm volatile("" :: "v"(y)); } } }
        __syncthreads();
    }
}
}
namespace lru {
__device__ __forceinline__ f32x2 sig2(const f32x2 x) { const f32x2 t = x * -1.4426950408889634f; const f32x2 d = (f32x2){__builtin_amdgcn_exp2f(t.x), __builtin_amdgcn_exp2f(t.y)} + 1.0f; return (f32x2){__builtin_amdgcn_rcpf(d.x), __builtin_amdgcn_rcpf(d.y)}; }
constexpr int TC = 64, NCH = L / TC, MB = TC / 16;

__device__ __forceinline__ void prep_wfrag(Frame& F) {
    const float* wa = F.in[6]; const float* wi = F.in[8]; u32x4* WF = (u32x4*)(F.ws + WS_WLRUF);
    for (int idx = F.bid * NTHREADS + F.tid; idx < 2 * 16 * 2 * 4 * 2 * 64; idx += F.G * NTHREADS) {
        const int lane = idx & 63, s = (idx >> 6) & 1, n = (idx >> 7) & 3, mat = (idx >> 9) & 1, h = (idx >> 10) & 15, dir = idx >> 14;
        const float* W = (mat == 0 ? wa : wi) + ((size_t)(dir * 16 + h) * 64) * 64; const int jo = 16 * n + (lane & 15), i0 = 32 * s + 8 * (lane >> 4);
        u32x4 o; o.x = pk2(W[(i0 + 0) * 64 + jo], W[(i0 + 1) * 64 + jo]); o.y = pk2(W[(i0 + 2) * 64 + jo], W[(i0 + 3) * 64 + jo]);
        o.z = pk2(W[(i0 + 4) * 64 + jo], W[(i0 + 5) * 64 + jo]); o.w = pk2(W[(i0 + 6) * 64 + jo], W[(i0 + 7) * 64 + jo]);
        WF[idx] = o;
    }
}

__device__ __forceinline__ void load_rows(const bf16_t* __restrict__ P0, int b, int t0, int m, int h, int j, int q, u32x4 (&pv)[2][4]) {
#pragma unroll
    for (int s = 0; s < 2; ++s)
#pragma unroll
        for (int tap = 0; tap < 4; ++tap) { const int tl = t0 + 16 * m + j + tap - 2; const bool ok = (tl >= 0) && (tl < L);
            const size_t off = ok ? (WS_P0 - WS_CTL - 8192) + (((size_t)b * L + tl) * 1024 + 64 * h + 32 * s + 8 * q) * 2 : (size_t)0;
            pv[s][tap] = *(const u32x4*)((const char*)P0 + off); }
}
__device__ __forceinline__ void stage1(Frame& F) {
    const bf16_t* P0 = (const bf16_t*)(F.ws + WS_CTL + 8192);
    const float* cw = F.in[4]; const float* cb = F.in[5]; const float* ba = F.in[7]; const float* bi = F.in[9]; const float* lam = F.in[10];
    const u32x4* WF = (const u32x4*)(F.ws + WS_WLRUF); f32x2* SUMM = (f32x2*)(F.ws + WS_SUMM);
    u32x2* HS = (u32x2*)(F.ws + WS_HS); u32x2* AF = (u32x2*)(F.ws + WS_AF); u32x2* AB = (u32x2*)(F.ws + WS_AB);
    LAS float* cwl = (LAS float*)(F.lds + MISC_OFF + 4096);
    LAS unsigned* hfl = (LAS unsigned*)(F.lds + F.wave * 8192) + F.lane;
    const LAS u32x4* wl = (const LAS u32x4*)(F.lds + 65536) + F.lane;
    asm volatile("" : "+v"(wl)); asm volatile("" : "+v"(hfl));
    const int lane = F.lane, j = lane & 15, q = lane >> 4;
    bf16x8 idf[2];
#pragma unroll
    for (int par = 0; par < 2; ++par) { const int kp = 16 * par + j;
#pragma unroll
        for (int jj = 0; jj < 8; ++jj) idf[par][jj] = (short)((q == (kp >> 3) && jj == (kp & 7)) ? 0x3F80 : 0); }
#pragma unroll 1
    for (int bix = F.bid; bix < NB * 16 * (NCH / 8); bix += F.G) {
        const int h = (bix >> 4) & 15, b = bix >> 8, chunk = (bix & 15) * 8 + F.wave; const int t0 = chunk * TC; const int task = ((b * NCH + chunk) << 4) + h;
        __syncthreads();
        if (F.tid < 320) cwl[F.tid] = F.tid < 256 ? cw[(F.tid >> 6) * 1024 + 64 * h + (F.tid & 63)] : cb[64 * h + (F.tid & 63)];
#pragma unroll
        for (int i = 0; i < 4; ++i) { const int e = F.tid + 512 * i; const int dir_ = e >> 10, rest = e & 1023;
            ((LAS u32x4*)(F.lds + 65536))[e] = WF[((size_t)(dir_ * 16 + h) * 16) * 64 + rest]; }
        __syncthreads();
#pragma unroll
        for (int dir = 0; dir < 2; ++dir) {
            float bac[4], bic[4], spc[4], cst[4], arun[4];
#pragma unroll
            for (int n = 0; n < 4; ++n) { const int c = 64 * h + 16 * n + j; bac[n] = ba[dir * 1024 + c]; bic[n] = bi[dir * 1024 + c]; spc[n] = -8.0f * 1.4426950408889634f * log1pf(expf(-lam[dir * 1024 + c])); cst[n] = 0.f; arun[n] = 1.f; }
            u32x4 pvn[2][4];
            load_rows(P0, b, t0, dir == 0 ? 0 : MB - 1, h, j, q, pvn);
#pragma unroll 1
            for (int mm = 0; mm < MB; ++mm) {
                const int m = dir == 0 ? mm : MB - 1 - mm;
                bf16x8 afr[2];
#pragma unroll
                for (int s = 0; s < 2; ++s) { const int chb = 32 * s + 8 * q; f32x2 xp[4];
                    { const f32x4 b0 = *(const LAS f32x4*)(cwl + 256 + chb), b1 = *(const LAS f32x4*)(cwl + 256 + chb + 4);
                      xp[0] = (f32x2){b0.x, b0.y}; xp[1] = (f32x2){b0.z, b0.w}; xp[2] = (f32x2){b1.x, b1.y}; xp[3] = (f32x2){b1.z, b1.w}; }
#pragma unroll
                    for (int tap = 0; tap < 4; ++tap) { const u32x4 pq = pvn[s][tap];
                        const f32x4 w0 = *(const LAS f32x4*)(cwl + tap * 64 + chb), w1 = *(const LAS f32x4*)(cwl + tap * 64 + chb + 4);
                        xp[0] += (f32x2){w0.x, w0.y} * (f32x2){__uint_as_float(pq.x << 16), __uint_as_float(pq.x & 0xffff0000u)}; xp[1] += (f32x2){w0.z, w0.w} * (f32x2){__uint_as_float(pq.y << 16), __uint_as_float(pq.y & 0xffff0000u)};
                        xp[2] += (f32x2){w1.x, w1.y} * (f32x2){__uint_as_float(pq.z << 16), __uint_as_float(pq.z & 0xffff0000u)}; xp[3] += (f32x2){w1.z, w1.w} * (f32x2){__uint_as_float(pq.w << 16), __uint_as_float(pq.w & 0xffff0000u)}; }
                    u32x4 pk; pk.x = pk2(xp[0].x, xp[0].y); pk.y = pk2(xp[1].x, xp[1].y); pk.z = pk2(xp[2].x, xp[2].y); pk.w = pk2(xp[3].x, xp[3].y); afr[s] = __builtin_bit_cast(bf16x8, pk); }
                __builtin_amdgcn_sched_barrier(0);
                if (mm + 1 < MB) load_rows(P0, b, t0, dir == 0 ? m + 1 : m - 1, h, j, q, pvn);
                f32x4 dx[4], da[4], di[4];
#pragma unroll
                for (int n = 0; n < 4; ++n) { const f32x4 z4 = (f32x4){0.f, 0.f, 0.f, 0.f};
                    dx[n] = __builtin_amdgcn_mfma_f32_16x16x32_bf16(afr[n >> 1], idf[n & 1], z4, 0, 0, 0);
                    const bf16x8 wa0 = __builtin_bit_cast(bf16x8, wl[(((dir * 2 + 0) * 4 + n) * 2 + 0) * 64]), wa1 = __builtin_bit_cast(bf16x8, wl[(((dir * 2 + 0) * 4 + n) * 2 + 1) * 64]);
                    const bf16x8 wi0 = __builtin_bit_cast(bf16x8, wl[(((dir * 2 + 1) * 4 + n) * 2 + 0) * 64]), wi1 = __builtin_bit_cast(bf16x8, wl[(((dir * 2 + 1) * 4 + n) * 2 + 1) * 64]);
                    da[n] = __builtin_amdgcn_mfma_f32_16x16x32_bf16(afr[0], wa0, z4, 0, 0, 0); da[n] = __builtin_amdgcn_mfma_f32_16x16x32_bf16(afr[1], wa1, da[n], 0, 0, 0);
                    di[n] = __builtin_amdgcn_mfma_f32_16x16x32_bf16(afr[0], wi0, z4, 0, 0, 0); di[n] = __builtin_amdgcn_mfma_f32_16x16x32_bf16(afr[1], wi1, di[n], 0, 0, 0); }
                float P[4][4], S[4][4], PT[4], ST[4];
#pragma unroll
                for (int n = 0; n < 4; ++n) { float av[4], bv[4];
#pragma unroll
                    for (int hp = 0; hp < 2; ++hp) {
                        const f32x2 rg = sig2((f32x2){da[n][2 * hp], da[n][2 * hp + 1]} + bac[n]), ig = sig2((f32x2){di[n][2 * hp], di[n][2 * hp + 1]} + bic[n]);
                        const f32x2 tq = rg * spc[n];
                        const f32x2 a = (f32x2){__builtin_amdgcn_exp2f(tq.x), __builtin_amdgcn_exp2f(tq.y)};
                        const f32x2 w = 1.0f - a * a;
                        const f32x2 mult = (f32x2){__builtin_amdgcn_sqrtf(fmaxf(w.x, 0.f)), __builtin_amdgcn_sqrtf(fmaxf(w.y, 0.f))};
                        const f32x2 bq = mult * (ig * (f32x2){dx[n][2 * hp], dx[n][2 * hp + 1]});
                        av[2 * hp] = a.x; av[2 * hp + 1] = a.y; bv[2 * hp] = bq.x; bv[2 * hp + 1] = bq.y; }
                    if (dir == 0) { P[n][0] = av[0]; S[n][0] = bv[0];
#pragma unroll
                        for (int r = 1; r < 4; ++r) { P[n][r] = P[n][r - 1] * av[r]; S[n][r] = av[r] * S[n][r - 1] + bv[r]; } }
                    else { P[n][3] = av[3]; S[n][3] = bv[3];
#pragma unroll
                        for (int r = 2; r >= 0; --r) { P[n][r] = P[n][r + 1] * av[r]; S[n][r] = av[r] * S[n][r + 1] + bv[r]; } }
                    PT[n] = dir == 0 ? P[n][3] : P[n][0]; ST[n] = dir == 0 ? S[n][3] : S[n][0]; }
                float pt[4][4], st[4][4];
#pragma unroll
                for (int n = 0; n < 4; ++n)
#pragma unroll
                    for (int g = 0; g < 4; ++g) { pt[n][g] = __shfl(PT[n], j + 16 * g); st[n][g] = __shfl(ST[n], j + 16 * g); }
#pragma unroll
                for (int n = 0; n < 4; ++n) {
                    float C = cst[n], A = arun[n], Cq = 0.f, Aq = 1.f;
#pragma unroll
                    for (int gg = 0; gg < 4; ++gg) { const int g = dir == 0 ? gg : 3 - gg; if (g == q) { Cq = C; Aq = A; } C = pt[n][g] * C + st[n][g]; A *= pt[n][g]; }
                    cst[n] = C; arun[n] = A;
                    float hl[4], ac[4];
#pragma unroll
                    for (int hp = 0; hp < 2; ++hp) { const f32x2 pp = (f32x2){P[n][2 * hp], P[n][2 * hp + 1]}; const f32x2 hq = (f32x2){S[n][2 * hp], S[n][2 * hp + 1]} + pp * Cq, aq = pp * Aq;
                        hl[2 * hp] = hq.x; hl[2 * hp + 1] = hq.y; ac[2 * hp] = aq.x; ac[2 * hp + 1] = aq.y; }
                    const size_t fo = ((size_t)(task * MB + m) * 4 + n) * 64 + lane;
                    if (dir == 0) {
                        hfl[((m * 4 + n) * 2 + 0) * 64] = pk2(hl[0], hl[1]); hfl[((m * 4 + n) * 2 + 1) * 64] = pk2(hl[2], hl[3]);
                        AF[fo] = (u32x2){pk2(ac[0], ac[1]), pk2(ac[2], ac[3])};
                    } else {
                        { const unsigned u0 = hfl[((m * 4 + n) * 2 + 0) * 64], u1 = hfl[((m * 4 + n) * 2 + 1) * 64];
                          hl[0] += __uint_as_float(u0 << 16); hl[1] += __uint_as_float(u0 & 0xffff0000u); hl[2] += __uint_as_float(u1 << 16); hl[3] += __uint_as_float(u1 & 0xffff0000u); }
                        HS[fo] = (u32x2){pk2(hl[0], hl[1]), pk2(hl[2], hl[3])}; AB[fo] = (u32x2){pk2(ac[0], ac[1]), pk2(ac[2], ac[3])};
                    }
                }
            }
            if (q == 0) {
#pragma unroll
                for (int n = 0; n < 4; ++n) SUMM[((size_t)(dir * NB + b) * NCH + chunk) * 1024 + 64 * h + 16 * n + j] = (f32x2){arun[n], cst[n]};
            }
        }
    }
}
__device__ __forceinline__ void stage2(Frame& F) {
    const bf16_t* P1 = (const bf16_t*)(F.ws + WS_P1); bf16_t* YLRU = (bf16_t*)(F.ws + WS_YLRU); const float* CARRY = (const float*)(F.ws + WS_CARRY);
    const u32x2* HS = (const u32x2*)(F.ws + WS_HS); const u32x2* AF = (const u32x2*)(F.ws + WS_AF); const u32x2* AB = (const u32x2*)(F.ws + WS_AB);
    LAS float* buf = (LAS float*)(F.lds + F.wave * 8192);
    const int lane = F.lane, j = lane & 15, q = lane >> 4, tk = lane >> 2, cg = lane & 3;
    const int gw = F.bid * NWAVES + F.wave, NGW = F.G * NWAVES;
    struct In { u32x2 hs[4], af[4], ab[4]; float cf[4], cbk[4]; u32x4 g0, g1; };
    auto issue = [&](int item, In& I) {
        const int m = item & (MB - 1), task = item >> 2, h = task & 15, chunk = (task >> 4) & (NCH - 1), b = task >> 11;
#pragma unroll
        for (int n = 0; n < 4; ++n) { const size_t fo = ((size_t)item * 4 + n) * 64 + lane; I.hs[n] = HS[fo]; I.af[n] = AF[fo]; I.ab[n] = AB[fo];
            const int c = 64 * h + 16 * n + j; I.cf[n] = CARRY[((size_t)(0 * NB + b) * NCH + chunk) * 1024 + c]; I.cbk[n] = CARRY[((size_t)(1 * NB + b) * NCH + chunk) * 1024 + c]; }
        const size_t o = ((size_t)b * L + chunk * TC + 16 * m + tk) * 1024 + 64 * h + 16 * cg;
        I.g0 = *(const u32x4*)(P1 + o); I.g1 = *(const u32x4*)(P1 + o + 8); };
    auto finish = [&](int item, const In& I) {
        const int m = item & (MB - 1), task = item >> 2, h = task & 15, chunk = (task >> 4) & (NCH - 1), b = task >> 11;
#pragma unroll
        for (int n = 0; n < 4; ++n) {
            const float h0 = __uint_as_float(I.hs[n].x << 16) + __uint_as_float(I.af[n].x << 16) * I.cf[n] + __uint_as_float(I.ab[n].x << 16) * I.cbk[n];
            const float h1 = __uint_as_float(I.hs[n].x & 0xffff0000u) + __uint_as_float(I.af[n].x & 0xffff0000u) * I.cf[n] + __uint_as_float(I.ab[n].x & 0xffff0000u) * I.cbk[n];
            const float h2 = __uint_as_float(I.hs[n].y << 16) + __uint_as_float(I.af[n].y << 16) * I.cf[n] + __uint_as_float(I.ab[n].y << 16) * I.cbk[n];
            const float h3 = __uint_as_float(I.hs[n].y & 0xffff0000u) + __uint_as_float(I.af[n].y & 0xffff0000u) * I.cf[n] + __uint_as_float(I.ab[n].y & 0xffff0000u) * I.cbk[n];
            buf[(4 * q + 0) * 68 + 16 * n + j] = h0; buf[(4 * q + 1) * 68 + 16 * n + j] = h1; buf[(4 * q + 2) * 68 + 16 * n + j] = h2; buf[(4 * q + 3) * 68 + 16 * n + j] = h3;
        }
        LDS_WAIT();
        const size_t o = ((size_t)b * L + chunk * TC + 16 * m + tk) * 1024 + 64 * h + 16 * cg;
        const LAS f32x4* br = (const LAS f32x4*)(buf + tk * 68 + 16 * cg);
        const f32x4 v0 = br[0], v1 = br[1], v2 = br[2], v3 = br[3];
        float gg[16];
        { const unsigned w[8] = {I.g0.x, I.g0.y, I.g0.z, I.g0.w, I.g1.x, I.g1.y, I.g1.z, I.g1.w};
#pragma unroll
          for (int i = 0; i < 8; ++i) { gg[2 * i] = gelu_tanh(__uint_as_float(w[i] << 16)); gg[2 * i + 1] = gelu_tanh(__uint_as_float(w[i] & 0xffff0000u)); } }
        u32x4 y0, y1;
        y0.x = pk2(v0.x * gg[0], v0.y * gg[1]); y0.y = pk2(v0.z * gg[2], v0.w * gg[3]); y0.z = pk2(v1.x * gg[4], v1.y * gg[5]); y0.w = pk2(v1.z * gg[6], v1.w * gg[7]);
        y1.x = pk2(v2.x * gg[8], v2.y * gg[9]); y1.y = pk2(v2.z * gg[10], v2.w * gg[11]); y1.z = pk2(v3.x * gg[12], v3.y * gg[13]); y1.w = pk2(v3.z * gg[14], v3.w * gg[15]);
        *(u32x4*)(YLRU + o) = y0; *(u32x4*)(YLRU + o + 8) = y1;
        LDS_WAIT(); };
    constexpr int NIT = NB * NCH * 16 * MB;
    In A, B; int item = gw;
    if (item < NIT) issue(item, A);
#pragma unroll 1
    for (; item < NIT; item += 2 * NGW) {
        if (item + NGW < NIT) issue(item + NGW, B);
        finish(item, A);
        if (item + NGW >= NIT) break;
        if (item + 2 * NGW < NIT) issue(item + 2 * NGW, A);
        finish(item + NGW, B);
    }
}
__device__ __forceinline__ void carry(Frame& F) {
    const f32x2* SUMM = (const f32x2*)(F.ws + WS_SUMM); float* CARRY = (float*)(F.ws + WS_CARRY);
    for (int idx = F.bid * NTHREADS + F.tid; idx < 2 * NB * 1024; idx += F.G * NTHREADS) {
        const int c = idx & 1023, db = idx >> 10, dir = db >> 2; const size_t base = (size_t)db * NCH * 1024 + c;
        float C = 0.f;
#pragma unroll 1
        for (int k0 = 0; k0 < NCH; k0 += 16) {
            f32x2 v[16];
#pragma unroll
            for (int i = 0; i < 16; ++i) { const int k = dir == 0 ? (k0 + i) : (NCH - 1 - k0 - i); v[i] = SUMM[base + (size_t)k * 1024]; }
#pragma unroll
            for (int i = 0; i < 16; ++i) { const int k = dir == 0 ? (k0 + i) : (NCH - 1 - k0 - i); CARRY[base + (size_t)k * 1024] = C; C = v[i].x * C + v[i].y; }
        }
    }
}
}
__device__ __forceinline__ void transpose_item(const float* __restrict__ W, int ldw, int k0, int n0, bf16_t* __restrict__ WT, size_t orow0, const float* __restrict__ kscale, LAS float* scr, int lane) {
    const int r8 = lane >> 3, c4 = (lane & 7) * 4;
#pragma unroll
    for (int i = 0; i < 8; ++i) { const int kk = 8 * i + r8; f32x4 v = *(const f32x4*)(W + (size_t)(k0 + kk) * ldw + n0 + c4);
        if (kscale) { const float s = kscale[k0 + kk]; v = v * s; }
        scr[kk * 33 + c4 + 0] = v.x; scr[kk * 33 + c4 + 1] = v.y; scr[kk * 33 + c4 + 2] = v.z; scr[kk * 33 + c4 + 3] = v.w; }
    LDS_WAIT();
    const int c = lane & 7;
#pragma unroll
    for (int j = 0; j < 4; ++j) { const int n = (lane >> 3) + 8 * j; const LAS float* s = scr + (8 * c) * 33 + n;
        u32x4 o; o.x = pk2(s[0 * 33], s[1 * 33]); o.y = pk2(s[2 * 33], s[3 * 33]); o.z = pk2(s[4 * 33], s[5 * 33]); o.w = pk2(s[6 * 33], s[7 * 33]);
        *(u32x4*)(WT + (orow0 + n) * 1024 + k0 + 8 * c) = o; }
    LDS_WAIT();
}

__device__ __forceinline__ void phase_prep(Frame& F) {
    LAS float* scr = (LAS float*)(F.lds + F.wave * 16384);
    const int gw = F.bid * NWAVES + F.wave, NGW = F.G * NWAVES;
    constexpr int I_IN = (1024 / 64) * (NIN / 32), I_SQ = (1024 / 64) * (1024 / 32);
    for (int it = gw; it < I_IN + 3 * I_SQ; it += NGW) {
        int r = it; const float* W; int N; bf16_t* WT;
        if (r < I_IN) { W = F.in[2]; N = NIN; WT = (bf16_t*)(F.ws + WS_WIN); }
        else { r -= I_IN; const int q = r / I_SQ; r -= q * I_SQ; N = 1024; W = q == 0 ? F.in[11] : q == 1 ? F.in[23] : F.in[24]; WT = (bf16_t*)(F.ws + (q == 0 ? WS_WLRU : q == 1 ? WS_WHY : WS_WOUT)); }
        const int nblk = N / 32, kb = r / nblk, nb = r % nblk;
        int orow = 32 * nb;
        if (N == NIN && orow >= 5120) { const int which = (orow - 5120) >> 10, cc = (orow - 5120) & 1023; orow = 5120 + 256 * (cc >> 7) + 128 * which + (cc & 127); }
        transpose_item(W, N, 64 * kb, 32 * nb, WT, (size_t)orow, nullptr, scr, F.lane);
    }
    { const float* x = F.in[0]; const float* g = F.in[1]; bf16_t* U = (bf16_t*)(F.ws + WS_U);
      f32x4 gg[4];
#pragma unroll
      for (int j = 0; j < 4; ++j) gg[j] = ((const f32x4*)g)[F.lane + 64 * j];
      auto ld = [&](int row, f32x4 (&v)[4]) { const f32x4* xr = (const f32x4*)(x + (size_t)row * D) + F.lane;
#pragma unroll
          for (int j = 0; j < 4; ++j) v[j] = xr[64 * j]; };
      auto fin = [&](int row, const f32x4 (&v)[4]) { float s = 0.f;
#pragma unroll
          for (int j = 0; j < 4; ++j) s += v[j].x * v[j].x + v[j].y * v[j].y + v[j].z * v[j].z + v[j].w * v[j].w;
          const float rstd = rsqrtf(wave_sum(s) * (1.0f / D) + EPS);
#pragma unroll
          for (int j = 0; j < 4; ++j) { u32x2 w; w.x = pk2(v[j].x * rstd * gg[j].x, v[j].y * rstd * gg[j].y); w.y = pk2(v[j].z * rstd * gg[j].z, v[j].w * rstd * gg[j].w);
              ((u32x2*)(U + (size_t)row * D))[F.lane + 64 * j] = w; } };
      f32x4 va[4], vb[4], vc[4]; int row = gw;
      if (row < T) ld(row, va);
      if (row + NGW < T) ld(row + NGW, vb);
#pragma unroll 1
      for (; row < T; row += 3 * NGW) {
          if (row + 2 * NGW < T) ld(row + 2 * NGW, vc);
          fin(row, va);
          if (row + NGW >= T) break;
          if (row + 3 * NGW < T) ld(row + 3 * NGW, va);
          fin(row + NGW, vb);
          if (row + 2 * NGW >= T) break;
          if (row + 4 * NGW < T) ld(row + 4 * NGW, vb);
          fin(row + 2 * NGW, vc);
      } }
    { const float *w1 = F.in[14], *b1 = F.in[15], *w2 = F.in[16], *b2 = F.in[17], *w3 = F.in[18], *b3 = F.in[19], *freq = F.in[21]; float* HH3 = (float*)(F.ws + WS_HH3);
      LAS float* feat = scr; LAS float* h1 = scr + 64; LAS float* h2 = scr + 128; const int u = F.lane; const float fr = freq[u];
#pragma unroll 1
      for (int t = gw; t < L; t += NGW) {
        asm volatile("" ::: "memory");
        if (u < HYEMB) { float f; if (u == 0) f = (float)t / (float)(L - 1);
            else { const int j = (u - 1) & 15; const float band = 1e-4f + (float)j * ((15.0f - 1e-4f) / 15.0f); const float arg = (6.283185307179586f * (float)t / (float)L) * band; f = (u <= 16) ? cosf(arg) : -sinf(arg); }
            feat[u] = f; }
        LDS_WAIT();
        float s = b1[u];
#pragma unroll 1
        for (int f = 0; f < HYEMB; ++f) s += feat[f] * w1[f * 64 + u];
        h1[u] = sinf(fr * s); LDS_WAIT();
        s = b2[u];
#pragma unroll 4
        for (int f = 0; f < 64; ++f) s += h1[f] * w2[f * 64 + u];
        h2[u] = sinf(fr * s); LDS_WAIT();
        s = b3[u];
#pragma unroll 4
        for (int f = 0; f < 64; ++f) s += h2[f] * w3[f * 64 + u];
        HH3[t * 64 + u] = sinf(fr * s); LDS_WAIT(); } }
    lru::prep_wfrag(F); hy::prep_w4frag(F);
    { u32x4* WRGF = (u32x4*)(F.ws + WS_WRG); const float* g = F.in[25]; const float* wr = F.in[26];
      for (int idx = F.bid * NTHREADS + F.tid; idx < 32 * 2 * 2 * 64; idx += F.G * NTHREADS) {
          const int lane = idx & 63, part = (idx >> 6) & 1, tile = (idx >> 7) & 1, s = idx >> 8; const int e = 16 * tile + (lane & 15), k0 = 32 * s + 8 * (lane >> 4);
          float w[8];
#pragma unroll
          for (int jj = 0; jj < 8; ++jj) { const float v = g[k0 + jj] * wr[(k0 + jj) * 32 + e]; const float hi = __uint_as_float(pk2(v, v) << 16); w[jj] = part == 0 ? hi : v - hi; }
          u32x4 o; o.x = pk2(w[0], w[1]); o.y = pk2(w[2], w[3]); o.z = pk2(w[4], w[5]); o.w = pk2(w[6], w[7]); WRGF[idx] = o; } }
}

template <int KIND, bool DYN> __device__ __forceinline__ void convert_weights(Frame& F, int rank, int nranks, int rnd_lo = 0, int rnd_hi = 1 << 20) {
    LAS float* scr = (LAS float*)(F.lds + F.wave * 16384);
    const int gw = rank * NWAVES + F.wave, NGW = nranks * NWAVES;
    constexpr int IPE = KIND == 0 ? (1024 / 64) * (2048 / 32) : (1024 / 64) * (1024 / 32), TOTAL_ALL = NE * IPE;
    const int TOTAL = (long)rnd_hi * NGW < (long)TOTAL_ALL ? rnd_hi * NGW : TOTAL_ALL;
    int* ctr = (int*)(F.ws + WS_CTL) + 130;
    auto claim = [&]() { int v = 0; if (DYN && F.lane == 0) v = atomicAdd(ctr, 1); return v; };
    const float* Wc = nullptr; bf16_t* WTc = nullptr; size_t orowc = 0; int k0c = 0; f32x4 vc[8];
    auto decode_load = [&](int it, const float*& W, bf16_t*& WT, size_t& orow, int& k0, f32x4 (&v)[8]) {
        const int e = it / IPE, r = it - e * IPE; int ldw, n0;
        if (KIND == 0) { const int kb = r / 64, nb = r % 64; n0 = 32 * nb; const int which = n0 >> 10, pn = (n0 & 1023) >> 7, j0 = n0 & 127;
            W = F.in[28] + (size_t)e * 1024 * 2048; ldw = 2048; k0 = 64 * kb; WT = (bf16_t*)(F.ws + WS_WGU); orow = (size_t)e * 2048 + 256 * pn + 128 * which + j0; }
        else { const int kb = r / 32, nb = r % 32; n0 = 32 * nb;
            W = F.in[30] + (size_t)e * 1024 * 1024; ldw = 1024; k0 = 64 * kb; WT = (bf16_t*)(F.ws + WS_WDN); orow = (size_t)e * 1024 + 32 * nb; }
        const int r8 = F.lane >> 3, c4 = (F.lane & 7) * 4;
#pragma unroll
        for (int i = 0; i < 8; ++i) { const int kk = 8 * i + r8; v[i] = *(const f32x4*)(W + (size_t)(k0 + kk) * ldw + n0 + c4); if (KIND == 0) v[i] = v[i] * F.in[25][k0 + kk]; }
    };
    int it, itn, raw2 = 0;
    if (DYN) { const int r0 = claim(), r1 = claim(); raw2 = claim(); it = __builtin_amdgcn_readfirstlane(r0); itn = __builtin_amdgcn_readfirstlane(r1); }
    else { it = rnd_lo * NGW + gw; itn = it + NGW; }
    if (it < TOTAL) decode_load(it, Wc, WTc, orowc, k0c, vc);
#pragma unroll 1
    while (it < TOTAL) {
        const float* Wn = nullptr; bf16_t* WTn = nullptr; size_t orown = 0; int k0n = 0; f32x4 vn[8];
        const bool more = itn < TOTAL;
        if (more) decode_load(itn, Wn, WTn, orown, k0n, vn);
        { const int r8 = F.lane >> 3, c4 = (F.lane & 7) * 4;
#pragma unroll
          for (int i = 0; i < 8; ++i) { const int kk = 8 * i + r8; scr[kk * 33 + c4 + 0] = vc[i].x; scr[kk * 33 + c4 + 1] = vc[i].y; scr[kk * 33 + c4 + 2] = vc[i].z; scr[kk * 33 + c4 + 3] = vc[i].w; }
          LDS_WAIT();
          const int c = F.lane & 7;
#pragma unroll
          for (int j = 0; j < 4; ++j) { const int n = (F.lane >> 3) + 8 * j; const LAS float* s = scr + (8 * c) * 33 + n;
              u32x4 o; o.x = pk2(s[0 * 33], s[1 * 33]); o.y = pk2(s[2 * 33], s[3 * 33]); o.z = pk2(s[4 * 33], s[5 * 33]); o.w = pk2(s[6 * 33], s[7 * 33]);
              *(u32x4*)(WTc + (orowc + n) * 1024 + k0c + 8 * c) = o; }
          LDS_WAIT(); }
        if (more) { Wc = Wn; WTc = WTn; orowc = orown; k0c = k0n;
#pragma unroll
            for (int i = 0; i < 8; ++i) vc[i] = vn[i]; }
        it = itn;
        if (DYN) { itn = __builtin_amdgcn_readfirstlane(raw2); raw2 = claim(); } else itn += NGW;
    }
}
__device__ __forceinline__ void phase_router_a(Frame& F) {
#ifdef MIXDESYNC
    convert_weights<0, false>(F, F.bid, F.G, 2 * MIXDESYNC); convert_weights<1, false>(F, F.bid, F.G);
#else
    REP(11) { convert_weights<0, false>(F, F.bid, F.G); convert_weights<1, false>(F, F.bid, F.G); }
#endif
    __syncthreads();
    { const f32x4* src = (const f32x4*)(F.ws + WS_WRG); LAS f32x4* dst = (LAS f32x4*)F.lds;
      for (int i = F.tid; i < 32 * 2 * 2 * 64; i += NTHREADS) dst[i] = src[i]; }
    LAS int* hist = (LAS int*)(F.lds + MISC_OFF);
    if (F.tid < 32) hist[F.tid] = 0;
    __syncthreads();
    const LAS u32x4* wl = (const LAS u32x4*)F.lds + F.lane;
    const bf16_t* HB = (const bf16_t*)(F.ws + WS_HN); const float* br = F.in[27];
    int* EROWTOK = (int*)(F.ws + WS_EROWTOK); float* EROWRS = (float*)(F.ws + WS_EROWRS); float* EROWGATE = (float*)(F.ws + WS_EROWGATE); int* TOKCODE = (int*)(F.ws + WS_TOKROW); LAS int* base = hist + 32;
    for (int g0 = 0; g0 < T / 16; g0 += F.G * NWAVES) {
        const int grp = g0 + F.bid * NWAVES + F.wave; const bool act = grp < T / 16;
        int te_[4] = {0, 0, 0, 0}, lr_[4] = {0, 0, 0, 0}; float gt_[4] = {0.f, 0.f, 0.f, 0.f}, rs_ = 0.f;
        const int n = F.lane & 15, g = F.lane >> 4; const int t = grp * 16 + n;
        if (act) {
        const u32x4* hp = (const u32x4*)(HB + (size_t)t * D + 8 * g);
        f32x4 acc[2] = {(f32x4){0.f, 0.f, 0.f, 0.f}, (f32x4){0.f, 0.f, 0.f, 0.f}}; f32x2 ss2 = (f32x2){0.f, 0.f};
        u32x4 hb[8];
#pragma unroll
        for (int u = 0; u < 8; ++u) hb[u] = hp[u * 4];
#pragma unroll 1
        for (int s0 = 0; s0 < 32; s0 += 8) {
#pragma unroll
            for (int u = 0; u < 8; ++u) { const int s = s0 + u; const u32x4 cur = hb[u];
                if (s0 + 8 < 32) hb[u] = hp[(s + 8) * 4];
                const bf16x8 bfr = __builtin_bit_cast(bf16x8, cur);
#pragma unroll
                for (int tile = 0; tile < 2; ++tile) {
                    acc[tile] = __builtin_amdgcn_mfma_f32_16x16x32_bf16(__builtin_bit_cast(bf16x8, wl[((s * 2 + tile) * 2 + 0) * 64]), bfr, acc[tile], 0, 0, 0);
                    acc[tile] = __builtin_amdgcn_mfma_f32_16x16x32_bf16(__builtin_bit_cast(bf16x8, wl[((s * 2 + tile) * 2 + 1) * 64]), bfr, acc[tile], 0, 0, 0); }
                const f32x2 a = (f32x2){__uint_as_float(cur.x << 16), __uint_as_float(cur.x & 0xffff0000u)}, b = (f32x2){__uint_as_float(cur.y << 16), __uint_as_float(cur.y & 0xffff0000u)};
                const f32x2 c = (f32x2){__uint_as_float(cur.z << 16), __uint_as_float(cur.z & 0xffff0000u)}, d = (f32x2){__uint_as_float(cur.w << 16), __uint_as_float(cur.w & 0xffff0000u)};
                ss2 += a * a; ss2 += b * b; ss2 += c * c; ss2 += d * d; }
        }
        float ss = ss2.x + ss2.y; ss += __shfl_xor(ss, 16); ss += __shfl_xor(ss, 32);
        const float rstd = rsqrtf(ss * (1.0f / D) + EPS);
        float v[8];
#pragma unroll
        for (int q = 0; q < 8; ++q) v[q] = acc[q >> 2][q & 3] * rstd + br[16 * (q >> 2) + 4 * g + (q & 3)];
        float tv[4]; int te[4];
#pragma unroll
        for (int k = 0; k < 4; ++k) {
            float mx = -3.0e38f; int mi = 0;
#pragma unroll
            for (int q = 0; q < 8; ++q) { const int ex = 16 * (q >> 2) + 4 * g + (q & 3); if (v[q] > mx) { mx = v[q]; mi = ex; } }
#pragma unroll
            for (int o = 16; o <= 32; o <<= 1) { const float om = __shfl_xor(mx, o); const int oi = __shfl_xor(mi, o); if (om > mx || (om == mx && oi < mi)) { mx = om; mi = oi; } }
            tv[k] = mx; te[k] = mi;
#pragma unroll
            for (int q = 0; q < 8; ++q) { const int ex = 16 * (q >> 2) + 4 * g + (q & 3); if (ex == mi) v[q] = -3.0e38f; }
        }
        const float e1 = __expf(tv[1] - tv[0]), e2 = __expf(tv[2] - tv[0]), e3 = __expf(tv[3] - tv[0]); const float inv = 1.0f / (1.0f + e1 + e2 + e3);
        if (g == 0) {
            gt_[0] = inv; gt_[1] = e1 * inv; gt_[2] = e2 * inv; gt_[3] = e3 * inv; rs_ = rstd;
#pragma unroll
            for (int k = 0; k < 4; ++k) { te_[k] = te[k]; lr_[k] = atomicAdd((int*)&hist[te[k]], 1); }
        }
        }
        __syncthreads();
        if (F.tid < 32) base[F.tid] = hist[F.tid] != 0 ? atomicAdd((int*)(F.ws + WS_CTL) + F.tid, hist[F.tid]) : 0;
        __syncthreads();
        if (act && g == 0) { int code[4];
#pragma unroll
            for (int k = 0; k < 4; ++k) { const int e = te_[k], pos = base[e] + lr_[k]; const size_t o = (size_t)e * T + pos;
                EROWTOK[o] = t; EROWRS[o] = rs_; EROWGATE[o] = gt_[k]; code[k] = (e << 15) | pos; }
            *(int4*)(TOKCODE + t * 4) = make_int4(code[0], code[1], code[2], code[3]); }
        __syncthreads();
        if (F.tid < 32) hist[F.tid] = 0;
        __syncthreads();
    }
}
__device__ __forceinline__ const LAS int* build_ptile(Frame& F) {
    LAS int* pt = (LAS int*)(F.lds + MISC_OFF + 256);
    __syncthreads();
    if (F.tid == 0) { const int* cnt = (const int*)(F.ws + WS_CTL); int o = 0; for (int e = 0; e < 32; ++e) { pt[e] = o; o += (cnt[e] + 255) >> 8; } pt[32] = o; }
    __syncthreads();
    return pt;
}
__device__ __forceinline__ void phase_router_b(Frame& F) {
    const LAS int* pt = build_ptile(F);
    LAS int* hist = (LAS int*)(F.lds + MISC_OFF); LAS int* base = hist + 32;
    const int* TOPE = (const int*)(F.ws + WS_TOPE); const float* TOPG = (const float*)(F.ws + WS_TOPG); const float* TOKRS = (const float*)(F.ws + WS_TOKRS);
    int* ROWTOK = (int*)(F.ws + WS_ROWTOK); float* ROWGATE = (float*)(F.ws + WS_ROWGATE); float* ROWRS = (float*)(F.ws + WS_ROWRS); int* TOKROW = (int*)(F.ws + WS_TOKROW);
    int* cursor = (int*)(F.ws + WS_CTL) + 64; const int* cnt = (const int*)(F.ws + WS_CTL);
    for (int chunk = F.bid; chunk < T * 4 / NTHREADS; chunk += F.G) {
        __syncthreads();
        if (F.tid < 32) hist[F.tid] = 0;
        __syncthreads();
        const int idx = chunk * NTHREADS + F.tid; const int e = TOPE[idx]; const int lr = atomicAdd((int*)&hist[e], 1);
        __syncthreads();
        if (F.tid < 32) base[F.tid] = hist[F.tid] ? atomicAdd(cursor + F.tid, hist[F.tid]) : 0;
        __syncthreads();
        const int row = pt[e] * 256 + base[e] + lr;
        ROWTOK[row] = idx >> 2; ROWGATE[row] = TOPG[idx]; ROWRS[row] = TOKRS[idx >> 2]; TOKROW[idx] = row;
    }
    if (F.bid == 0) for (int e = F.wave; e < 32; e += NWAVES) { const int r0 = pt[e] * 256 + cnt[e], r1 = pt[e + 1] * 256; for (int r = r0 + F.lane; r < r1; r += 64) { ROWTOK[r] = 0; ROWGATE[r] = 0.f; ROWRS[r] = 0.f; } }
}
#ifdef YS_FP8
__device__ __forceinline__ void phase_final(Frame& F) {
    const int gw = F.bid * NWAVES + F.wave, NGW = F.G * NWAVES;
    float* out = F.out; const bf16_t* HB = (const bf16_t*)(F.ws + WS_HN); const unsigned char* YS8 = (const unsigned char*)(F.ws + WS_YS); const int* TOKROW = (const int*)(F.ws + WS_TOKROW); const float* g = F.in[32];
    const LAS int* pt = build_ptile(F);
    struct In { u32x4 h[2]; u32x2 y[4][2]; };
    auto issue = [&](int t, const int4 rows, In& I) {
#pragma unroll
        for (int j = 0; j < 2; ++j) I.h[j] = ((const u32x4*)(HB + (size_t)t * D))[F.lane + 64 * j];
#pragma unroll
        for (int k = 0; k < 4; ++k) { const int code = k == 0 ? rows.x : k == 1 ? rows.y : k == 2 ? rows.z : rows.w; const size_t row = (size_t)(pt[code >> 15] * 256 + (code & 32767));
#pragma unroll
            for (int j = 0; j < 2; ++j) I.y[k][j] = ((const u32x2*)(YS8 + row * D))[F.lane + 64 * j]; } };
    auto finish = [&](int t, const In& I) {
        float v[2][8]; float s = 0.f;
#pragma unroll
        for (int j = 0; j < 2; ++j) { const unsigned hw[4] = {I.h[j].x, I.h[j].y, I.h[j].z, I.h[j].w};
#pragma unroll
            for (int i = 0; i < 4; ++i) { v[j][2 * i] = __uint_as_float(hw[i] << 16); v[j][2 * i + 1] = __uint_as_float(hw[i] & 0xffff0000u); }
#pragma unroll
            for (int k = 0; k < 4; ++k) { const f32x2 a = __builtin_amdgcn_cvt_pk_f32_fp8((int)I.y[k][j].x, false), b = __builtin_amdgcn_cvt_pk_f32_fp8((int)I.y[k][j].x, true),
                                                      c = __builtin_amdgcn_cvt_pk_f32_fp8((int)I.y[k][j].y, false), d = __builtin_amdgcn_cvt_pk_f32_fp8((int)I.y[k][j].y, true);
                v[j][0] += a.x; v[j][1] += a.y; v[j][2] += b.x; v[j][3] += b.y; v[j][4] += c.x; v[j][5] += c.y; v[j][6] += d.x; v[j][7] += d.y; }
#pragma unroll
            for (int i = 0; i < 8; ++i) s += v[j][i] * v[j][i]; }
        const float rstd = rsqrtf(wave_sum(s) * (1.0f / D) + EPS);
#pragma unroll
        for (int j = 0; j < 2; ++j) { const f32x4 g0 = ((const f32x4*)g)[2 * (F.lane + 64 * j)], g1 = ((const f32x4*)g)[2 * (F.lane + 64 * j) + 1];
            f32x4* o = (f32x4*)(out + (size_t)t * D) + 2 * (F.lane + 64 * j);
            o[0] = (f32x4){v[j][0] * rstd * g0.x, v[j][1] * rstd * g0.y, v[j][2] * rstd * g0.z, v[j][3] * rstd * g0.w};
            o[1] = (f32x4){v[j][4] * rstd * g1.x, v[j][5] * rstd * g1.y, v[j][6] * rstd * g1.z, v[j][7] * rstd * g1.w}; } };
    int t = gw;
    int4 rowsA = make_int4(0, 0, 0, 0), rowsB = make_int4(0, 0, 0, 0); In dA, dB;
    if (t < T) rowsA = *(const int4*)(TOKROW + t * 4);
    if (t + NGW < T) rowsB = *(const int4*)(TOKROW + (t + NGW) * 4);
    if (t < T) issue(t, rowsA, dA);
#pragma unroll 1
    for (; t < T; t += 2 * NGW) {
        const int t1 = t + NGW, t2 = t + 2 * NGW, t3 = t + 3 * NGW;
        if (t2 < T) rowsA = *(const int4*)(TOKROW + t2 * 4);
        if (t1 < T) issue(t1, rowsB, dB);
        finish(t, dA);
        if (t1 >= T) break;
        if (t3 < T) rowsB = *(const int4*)(TOKROW + t3 * 4);
        if (t2 < T) issue(t2, rowsA, dA);
        finish(t1, dB);
    }
}
#else
__device__ __forceinline__ void phase_final(Frame& F) {
    const int gw = F.bid * NWAVES + F.wave, NGW = F.G * NWAVES;
    float* out = F.out; const bf16_t* HB = (const bf16_t*)(F.ws + WS_HN); const bf16_t* YS = (const bf16_t*)(F.ws + WS_YS); const int* TOKROW = (const int*)(F.ws + WS_TOKROW); const float* g = F.in[32];
    const LAS int* pt = build_ptile(F);
    auto issue = [&](int t, const int4 rows, u32x2 (&d)[5][4]) {
#pragma unroll
        for (int j = 0; j < 4; ++j) d[0][j] = ((const u32x2*)(HB + (size_t)t * D))[F.lane + 64 * j];
#pragma unroll
        for (int k = 0; k < 4; ++k) { const int code = k == 0 ? rows.x : k == 1 ? rows.y : k == 2 ? rows.z : rows.w; const size_t row = (size_t)(pt[code >> 15] * 256 + (code & 32767));
#pragma unroll
            for (int j = 0; j < 4; ++j) d[1 + k][j] = ((const u32x2*)(YS + row * D))[F.lane + 64 * j]; } };
    auto finish = [&](int t, const u32x2 (&d)[5][4]) {
        f32x4 v[4];
#pragma unroll
        for (int j = 0; j < 4; ++j) { v[j] = (f32x4){__uint_as_float(d[0][j].x << 16), __uint_as_float(d[0][j].x & 0xffff0000u), __uint_as_float(d[0][j].y << 16), __uint_as_float(d[0][j].y & 0xffff0000u)};
#pragma unroll
            for (int k = 1; k < 5; ++k) { const u32x2 w = d[k][j];
                v[j].x += __uint_as_float(w.x << 16); v[j].y += __uint_as_float(w.x & 0xffff0000u); v[j].z += __uint_as_float(w.y << 16); v[j].w += __uint_as_float(w.y & 0xffff0000u); } }
        float s = 0.f;
#pragma unroll
        for (int j = 0; j < 4; ++j) s += v[j].x * v[j].x + v[j].y * v[j].y + v[j].z * v[j].z + v[j].w * v[j].w;
        const float rstd = rsqrtf(wave_sum(s) * (1.0f / D) + EPS);
#pragma unroll
        for (int j = 0; j < 4; ++j) { const f32x4 gg = ((const f32x4*)g)[F.lane + 64 * j];
            ((f32x4*)(out + (size_t)t * D))[F.lane + 64 * j] = (f32x4){v[j].x * rstd * gg.x, v[j].y * rstd * gg.y, v[j].z * rstd * gg.z, v[j].w * rstd * gg.w}; } };
    int t = gw;
    int4 rowsA = make_int4(0, 0, 0, 0), rowsB = make_int4(0, 0, 0, 0); u32x2 dA[5][4], dB[5][4];
    if (t < T) rowsA = *(const int4*)(TOKROW + t * 4);
    if (t + NGW < T) rowsB = *(const int4*)(TOKROW + (t + NGW) * 4);
    if (t < T) issue(t, rowsA, dA);
#pragma unroll 1
    for (; t < T; t += 2 * NGW) {
        const int t1 = t + NGW, t2 = t + 2 * NGW, t3 = t + 3 * NGW;
        if (t2 < T) rowsA = *(const int4*)(TOKROW + t2 * 4);
        if (t1 < T) issue(t1, rowsB, dB);
        finish(t, dA);
        if (t1 >= T) break;
        if (t3 < T) rowsB = *(const int4*)(TOKROW + t3 * 4);
        if (t2 < T) issue(t2, rowsA, dA);
        finish(t1, dB);
    }
}

#endif
__global__ void __launch_bounds__(NTHREADS, 2) mega(Args args) {
    extern __shared__ __attribute__((aligned(16))) unsigned char lds_raw[];
    cg::grid_group grid = cg::this_grid();
    Frame F; F.lds = (LAS unsigned char*)lds_raw; F.tid = threadIdx.x; F.lane = F.tid & 63; F.wave = __builtin_amdgcn_readfirstlane(F.tid >> 6); F.G = gridDim.x; F.bid = blockIdx.x;
    F.in = args.in; F.out = args.out; F.ws = args.ws;
    const int lo = args.ph_lo, hi = args.ph_hi;
    if (F.tid < 2) ((LAS unsigned*)(F.lds + MISC_OFF + 512))[F.tid] = 0u;
    __syncthreads();
    (void)xcd_barrier_post((unsigned*)(args.ws + WS_CTL + 16384) + args.li * XCD_BAR_WORDS, (volatile LAS unsigned*)(F.lds + MISC_OFF + 512));
#ifndef STAG1
#define STAG1 650
#endif
#define IN(k) (lo <= (k) && (k) < hi)
#define FRESH() do { size_t z_ = 0; F.tid = threadIdx.x; asm volatile("" : "+s"(z_), "+v"(F.tid)); F.ws = args.ws + z_; F.lane = F.tid & 63; ws = F.ws; } while (0)
#ifdef PROBE_PHASE
#define TS(k) do { if (blockIdx.x == 0 && threadIdx.x == 0) ((unsigned long long*)(args.ws + WS_CTL + 2048))[k] = __builtin_amdgcn_s_memrealtime(); } while (0)
#else
#define TS(k) do {} while (0)
#endif
#define SEAM(k) do { if (IN(k) && IN((k) + 1)) { if (hi > 1000) grid.sync();   else { XcdBarrier xb_; xb_.bar = (unsigned*)(args.ws + WS_CTL + 16384) + args.li * XCD_BAR_WORDS; xb_.x = xb_xcc_id(); xb_.st = (volatile LAS unsigned*)(F.lds + MISC_OFF + 512); xcd_barrier(xb_); if ((DUPMASK >> 21) & 1) xcd_barrier(xb_); } } } while (0)
    unsigned char* ws = args.ws;
    if (IN(0)) { TS(0); FRESH(); REP(0) phase_prep(F); } SEAM(0);
    if (IN(1)) { TS(1); FRESH();
        pg8::SchedDenseT<1> S; S.bias = args.in[3]; S.O.init(T / 256, NIN / 256, F.G, F.bid); S.A = (const char*)(ws + WS_U); S.B = (const char*)(ws + WS_WIN);
        pg8::EpiIn E{(bf16_t*)(ws + WS_P0), (bf16_t*)(ws + WS_P1), (bf16_t*)(ws + WS_PHY), (bf16_t*)(ws + WS_PG), args.in[3]};
#ifdef DESYNC1
        const int nbefore_ = DESYNC1 == 2 ? (((F.bid >> 3) & 1) ? 0 : 4) : DESYNC1 == 4 ? ((F.bid >> 3) & 3) : DESYNC1 == 3 ? 2 * ((F.bid >> 3) & 1) + 1 : 0;
        if (nbefore_ > 0) { hy::init_tw128(F); hy::filter_pass_a<false>(F, 0, nbefore_); __syncthreads(); }
#endif
        pg8::gemm_phase<pg8::EpiIn, pg8::SchedDenseT<1>, false>(F.lds, S, E); if ((DUPMASK >> 1) & 1) { pg8::gemm_phase<pg8::EpiIn, pg8::SchedDenseT<1>, false>(F.lds, S, E); } if ((DUPMASK >> 13) & 1) { pg8::EpiProbeStore E1{(bf16_t*)(ws + WS_YZ)}; pg8::gemm_phase<pg8::EpiProbeStore, pg8::SchedDenseT<1>, false>(F.lds, S, E1); } if ((DUPMASK >> 12) & 1) { pg8::EpiNone E0; pg8::gemm_phase<pg8::EpiNone, pg8::SchedDenseT<1>, false>(F.lds, S, E0); }
        if ((DUPMASK >> 18) & 1) { pg8::EpiNone E0; pg8::SchedDenseProbe SP; SP.O = S.O; SP.A = S.A; SP.B = S.B; pg8::gemm_phase<pg8::EpiNone, pg8::SchedDenseProbe, false>(F.lds, SP, E0); }
#ifdef DESYNC1
        if (nbefore_ < 4) { __syncthreads(); hy::init_tw128(F); hy::filter_pass_a<false>(F, nbefore_); }
#else
        hy::init_tw128(F); if ((DUPMASK >> 14) & 1) hy::filter_pass_a<true>(F); hy::filter_pass_a<false>(F);
#endif
    } SEAM(1);
#ifdef P2_ALTERNATE
    if (IN(2)) { TS(2); FRESH();
        const bool rev_ = ((F.bid >> 3) & 1) != 0;
        if (!rev_) { lru::stage1(F); __syncthreads(); hy::init_tw128(F); hy::filter_pass_b<false>(F); hy::prepass(F); }
        else { hy::prepass(F); __syncthreads(); FRESH(); hy::init_tw128(F); hy::filter_pass_b<false>(F); __syncthreads(); FRESH(); lru::stage1(F); }
    } SEAM(2);
#else
    if (IN(2)) { TS(2); FRESH(); REP(4) lru::stage1(F); __syncthreads(); hy::init_tw128(F); if ((DUPMASK >> 15) & 1) hy::filter_pass_b<true>(F); hy::filter_pass_b<false>(F); REP(2) hy::prepass(F); } SEAM(2);
#endif
    if (IN(3)) { TS(3); FRESH(); hy::init_tw128(F); REP(3) hy::data_pass_a(F); } SEAM(3);
    if (IN(4)) { TS(4); FRESH(); REP(16) lru::carry(F); hy::init_tw128(F); if ((DUPMASK >> 17) & 1) hy::data_pass_b<true>(F); hy::data_pass_b<false>(F); } SEAM(4);
    if (IN(5)) { TS(5); FRESH(); hy::init_tw128(F); if ((DUPMASK >> 5) & 1) hy::data_pass_c<true>(F); hy::data_pass_c<false>(F); __syncthreads(); REP(6) lru::stage2(F); } SEAM(5);
    if (IN(6)) { TS(6); FRESH();
        pg8::SchedMix S; S.O.init(T / 256, D / 256, F.G, F.bid); S.A0 = (const char*)(ws + WS_YLRU); S.A1 = (const char*)(ws + WS_YHY); S.B0 = (const char*)(ws + WS_WLRU); S.B1 = (const char*)(ws + WS_WHY);
        pg8::EpiMix E{(const bf16_t*)(ws + WS_PG), (bf16_t*)(ws + WS_MIX)};
#ifdef MIXDESYNC
        const int cls_ = (F.bid >> 3) & 3; constexpr int RND_ = MIXDESYNC;
        if (cls_ > 0) { convert_weights<0, false>(F, F.bid, F.G, 0, RND_ * cls_ / 4); __syncthreads(); }
#endif
        pg8::gemm_phase<pg8::EpiMix, pg8::SchedMix, false>(F.lds, S, E); if ((DUPMASK >> 7) & 1) { pg8::gemm_phase<pg8::EpiMix, pg8::SchedMix, false>(F.lds, S, E); }
#ifdef MIXDESYNC
        __syncthreads(); convert_weights<0, false>(F, F.bid, F.G, RND_ * cls_ / 4, RND_);
#endif
    } SEAM(6);
    if (IN(7)) { TS(7); FRESH();
        pg8::SchedDenseT<0> S; S.bias = nullptr; S.O.init(T / 256, D / 256, F.G, F.bid); S.A = (const char*)(ws + WS_MIX); S.B = (const char*)(ws + WS_WOUT);
        pg8::EpiH E{args.in[0], (bf16_t*)(ws + WS_HN)};
        { u32x4* z = (u32x4*)(ws + WS_EROWTOK); const u32x4 z4 = (u32x4){0u, 0u, 0u, 0u};
          for (int i = F.bid * NTHREADS + F.tid; i < 3 * NE * T / 4; i += F.G * NTHREADS) z[i] = z4; }
#ifdef MIXDESYNC
        const int cls_ = (F.bid >> 3) & 3; constexpr int RND_ = MIXDESYNC; const int rrem_ = RND_;
        if (cls_ > 0) { convert_weights<0, false>(F, F.bid, F.G, RND_, RND_ + rrem_ * cls_ / 4); __syncthreads(); }
#endif
        pg8::gemm_phase<pg8::EpiH, pg8::SchedDenseT<0>, false>(F.lds, S, E); if ((DUPMASK >> 8) & 1) { pg8::gemm_phase<pg8::EpiH, pg8::SchedDenseT<0>, false>(F.lds, S, E); }
#ifdef MIXDESYNC
        __syncthreads(); convert_weights<0, false>(F, F.bid, F.G, RND_ + rrem_ * cls_ / 4, 2 * RND_);
#endif
    } SEAM(7);
    if (IN(8)) { TS(8); FRESH(); phase_router_a(F); } SEAM(8);
    if (IN(10)) { TS(10); FRESH();
        const LAS int* pt = build_ptile(F);
        pg8::SchedMoE<8, true> S{args.in[29], (const float*)(ws + WS_EROWRS), pt, F.G, F.bid, (const char*)(ws + WS_HN), (const char*)(ws + WS_WGU), (size_t)2048 * 1024 * 2, (const int*)(ws + WS_EROWTOK)};
        pg8::EpiGU E{args.in[29], (const float*)(ws + WS_ROWRS), (bf16_t*)(ws + WS_ACT)};
#ifdef DESYNC_GU
        { const int rounds_ = (pt[32] * 8 + F.G - 1) / F.G; pg8::Unit u_; if (!S.next(rounds_ - 1, u_)) stagger_delay(1, DESYNC_GU); }
#endif
        pg8::gemm_phase<pg8::EpiGU, pg8::SchedMoE<8, true>, true>(F.lds, S, E); if ((DUPMASK >> 9) & 1) { pg8::gemm_phase<pg8::EpiGU, pg8::SchedMoE<8, true>, true>(F.lds, S, E); }
        if ((DUPMASK >> 19) & 1) { pg8::EpiNone E0; pg8::gemm_phase<pg8::EpiNone, pg8::SchedMoE<8, true>, true>(F.lds, S, E0); }
    } SEAM(10);
    if (IN(11)) { TS(11); FRESH();
        const LAS int* pt = build_ptile(F);
        pg8::SchedMoE<4, false> S{args.in[31], (const float*)(ws + WS_EROWGATE), pt, F.G, F.bid, (const char*)(ws + WS_ACT), (const char*)(ws + WS_WDN), (size_t)1024 * 1024 * 2, nullptr};
        pg8::EpiDN E{args.in[31], (const float*)(ws + WS_ROWGATE), (bf16_t*)(ws + WS_YS)};
#ifdef DESYNC_DN
        { const int rounds_ = (pt[32] * 4 + F.G - 1) / F.G; pg8::Unit u_; if (!S.next(rounds_ - 1, u_)) stagger_delay(1, DESYNC_DN); }
#endif
        pg8::gemm_phase<pg8::EpiDN, pg8::SchedMoE<4, false>, false>(F.lds, S, E); if ((DUPMASK >> 10) & 1) { pg8::gemm_phase<pg8::EpiDN, pg8::SchedMoE<4, false>, false>(F.lds, S, E); }
        if ((DUPMASK >> 20) & 1) { pg8::EpiNone E0; pg8::gemm_phase<pg8::EpiNone, pg8::SchedMoE<4, false>, false>(F.lds, S, E0); }
    } SEAM(11);
    if (IN(12)) { TS(12); FRESH(); phase_final(F); }
#undef IN
#undef SEAM
}
static int g_grid = 0;
static void launch_mega(Args a, int lo, int hi, hipStream_t stream, int li = 0) {
    a.ph_lo = lo; a.ph_hi = hi; a.li = li; a.pad = 0; void* params[] = {&a};
    hipError_t e = hipLaunchCooperativeKernel((const void*)mega, dim3(g_grid), dim3(NTHREADS), params, LDS_BYTES, stream);
    if (e != hipSuccess) fprintf(stderr, "kernel_launch: cooperative launch [%d,%d) failed: %s (grid %d)\n", lo, hi, hipGetErrorString(e), g_grid);
}
extern "C" void kernel_launch(void* const* d_in, const int* in_sizes, int n_in, void* d_out, int out_size, void* d_ws, size_t ws_size, hipStream_t stream) {
    if (n_in != 33 || out_size != T * D || ws_size < WS_END) { fprintf(stderr, "kernel_launch: unexpected shapes n_in %d out %d ws %zu\n", n_in, out_size, ws_size); return; }
    if (g_grid == 0) {
        int dev = 0, cus = 0, per_cu = 0;
        (void)hipGetDevice(&dev); (void)hipDeviceGetAttribute(&cus, hipDeviceAttributeMultiprocessorCount, dev);
        if (hipFuncSetAttribute((const void*)mega, hipFuncAttributeMaxDynamicSharedMemorySize, LDS_BYTES) != hipSuccess) { fprintf(stderr, "kernel_launch: hipFuncSetAttribute failed\n"); g_grid = -1; return; }
        if (hipOccupancyMaxActiveBlocksPerMultiprocessor(&per_cu, (const void*)mega, NTHREADS, LDS_BYTES) != hipSuccess || per_cu < 1) { fprintf(stderr, "kernel_launch: occupancy query says %d\n", per_cu); g_grid = -1; return; }
        g_grid = cus;
    }
    if (g_grid < 0) return;
    const float* in[33]; for (int i = 0; i < 33; ++i) in[i] = (const float*)d_in[i];
    unsigned char* ws = (unsigned char*)d_ws; float* out = (float*)d_out;
    int* cnt = (int*)(ws + WS_CTL); float* NORM = (float*)(ws + WS_NORM); float* HH3 = (float*)(ws + WS_HH3);
    bf16_t* YLRU = (bf16_t*)(ws + WS_YLRU); bf16_t* HN = (bf16_t*)(ws + WS_HN); bf16_t* YHY = (bf16_t*)(ws + WS_YHY);
    bf16_t* PG = (bf16_t*)(ws + WS_PG); bf16_t* P0 = (bf16_t*)(ws + WS_P0); bf16_t* P1 = (bf16_t*)(ws + WS_P1); bf16_t* PHY = (bf16_t*)(ws + WS_PHY);
    bf16_t* MIX = (bf16_t*)(ws + WS_MIX); float* MIXF = (float*)(ws + WS_MIXF); bf16_t* ACT = (bf16_t*)(ws + WS_ACT); bf16_t* YS = (bf16_t*)(ws + WS_YS);
    float* XR = (float*)(ws + WS_XR); float* HF = (float*)(ws + WS_HF); float* KC = (float*)(ws + WS_KC);
    int* ROWTOK = (int*)(ws + WS_ROWTOK); float* ROWGATE = (float*)(ws + WS_ROWGATE); float* ROWRS = (float*)(ws + WS_ROWRS);
    (void)hipMemsetAsync(ws + WS_CTL, 0, CTL_BYTES, stream);
    Args a{}; for (int i = 0; i < 33; ++i) a.in[i] = in[i]; a.out = out; a.ws = ws;
    launch_mega(a, 0, 13, stream);
}
```

```cpp
#define DUPMASK 0x0
#define DESYNC1 4
#define DN_REVERSE 1
#define P2_ALTERNATE 1
#define YS_FP8 1
#define YZ_BF8 1
#define KF_BF8 1
#define DN_FP8 1
#include <hip/hip_runtime.h>
#include <hip/hip_cooperative_groups.h>
#include <cstdio>
#include <cstdint>
namespace cg = cooperative_groups;

typedef unsigned short bf16_t;
typedef float f32x4 __attribute__((ext_vector_type(4)));
typedef float f32x2 __attribute__((ext_vector_type(2)));
typedef unsigned u32x4 __attribute__((ext_vector_type(4)));
typedef unsigned u32x2 __attribute__((ext_vector_type(2)));
typedef short bf16x8 __attribute__((ext_vector_type(8)));

constexpr int T = 32768, D = 1024, L = 8192, NB = 4, NE = 32, TOPK = 4, NIN = 7168, L2X = 16384;
constexpr int HEADS = 16, HBLK = 64, HYFF = 64, HYEMB = 33;
constexpr int NPAD = T * TOPK + NE * 256;
constexpr float EPS = 1e-5f;

constexpr size_t MiB = 1u << 20;
constexpr size_t WS_CTL = 0;
constexpr size_t CTL_BYTES = 64 * 1024;
constexpr size_t WS_NORM = 4096;
constexpr size_t WS_HH3 = 2 * MiB;
constexpr size_t WS_WRG = 4 * MiB;
constexpr size_t WS_TOPE = 5 * MiB;
constexpr size_t WS_TOPG = 6 * MiB;
constexpr size_t WS_TOKRS = 7 * MiB;
constexpr size_t WS_ROWTOK = 8 * MiB;
constexpr size_t WS_ROWGATE = 9 * MiB;
constexpr size_t WS_ROWRS = 10 * MiB;
constexpr size_t WS_TOKROW = 11 * MiB;
constexpr size_t WS_WF4 = 14 * MiB;
constexpr size_t WS_NORMP = 15 * MiB;
constexpr size_t WS_EROWTOK = 164 * MiB, WS_EROWRS = 168 * MiB, WS_EROWGATE = 172 * MiB;
constexpr size_t WS_WLRUF = 13 * MiB;
constexpr size_t WS_SUMM = 996 * MiB;
constexpr size_t WS_CARRY = 1004 * MiB;
constexpr size_t WS_WIN = 16 * MiB;
constexpr size_t WS_WLRU = 30 * MiB, WS_WHY = 32 * MiB, WS_WOUT = 34 * MiB;
constexpr size_t WS_U = 36 * MiB;
constexpr size_t WS_Z16 = 36 * MiB, WS_HN = 36 * MiB;
constexpr size_t WS_YHY = 100 * MiB;
constexpr size_t WS_PG = 164 * MiB;
constexpr size_t WS_P0 = 292 * MiB;
constexpr size_t WS_P1 = 356 * MiB;
constexpr size_t WS_PHY = 420 * MiB;
constexpr size_t WS_MIX = 356 * MiB;
constexpr size_t WS_HS = 740 * MiB;
constexpr size_t WS_YLRU = 292 * MiB;
constexpr size_t WS_AF = 804 * MiB, WS_AB = 932 * MiB;
constexpr size_t WS_MIXF = 484 * MiB;
constexpr size_t WS_ACT = 292 * MiB;
constexpr size_t WS_R2 = 612 * MiB;
constexpr size_t WS_YZ = 612 * MiB;
constexpr size_t WS_KF = 868 * MiB;
constexpr size_t WS_WDN = 612 * MiB;
constexpr size_t WS_WGU = 676 * MiB;
constexpr size_t WS_YS = 676 * MiB;
constexpr size_t WS_XR = 612 * MiB;
constexpr size_t WS_HF = 740 * MiB;
constexpr size_t WS_KC = 868 * MiB;
constexpr size_t WS_END = 1024 * MiB;

__device__ __forceinline__ float bf2f(bf16_t b) { return __uint_as_float(((unsigned)b) << 16); }
__device__ __forceinline__ bf16_t f2bf(float f) { unsigned u = __float_as_uint(f); u += 0x7fffu + ((u >> 16) & 1u); return (bf16_t)(u >> 16); }
__device__ __forceinline__ unsigned pk2(float lo, float hi) { unsigned r; asm("v_cvt_pk_bf16_f32 %0, %1, %2" : "=v"(r) : "v"(lo), "v"(hi)); return r; }
__device__ __forceinline__ float fexp(float x) { return __builtin_amdgcn_exp2f(x * 1.4426950408889634f); }
__device__ __forceinline__ float sigmoidf_(float x) { return __builtin_amdgcn_rcpf(1.0f + fexp(-x)); }
__device__ __forceinline__ float gelu_tanh(float x) { const float u = 0.7978845608028654f * (x + 0.044715f * x * x * x); return x * sigmoidf_(2.0f * u); }
__device__ __forceinline__ float swiglu(float g, float u) { const float g_ = fminf(g, 7.0f); const float u_ = fminf(fmaxf(u, -7.0f), 7.0f); return (u_ + 1.0f) * (g_ * sigmoidf_(1.702f * g_)); }
__device__ __forceinline__ float wave_sum(float v) {
#pragma unroll
    for (int o = 1; o < 64; o <<= 1) v += __shfl_xor(v, o);
    return v;
}
__device__ __forceinline__ int expert_offpad(const int* cnt, int e) { int o = 0; for (int i = 0; i < e; ++i) o += (cnt[i] + 255) & ~255; return o; }
__device__ __forceinline__ float hy_delta_abs(int c) {
    const float lo = -4.605170185988091f / 1.5f, hi = -4.605170185988091f / 0.3f;
    return fabsf(lo + (hi - lo) * ((float)c / 1023.0f));
}
#define LAS __attribute__((address_space(3)))
constexpr int NWAVES = 8, NTHREADS = 512, LDS_BYTES = 147456, MISC_OFF = 131072;

typedef long l64x2 __attribute__((ext_vector_type(2)));
namespace pg8 {
constexpr int BM = 256, BK = 64, HALF = 128, HTB = HALF * BK * 2, NXCD = 8, WGM = 8, KD = 1024;
__host__ __device__ __forceinline__ int lds_byte(int r, int c) { const int st = (r >> 4) * 2 + (c >> 5), rr = r & 15, cc = c & 31, ob = rr * 64 + cc * 2; return st * 1024 + (ob ^ (((ob >> 9) & 1) << 5)); }
__host__ __device__ __forceinline__ void stage_rc(int b, int& R, int& C) { const int st = b / 1024, sb = b % 1024, swz = sb ^ (((sb >> 9) & 1) << 5); R = (st >> 1) * 16 + swz / 64; C = (st & 1) * 32 + (swz % 64) / 2; }
__host__ __device__ __forceinline__ int perm32(int rho) { const int n = rho >> 4, i = rho & 15; return 8 * (i >> 2) + 4 * n + (i & 3); }

struct Unit { const char* A; const char* B; int pm, pn, e, gm; };

struct DenseOrder {
    int nM, nN, nwg, G, c;
    __device__ __forceinline__ void init(int nM_, int nN_, int G_, int c_) { nM = nM_; nN = nN_; nwg = nM * nN; G = G_; c = c_; }
    __device__ __forceinline__ bool tile(int i, int& pm, int& pn) const {
        const long Lx = (long)i * G + c; if (Lx >= nwg) return false;
        int wgid = (int)Lx; { const int q = nwg / NXCD, r = nwg % NXCD, xcd = wgid % NXCD, off = wgid / NXCD; wgid = (xcd < r ? xcd * (q + 1) : r * (q + 1) + (xcd - r) * q) + off; }
        const int nig = WGM * nN, gid = wgid / nig, fm = gid * WGM, gsz = (nM - fm) < WGM ? (nM - fm) : WGM;
        pm = fm + ((wgid % nig) % gsz); pn = (wgid % nig) / gsz; return true;
    }
};

__device__ __forceinline__ unsigned cvt_pk_bf16(float lo, float hi) { unsigned r; asm volatile("v_cvt_pk_bf16_f32 %0, %1, %2" : "=v"(r) : "v"(lo), "v"(hi)); return r; }

template <class Epi, class Sched, bool GATHER, int ESZ = 2>
__device__ __forceinline__ void gemm_phase(LAS unsigned char* lds, const Sched& S, const Epi& E) {
    int tid_ = threadIdx.x; asm volatile("" : "+v"(tid_));
    const int tid = tid_, wid = __builtin_amdgcn_readfirstlane(tid >> 6), lane = tid & 63, wr = wid >> 2, wc = wid & 3, fr = lane & 15, fq = lane >> 4;
    constexpr int K = KD, ROWB = K * ESZ  , nt = ROWB / (BK * 2);
    int Rr[2], Cc[2]; unsigned voffB[2];
#pragma unroll
    for (int i = 0; i < 2; ++i) { int R, C; stage_rc(tid * 16 + i * 8192, R, C); Rr[i] = R; Cc[i] = C; const int Rb = (R & ~31) + perm32(R & 31); voffB[i] = (unsigned)(Rb * ROWB + C * 2); }
    constexpr size_t kstep = (size_t)(BK * 2);
    constexpr size_t hstep = (size_t)HALF * ROWB;
    const unsigned ldsw = (unsigned)wid * 1024u;
    const int aoff = lds_byte(wr * 64 + fr, fq * 8), boff = lds_byte(wc * 32 + fr, fq * 8);
#define PG8_SA(b, h) (((b) * 2 + (h)) * HTB)
#define PG8_SB(b, h) ((4 + (b) * 2 + (h)) * HTB)
#define PG8_GLDS(gp, lp) __builtin_amdgcn_global_load_lds((const unsigned*)(gp), (LAS unsigned*)(lp), 16, 0, 0)
#define PG8_STAGEB(bufoff, gbase) do { PG8_GLDS((const char*)(gbase) + voffB[0], lds + (bufoff) + ldsw); PG8_GLDS((const char*)(gbase) + voffB[1], lds + (bufoff) + ldsw + 8192); } while (0)
#define PG8_STAGEA(bufoff, gbase, o0, o1) do { PG8_GLDS((const char*)(gbase) + (o0), lds + (bufoff) + ldsw); PG8_GLDS((const char*)(gbase) + (o1), lds + (bufoff) + ldsw + 8192); } while (0)
#define PG8_LDA(dst, b, h) do { _Pragma("unroll") for (int m = 0; m < 4; ++m) _Pragma("unroll") for (int k = 0; k < 2; ++k) dst[m][k] = *(const LAS bf16x8*)(lds + PG8_SA(b, h) + aoff + m * 2048 + k * 1024); } while (0)
#define PG8_LDB(dst, b, h) do { _Pragma("unroll") for (int n = 0; n < 2; ++n) _Pragma("unroll") for (int k = 0; k < 2; ++k) dst[n][k] = *(const LAS bf16x8*)(lds + PG8_SB(b, h) + boff + n * 2048 + k * 1024); } while (0)
#define PG8_MMA(ai, bj, At, Bt) do { __builtin_amdgcn_s_setprio(1); _Pragma("unroll") for (int m = 0; m < 4; ++m) _Pragma("unroll") for (int n = 0; n < 2; ++n) _Pragma("unroll") for (int k = 0; k < 2; ++k) \
        { if constexpr (ESZ == 2) acc[ai][bj][m][n] = __builtin_amdgcn_mfma_f32_16x16x32_bf16(Bt[n][k], At[m][k], acc[ai][bj][m][n], 0, 0, 0); \
          else { const l64x2 b_ = __builtin_bit_cast(l64x2, Bt[n][k]), a_ = __builtin_bit_cast(l64x2, At[m][k]); \
                 acc[ai][bj][m][n] = __builtin_amdgcn_mfma_f32_16x16x32_fp8_fp8(b_.x, a_.x, acc[ai][bj][m][n], 0, 0, 0); acc[ai][bj][m][n] = __builtin_amdgcn_mfma_f32_16x16x32_fp8_fp8(b_.y, a_.y, acc[ai][bj][m][n], 0, 0, 0); } } \
        __builtin_amdgcn_s_setprio(0); } while (0)
#define PG8_WAIT_V(n) asm volatile("s_waitcnt vmcnt(" #n ")" ::: "memory")
#define PG8_WAIT_L(n) asm volatile("s_waitcnt lgkmcnt(" #n ")" ::: "memory")
#define PG8_WAIT_V8_UNLESS(flag) asm volatile("s_cmp_lg_u32 %0, 0\n\ts_cbranch_scc1 .Lskipw%=\n\ts_waitcnt vmcnt(8)\n.Lskipw%=:" :: "s"(flag) : "scc", "memory")
#define PG8_BAR __builtin_amdgcn_s_barrier()
#define PG8_SCHED __builtin_amdgcn_sched_barrier(0)
    Unit cur, nxt; int ui = 0;
    if (!S.next(0, cur)) return;
    LAS int* tokbuf = (LAS int*)(lds + MISC_OFF + 3072);
#define PG8_AOFF(par, h, i) (GATHER ? ((unsigned)tokbuf[(par) * 256 + (h) * HALF + Rr[i]] * (unsigned)ROWB + (unsigned)(Cc[i] * 2)) : ((unsigned)(Rr[i] * ROWB + Cc[i] * 2) + (unsigned)((h) * hstep)))
    LAS float* side = (LAS float*)(lds + MISC_OFF + 6144);
    if (GATHER || Sched::NSIDE > 0) {
        if (GATHER && tid < 256) tokbuf[tid] = S.ROWTOK_row(cur, tid);
        if (Sched::NSIDE > 0 && tid < 256 * Sched::NSIDE) side[tid] = *S.side_addr(cur, tid >> 8, tid & 255);
        asm volatile("s_waitcnt vmcnt(0) lgkmcnt(0)" ::: "memory"); __builtin_amdgcn_s_barrier(); }
    f32x4 acc[2][2][4][2];
#pragma unroll
    for (int a = 0; a < 2; ++a)
#pragma unroll
        for (int b = 0; b < 2; ++b)
#pragma unroll
            for (int m = 0; m < 4; ++m)
#pragma unroll
                for (int n = 0; n < 2; ++n) acc[a][b][m][n] = (f32x4){0.f, 0.f, 0.f, 0.f};
    bf16x8 At[4][2], B0[2][2], B1[2][2];
    const char* cA = cur.A; const char* cB = cur.B;
    PG8_STAGEB(PG8_SB(0, 0), cB); PG8_STAGEB(PG8_SB(0, 1), cB + hstep); PG8_STAGEA(PG8_SA(0, 0), cA, PG8_AOFF(0, 0, 0), PG8_AOFF(0, 0, 1)); PG8_STAGEA(PG8_SA(0, 1), cA, PG8_AOFF(0, 1, 0), PG8_AOFF(0, 1, 1));
    if (wr == 1) PG8_BAR;
    PG8_WAIT_V(2); PG8_BAR;
    PG8_STAGEB(PG8_SB(1, 0), cB + kstep); PG8_STAGEA(PG8_SA(1, 0), cA + kstep, PG8_AOFF(0, 0, 0), PG8_AOFF(0, 0, 1)); PG8_STAGEB(PG8_SB(1, 1), cB + hstep + kstep);
    PG8_WAIT_V(6); PG8_BAR;
    for (;;) {
        const bool has_next = S.next(ui + 1, nxt);
        const char* nA = has_next ? nxt.A : cA; const char* nB = has_next ? nxt.B : cB;
        const int pc = ui & 1, pn_ = has_next ? (pc ^ 1) : pc;
        if (Sched::NSIDE > 0 && has_next && wid < 4 * Sched::NSIDE) __builtin_amdgcn_global_load_lds((const unsigned*)S.side_addr(nxt, wid >> 2, (wid & 3) * 64 + lane), (LAS unsigned*)(side + ((ui + 1) % 3) * 512 + wid * 64), 4, 0, 0);
        if (GATHER && has_next && wid < 4) __builtin_amdgcn_global_load_lds((const unsigned*)(S.ROWTOK + S.rowoff(nxt) + wid * 64 + lane), (LAS unsigned*)(tokbuf + pn_ * 256 + wid * 64), 4, 0, 0);
        for (int t = 0; t < nt; t += 2) {
            const bool last = (t == nt - 2);
            const char* a1 = cA + (size_t)(t + 1) * kstep;
            const char* a2 = last ? nA : cA + (size_t)(t + 2) * kstep; const char* b2 = last ? nB : cB + (size_t)(t + 2) * kstep;
            const char* a3 = a2 + kstep; const char* b3 = b2 + kstep;
            const int px = last ? pn_ : pc;
            PG8_LDB(B0, 0, 0); PG8_LDB(B1, 0, 1); PG8_SCHED; PG8_LDA(At, 0, 0); PG8_STAGEA(PG8_SA(1, 1), a1, PG8_AOFF(pc, 1, 0), PG8_AOFF(pc, 1, 1));
            PG8_WAIT_V(8); PG8_WAIT_L(0); PG8_BAR; PG8_MMA(0, 0, At, B0); PG8_MMA(0, 1, At, B1); PG8_BAR; PG8_SCHED;
            PG8_LDA(At, 0, 1); PG8_STAGEB(PG8_SB(0, 0), b2); PG8_STAGEB(PG8_SB(0, 1), b2 + hstep); PG8_STAGEA(PG8_SA(0, 0), a2, PG8_AOFF(px, 0, 0), PG8_AOFF(px, 0, 1));
            PG8_WAIT_V(8); PG8_WAIT_L(0); PG8_BAR; PG8_MMA(1, 0, At, B0); PG8_MMA(1, 1, At, B1); PG8_BAR; PG8_SCHED;
            PG8_LDB(B0, 1, 0); PG8_LDB(B1, 1, 1); PG8_SCHED; PG8_LDA(At, 1, 0); PG8_STAGEA(PG8_SA(0, 1), a2, PG8_AOFF(px, 1, 0), PG8_AOFF(px, 1, 1));
            PG8_WAIT_V(8); PG8_WAIT_L(0); PG8_BAR; PG8_MMA(0, 0, At, B0); PG8_MMA(0, 1, At, B1); PG8_BAR; PG8_SCHED;
            PG8_LDA(At, 1, 1); PG8_STAGEB(PG8_SB(1, 0), b3); PG8_STAGEB(PG8_SB(1, 1), b3 + hstep); PG8_STAGEA(PG8_SA(1, 0), a3, PG8_AOFF(px, 0, 0), PG8_AOFF(px, 0, 1));
            PG8_WAIT_V(8); PG8_WAIT_L(0); PG8_BAR; PG8_MMA(1, 0, At, B0); PG8_MMA(1, 1, At, B1); PG8_BAR; PG8_SCHED;
        }
        if (wr == 0) PG8_BAR;
        bool keep = false;
        if constexpr (Epi::CHAIN) keep = E(acc, cur, wr, wc, fr, fq, (const LAS float*)(side + (ui % 3) * 512)); else E(acc, cur, wr, wc, fr, fq, (const LAS float*)(side + (ui % 3) * 512));
        if (!has_next) break;
        if (!keep) {
#pragma unroll
        for (int a = 0; a < 2; ++a)
#pragma unroll
            for (int b = 0; b < 2; ++b)
#pragma unroll
                for (int m = 0; m < 4; ++m)
#pragma unroll
                    for (int n = 0; n < 2; ++n) acc[a][b][m][n] = (f32x4){0.f, 0.f, 0.f, 0.f};
        }
        cur = nxt; cA = nA; cB = nB; ++ui;
        if (wr == 1) PG8_BAR;
    }
    PG8_WAIT_V(0);
    PG8_BAR;
#undef PG8_SA
#undef PG8_AOFF
#undef PG8_SB
#undef PG8_GLDS
#undef PG8_STAGEA
#undef PG8_STAGEB
#undef PG8_LDA
#undef PG8_LDB
#undef PG8_MMA
#undef PG8_WAIT_V
#undef PG8_WAIT_L
#undef PG8_WAIT_V8_UNLESS
#undef PG8_BAR
#undef PG8_SCHED
}

__device__ __forceinline__ void store8bf(bf16_t* p, const f32x4 v0, const f32x4 v1) {
    u32x4 w; w.x = cvt_pk_bf16(v0[0], v0[1]); w.y = cvt_pk_bf16(v0[2], v0[3]); w.z = cvt_pk_bf16(v1[0], v1[1]); w.w = cvt_pk_bf16(v1[2], v1[3]); *(u32x4*)p = w;
}
__device__ __forceinline__ void load8bf(const bf16_t* p, f32x4& v0, f32x4& v1) {
    const u32x4 w = *(const u32x4*)p;
    v0 = (f32x4){__uint_as_float(w.x << 16), __uint_as_float(w.x & 0xffff0000u), __uint_as_float(w.y << 16), __uint_as_float(w.y & 0xffff0000u)};
    v1 = (f32x4){__uint_as_float(w.z << 16), __uint_as_float(w.z & 0xffff0000u), __uint_as_float(w.w << 16), __uint_as_float(w.w & 0xffff0000u)};
}
__device__ __forceinline__ f32x2 lo2(const f32x4 v) { return (f32x2){v.x, v.y}; }
__device__ __forceinline__ f32x2 hi2(const f32x4 v) { return (f32x2){v.z, v.w}; }
__device__ __forceinline__ f32x2 sigmoid2(const f32x2 x) { const f32x2 t = x * -1.4426950408889634f; const f32x2 d = (f32x2){__builtin_amdgcn_exp2f(t.x), __builtin_amdgcn_exp2f(t.y)} + 1.0f; return (f32x2){__builtin_amdgcn_rcpf(d.x), __builtin_amdgcn_rcpf(d.y)}; }
__device__ __forceinline__ f32x2 swiglu2(const f32x2 g, const f32x2 u) {
    const f32x2 g_ = (f32x2){fminf(g.x, 7.0f), fminf(g.y, 7.0f)}; const f32x2 u_ = (f32x2){fminf(fmaxf(u.x, -7.0f), 7.0f), fminf(fmaxf(u.y, -7.0f), 7.0f)};
    const f32x2 t = g_ * (-1.702f * 1.4426950408889634f); const f32x2 d = (f32x2){__builtin_amdgcn_exp2f(t.x), __builtin_amdgcn_exp2f(t.y)} + 1.0f;
    const f32x2 p = g_ * (f32x2){__builtin_amdgcn_rcpf(d.x), __builtin_amdgcn_rcpf(d.y)}; return u_ * p + p; }
__device__ __forceinline__ void store8bf2(bf16_t* p, const f32x2 a, const f32x2 b, const f32x2 c, const f32x2 d) {
    u32x4 w; w.x = cvt_pk_bf16(a.x, a.y); w.y = cvt_pk_bf16(b.x, b.y); w.z = cvt_pk_bf16(c.x, c.y); w.w = cvt_pk_bf16(d.x, d.y); *(u32x4*)p = w; }
#define EPI_ROWS(ai, m) ((ai) * HALF + wr * 64 + (m) * 16 + fr)
#define EPI_COLS(bj) ((bj) * HALF + wc * 32 + 8 * fq)

struct EpiNone {
    static constexpr bool CHAIN = false;
    __device__ __forceinline__ void operator()(const f32x4 (&acc)[2][2][4][2], const Unit&, int, int, int, int, const LAS float*) const {
#pragma unroll
        for (int a = 0; a < 2; ++a)
#pragma unroll
            for (int b = 0; b < 2; ++b)
#pragma unroll
                for (int m = 0; m < 4; ++m)
#pragma unroll
                    for (int n = 0; n < 2; ++n) asm volatile("" :: "v"(acc[a][b][m][n]));
    }
};
struct EpiProbeStore {
    static constexpr bool CHAIN = false;
    bf16_t* dst;
    __device__ __forceinline__ void operator()(const f32x4 (&acc)[2][2][4][2], const Unit& u, int wr, int wc, int fr, int fq, const LAS float* side) const {
#pragma unroll
        for (int ai = 0; ai < 2; ++ai)
#pragma unroll
            for (int m = 0; m < 4; ++m) {
#if defined(PROBE_LOCAL)
                bf16_t* rowp = dst + (size_t)(blockIdx.x * 256 + EPI_ROWS(ai, m)) * 256;
#elif defined(PROBE_MIXED)
                bf16_t* rowp = (blockIdx.x & 3) ? dst + (size_t)(blockIdx.x * 256 + EPI_ROWS(ai, m)) * 256 : dst + (size_t)(u.pm * BM + EPI_ROWS(ai, m)) * 4096 + (u.pn & 15) * 256;
#elif defined(PROBE_WIDE)
                bf16_t* rowp = dst + (size_t)(u.pm * BM + EPI_ROWS(ai, m)) * 4096 + (u.pn & 15) * 256;
#else
                bf16_t* rowp = dst + (size_t)(u.pm * BM + EPI_ROWS(ai, m)) * 1024 + (u.pn & 3) * 256;
#endif
#pragma unroll
                for (int bj = 0; bj < 2; ++bj) store8bf(rowp + EPI_COLS(bj), acc[ai][bj][m][0], acc[ai][bj][m][1]); }
    }
};
struct EpiIn {
    static constexpr bool CHAIN = false;
    bf16_t *P0, *P1, *PHY, *PG; const float* bias;
    __device__ __forceinline__ void operator()(const f32x4 (&acc)[2][2][4][2], const Unit& u, int wr, int wc, int fr, int fq, const LAS float* side) const {
        const int seg = u.pn >> 2; bf16_t* dst; int ld, colt; int act = 0;
        if (seg == 0) { dst = P0; ld = 1024; colt = u.pn * 256; }
        else if (seg == 1) { dst = P1; ld = 1024; colt = u.pn * 256 - 1024; }
        else if (seg < 5) { dst = PHY; ld = 3072; colt = u.pn * 256 - 2048; }
        else { dst = PG; ld = 2048; colt = (u.pn - 20) * 128; act = 2; }
        f32x4 bv[2][2];
#pragma unroll
        for (int bj = 0; bj < 2; ++bj)
#pragma unroll
            for (int n = 0; n < 2; ++n) bv[bj][n] = *(const LAS f32x4*)(side + EPI_COLS(bj) + 4 * n);
        if (act == 2) {
#pragma unroll
            for (int ai = 0; ai < 2; ++ai)
#pragma unroll
                for (int m = 0; m < 4; ++m) { bf16_t* rowp = dst + (size_t)(u.pm * BM + EPI_ROWS(ai, m)) * ld + colt + wc * 32 + 8 * fq;
                    f32x2 rho[4], sh[4];
#pragma unroll
                    for (int n = 0; n < 2; ++n)
#pragma unroll
                        for (int hh = 0; hh < 2; ++hh) {
                            const f32x2 al = (hh ? hi2(acc[ai][0][m][n]) : lo2(acc[ai][0][m][n])) + (hh ? hi2(bv[0][n]) : lo2(bv[0][n]));
                            f32x2 ah = (hh ? hi2(acc[ai][1][m][n]) : lo2(acc[ai][1][m][n])) + (hh ? hi2(bv[1][n]) : lo2(bv[1][n]));
                            ah = (f32x2){fmaxf(ah.x, -80.0f), fmaxf(ah.y, -80.0f)};
                            const f32x2 tl = al * -1.4426950408889634f, th = ah * -1.4426950408889634f;
                            const f32x2 dl = (f32x2){__builtin_amdgcn_exp2f(tl.x), __builtin_amdgcn_exp2f(tl.y)} + 1.0f, dh = (f32x2){__builtin_amdgcn_exp2f(th.x), __builtin_amdgcn_exp2f(th.y)} + 1.0f;
                            sh[2 * n + hh] = (f32x2){__builtin_amdgcn_rcpf(dh.x), __builtin_amdgcn_rcpf(dh.y)};
                            rho[2 * n + hh] = dh * (f32x2){__builtin_amdgcn_rcpf(dl.x), __builtin_amdgcn_rcpf(dl.y)}; }
                    store8bf2(rowp, rho[0], rho[1], rho[2], rho[3]); store8bf2(rowp + 1024, sh[0], sh[1], sh[2], sh[3]); }
            return;
        }
#pragma unroll
        for (int ai = 0; ai < 2; ++ai)
#pragma unroll
            for (int m = 0; m < 4; ++m) { bf16_t* rowp = dst + (size_t)(u.pm * BM + EPI_ROWS(ai, m)) * ld + colt;
#pragma unroll
                for (int bj = 0; bj < 2; ++bj) { f32x2 a = lo2(acc[ai][bj][m][0]) + lo2(bv[bj][0]), b = hi2(acc[ai][bj][m][0]) + hi2(bv[bj][0]), c = lo2(acc[ai][bj][m][1]) + lo2(bv[bj][1]), d = hi2(acc[ai][bj][m][1]) + hi2(bv[bj][1]);
                    store8bf2(rowp + EPI_COLS(bj), a, b, c, d); } }
    }
};
struct EpiMix {
    static constexpr bool CHAIN = true;
    const bf16_t* PG; bf16_t* MIX;
    __device__ __forceinline__ bool operator()(f32x4 (&acc)[2][2][4][2], const Unit& u, int wr, int wc, int fr, int fq, const LAS float*) const {
#pragma unroll
        for (int ai = 0; ai < 2; ++ai)
#pragma unroll
            for (int m = 0; m < 4; ++m) { const size_t row = (size_t)(u.pm * BM + EPI_ROWS(ai, m));
#pragma unroll
                for (int bj = 0; bj < 2; ++bj) { const int col = u.pn * 256 + EPI_COLS(bj);
                    f32x4 h0, h1; load8bf(PG + row * 2048 + (u.e == 0 ? 0 : 1024) + col, h0, h1);
                    if (u.e == 0) { acc[ai][bj][m][0] *= h0; acc[ai][bj][m][1] *= h1; }
                    else store8bf(MIX + row * 1024 + col, h0 * acc[ai][bj][m][0], h1 * acc[ai][bj][m][1]); } }
        return u.e == 0;
    }
};
struct EpiH {
    static constexpr bool CHAIN = false;
    const float* x; bf16_t* HB;
    __device__ __forceinline__ void operator()(const f32x4 (&acc)[2][2][4][2], const Unit& u, int wr, int wc, int fr, int fq, const LAS float* side) const {
#pragma unroll
        for (int ai = 0; ai < 2; ++ai)
#pragma unroll
            for (int m = 0; m < 4; ++m) { const size_t row = (size_t)(u.pm * BM + EPI_ROWS(ai, m));
#pragma unroll
                for (int bj = 0; bj < 2; ++bj) { const size_t o = row * 1024 + u.pn * 256 + EPI_COLS(bj);
                    const f32x4 v0 = *(const f32x4*)(x + o) + acc[ai][bj][m][0], v1 = *(const f32x4*)(x + o + 4) + acc[ai][bj][m][1];
                    store8bf(HB + o, v0, v1); } }
    }
};
struct EpiGU {
    static constexpr bool CHAIN = false;
    const float* bgu; const float* ROWRS; bf16_t* ACT;
    __device__ __forceinline__ void operator()(const f32x4 (&acc)[2][2][4][2], const Unit& u, int wr, int wc, int fr, int fq, const LAS float* side) const {
        const int colp = u.pn * 128 + wc * 32 + 8 * fq;
        f32x4 bg[2], bu[2];
#pragma unroll
        for (int n = 0; n < 2; ++n) { bg[n] = *(const LAS f32x4*)(side + wc * 32 + 8 * fq + 4 * n); bu[n] = *(const LAS f32x4*)(side + 128 + wc * 32 + 8 * fq + 4 * n); }
#pragma unroll
        for (int ai = 0; ai < 2; ++ai)
#pragma unroll
            for (int m = 0; m < 4; ++m) { const size_t row = (size_t)u.gm * BM + EPI_ROWS(ai, m); const float rs = side[256 + EPI_ROWS(ai, m)];
                f32x2 o[4];
#pragma unroll
                for (int n = 0; n < 2; ++n) {
                    o[2 * n] = swiglu2(lo2(acc[ai][0][m][n]) * rs + lo2(bg[n]), lo2(acc[ai][1][m][n]) * rs + lo2(bu[n]));
                    o[2 * n + 1] = swiglu2(hi2(acc[ai][0][m][n]) * rs + hi2(bg[n]), hi2(acc[ai][1][m][n]) * rs + hi2(bu[n])); }
#ifdef DN_FP8
                { int w0 = __builtin_amdgcn_cvt_pk_fp8_f32(o[0].x, o[0].y, 0, false); w0 = __builtin_amdgcn_cvt_pk_fp8_f32(o[1].x, o[1].y, w0, true);
                  int w1 = __builtin_amdgcn_cvt_pk_fp8_f32(o[2].x, o[2].y, 0, false); w1 = __builtin_amdgcn_cvt_pk_fp8_f32(o[3].x, o[3].y, w1, true);
                  *(u32x2*)((unsigned char*)ACT + row * 1024 + colp) = (u32x2){(unsigned)w0, (unsigned)w1}; } }
#else
                store8bf2(ACT + row * 1024 + colp, o[0], o[1], o[2], o[3]); }
#endif
    }
};
struct EpiDN {
    static constexpr bool CHAIN = false;
    const float* bdn; const float* ROWGATE; bf16_t* YS;
    __device__ __forceinline__ void operator()(const f32x4 (&acc)[2][2][4][2], const Unit& u, int wr, int wc, int fr, int fq, const LAS float* side) const {
        f32x4 bv[2][2];
#pragma unroll
        for (int bj = 0; bj < 2; ++bj)
#pragma unroll
            for (int n = 0; n < 2; ++n) bv[bj][n] = *(const LAS f32x4*)(side + EPI_COLS(bj) + 4 * n);
#pragma unroll
        for (int ai = 0; ai < 2; ++ai)
#pragma unroll
            for (int m = 0; m < 4; ++m) { const size_t row = (size_t)u.gm * BM + EPI_ROWS(ai, m); const float gt = side[256 + EPI_ROWS(ai, m)];
#pragma unroll
                for (int bj = 0; bj < 2; ++bj) {
                    const f32x2 a = (lo2(acc[ai][bj][m][0]) + lo2(bv[bj][0])) * gt, b = (hi2(acc[ai][bj][m][0]) + hi2(bv[bj][0])) * gt, c = (lo2(acc[ai][bj][m][1]) + lo2(bv[bj][1])) * gt, d = (hi2(acc[ai][bj][m][1]) + hi2(bv[bj][1])) * gt;
#ifdef YS_FP8
                    int w0 = __builtin_amdgcn_cvt_pk_fp8_f32(a.x, a.y, 0, false); w0 = __builtin_amdgcn_cvt_pk_fp8_f32(b.x, b.y, w0, true);
                    int w1 = __builtin_amdgcn_cvt_pk_fp8_f32(c.x, c.y, 0, false); w1 = __builtin_amdgcn_cvt_pk_fp8_f32(d.x, d.y, w1, true);
                    *(u32x2*)((unsigned char*)YS + row * 1024 + u.pn * 256 + EPI_COLS(bj)) = (u32x2){(unsigned)w0, (unsigned)w1};
#else
                    store8bf2(YS + row * 1024 + u.pn * 256 + EPI_COLS(bj), a, b, c, d);
#endif
                } }
    }
};

template <int NS> struct SchedDenseT {
    static constexpr int NSIDE = NS; const float* bias;
    __device__ __forceinline__ const float* side_addr(const Unit& u, int, int idx) const {
        const int p = u.pn - 20; return p < 0 ? bias + u.pn * 256 + idx : bias + (idx < 128 ? 5120 + 128 * p + idx : 6144 + 128 * p + (idx - 128)); }
    DenseOrder O; const char* A; const char* B;
    __device__ __forceinline__ bool next(int i, Unit& u) const { int pm, pn; if (!O.tile(i, pm, pn)) return false; u.pm = pm; u.pn = pn; u.e = 0; u.gm = pm;
        u.A = A + (size_t)pm * (BM * KD * 2); u.B = B + (size_t)pn * (BM * KD * 2); return true; }
    static constexpr const unsigned* ROWTOK = nullptr; __device__ __forceinline__ int ROWTOK_row(const Unit&, int) const { return 0; } __device__ __forceinline__ size_t rowoff(const Unit&) const { return 0; }
};
struct SchedDenseProbe {
    static constexpr int NSIDE = 0; __device__ __forceinline__ const float* side_addr(const Unit&, int, int) const { return nullptr; }
    DenseOrder O; const char* A; const char* B;
    __device__ __forceinline__ bool next(int i, Unit& u) const { int pm, pn; if (!O.tile(i, pm, pn)) return false; u.pm = pm; u.pn = pn; u.e = 0; u.gm = pm;
        u.A = A + (size_t)(pm & 1) * (BM * KD * 2); u.B = B + (size_t)(pn & 1) * (BM * KD * 2); return true; }
    static constexpr const unsigned* ROWTOK = nullptr; __device__ __forceinline__ int ROWTOK_row(const Unit&, int) const { return 0; } __device__ __forceinline__ size_t rowoff(const Unit&) const { return 0; }
};
struct SchedMix {
    static constexpr int NSIDE = 0; __device__ __forceinline__ const float* side_addr(const Unit&, int, int) const { return nullptr; }
    DenseOrder O; const char* A0; const char* A1; const char* B0; const char* B1;
    __device__ __forceinline__ bool next(int i, Unit& u) const { int pm, pn; if (!O.tile(i >> 1, pm, pn)) return false; const int w = i & 1; u.pm = pm; u.pn = pn; u.e = w; u.gm = pm;
        u.A = (w ? A1 : A0) + (size_t)pm * (BM * KD * 2); u.B = (w ? B1 : B0) + (size_t)pn * (BM * KD * 2); return true; }
    static constexpr const unsigned* ROWTOK = nullptr; __device__ __forceinline__ int ROWTOK_row(const Unit&, int) const { return 0; } __device__ __forceinline__ size_t rowoff(const Unit&) const { return 0; }
};
template <int NT, bool GATHER> struct SchedMoE {
    static constexpr int NSIDE = 2; const float* sbias; const float* srow;
    __device__ __forceinline__ const float* side_addr(const Unit& u, int k, int idx) const {
        if (k == 1) return srow + (size_t)u.e * T + u.pm + idx;
        return NT == 8 ? sbias + u.e * 2048 + (idx < 128 ? 128 * u.pn + idx : 1024 + 128 * u.pn + idx - 128) : sbias + u.e * 1024 + 256 * u.pn + idx; }
    const LAS int* ptile; int G, c; const char* A; const char* B; size_t bstride  ; const int* ROWTOK; int esz = 2  ;
    __device__ __forceinline__ bool next(int i, Unit& u) const {
        const int ngm = __builtin_amdgcn_readfirstlane(ptile[32]);
        int gm, pn;
        if (G == 256) {
            const int x = c & 7, y = c >> 3; gm = i * (256 / NT) + x * (32 / NT) + y / NT; pn = y % NT;
#ifdef LAST_SPREAD
            if ((i + 1) * (256 / NT) > ngm) gm = i * (256 / NT) + (y / NT) * 8 + x;
#endif
            if (gm >= ngm) return false;
#ifdef DN_REVERSE
            if (NT == 4) gm = ngm - 1 - gm;
#endif
        } else { const long Lx = (long)i * G + c; if (Lx >= (long)ngm * NT) return false; gm = (int)(Lx / NT); pn = (int)(Lx % NT); }
        int e = 0;
#pragma unroll 1
        for (int q = 1; q < 32; ++q) e += (__builtin_amdgcn_readfirstlane(ptile[q]) <= gm) ? 1 : 0;
        u.pm = (gm - __builtin_amdgcn_readfirstlane(ptile[e])) * BM; u.gm = gm; u.pn = pn; u.e = e;
        u.A = GATHER ? A : A + (size_t)gm * (BM * KD * esz); u.B = B + (size_t)e * bstride + (size_t)pn * (BM * KD * esz); return true; }
    __device__ __forceinline__ int ROWTOK_row(const Unit& u, int r) const { return GATHER ? ROWTOK[(size_t)u.e * T + u.pm + r] : 0; }
    __device__ __forceinline__ size_t rowoff(const Unit& u) const { return (size_t)u.e * T + u.pm; }
};
}
struct Args { const float* in[33]; float* out; unsigned char* ws; int ph_lo, ph_hi, li, pad; };
#define LDS_WAIT() asm volatile("s_waitcnt lgkmcnt(0)" ::: "memory")

struct Frame {
    LAS unsigned char* lds; int tid, lane, wave, G, bid; const float* const* in; float* out; unsigned char* ws;
};

#ifndef DUPMASK
#define DUPMASK 0
#endif
#define REP(bit) for (int rep_ = 0; rep_ < (((DUPMASK >> (bit)) & 1) ? 2 : 1); ++rep_)

#define XB_TMO      128
#define XB_XCNT(j)  (256  + 64 * (j))
#define XB_XSUB(j)  (1280 + 64 * (j))
#define XB_XGEN(j)  (2304 + 64 * (j))
#define XB_TOP      3328
#define XB_TOPGEN   3392
#define XCD_BAR_WORDS 3456
#define XB_SPIN_CAP (1u << 18)

__device__ __forceinline__ unsigned xb_ld(unsigned* p)              { return __hip_atomic_load(p, __ATOMIC_RELAXED, __HIP_MEMORY_SCOPE_AGENT); }
__device__ __forceinline__ unsigned xb_add(unsigned* p, unsigned v) { return __hip_atomic_fetch_add(p, v, __ATOMIC_RELAXED, __HIP_MEMORY_SCOPE_AGENT); }
__device__ __forceinline__ unsigned xb_xcc_id() { return (unsigned)__builtin_amdgcn_s_getreg((3 << 11) | 20) & 0xFu; }
#define XB_SPIN(cond, bar) do { unsigned _sp = 0; while (cond) { __builtin_amdgcn_s_sleep(1); \
    if ((++_sp & 255u) == 0u) { if (xb_ld(&(bar)[XB_TMO])) break; if (_sp > XB_SPIN_CAP) { atomicAdd(&(bar)[XB_TMO], 1u); break; } } } } while (0)

struct XcdBarrier {
    unsigned* bar; unsigned x;
    volatile LAS unsigned* st;
};

__device__ __forceinline__ XcdBarrier xcd_barrier_post(unsigned* bar, volatile LAS unsigned* st) {
    XcdBarrier b; b.bar = bar; b.x = xb_xcc_id(); b.st = st;
    if (threadIdx.x == 0) (void)xb_add(&bar[XB_XCNT(b.x)], 1u);
    return b;
}
__device__ __forceinline__ void xcd_barrier_complete(unsigned* bar, unsigned x, unsigned& nloc, unsigned& nx) {
    const unsigned G = gridDim.x * gridDim.y * gridDim.z;
    unsigned sum, cnt, mine, sp = 0u;
    for (;;) {
        sum = 0u; cnt = 0u; mine = 0u;
#pragma unroll
        for (unsigned j = 0; j < 16; ++j) { const unsigned c = xb_ld(&bar[XB_XCNT(j)]); sum += c; cnt += (c > 0u) ? 1u : 0u; mine = (j == x) ? c : mine; }
        if (sum == G) break;
        __builtin_amdgcn_s_sleep(1);
        if ((++sp & 255u) == 0u) { if (xb_ld(&bar[XB_TMO])) break; if (sp > XB_SPIN_CAP) { atomicAdd(&bar[XB_TMO], 1u); break; } }
    }
    nloc = mine > 0u ? mine : 1u; nx = cnt > 0u ? cnt : 1u;
}

__device__ __forceinline__ void xcd_barrier(const XcdBarrier& b) {
    asm volatile("s_waitcnt vmcnt(0)" ::: "memory");
    __syncthreads();
    if (threadIdx.x == 0) {
        unsigned* bar = b.bar;
        __builtin_amdgcn_s_waitcnt(0);
        unsigned nloc = b.st[0], nx = b.st[1];
        if (nloc == 0u) { xcd_barrier_complete(bar, b.x, nloc, nx); b.st[0] = nloc; b.st[1] = nx; }
        const unsigned old = xb_add(&bar[XB_XSUB(b.x)], 1u);
        const unsigned gen = old / nloc;
        if (old + 1u == (gen + 1u) * nloc) {
            __builtin_amdgcn_fence(__ATOMIC_RELEASE, "agent");
            asm volatile("s_waitcnt vmcnt(0)" ::: "memory");
            const unsigned og = xb_add(&bar[XB_TOP], 1u);
            const unsigned tg = og / nx;
            if (og + 1u == (tg + 1u) * nx) xb_add(&bar[XB_TOPGEN], 1u);
            else XB_SPIN(xb_ld(&bar[XB_TOPGEN]) == tg, bar);
            __builtin_amdgcn_fence(__ATOMIC_ACQUIRE, "agent");
            xb_add(&bar[XB_XGEN(b.x)], 1u);
            asm volatile("s_waitcnt vmcnt(0)" ::: "memory");
        } else {
            XB_SPIN(xb_ld(&bar[XB_XGEN(b.x)]) == gen, bar);
            __builtin_amdgcn_fence(__ATOMIC_ACQUIRE, "agent");
            asm volatile("s_waitcnt vmcnt(0)" ::: "memory");
        }
    }
    __syncthreads();
}


__device__ __forceinline__ void stagger_delay(int cls, int ticks_per_class) {
    if (cls > 0) { const unsigned long long t0 = __builtin_amdgcn_s_memrealtime(); const unsigned long long want = (unsigned long long)(cls * ticks_per_class);
        while (__builtin_amdgcn_s_memrealtime() - t0 < want) __builtin_amdgcn_s_sleep(32); }
}
namespace hy {
constexpr int TW128_OFF = MISC_OFF + 1024, TWT_OFF = MISC_OFF + 2048;

__host__ __device__ constexpr float twc16(int m) { return m == 0 ? 1.f : m == 1 ? 0.92387953251128674f : m == 2 ? 0.70710678118654752f : m == 3 ? 0.38268343236508977f : m == 4 ? 0.f : m == 5 ? -0.38268343236508977f : m == 6 ? -0.70710678118654752f : -0.92387953251128674f; }
__host__ __device__ constexpr float tws16(int m) { return m == 0 ? 0.f : m == 1 ? 0.38268343236508977f : m == 2 ? 0.70710678118654752f : m == 3 ? 0.92387953251128674f : m == 4 ? 1.f : m == 5 ? 0.92387953251128674f : m == 6 ? 0.70710678118654752f : 0.38268343236508977f; }
template <int N> __host__ __device__ constexpr int brev(int i) { int r = 0; for (int b = 1, c = N >> 1; b < N; b <<= 1, c >>= 1) if (i & b) r |= c; return r; }

typedef f32x2 P2;
template <int N, bool INV> __device__ __forceinline__ void fft_reg(P2 (&xr)[N], P2 (&xi)[N]) {
#pragma unroll
    for (int len = N; len >= 2; len >>= 1) {
        const int half = len >> 1;
#pragma unroll
        for (int start = 0; start < N; start += len) {
#pragma unroll
            for (int j = 0; j < half; ++j) {
                const int i0 = start + j, i1 = i0 + half;
                const P2 ar = xr[i0], ai = xi[i0], br = xr[i1], bi = xi[i1];
                xr[i0] = ar + br; xi[i0] = ai + bi;
                const P2 tr = ar - br, ti = ai - bi;
                const int m = j * (16 / len);
                if (m == 0) { xr[i1] = tr; xi[i1] = ti; }
                else if (m == 4) { if (INV) { xr[i1] = -ti; xi[i1] = tr; } else { xr[i1] = ti; xi[i1] = -tr; } }
                else { const float c = twc16(m), s = INV ? tws16(m) : -tws16(m); xr[i1] = tr * c - ti * s; xi[i1] = tr * s + ti * c; }
            }
        }
    }
}
__device__ __forceinline__ unsigned pkh(float a, float b) { return __builtin_bit_cast(unsigned, __builtin_amdgcn_cvt_pkrtz(a, b)); }
__device__ __forceinline__ u32x2 pkc(const P2 re, const P2 im) { u32x2 r; r.x = pkh(re.x, re.y); r.y = pkh(im.x, im.y); return r; }
__device__ __forceinline__ float h2f_lo(unsigned u) { return (float)__builtin_bit_cast(_Float16, (unsigned short)(u & 0xffffu)); }
__device__ __forceinline__ float h2f_hi(unsigned u) { return (float)__builtin_bit_cast(_Float16, (unsigned short)(u >> 16)); }
__device__ __forceinline__ P2 unpk2(unsigned u) { return (P2){h2f_lo(u), h2f_hi(u)}; }
#ifdef YZ_BF8
typedef unsigned yz_t;
__device__ __forceinline__ yz_t pkyz(const P2 re, const P2 im) { int v = __builtin_amdgcn_cvt_pk_bf8_f32(re.x, re.y, 0, false); v = __builtin_amdgcn_cvt_pk_bf8_f32(im.x, im.y, v, true); return (unsigned)v; }
__device__ __forceinline__ P2 yzre(const yz_t u) { return __builtin_amdgcn_cvt_pk_f32_bf8((int)u, false); }
__device__ __forceinline__ P2 yzim(const yz_t u) { return __builtin_amdgcn_cvt_pk_f32_bf8((int)u, true); }
#ifdef KF_BF8
constexpr float KF_SCALE = 64.0f, YZ_ZSCALE = 1.0f / 1024.0f;
#else
constexpr float KF_SCALE = 1.0f, YZ_ZSCALE = 1.0f / 16.0f;
#endif
#else
typedef u32x2 yz_t;
__device__ __forceinline__ yz_t pkyz(const P2 re, const P2 im) { return pkc(re, im); }
__device__ __forceinline__ P2 yzre(const yz_t u) { return unpk2(u.x); }
__device__ __forceinline__ P2 yzim(const yz_t u) { return unpk2(u.y); }
constexpr float YZ_ZSCALE = 1.0f, KF_SCALE = 1.0f;
#endif
#ifdef KF_BF8
typedef yz_t kf_t;
#define KF_PK(re, im) pkyz(re, im)
#define KF_RE(u) yzre(u)
#define KF_IM(u) yzim(u)
#else
typedef u32x2 kf_t;
#define KF_PK(re, im) pkc(re, im)
#define KF_RE(u) unpk2((u).x)
#define KF_IM(u) unpk2((u).y)
#endif
__device__ __forceinline__ P2 bf2p(unsigned u) { return (P2){__uint_as_float(u << 16), __uint_as_float(u & 0xffff0000u)}; }
__device__ __forceinline__ void cmul(P2& xr, P2& xi, float c, float s) { const P2 r = xr * c - xi * s, i = xr * s + xi * c; xr = r; xi = i; }

__device__ __forceinline__ void init_tw128(Frame& F) {
    __syncthreads();
    if (F.tid < 128) { float s, c; sincospif((float)F.tid * (1.0f / 64.0f), &s, &c); ((LAS f32x2*)(F.lds + TW128_OFF))[F.tid] = (f32x2){c, s}; }
    __syncthreads();
}
__device__ __forceinline__ void tile_tw(Frame& F, int a, bool inv) {
    if (F.tid < 128) { const int m = (a * F.tid) & (L2X - 1); float s, c; sincospif((float)m * (1.0f / 8192.0f), &s, &c); ((LAS f32x2*)(F.lds + TWT_OFF))[F.tid] = (f32x2){c, inv ? s : -s}; }
}
template <bool INV> __device__ __forceinline__ void stage1(Frame& F, P2 (&xr)[16], P2 (&xi)[16], int s) {
    fft_reg<16, INV>(xr, xi);
    const LAS f32x2* tw = (const LAS f32x2*)(F.lds + TW128_OFF); LAS f32x4* tile = (LAS f32x4*)F.lds;
#pragma unroll
    for (int q = 0; q < 16; ++q) { const int p = brev<16>(q); const f32x2 w = tw[s * q]; const float c = w.x, sn = INV ? w.y : -w.y;
        P2 a = xr[p], b = xi[p]; cmul(a, b, c, sn);
        tile[(s * 16 + q) * 64 + F.lane] = (f32x4){a.x, a.y, b.x, b.y}; }
}
__device__ __forceinline__ void stage2_read(Frame& F, P2 (&xr)[8], P2 (&xi)[8], int qq) {
    const LAS f32x4* tile = (const LAS f32x4*)F.lds;
#pragma unroll
    for (int s = 0; s < 8; ++s) { const f32x4 v = tile[(s * 16 + qq) * 64 + F.lane]; xr[s] = (P2){v.x, v.y}; xi[s] = (P2){v.z, v.w}; }
}
__device__ __forceinline__ void hyq2(const bf16_t* __restrict__ PHY, size_t row, int tl, int col, const float (&w)[3][2], const float (&b)[2], float& q0, float& q1) {
    q0 = b[0]; q1 = b[1];
#pragma unroll
    for (int k = 0; k < 3; ++k) { const int tt = tl + k - 1; const bool ok = (tt >= 0) && (tt < L);
        const unsigned u = ok ? *(const unsigned*)(PHY + (row + k - 1) * 3072 + col) : 0u;
        q0 += w[k][0] * __uint_as_float(u << 16); q1 += w[k][1] * __uint_as_float(u & 0xffff0000u); }
}
struct ConvW { float w[3][3][2]; float b[3][2]; };
__device__ __forceinline__ void load_convw(ConvW& W, const float* __restrict__ cw, const float* __restrict__ cb, int c0) {
#pragma unroll
    for (int seg = 0; seg < 3; ++seg) {
#pragma unroll
        for (int k = 0; k < 3; ++k) { const f32x2 v = *(const f32x2*)(cw + k * 3072 + seg * 1024 + c0); W.w[seg][k][0] = v.x; W.w[seg][k][1] = v.y; }
        const f32x2 v = *(const f32x2*)(cb + seg * 1024 + c0); W.b[seg][0] = v.x; W.b[seg][1] = v.y; }
}


__device__ __forceinline__ void bf8_to_f(const u32x4 u, float (&f)[8]) {
    f[0] = __uint_as_float(u.x << 16); f[1] = __uint_as_float(u.x & 0xffff0000u); f[2] = __uint_as_float(u.y << 16); f[3] = __uint_as_float(u.y & 0xffff0000u);
    f[4] = __uint_as_float(u.z << 16); f[5] = __uint_as_float(u.z & 0xffff0000u); f[6] = __uint_as_float(u.w << 16); f[7] = __uint_as_float(u.w & 0xffff0000u);
}
__device__ __forceinline__ void prepass(Frame& F) {
    const bf16_t* PHY = (const bf16_t*)(F.ws + WS_PHY); bf16_t* Z16 = (bf16_t*)(F.ws + WS_Z16); bf16_t* X1Q = (bf16_t*)(F.ws + WS_YHY); const float* cw = F.in[12]; const float* cb = F.in[13];
    const int gw = F.bid * NWAVES + F.wave, NGW = F.G * NWAVES;
#pragma unroll 1
    for (int item = gw; item < (T / 16) * 2; item += NGW) {
        const int half = item & 1, row0 = (item >> 1) * 16, tl0 = row0 & (L - 1), c0 = half * 512 + 8 * F.lane;
        float w[3][3][8], bs[3][8];
#pragma unroll
        for (int seg = 0; seg < 3; ++seg) {
#pragma unroll
            for (int k = 0; k < 3; ++k) { const f32x4 a = *(const f32x4*)(cw + k * 3072 + seg * 1024 + c0), b = *(const f32x4*)(cw + k * 3072 + seg * 1024 + c0 + 4);
                w[seg][k][0] = a.x; w[seg][k][1] = a.y; w[seg][k][2] = a.z; w[seg][k][3] = a.w; w[seg][k][4] = b.x; w[seg][k][5] = b.y; w[seg][k][6] = b.z; w[seg][k][7] = b.w; }
            const f32x4 a = *(const f32x4*)(cb + seg * 1024 + c0), b = *(const f32x4*)(cb + seg * 1024 + c0 + 4);
            bs[seg][0] = a.x; bs[seg][1] = a.y; bs[seg][2] = a.z; bs[seg][3] = a.w; bs[seg][4] = b.x; bs[seg][5] = b.y; bs[seg][6] = b.z; bs[seg][7] = b.w; }
        const u32x4 zero4 = (u32x4){0u, 0u, 0u, 0u};
        u32x4 prev[3], cur[3];
#pragma unroll
        for (int seg = 0; seg < 3; ++seg) { prev[seg] = tl0 > 0 ? *(const u32x4*)(PHY + (size_t)(row0 - 1) * 3072 + seg * 1024 + c0) : zero4; cur[seg] = *(const u32x4*)(PHY + (size_t)row0 * 3072 + seg * 1024 + c0); }
#pragma unroll 1
        for (int sub = 0; sub < 4; ++sub) {
            u32x4 nx[4][3];
#pragma unroll
            for (int r = 0; r < 4; ++r)
#pragma unroll
                for (int seg = 0; seg < 3; ++seg) { const int tn = tl0 + sub * 4 + r + 1; nx[r][seg] = tn < L ? *(const u32x4*)(PHY + (size_t)(row0 + sub * 4 + r + 1) * 3072 + seg * 1024 + c0) : zero4; }
#pragma unroll
            for (int r = 0; r < 4; ++r) {
                float q[3][8];
#pragma unroll
                for (int seg = 0; seg < 3; ++seg) { float a[8], b[8], c[8]; bf8_to_f(prev[seg], a); bf8_to_f(cur[seg], b); bf8_to_f(nx[r][seg], c);
#pragma unroll
                    for (int e = 0; e < 8; ++e) q[seg][e] = bs[seg][e] + w[seg][0][e] * a[e] + w[seg][1][e] * b[e] + w[seg][2][e] * c[e];
                    prev[seg] = cur[seg]; cur[seg] = nx[r][seg]; }
                const size_t o = (size_t)(row0 + sub * 4 + r) * 1024 + c0;
                u32x4 zo, xo;
                zo.x = pk2(q[2][0] * q[0][0], q[2][1] * q[0][1]); zo.y = pk2(q[2][2] * q[0][2], q[2][3] * q[0][3]); zo.z = pk2(q[2][4] * q[0][4], q[2][5] * q[0][5]); zo.w = pk2(q[2][6] * q[0][6], q[2][7] * q[0][7]);
                xo.x = pk2(q[1][0], q[1][1]); xo.y = pk2(q[1][2], q[1][3]); xo.z = pk2(q[1][4], q[1][5]); xo.w = pk2(q[1][6], q[1][7]);
                *(u32x4*)(Z16 + o) = zo; *(u32x4*)(X1Q + o) = xo;
            }
        }
    }
}

__device__ __forceinline__ void prep_w4frag(Frame& F) {
    const float* w4 = F.in[20]; u32x4* WF4 = (u32x4*)(F.ws + WS_WF4);
    for (int idx = F.bid * NTHREADS + F.tid; idx < 2 * 64 * 2 * 64; idx += F.G * NTHREADS) {
        const int lane = idx & 63, s = (idx >> 6) & 1, cb = (idx >> 7) & 63, dir = idx >> 13; const int col = dir * 1024 + 16 * cb + (lane & 15), k0 = 32 * s + 8 * (lane >> 4);
        u32x4 o; o.x = pk2(w4[(k0 + 0) * 2048 + col], w4[(k0 + 1) * 2048 + col]); o.y = pk2(w4[(k0 + 2) * 2048 + col], w4[(k0 + 3) * 2048 + col]);
        o.z = pk2(w4[(k0 + 4) * 2048 + col], w4[(k0 + 5) * 2048 + col]); o.w = pk2(w4[(k0 + 6) * 2048 + col], w4[(k0 + 7) * 2048 + col]);
        WF4[idx] = o; }
}
__device__ __forceinline__ void fa_load(const float* __restrict__ w4, int c0, int bt, f32x2 (&wf)[16], f32x2 (&wb)[16]) {
#pragma unroll
    for (int e = 0; e < 16; ++e) { wf[e] = *(const f32x2*)(w4 + (16 * bt + e) * 2048 + c0); wb[e] = *(const f32x2*)(w4 + (16 * bt + e) * 2048 + 1024 + c0); }
}
__device__ __forceinline__ void fa_compute(const LAS f32x4* hrow, int bt, const f32x2 (&wf)[16], const f32x2 (&wb)[16], float (&r0)[16], float (&r1)[16], float& l0, float& l1, bool lag0) {
#pragma unroll
    for (int e4 = 0; e4 < 4; ++e4) { const int u4 = 4 * bt + e4; __builtin_amdgcn_sched_barrier(0);
#pragma unroll
        for (int j = 0; j < 16; ++j) { const f32x4 hv = hrow[(8 * j) * 16 + u4];
#pragma unroll
            for (int e = 0; e < 4; ++e) { r0[j] += hv[e] * (j < 8 ? wf[4 * e4 + e].x : wb[4 * e4 + e].x); r1[j] += hv[e] * (j < 8 ? wf[4 * e4 + e].y : wb[4 * e4 + e].y); } }
        if (lag0) { const f32x4 hv = hrow[u4];
#pragma unroll
            for (int e = 0; e < 4; ++e) { l0 += hv[e] * wb[4 * e4 + e].x; l1 += hv[e] * wb[4 * e4 + e].y; } } }
}
template <bool DRY = false> __device__ __forceinline__ void filter_pass_a(Frame& F, int k_lo = 0, int k_hi = 1 << 20) {
    const float* HH3 = (const float*)(F.ws + WS_HH3); const float* w4 = F.in[20]; float* NORM = (float*)(F.ws + WS_NORMP); kf_t* YK = (kf_t*)(F.ws + WS_KF);
    const int s = F.wave; const LAS f32x2* twt = (const LAS f32x2*)(F.lds + TWT_OFF);
    for (int kk = k_lo, tl = F.bid + k_lo * F.G; kk < k_hi && tl < 128 * 8; ++kk, tl += F.G) {
        const int n1 = tl >> 3, ct = tl & 7, c0 = ct * 128 + 2 * F.lane;
        tile_tw(F, n1, false);
        { const int rw = F.tid >> 2, part = F.tid & 3; const int n = n1 + 128 * rw; const int t = n < L ? n : ((2 * L - n) & (L - 1));
          const f32x4* src = (const f32x4*)(HH3 + t * 64 + part * 16); LAS f32x4* dst = (LAS f32x4*)(F.lds + rw * 256 + part * 64);
          const f32x4 a = src[0], b = src[1], c = src[2], d = src[3]; dst[0] = a; dst[1] = b; dst[2] = c; dst[3] = d; }
        __syncthreads();
        P2 xr[16], xi[16]; P2 lag0 = (P2){0.f, 0.f};
        const P2 da = (P2){hy_delta_abs(c0), hy_delta_abs(c0 + 1)};
        { const u32x4* WF4 = (const u32x4*)(F.ws + WS_WF4); const int cb = ct * 8 + s, jl = F.lane & 15, ql = F.lane >> 4;
          bf16x8 bfr[2][2];
#pragma unroll
          for (int dir = 0; dir < 2; ++dir)
#pragma unroll
              for (int ks = 0; ks < 2; ++ks) bfr[dir][ks] = __builtin_bit_cast(bf16x8, WF4[(((dir * 64 + cb) * 2 + ks) * 64) + F.lane]);
          LAS float* kt = (LAS float*)(F.lds + 32768);
#pragma unroll
          for (int m = 0; m < 8; ++m) {
              bf16x8 afr[2];
#pragma unroll
              for (int ks = 0; ks < 2; ++ks) { const LAS f32x4* hp = (const LAS f32x4*)(F.lds + (16 * m + jl) * 256 + (32 * ks + 8 * ql) * 4); const f32x4 x0 = hp[0], x1 = hp[1];
                  u32x4 pk; pk.x = pk2(x0.x, x0.y); pk.y = pk2(x0.z, x0.w); pk.z = pk2(x1.x, x1.y); pk.w = pk2(x1.z, x1.w); afr[ks] = __builtin_bit_cast(bf16x8, pk); }
              f32x4 d = (f32x4){0.f, 0.f, 0.f, 0.f};
              d = __builtin_amdgcn_mfma_f32_16x16x32_bf16(afr[0], bfr[m >> 2][0], d, 0, 0, 0); d = __builtin_amdgcn_mfma_f32_16x16x32_bf16(afr[1], bfr[m >> 2][1], d, 0, 0, 0);
#pragma unroll
              for (int r = 0; r < 4; ++r) kt[(16 * m + 4 * ql + r) * 132 + 16 * s + jl] = d[r]; }
          if (n1 == 0 && s == 0) { const LAS float* h0 = (const LAS float*)F.lds;
#pragma unroll 4
              for (int u = 0; u < 64; ++u) { const f32x2 wb = *(const f32x2*)(w4 + u * 2048 + 1024 + c0); lag0 += h0[u] * wb; } }
          __syncthreads();
#pragma unroll
          for (int j = 0; j < 16; ++j) xr[j] = *(const LAS f32x2*)(kt + (s + 8 * j) * 132 + 2 * F.lane);
        }
        __syncthreads();
        P2 na = (P2){0.f, 0.f};
#pragma unroll
        for (int j = 0; j < 16; ++j) { const int n = n1 + 128 * (s + 8 * j); const int t = j < 8 ? n : ((2 * L - n) & (L - 1)); const float tt = (float)t * (1.0f / (float)(L - 1));
            P2 v = xr[j] * (P2){fexp(-tt * da.x), fexp(-tt * da.y)};
            if (n == L) v = (P2){0.f, 0.f};
            if (j == 0) v += lag0;
            xr[j] = v; xi[j] = (P2){0.f, 0.f}; na += (P2){fabsf(v.x), fabsf(v.y)}; }
        { LAS f32x2* nred = (LAS f32x2*)(F.lds + MISC_OFF + 12288); nred[s * 64 + F.lane] = na; }
        stage1<false>(F, xr, xi, s);
        __syncthreads();
        if (s == 0) { const LAS f32x2* nred = (const LAS f32x2*)(F.lds + MISC_OFF + 12288); f32x2 a = nred[F.lane];
#pragma unroll
            for (int w = 1; w < 8; ++w) { const f32x2 b = nred[w * 64 + F.lane]; a.x += b.x; a.y += b.y; }
            if (!DRY) *(f32x2*)(NORM + (size_t)n1 * 1024 + c0) = a; else asm volatile("" :: "v"(a)); }
#pragma unroll
        for (int h = 0; h < 2; ++h) { const int qq = s + 8 * h; P2 a[8], b[8];
            stage2_read(F, a, b, qq); fft_reg<8, false>(a, b);
#pragma unroll
            for (int r = 0; r < 8; ++r) { const int p = brev<8>(r), k2 = qq + 16 * r; const f32x2 w = twt[k2];
                P2 x = a[p], y = b[p]; cmul(x, y, w.x, w.y);
                if (!DRY) YK[((size_t)k2 * 128 + n1) * 512 + (c0 >> 1)] = KF_PK(x, y); else asm volatile("" :: "v"(x), "v"(y)); } }
        __syncthreads();
    }
}
template <bool DRY = false> __device__ __forceinline__ void filter_pass_b(Frame& F) {
    const float* NORM = (const float*)(F.ws + WS_NORMP); kf_t* KF = (kf_t*)(F.ws + WS_KF); const int s = F.wave;
    for (int tl = F.bid; tl < 128 * 8; tl += F.G) {
        const int k2 = tl >> 3, ct = tl & 7, c0 = ct * 128 + 2 * F.lane; const size_t base = (size_t)k2 * 128 * 512 + (c0 >> 1);
        { LAS float* nsum = (LAS float*)(F.lds + MISC_OFF + 12288); const int ch = F.tid & 127, qt = F.tid >> 7; float a = 0.f;
#pragma unroll 8
          for (int i = 0; i < 32; ++i) a += NORM[(size_t)(qt * 32 + i) * 1024 + ct * 128 + ch];
          __syncthreads(); nsum[qt * 128 + ch] = a; __syncthreads(); }
        P2 sc;
        { const LAS float* nsum = (const LAS float*)(F.lds + MISC_OFF + 12288); const int ch = 2 * F.lane;
          sc.x = 1.0f / ((nsum[ch] + nsum[128 + ch]) + (nsum[256 + ch] + nsum[384 + ch])); sc.y = 1.0f / ((nsum[ch + 1] + nsum[128 + ch + 1]) + (nsum[256 + ch + 1] + nsum[384 + ch + 1])); }
        P2 xr[16], xi[16];
#pragma unroll
        for (int j = 0; j < 16; ++j) { const kf_t u = KF[base + (size_t)(s + 8 * j) * 512]; xr[j] = KF_RE(u); xi[j] = KF_IM(u); }
        stage1<false>(F, xr, xi, s);
        __syncthreads();
#pragma unroll
        for (int h = 0; h < 2; ++h) { const int qq = s + 8 * h; P2 a[8], b[8];
            stage2_read(F, a, b, qq); fft_reg<8, false>(a, b);
#pragma unroll
            for (int r = 0; r < 8; ++r) { const int p = brev<8>(r), k1 = qq + 16 * r;
                const kf_t o_ = KF_PK(a[p] * (sc * KF_SCALE), b[p] * (sc * KF_SCALE)); if (!DRY) KF[base + (size_t)k1 * 512] = o_; else asm volatile("" :: "v"(o_)); } }
        __syncthreads();
    }
}
__device__ __forceinline__ void data_pass_a(Frame& F) {
    const bf16_t* Z16 = (const bf16_t*)(F.ws + WS_Z16); yz_t* YZ = (yz_t*)(F.ws + WS_YZ); const int s = F.wave; const LAS f32x2* twt = (const LAS f32x2*)(F.lds + TWT_OFF);
    unsigned zn[16];
    auto zload = [&](int tl, unsigned (&z)[16]) { const int ct = tl & 7, n1 = (tl >> 3) & 127, p = tl >> 10, c0 = ct * 128 + 2 * F.lane;
#pragma unroll
        for (int j = 0; j < 8; ++j) { const int t = n1 + 128 * (s + 8 * j);
            z[2 * j] = *(const unsigned*)(Z16 + ((size_t)(2 * p) * L + t) * 1024 + c0); z[2 * j + 1] = *(const unsigned*)(Z16 + ((size_t)(2 * p + 1) * L + t) * 1024 + c0); } };
    if (F.bid < 2 * 128 * 8) zload(F.bid, zn);
    for (int tl = F.bid; tl < 2 * 128 * 8; tl += F.G) {
        const int ct = tl & 7, n1 = (tl >> 3) & 127, p = tl >> 10, c0 = ct * 128 + 2 * F.lane;
        tile_tw(F, n1, false);
        P2 xr[16], xi[16];
#pragma unroll
        for (int j = 0; j < 8; ++j) { xr[j] = bf2p(zn[2 * j]); xi[j] = bf2p(zn[2 * j + 1]); }
        if (tl + F.G < 2 * 128 * 8) zload(tl + F.G, zn);
#pragma unroll
        for (int j = 8; j < 16; ++j) { xr[j] = (P2){0.f, 0.f}; xi[j] = (P2){0.f, 0.f}; }
        stage1<false>(F, xr, xi, s);
        __syncthreads();
#pragma unroll
        for (int h = 0; h < 2; ++h) { const int qq = s + 8 * h; P2 a[8], b[8];
            stage2_read(F, a, b, qq); fft_reg<8, false>(a, b);
#pragma unroll
            for (int r = 0; r < 8; ++r) { const int pp = brev<8>(r), k2 = qq + 16 * r; const f32x2 w = twt[k2];
                P2 x = a[pp], y = b[pp]; cmul(x, y, w.x, w.y);
                YZ[(((size_t)p * 128 + k2) * 128 + n1) * 512 + (c0 >> 1)] = pkyz(x, y); } }
        __syncthreads();
    }
}
template <bool DRY = false> __device__ __forceinline__ void data_pass_b(Frame& F) {
    yz_t* YZ = (yz_t*)(F.ws + WS_YZ); const kf_t* KF = (const kf_t*)(F.ws + WS_KF); const int s = F.wave;
    const LAS f32x2* twt = (const LAS f32x2*)(F.lds + TWT_OFF); const LAS f32x2* tw = (const LAS f32x2*)(F.lds + TW128_OFF); LAS f32x4* tile = (LAS f32x4*)F.lds;
    int* qctr = (int*)(F.ws + WS_CTL) + 128 + (DRY ? 1 : 0); LAS int* qslot = (LAS int*)(F.lds + MISC_OFF + 768);
    for (;;) {
        __syncthreads();
        if (F.tid == 0) *qslot = atomicAdd(qctr, 1);
        __syncthreads();
        const int tl = *qslot; if (tl >= 128 * 8) break;
        const int k2 = tl >> 3, ct = tl & 7, c0 = ct * 128 + 2 * F.lane; const size_t kbase = (size_t)k2 * 128 * 512 + (c0 >> 1);
        tile_tw(F, k2, true);
#pragma unroll 1
        for (int p = 0; p < 2; ++p) {
            const size_t base = ((size_t)p * 128 + k2) * 128 * 512 + (c0 >> 1);
            kf_t kfp[2][8];
#pragma unroll
            for (int h = 0; h < 2; ++h)
#pragma unroll
                for (int r = 0; r < 8; ++r) kfp[h][r] = KF[kbase + (size_t)(s + 8 * h + 16 * r) * 512];
            { P2 xr[16], xi[16];
#pragma unroll
              for (int j = 0; j < 16; ++j) { const yz_t u = YZ[base + (size_t)(s + 8 * j) * 512]; xr[j] = yzre(u); xi[j] = yzim(u); }
              stage1<false>(F, xr, xi, s); }
            __syncthreads();
#pragma unroll
            for (int h = 0; h < 2; ++h) { const int qq = s + 8 * h; P2 a[8], b[8], gr[8], gi[8];
                if (h == 1) __builtin_amdgcn_sched_barrier(0);
                stage2_read(F, a, b, qq); fft_reg<8, false>(a, b);
#pragma unroll
                for (int r = 0; r < 8; ++r) { const int pp = brev<8>(r); const P2 kr = KF_RE(kfp[h][r]), ki = KF_IM(kfp[h][r]);
                    gr[r] = a[pp] * kr - b[pp] * ki; gi[r] = a[pp] * ki + b[pp] * kr; }
                fft_reg<8, true>(gr, gi);
#pragma unroll
                for (int bq = 0; bq < 8; ++bq) { const int pp = brev<8>(bq); const f32x2 w = tw[bq * qq];
                    P2 x = gr[pp], y = gi[pp]; cmul(x, y, w.x, w.y);
                    tile[(bq * 16 + qq) * 64 + F.lane] = (f32x4){x.x, x.y, y.x, y.y}; } }
            __syncthreads();
            { P2 xr[16], xi[16];
#pragma unroll
              for (int q = 0; q < 16; ++q) { const f32x4 v = tile[(s * 16 + q) * 64 + F.lane]; xr[q] = (P2){v.x, v.y}; xi[q] = (P2){v.z, v.w}; }
              fft_reg<16, true>(xr, xi);
#pragma unroll
              for (int a = 0; a < 16; ++a) { const int pp = brev<16>(a), m2 = s + 8 * a; const f32x2 w = twt[m2];
                  P2 x = xr[pp], y = xi[pp]; cmul(x, y, w.x, w.y);
                  if (!DRY) YZ[base + (size_t)m2 * 512] = pkyz(x * YZ_ZSCALE, y * YZ_ZSCALE); else asm volatile("" :: "v"(x), "v"(y)); } }
            __syncthreads();
        }
    }
}
template <bool DRY = false> __device__ __forceinline__ void data_pass_c(Frame& F) {
    const bf16_t* Z16 = (const bf16_t*)(F.ws + WS_Z16); const yz_t* YZ = (const yz_t*)(F.ws + WS_YZ); bf16_t* YHY = (bf16_t*)(F.ws + WS_YHY); const float* hbias = F.in[22]; const int s = F.wave;
    yz_t yzn[16];
    auto yzload = [&](int tl, yz_t (&y)[16]) { const int ct = tl & 7, m2 = (tl >> 3) & 127, p = tl >> 10, c0 = ct * 128 + 2 * F.lane;
#pragma unroll
        for (int j = 0; j < 16; ++j) y[j] = YZ[(((size_t)p * 128 + (s + 8 * j)) * 128 + m2) * 512 + (c0 >> 1)]; };
    if (F.bid < 2 * 128 * 8) yzload(F.bid, yzn);
    for (int tl = F.bid; tl < 2 * 128 * 8; tl += F.G) {
        const int ct = tl & 7, m2 = (tl >> 3) & 127, p = tl >> 10, c0 = ct * 128 + 2 * F.lane;
        unsigned uzp[2][4][2], uxp[2][4][2];
#pragma unroll
        for (int h = 0; h < 2; ++h)
#pragma unroll
            for (int r = 0; r < 4; ++r)
#pragma unroll
                for (int bb = 0; bb < 2; ++bb) { const size_t row = (size_t)(2 * p + bb) * L + 128 * (s + 8 * h + 16 * r) + m2;
                    uzp[h][r][bb] = *(const unsigned*)(Z16 + row * 1024 + c0); uxp[h][r][bb] = *(const unsigned*)(YHY + row * 1024 + c0); }
        { P2 xr[16], xi[16];
#pragma unroll
          for (int j = 0; j < 16; ++j) { xr[j] = yzre(yzn[j]); xi[j] = yzim(yzn[j]); }
          if (tl + F.G < 2 * 128 * 8) yzload(tl + F.G, yzn);
          stage1<true>(F, xr, xi, s); }
        __syncthreads();
        const P2 hb = *(const f32x2*)(hbias + c0);
#pragma unroll
        for (int h = 0; h < 2; ++h) { const int qq = s + 8 * h; P2 a[8], b[8];
            stage2_read(F, a, b, qq); fft_reg<8, true>(a, b);
#pragma unroll
            for (int r = 0; r < 4; ++r) { const int pp = brev<8>(r), t = 128 * (qq + 16 * r) + m2;
#pragma unroll
                for (int bb = 0; bb < 2; ++bb) { const size_t row = (size_t)(2 * p + bb) * L + t;
                    const P2 z = bf2p(uzp[h][r][bb]), x1 = bf2p(uxp[h][r][bb]);
                    const P2 cv = (bb == 0 ? a[pp] : b[pp]) * (1.0f / ((float)L2X * YZ_ZSCALE * KF_SCALE));
                    const P2 y = x1 * (cv + hb * z);
                    if (!DRY) *(unsigned*)(YHY + row * 1024 + c0) = pk2(y.x, y.y); else asm volatile("" :: "v"(y)); } } }
        __syncthreads();
    }
}
}
namespace lru {
__device__ __forceinline__ f32x2 sig2(const f32x2 x) { const f32x2 t = x * -1.4426950408889634f; const f32x2 d = (f32x2){__builtin_amdgcn_exp2f(t.x), __builtin_amdgcn_exp2f(t.y)} + 1.0f; return (f32x2){__builtin_amdgcn_rcpf(d.x), __builtin_amdgcn_rcpf(d.y)}; }
constexpr int TC = 64, NCH = L / TC, MB = TC / 16;

__device__ __forceinline__ void prep_wfrag(Frame& F) {
    const float* wa = F.in[6]; const float* wi = F.in[8]; u32x4* WF = (u32x4*)(F.ws + WS_WLRUF);
    for (int idx = F.bid * NTHREADS + F.tid; idx < 2 * 16 * 2 * 4 * 2 * 64; idx += F.G * NTHREADS) {
        const int lane = idx & 63, s = (idx >> 6) & 1, n = (idx >> 7) & 3, mat = (idx >> 9) & 1, h = (idx >> 10) & 15, dir = idx >> 14;
        const float* W = (mat == 0 ? wa : wi) + ((size_t)(dir * 16 + h) * 64) * 64; const int jo = 16 * n + (lane & 15), i0 = 32 * s + 8 * (lane >> 4);
        u32x4 o; o.x = pk2(W[(i0 + 0) * 64 + jo], W[(i0 + 1) * 64 + jo]); o.y = pk2(W[(i0 + 2) * 64 + jo], W[(i0 + 3) * 64 + jo]);
        o.z = pk2(W[(i0 + 4) * 64 + jo], W[(i0 + 5) * 64 + jo]); o.w = pk2(W[(i0 + 6) * 64 + jo], W[(i0 + 7) * 64 + jo]);
        WF[idx] = o;
    }
}

__device__ __forceinline__ void load_rows(const bf16_t* __restrict__ P0, int b, int t0, int m, int h, int j, int q, u32x4 (&pv)[2][4]) {
#pragma unroll
    for (int s = 0; s < 2; ++s)
#pragma unroll
        for (int tap = 0; tap < 4; ++tap) { const int tl = t0 + 16 * m + j + tap - 2; const bool ok = (tl >= 0) && (tl < L);
            const size_t off = ok ? (WS_P0 - WS_CTL - 8192) + (((size_t)b * L + tl) * 1024 + 64 * h + 32 * s + 8 * q) * 2 : (size_t)0;
            pv[s][tap] = *(const u32x4*)((const char*)P0 + off); }
}
__device__ __forceinline__ void stage1(Frame& F) {
    const bf16_t* P0 = (const bf16_t*)(F.ws + WS_CTL + 8192);
    const float* cw = F.in[4]; const float* cb = F.in[5]; const float* ba = F.in[7]; const float* bi = F.in[9]; const float* lam = F.in[10];
    const u32x4* WF = (const u32x4*)(F.ws + WS_WLRUF); f32x2* SUMM = (f32x2*)(F.ws + WS_SUMM);
    u32x2* HS = (u32x2*)(F.ws + WS_HS); u32x2* AF = (u32x2*)(F.ws + WS_AF); u32x2* AB = (u32x2*)(F.ws + WS_AB);
    LAS float* cwl = (LAS float*)(F.lds + MISC_OFF + 4096);
    LAS unsigned* hfl = (LAS unsigned*)(F.lds + F.wave * 8192) + F.lane;
    const LAS u32x4* wl = (const LAS u32x4*)(F.lds + 65536) + F.lane;
    asm volatile("" : "+v"(wl)); asm volatile("" : "+v"(hfl));
    const int lane = F.lane, j = lane & 15, q = lane >> 4;
    bf16x8 idf[2];
#pragma unroll
    for (int par = 0; par < 2; ++par) { const int kp = 16 * par + j;
#pragma unroll
        for (int jj = 0; jj < 8; ++jj) idf[par][jj] = (short)((q == (kp >> 3) && jj == (kp & 7)) ? 0x3F80 : 0); }
#pragma unroll 1
    for (int bix = F.bid; bix < NB * 16 * (NCH / 8); bix += F.G) {
        const int h = (bix >> 4) & 15, b = bix >> 8, chunk = (bix & 15) * 8 + F.wave; const int t0 = chunk * TC; const int task = ((b * NCH + chunk) << 4) + h;
        __syncthreads();
        if (F.tid < 320) cwl[F.tid] = F.tid < 256 ? cw[(F.tid >> 6) * 1024 + 64 * h + (F.tid & 63)] : cb[64 * h + (F.tid & 63)];
#pragma unroll
        for (int i = 0; i < 4; ++i) { const int e = F.tid + 512 * i; const int dir_ = e >> 10, rest = e & 1023;
            ((LAS u32x4*)(F.lds + 65536))[e] = WF[((size_t)(dir_ * 16 + h) * 16) * 64 + rest]; }
        __syncthreads();
#pragma unroll
        for (int dir = 0; dir < 2; ++dir) {
            float bac[4], bic[4], spc[4], cst[4], arun[4];
#pragma unroll
            for (int n = 0; n < 4; ++n) { const int c = 64 * h + 16 * n + j; bac[n] = ba[dir * 1024 + c]; bic[n] = bi[dir * 1024 + c]; spc[n] = -8.0f * 1.4426950408889634f * log1pf(expf(-lam[dir * 1024 + c])); cst[n] = 0.f; arun[n] = 1.f; }
            u32x4 pvn[2][4];
            load_rows(P0, b, t0, dir == 0 ? 0 : MB - 1, h, j, q, pvn);
#pragma unroll 1
            for (int mm = 0; mm < MB; ++mm) {
                const int m = dir == 0 ? mm : MB - 1 - mm;
                bf16x8 afr[2];
#pragma unroll
                for (int s = 0; s < 2; ++s) { const int chb = 32 * s + 8 * q; f32x2 xp[4];
                    { const f32x4 b0 = *(const LAS f32x4*)(cwl + 256 + chb), b1 = *(const LAS f32x4*)(cwl + 256 + chb + 4);
                      xp[0] = (f32x2){b0.x, b0.y}; xp[1] = (f32x2){b0.z, b0.w}; xp[2] = (f32x2){b1.x, b1.y}; xp[3] = (f32x2){b1.z, b1.w}; }
#pragma unroll
                    for (int tap = 0; tap < 4; ++tap) { const u32x4 pq = pvn[s][tap];
                        const f32x4 w0 = *(const LAS f32x4*)(cwl + tap * 64 + chb), w1 = *(const LAS f32x4*)(cwl + tap * 64 + chb + 4);
                        xp[0] += (f32x2){w0.x, w0.y} * (f32x2){__uint_as_float(pq.x << 16), __uint_as_float(pq.x & 0xffff0000u)}; xp[1] += (f32x2){w0.z, w0.w} * (f32x2){__uint_as_float(pq.y << 16), __uint_as_float(pq.y & 0xffff0000u)};
                        xp[2] += (f32x2){w1.x, w1.y} * (f32x2){__uint_as_float(pq.z << 16), __uint_as_float(pq.z & 0xffff0000u)}; xp[3] += (f32x2){w1.z, w1.w} * (f32x2){__uint_as_float(pq.w << 16), __uint_as_float(pq.w & 0xffff0000u)}; }
                    u32x4 pk; pk.x = pk2(xp[0].x, xp[0].y); pk.y = pk2(xp[1].x, xp[1].y); pk.z = pk2(xp[2].x, xp[2].y); pk.w = pk2(xp[3].x, xp[3].y); afr[s] = __builtin_bit_cast(bf16x8, pk); }
                __builtin_amdgcn_sched_barrier(0);
                if (mm + 1 < MB) load_rows(P0, b, t0, dir == 0 ? m + 1 : m - 1, h, j, q, pvn);
                f32x4 dx[4], da[4], di[4];
#pragma unroll
                for (int n = 0; n < 4; ++n) { const f32x4 z4 = (f32x4){0.f, 0.f, 0.f, 0.f};
                    dx[n] = __builtin_amdgcn_mfma_f32_16x16x32_bf16(afr[n >> 1], idf[n & 1], z4, 0, 0, 0);
                    const bf16x8 wa0 = __builtin_bit_cast(bf16x8, wl[(((dir * 2 + 0) * 4 + n) * 2 + 0) * 64]), wa1 = __builtin_bit_cast(bf16x8, wl[(((dir * 2 + 0) * 4 + n) * 2 + 1) * 64]);
                    const bf16x8 wi0 = __builtin_bit_cast(bf16x8, wl[(((dir * 2 + 1) * 4 + n) * 2 + 0) * 64]), wi1 = __builtin_bit_cast(bf16x8, wl[(((dir * 2 + 1) * 4 + n) * 2 + 1) * 64]);
                    da[n] = __builtin_amdgcn_mfma_f32_16x16x32_bf16(afr[0], wa0, z4, 0, 0, 0); da[n] = __builtin_amdgcn_mfma_f32_16x16x32_bf16(afr[1], wa1, da[n], 0, 0, 0);
                    di[n] = __builtin_amdgcn_mfma_f32_16x16x32_bf16(afr[0], wi0, z4, 0, 0, 0); di[n] = __builtin_amdgcn_mfma_f32_16x16x32_bf16(afr[1], wi1, di[n], 0, 0, 0); }
                float P[4][4], S[4][4], PT[4], ST[4];
#pragma unroll
                for (int n = 0; n < 4; ++n) { float av[4], bv[4];
#pragma unroll
                    for (int hp = 0; hp < 2; ++hp) {
                        const f32x2 rg = sig2((f32x2){da[n][2 * hp], da[n][2 * hp + 1]} + bac[n]), ig = sig2((f32x2){di[n][2 * hp], di[n][2 * hp + 1]} + bic[n]);
                        const f32x2 tq = rg * spc[n];
                        const f32x2 a = (f32x2){__builtin_amdgcn_exp2f(tq.x), __builtin_amdgcn_exp2f(tq.y)};
                        const f32x2 w = 1.0f - a * a;
                        const f32x2 mult = (f32x2){__builtin_amdgcn_sqrtf(fmaxf(w.x, 0.f)), __builtin_amdgcn_sqrtf(fmaxf(w.y, 0.f))};
                        const f32x2 bq = mult * (ig * (f32x2){dx[n][2 * hp], dx[n][2 * hp + 1]});
                        av[2 * hp] = a.x; av[2 * hp + 1] = a.y; bv[2 * hp] = bq.x; bv[2 * hp + 1] = bq.y; }
                    if (dir == 0) { P[n][0] = av[0]; S[n][0] = bv[0];
#pragma unroll
                        for (int r = 1; r < 4; ++r) { P[n][r] = P[n][r - 1] * av[r]; S[n][r] = av[r] * S[n][r - 1] + bv[r]; } }
                    else { P[n][3] = av[3]; S[n][3] = bv[3];
#pragma unroll
                        for (int r = 2; r >= 0; --r) { P[n][r] = P[n][r + 1] * av[r]; S[n][r] = av[r] * S[n][r + 1] + bv[r]; } }
                    PT[n] = dir == 0 ? P[n][3] : P[n][0]; ST[n] = dir == 0 ? S[n][3] : S[n][0]; }
                float pt[4][4], st[4][4];
#pragma unroll
                for (int n = 0; n < 4; ++n)
#pragma unroll
                    for (int g = 0; g < 4; ++g) { pt[n][g] = __shfl(PT[n], j + 16 * g); st[n][g] = __shfl(ST[n], j + 16 * g); }
#pragma unroll
                for (int n = 0; n < 4; ++n) {
                    float C = cst[n], A = arun[n], Cq = 0.f, Aq = 1.f;
#pragma unroll
                    for (int gg = 0; gg < 4; ++gg) { const int g = dir == 0 ? gg : 3 - gg; if (g == q) { Cq = C; Aq = A; } C = pt[n][g] * C + st[n][g]; A *= pt[n][g]; }
                    cst[n] = C; arun[n] = A;
                    float hl[4], ac[4];
#pragma unroll
                    for (int hp = 0; hp < 2; ++hp) { const f32x2 pp = (f32x2){P[n][2 * hp], P[n][2 * hp + 1]}; const f32x2 hq = (f32x2){S[n][2 * hp], S[n][2 * hp + 1]} + pp * Cq, aq = pp * Aq;
                        hl[2 * hp] = hq.x; hl[2 * hp + 1] = hq.y; ac[2 * hp] = aq.x; ac[2 * hp + 1] = aq.y; }
                    const size_t fo = ((size_t)(task * MB + m) * 4 + n) * 64 + lane;
                    if (dir == 0) {
                        hfl[((m * 4 + n) * 2 + 0) * 64] = pk2(hl[0], hl[1]); hfl[((m * 4 + n) * 2 + 1) * 64] = pk2(hl[2], hl[3]);
                        AF[fo] = (u32x2){pk2(ac[0], ac[1]), pk2(ac[2], ac[3])};
                    } else {
                        { const unsigned u0 = hfl[((m * 4 + n) * 2 + 0) * 64], u1 = hfl[((m * 4 + n) * 2 + 1) * 64];
                          hl[0] += __uint_as_float(u0 << 16); hl[1] += __uint_as_float(u0 & 0xffff0000u); hl[2] += __uint_as_float(u1 << 16); hl[3] += __uint_as_float(u1 & 0xffff0000u); }
                        HS[fo] = (u32x2){pk2(hl[0], hl[1]), pk2(hl[2], hl[3])}; AB[fo] = (u32x2){pk2(ac[0], ac[1]), pk2(ac[2], ac[3])};
                    }
                }
            }
            if (q == 0) {
#pragma unroll
                for (int n = 0; n < 4; ++n) SUMM[((size_t)(dir * NB + b) * NCH + chunk) * 1024 + 64 * h + 16 * n + j] = (f32x2){arun[n], cst[n]};
            }
        }
    }
}
__device__ __forceinline__ void stage2(Frame& F) {
    const bf16_t* P1 = (const bf16_t*)(F.ws + WS_P1); bf16_t* YLRU = (bf16_t*)(F.ws + WS_YLRU); const float* CARRY = (const float*)(F.ws + WS_CARRY);
    const u32x2* HS = (const u32x2*)(F.ws + WS_HS); const u32x2* AF = (const u32x2*)(F.ws + WS_AF); const u32x2* AB = (const u32x2*)(F.ws + WS_AB);
    LAS float* buf = (LAS float*)(F.lds + F.wave * 8192);
    const int lane = F.lane, j = lane & 15, q = lane >> 4, tk = lane >> 2, cg = lane & 3;
    const int gw = F.bid * NWAVES + F.wave, NGW = F.G * NWAVES;
    struct In { u32x2 hs[4], af[4], ab[4]; float cf[4], cbk[4]; u32x4 g0, g1; };
    auto issue = [&](int item, In& I) {
        const int m = item & (MB - 1), task = item >> 2, h = task & 15, chunk = (task >> 4) & (NCH - 1), b = task >> 11;
#pragma unroll
        for (int n = 0; n < 4; ++n) { const size_t fo = ((size_t)item * 4 + n) * 64 + lane; I.hs[n] = HS[fo]; I.af[n] = AF[fo]; I.ab[n] = AB[fo];
            const int c = 64 * h + 16 * n + j; I.cf[n] = CARRY[((size_t)(0 * NB + b) * NCH + chunk) * 1024 + c]; I.cbk[n] = CARRY[((size_t)(1 * NB + b) * NCH + chunk) * 1024 + c]; }
        const size_t o = ((size_t)b * L + chunk * TC + 16 * m + tk) * 1024 + 64 * h + 16 * cg;
        I.g0 = *(const u32x4*)(P1 + o); I.g1 = *(const u32x4*)(P1 + o + 8); };
    auto finish = [&](int item, const In& I) {
        const int m = item & (MB - 1), task = item >> 2, h = task & 15, chunk = (task >> 4) & (NCH - 1), b = task >> 11;
#pragma unroll
        for (int n = 0; n < 4; ++n) {
            const float h0 = __uint_as_float(I.hs[n].x << 16) + __uint_as_float(I.af[n].x << 16) * I.cf[n] + __uint_as_float(I.ab[n].x << 16) * I.cbk[n];
            const float h1 = __uint_as_float(I.hs[n].x & 0xffff0000u) + __uint_as_float(I.af[n].x & 0xffff0000u) * I.cf[n] + __uint_as_float(I.ab[n].x & 0xffff0000u) * I.cbk[n];
            const float h2 = __uint_as_float(I.hs[n].y << 16) + __uint_as_float(I.af[n].y << 16) * I.cf[n] + __uint_as_float(I.ab[n].y << 16) * I.cbk[n];
            const float h3 = __uint_as_float(I.hs[n].y & 0xffff0000u) + __uint_as_float(I.af[n].y & 0xffff0000u) * I.cf[n] + __uint_as_float(I.ab[n].y & 0xffff0000u) * I.cbk[n];
            buf[(4 * q + 0) * 68 + 16 * n + j] = h0; buf[(4 * q + 1) * 68 + 16 * n + j] = h1; buf[(4 * q + 2) * 68 + 16 * n + j] = h2; buf[(4 * q + 3) * 68 + 16 * n + j] = h3;
        }
        LDS_WAIT();
        const size_t o = ((size_t)b * L + chunk * TC + 16 * m + tk) * 1024 + 64 * h + 16 * cg;
        const LAS f32x4* br = (const LAS f32x4*)(buf + tk * 68 + 16 * cg);
        const f32x4 v0 = br[0], v1 = br[1], v2 = br[2], v3 = br[3];
        float gg[16];
        { const unsigned w[8] = {I.g0.x, I.g0.y, I.g0.z, I.g0.w, I.g1.x, I.g1.y, I.g1.z, I.g1.w};
#pragma unroll
          for (int i = 0; i < 8; ++i) { gg[2 * i] = gelu_tanh(__uint_as_float(w[i] << 16)); gg[2 * i + 1] = gelu_tanh(__uint_as_float(w[i] & 0xffff0000u)); } }
        u32x4 y0, y1;
        y0.x = pk2(v0.x * gg[0], v0.y * gg[1]); y0.y = pk2(v0.z * gg[2], v0.w * gg[3]); y0.z = pk2(v1.x * gg[4], v1.y * gg[5]); y0.w = pk2(v1.z * gg[6], v1.w * gg[7]);
        y1.x = pk2(v2.x * gg[8], v2.y * gg[9]); y1.y = pk2(v2.z * gg[10], v2.w * gg[11]); y1.z = pk2(v3.x * gg[12], v3.y * gg[13]); y1.w = pk2(v3.z * gg[14], v3.w * gg[15]);
        *(u32x4*)(YLRU + o) = y0; *(u32x4*)(YLRU + o + 8) = y1;
        LDS_WAIT(); };
    constexpr int NIT = NB * NCH * 16 * MB;
    In A, B; int item = gw;
    if (item < NIT) issue(item, A);
#pragma unroll 1
    for (; item < NIT; item += 2 * NGW) {
        if (item + NGW < NIT) issue(item + NGW, B);
        finish(item, A);
        if (item + NGW >= NIT) break;
        if (item + 2 * NGW < NIT) issue(item + 2 * NGW, A);
        finish(item + NGW, B);
    }
}
__device__ __forceinline__ void carry(Frame& F) {
    const f32x2* SUMM = (const f32x2*)(F.ws + WS_SUMM); float* CARRY = (float*)(F.ws + WS_CARRY);
    for (int idx = F.bid * NTHREADS + F.tid; idx < 2 * NB * 1024; idx += F.G * NTHREADS) {
        const int c = idx & 1023, db = idx >> 10, dir = db >> 2; const size_t base = (size_t)db * NCH * 1024 + c;
        float C = 0.f;
#pragma unroll 1
        for (int k0 = 0; k0 < NCH; k0 += 16) {
            f32x2 v[16];
#pragma unroll
            for (int i = 0; i < 16; ++i) { const int k = dir == 0 ? (k0 + i) : (NCH - 1 - k0 - i); v[i] = SUMM[base + (size_t)k * 1024]; }
#pragma unroll
            for (int i = 0; i < 16; ++i) { const int k = dir == 0 ? (k0 + i) : (NCH - 1 - k0 - i); CARRY[base + (size_t)k * 1024] = C; C = v[i].x * C + v[i].y; }
        }
    }
}
}
__device__ __forceinline__ void transpose_item(const float* __restrict__ W, int ldw, int k0, int n0, bf16_t* __restrict__ WT, size_t orow0, const float* __restrict__ kscale, LAS float* scr, int lane) {
    const int r8 = lane >> 3, c4 = (lane & 7) * 4;
#pragma unroll
    for (int i = 0; i < 8; ++i) { const int kk = 8 * i + r8; f32x4 v = *(const f32x4*)(W + (size_t)(k0 + kk) * ldw + n0 + c4);
        if (kscale) { const float s = kscale[k0 + kk]; v = v * s; }
        scr[kk * 33 + c4 + 0] = v.x; scr[kk * 33 + c4 + 1] = v.y; scr[kk * 33 + c4 + 2] = v.z; scr[kk * 33 + c4 + 3] = v.w; }
    LDS_WAIT();
    const int c = lane & 7;
#pragma unroll
    for (int j = 0; j < 4; ++j) { const int n = (lane >> 3) + 8 * j; const LAS float* s = scr + (8 * c) * 33 + n;
        u32x4 o; o.x = pk2(s[0 * 33], s[1 * 33]); o.y = pk2(s[2 * 33], s[3 * 33]); o.z = pk2(s[4 * 33], s[5 * 33]); o.w = pk2(s[6 * 33], s[7 * 33]);
        *(u32x4*)(WT + (orow0 + n) * 1024 + k0 + 8 * c) = o; }
    LDS_WAIT();
}

__device__ __forceinline__ void phase_prep(Frame& F) {
    LAS float* scr = (LAS float*)(F.lds + F.wave * 16384);
    const int gw = F.bid * NWAVES + F.wave, NGW = F.G * NWAVES;
    constexpr int I_IN = (1024 / 64) * (NIN / 32), I_SQ = (1024 / 64) * (1024 / 32);
    for (int it = gw; it < I_IN + 3 * I_SQ; it += NGW) {
        int r = it; const float* W; int N; bf16_t* WT;
        if (r < I_IN) { W = F.in[2]; N = NIN; WT = (bf16_t*)(F.ws + WS_WIN); }
        else { r -= I_IN; const int q = r / I_SQ; r -= q * I_SQ; N = 1024; W = q == 0 ? F.in[11] : q == 1 ? F.in[23] : F.in[24]; WT = (bf16_t*)(F.ws + (q == 0 ? WS_WLRU : q == 1 ? WS_WHY : WS_WOUT)); }
        const int nblk = N / 32, kb = r / nblk, nb = r % nblk;
        int orow = 32 * nb;
        if (N == NIN && orow >= 5120) { const int which = (orow - 5120) >> 10, cc = (orow - 5120) & 1023; orow = 5120 + 256 * (cc >> 7) + 128 * which + (cc & 127); }
        transpose_item(W, N, 64 * kb, 32 * nb, WT, (size_t)orow, nullptr, scr, F.lane);
    }
    { const float* x = F.in[0]; const float* g = F.in[1]; bf16_t* U = (bf16_t*)(F.ws + WS_U);
      f32x4 gg[4];
#pragma unroll
      for (int j = 0; j < 4; ++j) gg[j] = ((const f32x4*)g)[F.lane + 64 * j];
      auto ld = [&](int row, f32x4 (&v)[4]) { const f32x4* xr = (const f32x4*)(x + (size_t)row * D) + F.lane;
#pragma unroll
          for (int j = 0; j < 4; ++j) v[j] = xr[64 * j]; };
      auto fin = [&](int row, const f32x4 (&v)[4]) { float s = 0.f;
#pragma unroll
          for (int j = 0; j < 4; ++j) s += v[j].x * v[j].x + v[j].y * v[j].y + v[j].z * v[j].z + v[j].w * v[j].w;
          const float rstd = rsqrtf(wave_sum(s) * (1.0f / D) + EPS);
#pragma unroll
          for (int j = 0; j < 4; ++j) { u32x2 w; w.x = pk2(v[j].x * rstd * gg[j].x, v[j].y * rstd * gg[j].y); w.y = pk2(v[j].z * rstd * gg[j].z, v[j].w * rstd * gg[j].w);
              ((u32x2*)(U + (size_t)row * D))[F.lane + 64 * j] = w; } };
      f32x4 va[4], vb[4], vc[4]; int row = gw;
      if (row < T) ld(row, va);
      if (row + NGW < T) ld(row + NGW, vb);
#pragma unroll 1
      for (; row < T; row += 3 * NGW) {
          if (row + 2 * NGW < T) ld(row + 2 * NGW, vc);
          fin(row, va);
          if (row + NGW >= T) break;
          if (row + 3 * NGW < T) ld(row + 3 * NGW, va);
          fin(row + NGW, vb);
          if (row + 2 * NGW >= T) break;
          if (row + 4 * NGW < T) ld(row + 4 * NGW, vb);
          fin(row + 2 * NGW, vc);
      } }
    { const float *w1 = F.in[14], *b1 = F.in[15], *w2 = F.in[16], *b2 = F.in[17], *w3 = F.in[18], *b3 = F.in[19], *freq = F.in[21]; float* HH3 = (float*)(F.ws + WS_HH3);
      LAS float* feat = scr; LAS float* h1 = scr + 64; LAS float* h2 = scr + 128; const int u = F.lane; const float fr = freq[u];
#pragma unroll 1
      for (int t = gw; t < L; t += NGW) {
        asm volatile("" ::: "memory");
        if (u < HYEMB) { float f; if (u == 0) f = (float)t / (float)(L - 1);
            else { const int j = (u - 1) & 15; const float band = 1e-4f + (float)j * ((15.0f - 1e-4f) / 15.0f); const float arg = (6.283185307179586f * (float)t / (float)L) * band; f = (u <= 16) ? cosf(arg) : -sinf(arg); }
            feat[u] = f; }
        LDS_WAIT();
        float s = b1[u];
#pragma unroll 1
        for (int f = 0; f < HYEMB; ++f) s += feat[f] * w1[f * 64 + u];
        h1[u] = sinf(fr * s); LDS_WAIT();
        s = b2[u];
#pragma unroll 4
        for (int f = 0; f < 64; ++f) s += h1[f] * w2[f * 64 + u];
        h2[u] = sinf(fr * s); LDS_WAIT();
        s = b3[u];
#pragma unroll 4
        for (int f = 0; f < 64; ++f) s += h2[f] * w3[f * 64 + u];
        HH3[t * 64 + u] = sinf(fr * s); LDS_WAIT(); } }
    lru::prep_wfrag(F); hy::prep_w4frag(F);
    { u32x4* WRGF = (u32x4*)(F.ws + WS_WRG); const float* g = F.in[25]; const float* wr = F.in[26];
      for (int idx = F.bid * NTHREADS + F.tid; idx < 32 * 2 * 2 * 64; idx += F.G * NTHREADS) {
          const int lane = idx & 63, part = (idx >> 6) & 1, tile = (idx >> 7) & 1, s = idx >> 8; const int e = 16 * tile + (lane & 15), k0 = 32 * s + 8 * (lane >> 4);
          float w[8];
#pragma unroll
          for (int jj = 0; jj < 8; ++jj) { const float v = g[k0 + jj] * wr[(k0 + jj) * 32 + e]; const float hi = __uint_as_float(pk2(v, v) << 16); w[jj] = part == 0 ? hi : v - hi; }
          u32x4 o; o.x = pk2(w[0], w[1]); o.y = pk2(w[2], w[3]); o.z = pk2(w[4], w[5]); o.w = pk2(w[6], w[7]); WRGF[idx] = o; } }
}

template <int KIND, bool DYN> __device__ __forceinline__ void convert_weights(Frame& F, int rank, int nranks, int rnd_lo = 0, int rnd_hi = 1 << 20) {
    LAS float* scr = (LAS float*)(F.lds + F.wave * 16384);
    const int gw = rank * NWAVES + F.wave, NGW = nranks * NWAVES;
    constexpr int IPE = KIND == 0 ? (1024 / 64) * (2048 / 32) : (1024 / 64) * (1024 / 32), TOTAL_ALL = NE * IPE;
    const int TOTAL = (long)rnd_hi * NGW < (long)TOTAL_ALL ? rnd_hi * NGW : TOTAL_ALL;
    int* ctr = (int*)(F.ws + WS_CTL) + 130;
    auto claim = [&]() { int v = 0; if (DYN && F.lane == 0) v = atomicAdd(ctr, 1); return v; };
    const float* Wc = nullptr; bf16_t* WTc = nullptr; size_t orowc = 0; int k0c = 0; f32x4 vc[8];
    auto decode_load = [&](int it, const float*& W, bf16_t*& WT, size_t& orow, int& k0, f32x4 (&v)[8]) {
        const int e = it / IPE, r = it - e * IPE; int ldw, n0;
        if (KIND == 0) { const int kb = r / 64, nb = r % 64; n0 = 32 * nb; const int which = n0 >> 10, pn = (n0 & 1023) >> 7, j0 = n0 & 127;
            W = F.in[28] + (size_t)e * 1024 * 2048; ldw = 2048; k0 = 64 * kb; WT = (bf16_t*)(F.ws + WS_WGU); orow = (size_t)e * 2048 + 256 * pn + 128 * which + j0; }
        else { const int kb = r / 32, nb = r % 32; n0 = 32 * nb;
            W = F.in[30] + (size_t)e * 1024 * 1024; ldw = 1024; k0 = 64 * kb; WT = (bf16_t*)(F.ws + WS_WDN); orow = (size_t)e * 1024 + 32 * nb; }
        const int r8 = F.lane >> 3, c4 = (F.lane & 7) * 4;
#pragma unroll
        for (int i = 0; i < 8; ++i) { const int kk = 8 * i + r8; v[i] = *(const f32x4*)(W + (size_t)(k0 + kk) * ldw + n0 + c4); if (KIND == 0) v[i] = v[i] * F.in[25][k0 + kk]; }
    };
    int it, itn, raw2 = 0;
    if (DYN) { const int r0 = claim(), r1 = claim(); raw2 = claim(); it = __builtin_amdgcn_readfirstlane(r0); itn = __builtin_amdgcn_readfirstlane(r1); }
    else { it = rnd_lo * NGW + gw; itn = it + NGW; }
    if (it < TOTAL) decode_load(it, Wc, WTc, orowc, k0c, vc);
#pragma unroll 1
    while (it < TOTAL) {
        const float* Wn = nullptr; bf16_t* WTn = nullptr; size_t orown = 0; int k0n = 0; f32x4 vn[8];
        const bool more = itn < TOTAL;
        if (more) decode_load(itn, Wn, WTn, orown, k0n, vn);
        { const int r8 = F.lane >> 3, c4 = (F.lane & 7) * 4;
#pragma unroll
          for (int i = 0; i < 8; ++i) { const int kk = 8 * i + r8; scr[kk * 33 + c4 + 0] = vc[i].x; scr[kk * 33 + c4 + 1] = vc[i].y; scr[kk * 33 + c4 + 2] = vc[i].z; scr[kk * 33 + c4 + 3] = vc[i].w; }
          LDS_WAIT();
          const int c = F.lane & 7;
#pragma unroll
          for (int j = 0; j < 4; ++j) { const int n = (F.lane >> 3) + 8 * j; const LAS float* s = scr + (8 * c) * 33 + n;
#ifdef DN_FP8
              if (KIND == 1) { int w0 = __builtin_amdgcn_cvt_pk_fp8_f32(s[0 * 33], s[1 * 33], 0, false); w0 = __builtin_amdgcn_cvt_pk_fp8_f32(s[2 * 33], s[3 * 33], w0, true);
                  int w1 = __builtin_amdgcn_cvt_pk_fp8_f32(s[4 * 33], s[5 * 33], 0, false); w1 = __builtin_amdgcn_cvt_pk_fp8_f32(s[6 * 33], s[7 * 33], w1, true);
                  *(u32x2*)((unsigned char*)WTc + (orowc + n) * 1024 + k0c + 8 * c) = (u32x2){(unsigned)w0, (unsigned)w1}; } else
#endif
              { u32x4 o; o.x = pk2(s[0 * 33], s[1 * 33]); o.y = pk2(s[2 * 33], s[3 * 33]); o.z = pk2(s[4 * 33], s[5 * 33]); o.w = pk2(s[6 * 33], s[7 * 33]);
              *(u32x4*)(WTc + (orowc + n) * 1024 + k0c + 8 * c) = o; } }
          LDS_WAIT(); }
        if (more) { Wc = Wn; WTc = WTn; orowc = orown; k0c = k0n;
#pragma unroll
            for (int i = 0; i < 8; ++i) vc[i] = vn[i]; }
        it = itn;
        if (DYN) { itn = __builtin_amdgcn_readfirstlane(raw2); raw2 = claim(); } else itn += NGW;
    }
}
__device__ __forceinline__ void phase_router_a(Frame& F) {
#ifdef MIXDESYNC
    convert_weights<0, false>(F, F.bid, F.G, 2 * MIXDESYNC); convert_weights<1, false>(F, F.bid, F.G);
#else
    REP(11) { convert_weights<0, false>(F, F.bid, F.G); convert_weights<1, false>(F, F.bid, F.G); }
#endif
    __syncthreads();
    { const f32x4* src = (const f32x4*)(F.ws + WS_WRG); LAS f32x4* dst = (LAS f32x4*)F.lds;
      for (int i = F.tid; i < 32 * 2 * 2 * 64; i += NTHREADS) dst[i] = src[i]; }
    LAS int* hist = (LAS int*)(F.lds + MISC_OFF);
    if (F.tid < 32) hist[F.tid] = 0;
    __syncthreads();
    const LAS u32x4* wl = (const LAS u32x4*)F.lds + F.lane;
    const bf16_t* HB = (const bf16_t*)(F.ws + WS_HN); const float* br = F.in[27];
    int* EROWTOK = (int*)(F.ws + WS_EROWTOK); float* EROWRS = (float*)(F.ws + WS_EROWRS); float* EROWGATE = (float*)(F.ws + WS_EROWGATE); int* TOKCODE = (int*)(F.ws + WS_TOKROW); LAS int* base = hist + 32;
    for (int g0 = 0; g0 < T / 16; g0 += F.G * NWAVES) {
        const int grp = g0 + F.bid * NWAVES + F.wave; const bool act = grp < T / 16;
        int te_[4] = {0, 0, 0, 0}, lr_[4] = {0, 0, 0, 0}; float gt_[4] = {0.f, 0.f, 0.f, 0.f}, rs_ = 0.f;
        const int n = F.lane & 15, g = F.lane >> 4; const int t = grp * 16 + n;
        if (act) {
        const u32x4* hp = (const u32x4*)(HB + (size_t)t * D + 8 * g);
        f32x4 acc[2] = {(f32x4){0.f, 0.f, 0.f, 0.f}, (f32x4){0.f, 0.f, 0.f, 0.f}}; f32x2 ss2 = (f32x2){0.f, 0.f};
        u32x4 hb[8];
#pragma unroll
        for (int u = 0; u < 8; ++u) hb[u] = hp[u * 4];
#pragma unroll 1
        for (int s0 = 0; s0 < 32; s0 += 8) {
#pragma unroll
            for (int u = 0; u < 8; ++u) { const int s = s0 + u; const u32x4 cur = hb[u];
                if (s0 + 8 < 32) hb[u] = hp[(s + 8) * 4];
                const bf16x8 bfr = __builtin_bit_cast(bf16x8, cur);
#pragma unroll
                for (int tile = 0; tile < 2; ++tile) {
                    acc[tile] = __builtin_amdgcn_mfma_f32_16x16x32_bf16(__builtin_bit_cast(bf16x8, wl[((s * 2 + tile) * 2 + 0) * 64]), bfr, acc[tile], 0, 0, 0);
                    acc[tile] = __builtin_amdgcn_mfma_f32_16x16x32_bf16(__builtin_bit_cast(bf16x8, wl[((s * 2 + tile) * 2 + 1) * 64]), bfr, acc[tile], 0, 0, 0); }
                const f32x2 a = (f32x2){__uint_as_float(cur.x << 16), __uint_as_float(cur.x & 0xffff0000u)}, b = (f32x2){__uint_as_float(cur.y << 16), __uint_as_float(cur.y & 0xffff0000u)};
                const f32x2 c = (f32x2){__uint_as_float(cur.z << 16), __uint_as_float(cur.z & 0xffff0000u)}, d = (f32x2){__uint_as_float(cur.w << 16), __uint_as_float(cur.w & 0xffff0000u)};
                ss2 += a * a; ss2 += b * b; ss2 += c * c; ss2 += d * d; }
        }
        float ss = ss2.x + ss2.y; ss += __shfl_xor(ss, 16); ss += __shfl_xor(ss, 32);
        const float rstd = rsqrtf(ss * (1.0f / D) + EPS);
        float v[8];
#pragma unroll
        for (int q = 0; q < 8; ++q) v[q] = acc[q >> 2][q & 3] * rstd + br[16 * (q >> 2) + 4 * g + (q & 3)];
        float tv[4]; int te[4];
#pragma unroll
        for (int k = 0; k < 4; ++k) {
            float mx = -3.0e38f; int mi = 0;
#pragma unroll
            for (int q = 0; q < 8; ++q) { const int ex = 16 * (q >> 2) + 4 * g + (q & 3); if (v[q] > mx) { mx = v[q]; mi = ex; } }
#pragma unroll
            for (int o = 16; o <= 32; o <<= 1) { const float om = __shfl_xor(mx, o); const int oi = __shfl_xor(mi, o); if (om > mx || (om == mx && oi < mi)) { mx = om; mi = oi; } }
            tv[k] = mx; te[k] = mi;
#pragma unroll
            for (int q = 0; q < 8; ++q) { const int ex = 16 * (q >> 2) + 4 * g + (q & 3); if (ex == mi) v[q] = -3.0e38f; }
        }
        const float e1 = __expf(tv[1] - tv[0]), e2 = __expf(tv[2] - tv[0]), e3 = __expf(tv[3] - tv[0]); const float inv = 1.0f / (1.0f + e1 + e2 + e3);
        if (g == 0) {
            gt_[0] = inv; gt_[1] = e1 * inv; gt_[2] = e2 * inv; gt_[3] = e3 * inv; rs_ = rstd;
#pragma unroll
            for (int k = 0; k < 4; ++k) { te_[k] = te[k]; lr_[k] = atomicAdd((int*)&hist[te[k]], 1); }
        }
        }
        __syncthreads();
        if (F.tid < 32) base[F.tid] = hist[F.tid] != 0 ? atomicAdd((int*)(F.ws + WS_CTL) + F.tid, hist[F.tid]) : 0;
        __syncthreads();
        if (act && g == 0) { int code[4];
#pragma unroll
            for (int k = 0; k < 4; ++k) { const int e = te_[k], pos = base[e] + lr_[k]; const size_t o = (size_t)e * T + pos;
                EROWTOK[o] = t; EROWRS[o] = rs_; EROWGATE[o] = gt_[k]; code[k] = (e << 15) | pos; }
            *(int4*)(TOKCODE + t * 4) = make_int4(code[0], code[1], code[2], code[3]); }
        __syncthreads();
        if (F.tid < 32) hist[F.tid] = 0;
        __syncthreads();
    }
}
__device__ __forceinline__ const LAS int* build_ptile(Frame& F) {
    LAS int* pt = (LAS int*)(F.lds + MISC_OFF + 256);
    __syncthreads();
    if (F.tid == 0) { const int* cnt = (const int*)(F.ws + WS_CTL); int o = 0; for (int e = 0; e < 32; ++e) { pt[e] = o; o += (cnt[e] + 255) >> 8; } pt[32] = o; }
    __syncthreads();
    return pt;
}
__device__ __forceinline__ void phase_router_b(Frame& F) {
    const LAS int* pt = build_ptile(F);
    LAS int* hist = (LAS int*)(F.lds + MISC_OFF); LAS int* base = hist + 32;
    const int* TOPE = (const int*)(F.ws + WS_TOPE); const float* TOPG = (const float*)(F.ws + WS_TOPG); const float* TOKRS = (const float*)(F.ws + WS_TOKRS);
    int* ROWTOK = (int*)(F.ws + WS_ROWTOK); float* ROWGATE = (float*)(F.ws + WS_ROWGATE); float* ROWRS = (float*)(F.ws + WS_ROWRS); int* TOKROW = (int*)(F.ws + WS_TOKROW);
    int* cursor = (int*)(F.ws + WS_CTL) + 64; const int* cnt = (const int*)(F.ws + WS_CTL);
    for (int chunk = F.bid; chunk < T * 4 / NTHREADS; chunk += F.G) {
        __syncthreads();
        if (F.tid < 32) hist[F.tid] = 0;
        __syncthreads();
        const int idx = chunk * NTHREADS + F.tid; const int e = TOPE[idx]; const int lr = atomicAdd((int*)&hist[e], 1);
        __syncthreads();
        if (F.tid < 32) base[F.tid] = hist[F.tid] ? atomicAdd(cursor + F.tid, hist[F.tid]) : 0;
        __syncthreads();
        const int row = pt[e] * 256 + base[e] + lr;
        ROWTOK[row] = idx >> 2; ROWGATE[row] = TOPG[idx]; ROWRS[row] = TOKRS[idx >> 2]; TOKROW[idx] = row;
    }
    if (F.bid == 0) for (int e = F.wave; e < 32; e += NWAVES) { const int r0 = pt[e] * 256 + cnt[e], r1 = pt[e + 1] * 256; for (int r = r0 + F.lane; r < r1; r += 64) { ROWTOK[r] = 0; ROWGATE[r] = 0.f; ROWRS[r] = 0.f; } }
}
#ifdef YS_FP8
__device__ __forceinline__ void phase_final(Frame& F) {
    const int gw = F.bid * NWAVES + F.wave, NGW = F.G * NWAVES;
    float* out = F.out; const bf16_t* HB = (const bf16_t*)(F.ws + WS_HN); const unsigned char* YS8 = (const unsigned char*)(F.ws + WS_YS); const int* TOKROW = (const int*)(F.ws + WS_TOKROW); const float* g = F.in[32];
    const LAS int* pt = build_ptile(F);
    struct In { u32x4 h[2]; u32x2 y[4][2]; };
    auto issue = [&](int t, const int4 rows, In& I) {
#pragma unroll
        for (int j = 0; j < 2; ++j) I.h[j] = ((const u32x4*)(HB + (size_t)t * D))[F.lane + 64 * j];
#pragma unroll
        for (int k = 0; k < 4; ++k) { const int code = k == 0 ? rows.x : k == 1 ? rows.y : k == 2 ? rows.z : rows.w; const size_t row = (size_t)(pt[code >> 15] * 256 + (code & 32767));
#pragma unroll
            for (int j = 0; j < 2; ++j) I.y[k][j] = ((const u32x2*)(YS8 + row * D))[F.lane + 64 * j]; } };
    auto finish = [&](int t, const In& I) {
        float v[2][8]; float s = 0.f;
#pragma unroll
        for (int j = 0; j < 2; ++j) { const unsigned hw[4] = {I.h[j].x, I.h[j].y, I.h[j].z, I.h[j].w};
#pragma unroll
            for (int i = 0; i < 4; ++i) { v[j][2 * i] = __uint_as_float(hw[i] << 16); v[j][2 * i + 1] = __uint_as_float(hw[i] & 0xffff0000u); }
#pragma unroll
            for (int k = 0; k < 4; ++k) { const f32x2 a = __builtin_amdgcn_cvt_pk_f32_fp8((int)I.y[k][j].x, false), b = __builtin_amdgcn_cvt_pk_f32_fp8((int)I.y[k][j].x, true),
                                                      c = __builtin_amdgcn_cvt_pk_f32_fp8((int)I.y[k][j].y, false), d = __builtin_amdgcn_cvt_pk_f32_fp8((int)I.y[k][j].y, true);
                v[j][0] += a.x; v[j][1] += a.y; v[j][2] += b.x; v[j][3] += b.y; v[j][4] += c.x; v[j][5] += c.y; v[j][6] += d.x; v[j][7] += d.y; }
#pragma unroll
            for (int i = 0; i < 8; ++i) s += v[j][i] * v[j][i]; }
        const float rstd = rsqrtf(wave_sum(s) * (1.0f / D) + EPS);
#pragma unroll
        for (int j = 0; j < 2; ++j) { const f32x4 g0 = ((const f32x4*)g)[2 * (F.lane + 64 * j)], g1 = ((const f32x4*)g)[2 * (F.lane + 64 * j) + 1];
            f32x4* o = (f32x4*)(out + (size_t)t * D) + 2 * (F.lane + 64 * j);
            o[0] = (f32x4){v[j][0] * rstd * g0.x, v[j][1] * rstd * g0.y, v[j][2] * rstd * g0.z, v[j][3] * rstd * g0.w};
            o[1] = (f32x4){v[j][4] * rstd * g1.x, v[j][5] * rstd * g1.y, v[j][6] * rstd * g1.z, v[j][7] * rstd * g1.w}; } };
    int t = gw;
    int4 rowsA = make_int4(0, 0, 0, 0), rowsB = make_int4(0, 0, 0, 0); In dA, dB;
    if (t < T) rowsA = *(const int4*)(TOKROW + t * 4);
    if (t + NGW < T) rowsB = *(const int4*)(TOKROW + (t + NGW) * 4);
    if (t < T) issue(t, rowsA, dA);
#pragma unroll 1
    for (; t < T; t += 2 * NGW) {
        const int t1 = t + NGW, t2 = t + 2 * NGW, t3 = t + 3 * NGW;
        if (t2 < T) rowsA = *(const int4*)(TOKROW + t2 * 4);
        if (t1 < T) issue(t1, rowsB, dB);
        finish(t, dA);
        if (t1 >= T) break;
        if (t3 < T) rowsB = *(const int4*)(TOKROW + t3 * 4);
        if (t2 < T) issue(t2, rowsA, dA);
        finish(t1, dB);
    }
}
#else
__device__ __forceinline__ void phase_final(Frame& F) {
    const int gw = F.bid * NWAVES + F.wave, NGW = F.G * NWAVES;
    float* out = F.out; const bf16_t* HB = (const bf16_t*)(F.ws + WS_HN); const bf16_t* YS = (const bf16_t*)(F.ws + WS_YS); const int* TOKROW = (const int*)(F.ws + WS_TOKROW); const float* g = F.in[32];
    const LAS int* pt = build_ptile(F);
    auto issue = [&](int t, const int4 rows, u32x2 (&d)[5][4]) {
#pragma unroll
        for (int j = 0; j < 4; ++j) d[0][j] = ((const u32x2*)(HB + (size_t)t * D))[F.lane + 64 * j];
#pragma unroll
        for (int k = 0; k < 4; ++k) { const int code = k == 0 ? rows.x : k == 1 ? rows.y : k == 2 ? rows.z : rows.w; const size_t row = (size_t)(pt[code >> 15] * 256 + (code & 32767));
#pragma unroll
            for (int j = 0; j < 4; ++j) d[1 + k][j] = ((const u32x2*)(YS + row * D))[F.lane + 64 * j]; } };
    auto finish = [&](int t, const u32x2 (&d)[5][4]) {
        f32x4 v[4];
#pragma unroll
        for (int j = 0; j < 4; ++j) { v[j] = (f32x4){__uint_as_float(d[0][j].x << 16), __uint_as_float(d[0][j].x & 0xffff0000u), __uint_as_float(d[0][j].y << 16), __uint_as_float(d[0][j].y & 0xffff0000u)};
#pragma unroll
            for (int k = 1; k < 5; ++k) { const u32x2 w = d[k][j];
                v[j].x += __uint_as_float(w.x << 16); v[j].y += __uint_as_float(w.x & 0xffff0000u); v[j].z += __uint_as_float(w.y << 16); v[j].w += __uint_as_float(w.y & 0xffff0000u); } }
        float s = 0.f;
#pragma unroll
        for (int j = 0; j < 4; ++j) s += v[j].x * v[j].x + v[j].y * v[j].y + v[j].z * v[j].z + v[j].w * v[j].w;
        const float rstd = rsqrtf(wave_sum(s) * (1.0f / D) + EPS);
#pragma unroll
        for (int j = 0; j < 4; ++j) { const f32x4 gg = ((const f32x4*)g)[F.lane + 64 * j];
            ((f32x4*)(out + (size_t)t * D))[F.lane + 64 * j] = (f32x4){v[j].x * rstd * gg.x, v[j].y * rstd * gg.y, v[j].z * rstd * gg.z, v[j].w * rstd * gg.w}; } };
    int t = gw;
    int4 rowsA = make_int4(0, 0, 0, 0), rowsB = make_int4(0, 0, 0, 0); u32x2 dA[5][4], dB[5][4];
    if (t < T) rowsA = *(const int4*)(TOKROW + t * 4);
    if (t + NGW < T) rowsB = *(const int4*)(TOKROW + (t + NGW) * 4);
    if (t < T) issue(t, rowsA, dA);
#pragma unroll 1
    for (; t < T; t += 2 * NGW) {
        const int t1 = t + NGW, t2 = t + 2 * NGW, t3 = t + 3 * NGW;
        if (t2 < T) rowsA = *(const int4*)(TOKROW + t2 * 4);
        if (t1 < T) issue(t1, rowsB, dB);
        finish(t, dA);
        if (t1 >= T) break;
        if (t3 < T) rowsB = *(const int4*)(TOKROW + t3 * 4);
        if (t2 < T) issue(t2, rowsA, dA);
        finish(t1, dB);
    }
}

#endif
__global__ void __launch_bounds__(NTHREADS, 2) mega(Args args) {
    extern __shared__ __attribute__((aligned(16))) unsigned char lds_raw[];
    cg::grid_group grid = cg::this_grid();
    Frame F; F.lds = (LAS unsigned char*)lds_raw; F.tid = threadIdx.x; F.lane = F.tid & 63; F.wave = __builtin_amdgcn_readfirstlane(F.tid >> 6); F.G = gridDim.x; F.bid = blockIdx.x;
    F.in = args.in; F.out = args.out; F.ws = args.ws;
    const int lo = args.ph_lo, hi = args.ph_hi;
    if (F.tid < 2) ((LAS unsigned*)(F.lds + MISC_OFF + 512))[F.tid] = 0u;
    __syncthreads();
    (void)xcd_barrier_post((unsigned*)(args.ws + WS_CTL + 16384) + args.li * XCD_BAR_WORDS, (volatile LAS unsigned*)(F.lds + MISC_OFF + 512));
#ifndef STAG1
#define STAG1 650
#endif
#define IN(k) (lo <= (k) && (k) < hi)
#define FRESH() do { size_t z_ = 0; F.tid = threadIdx.x; asm volatile("" : "+s"(z_), "+v"(F.tid)); F.ws = args.ws + z_; F.lane = F.tid & 63; ws = F.ws; } while (0)
#ifdef PROBE_PHASE
#define TS(k) do { if (blockIdx.x == 0 && threadIdx.x == 0) ((unsigned long long*)(args.ws + WS_CTL + 2048))[k] = __builtin_amdgcn_s_memrealtime(); } while (0)
#else
#define TS(k) do {} while (0)
#endif
#define SEAM(k) do { if (IN(k) && IN((k) + 1)) { if (hi > 1000) grid.sync();   else { XcdBarrier xb_; xb_.bar = (unsigned*)(args.ws + WS_CTL + 16384) + args.li * XCD_BAR_WORDS; xb_.x = xb_xcc_id(); xb_.st = (volatile LAS unsigned*)(F.lds + MISC_OFF + 512); xcd_barrier(xb_); if ((DUPMASK >> 21) & 1) xcd_barrier(xb_); } } } while (0)
    unsigned char* ws = args.ws;
    if (IN(0)) { TS(0); FRESH(); REP(0) phase_prep(F); } SEAM(0);
    if (IN(1)) { TS(1); FRESH();
        pg8::SchedDenseT<1> S; S.bias = args.in[3]; S.O.init(T / 256, NIN / 256, F.G, F.bid); S.A = (const char*)(ws + WS_U); S.B = (const char*)(ws + WS_WIN);
        pg8::EpiIn E{(bf16_t*)(ws + WS_P0), (bf16_t*)(ws + WS_P1), (bf16_t*)(ws + WS_PHY), (bf16_t*)(ws + WS_PG), args.in[3]};
#ifdef DESYNC1
        const int nbefore_ = DESYNC1 == 2 ? (((F.bid >> 3) & 1) ? 0 : 4) : DESYNC1 == 4 ? ((F.bid >> 3) & 3) : DESYNC1 == 3 ? 2 * ((F.bid >> 3) & 1) + 1 : 0;
        if (nbefore_ > 0) { hy::init_tw128(F); hy::filter_pass_a<false>(F, 0, nbefore_); __syncthreads(); }
#endif
        pg8::gemm_phase<pg8::EpiIn, pg8::SchedDenseT<1>, false>(F.lds, S, E); if ((DUPMASK >> 1) & 1) { pg8::gemm_phase<pg8::EpiIn, pg8::SchedDenseT<1>, false>(F.lds, S, E); } if ((DUPMASK >> 13) & 1) { pg8::EpiProbeStore E1{(bf16_t*)(ws + WS_YZ)}; pg8::gemm_phase<pg8::EpiProbeStore, pg8::SchedDenseT<1>, false>(F.lds, S, E1); } if ((DUPMASK >> 12) & 1) { pg8::EpiNone E0; pg8::gemm_phase<pg8::EpiNone, pg8::SchedDenseT<1>, false>(F.lds, S, E0); }
        if ((DUPMASK >> 18) & 1) { pg8::EpiNone E0; pg8::SchedDenseProbe SP; SP.O = S.O; SP.A = S.A; SP.B = S.B; pg8::gemm_phase<pg8::EpiNone, pg8::SchedDenseProbe, false>(F.lds, SP, E0); }
#ifdef DESYNC1
        if (nbefore_ < 4) { __syncthreads(); hy::init_tw128(F); hy::filter_pass_a<false>(F, nbefore_); }
#else
        hy::init_tw128(F); if ((DUPMASK >> 14) & 1) hy::filter_pass_a<true>(F); hy::filter_pass_a<false>(F);
#endif
    } SEAM(1);
#ifdef P2_ALTERNATE
    if (IN(2)) { TS(2); FRESH();
        const bool rev_ = ((F.bid >> 3) & 1) != 0;
        if (!rev_) { lru::stage1(F); __syncthreads(); hy::init_tw128(F); hy::filter_pass_b<false>(F); hy::prepass(F); }
        else { hy::prepass(F); __syncthreads(); FRESH(); hy::init_tw128(F); hy::filter_pass_b<false>(F); __syncthreads(); FRESH(); lru::stage1(F); }
    } SEAM(2);
#else
    if (IN(2)) { TS(2); FRESH(); REP(4) lru::stage1(F); __syncthreads(); hy::init_tw128(F); if ((DUPMASK >> 15) & 1) hy::filter_pass_b<true>(F); hy::filter_pass_b<false>(F); REP(2) hy::prepass(F); } SEAM(2);
#endif
    if (IN(3)) { TS(3); FRESH(); hy::init_tw128(F); REP(3) hy::data_pass_a(F); } SEAM(3);
    if (IN(4)) { TS(4); FRESH(); REP(16) lru::carry(F); hy::init_tw128(F); if ((DUPMASK >> 17) & 1) hy::data_pass_b<true>(F); hy::data_pass_b<false>(F); } SEAM(4);
    if (IN(5)) { TS(5); FRESH(); hy::init_tw128(F); if ((DUPMASK >> 5) & 1) hy::data_pass_c<true>(F); hy::data_pass_c<false>(F); __syncthreads(); REP(6) lru::stage2(F); } SEAM(5);
    if (IN(6)) { TS(6); FRESH();
        pg8::SchedMix S; S.O.init(T / 256, D / 256, F.G, F.bid); S.A0 = (const char*)(ws + WS_YLRU); S.A1 = (const char*)(ws + WS_YHY); S.B0 = (const char*)(ws + WS_WLRU); S.B1 = (const char*)(ws + WS_WHY);
        pg8::EpiMix E{(const bf16_t*)(ws + WS_PG), (bf16_t*)(ws + WS_MIX)};
#ifdef MIXDESYNC
        const int cls_ = (F.bid >> 3) & 3; constexpr int RND_ = MIXDESYNC;
        if (cls_ > 0) { convert_weights<0, false>(F, F.bid, F.G, 0, RND_ * cls_ / 4); __syncthreads(); }
#endif
        pg8::gemm_phase<pg8::EpiMix, pg8::SchedMix, false>(F.lds, S, E); if ((DUPMASK >> 7) & 1) { pg8::gemm_phase<pg8::EpiMix, pg8::SchedMix, false>(F.lds, S, E); }
#ifdef MIXDESYNC
        __syncthreads(); convert_weights<0, false>(F, F.bid, F.G, RND_ * cls_ / 4, RND_);
#endif
    } SEAM(6);
    if (IN(7)) { TS(7); FRESH();
        pg8::SchedDenseT<0> S; S.bias = nullptr; S.O.init(T / 256, D / 256, F.G, F.bid); S.A = (const char*)(ws + WS_MIX); S.B = (const char*)(ws + WS_WOUT);
        pg8::EpiH E{args.in[0], (bf16_t*)(ws + WS_HN)};
        { u32x4* z = (u32x4*)(ws + WS_EROWTOK); const u32x4 z4 = (u32x4){0u, 0u, 0u, 0u};
          for (int i = F.bid * NTHREADS + F.tid; i < 3 * NE * T / 4; i += F.G * NTHREADS) z[i] = z4; }
#ifdef MIXDESYNC
        const int cls_ = (F.bid >> 3) & 3; constexpr int RND_ = MIXDESYNC; const int rrem_ = RND_;
        if (cls_ > 0) { convert_weights<0, false>(F, F.bid, F.G, RND_, RND_ + rrem_ * cls_ / 4); __syncthreads(); }
#endif
        pg8::gemm_phase<pg8::EpiH, pg8::SchedDenseT<0>, false>(F.lds, S, E); if ((DUPMASK >> 8) & 1) { pg8::gemm_phase<pg8::EpiH, pg8::SchedDenseT<0>, false>(F.lds, S, E); }
#ifdef MIXDESYNC
        __syncthreads(); convert_weights<0, false>(F, F.bid, F.G, RND_ + rrem_ * cls_ / 4, 2 * RND_);
#endif
    } SEAM(7);
    if (IN(8)) { TS(8); FRESH(); phase_router_a(F); } SEAM(8);
    if (IN(10)) { TS(10); FRESH();
        const LAS int* pt = build_ptile(F);
        pg8::SchedMoE<8, true> S{args.in[29], (const float*)(ws + WS_EROWRS), pt, F.G, F.bid, (const char*)(ws + WS_HN), (const char*)(ws + WS_WGU), (size_t)2048 * 1024 * 2, (const int*)(ws + WS_EROWTOK)};
        pg8::EpiGU E{args.in[29], (const float*)(ws + WS_ROWRS), (bf16_t*)(ws + WS_ACT)};
#ifdef DESYNC_GU
        { const int rounds_ = (pt[32] * 8 + F.G - 1) / F.G; pg8::Unit u_; if (!S.next(rounds_ - 1, u_)) stagger_delay(1, DESYNC_GU); }
#endif
        pg8::gemm_phase<pg8::EpiGU, pg8::SchedMoE<8, true>, true>(F.lds, S, E); if ((DUPMASK >> 9) & 1) { pg8::gemm_phase<pg8::EpiGU, pg8::SchedMoE<8, true>, true>(F.lds, S, E); }
        if ((DUPMASK >> 19) & 1) { pg8::EpiNone E0; pg8::gemm_phase<pg8::EpiNone, pg8::SchedMoE<8, true>, true>(F.lds, S, E0); }
    } SEAM(10);
    if (IN(11)) { TS(11); FRESH();
        const LAS int* pt = build_ptile(F);
#ifdef DN_FP8
        pg8::SchedMoE<4, false> S{args.in[31], (const float*)(ws + WS_EROWGATE), pt, F.G, F.bid, (const char*)(ws + WS_ACT), (const char*)(ws + WS_WDN), (size_t)1024 * 1024 * 1, nullptr, 1};
#else
        pg8::SchedMoE<4, false> S{args.in[31], (const float*)(ws + WS_EROWGATE), pt, F.G, F.bid, (const char*)(ws + WS_ACT), (const char*)(ws + WS_WDN), (size_t)1024 * 1024 * 2, nullptr};
#endif
        pg8::EpiDN E{args.in[31], (const float*)(ws + WS_ROWGATE), (bf16_t*)(ws + WS_YS)};
#ifdef DESYNC_DN
        { const int rounds_ = (pt[32] * 4 + F.G - 1) / F.G; pg8::Unit u_; if (!S.next(rounds_ - 1, u_)) stagger_delay(1, DESYNC_DN); }
#endif
#ifdef DN_FP8
        pg8::gemm_phase<pg8::EpiDN, pg8::SchedMoE<4, false>, false, 1>(F.lds, S, E);
#else
        pg8::gemm_phase<pg8::EpiDN, pg8::SchedMoE<4, false>, false>(F.lds, S, E);
#endif
        if ((DUPMASK >> 10) & 1) { pg8::gemm_phase<pg8::EpiDN, pg8::SchedMoE<4, false>, false>(F.lds, S, E); }
        if ((DUPMASK >> 20) & 1) { pg8::EpiNone E0; pg8::gemm_phase<pg8::EpiNone, pg8::SchedMoE<4, false>, false>(F.lds, S, E0); }
    } SEAM(11);
    if (IN(12)) { TS(12); FRESH(); phase_final(F); }
#undef IN
#undef SEAM
}
static int g_grid = 0;
static void launch_mega(Args a, int lo, int hi, hipStream_t stream, int li = 0) {
    a.ph_lo = lo; a.ph_hi = hi; a.li = li; a.pad = 0; void* params[] = {&a};
    hipError_t e = hipLaunchCooperativeKernel((const void*)mega, dim3(g_grid), dim3(NTHREADS), params, LDS_BYTES, stream);
    if (e != hipSuccess) fprintf(stderr, "kernel_launch: cooperative launch [%d,%d) failed: %s (grid %d)\n", lo, hi, hipGetErrorString(e), g_grid);
}
extern "C" void kernel_launch(void* const* d_in, const int* in_sizes, int n_in, void* d_out, int out_size, void* d_ws, size_t ws_size, hipStream_t stream) {
    if (n_in != 33 || out_size != T * D || ws_size < WS_END) { fprintf(stderr, "kernel_launch: unexpected shapes n_in %d out %d ws %zu\n", n_in, out_size, ws_size); return; }
    if (g_grid == 0) {
        int dev = 0, cus = 0, per_cu = 0;
        (void)hipGetDevice(&dev); (void)hipDeviceGetAttribute(&cus, hipDeviceAttributeMultiprocessorCount, dev);
        if (hipFuncSetAttribute((const void*)mega, hipFuncAttributeMaxDynamicSharedMemorySize, LDS_BYTES) != hipSuccess) { fprintf(stderr, "kernel_launch: hipFuncSetAttribute failed\n"); g_grid = -1; return; }
        if (hipOccupancyMaxActiveBlocksPerMultiprocessor(&per_cu, (const void*)mega, NTHREADS, LDS_BYTES) != hipSuccess || per_cu < 1) { fprintf(stderr, "kernel_launch: occupancy query says %d\n", per_cu); g_grid = -1; return; }
        g_grid = cus;
    }
    if (g_grid < 0) return;
    const float* in[33]; for (int i = 0; i < 33; ++i) in[i] = (const float*)d_in[i];
    unsigned char* ws = (unsigned char*)d_ws; float* out = (float*)d_out;
    int* cnt = (int*)(ws + WS_CTL); float* NORM = (float*)(ws + WS_NORM); float* HH3 = (float*)(ws + WS_HH3);
    bf16_t* YLRU = (bf16_t*)(ws + WS_YLRU); bf16_t* HN = (bf16_t*)(ws + WS_HN); bf16_t* YHY = (bf16_t*)(ws + WS_YHY);
    bf16_t* PG = (bf16_t*)(ws + WS_PG); bf16_t* P0 = (bf16_t*)(ws + WS_P0); bf16_t* P1 = (bf16_t*)(ws + WS_P1); bf16_t* PHY = (bf16_t*)(ws + WS_PHY);
    bf16_t* MIX = (bf16_t*)(ws + WS_MIX); float* MIXF = (float*)(ws + WS_MIXF); bf16_t* ACT = (bf16_t*)(ws + WS_ACT); bf16_t* YS = (bf16_t*)(ws + WS_YS);
    float* XR = (float*)(ws + WS_XR); float* HF = (float*)(ws + WS_HF); float* KC = (float*)(ws + WS_KC);
    int* ROWTOK = (int*)(ws + WS_ROWTOK); float* ROWGATE = (float*)(ws + WS_ROWGATE); float* ROWRS = (float*)(ws + WS_ROWRS);
    (void)hipMemsetAsync(ws + WS_CTL, 0, CTL_BYTES, stream);
    Args a{}; for (int i = 0; i < 33; ++i) a.in[i] = in[i]; a.out = out; a.ws = ws;
    launch_mega(a, 0, 13, stream);
}
```

```cpp
#define DUPMASK 0x0
#define DESYNC1 4
#define DN_REVERSE 1
#define P2_ALTERNATE 1
#define YS_FP8 1
#define YZ_BF8 1
#define KF_BF8 1
#define DN_FP8 1
#define GU_FP8 1
#include <hip/hip_runtime.h>
#include <hip/hip_cooperative_groups.h>
#include <cstdio>
#include <cstdint>
namespace cg = cooperative_groups;

typedef unsigned short bf16_t;
typedef float f32x4 __attribute__((ext_vector_type(4)));
typedef float f32x2 __attribute__((ext_vector_type(2)));
typedef unsigned u32x4 __attribute__((ext_vector_type(4)));
typedef unsigned u32x2 __attribute__((ext_vector_type(2)));
typedef short bf16x8 __attribute__((ext_vector_type(8)));

constexpr int T = 32768, D = 1024, L = 8192, NB = 4, NE = 32, TOPK = 4, NIN = 7168, L2X = 16384;
constexpr int HEADS = 16, HBLK = 64, HYFF = 64, HYEMB = 33;
constexpr int NPAD = T * TOPK + NE * 256;
constexpr float EPS = 1e-5f;

constexpr size_t MiB = 1u << 20;
constexpr size_t WS_CTL = 0;
constexpr size_t CTL_BYTES = 64 * 1024;
constexpr size_t WS_NORM = 4096;
constexpr size_t WS_HH3 = 2 * MiB;
constexpr size_t WS_WRG = 4 * MiB;
constexpr size_t WS_TOPE = 5 * MiB;
constexpr size_t WS_TOPG = 6 * MiB;
constexpr size_t WS_TOKRS = 7 * MiB;
constexpr size_t WS_ROWTOK = 8 * MiB;
constexpr size_t WS_ROWGATE = 9 * MiB;
constexpr size_t WS_ROWRS = 10 * MiB;
constexpr size_t WS_TOKROW = 11 * MiB;
constexpr size_t WS_WF4 = 14 * MiB;
constexpr size_t WS_NORMP = 15 * MiB;
constexpr size_t WS_EROWTOK = 164 * MiB, WS_EROWRS = 168 * MiB, WS_EROWGATE = 172 * MiB;
constexpr size_t WS_HB8 = 100 * MiB;
constexpr size_t WS_WLRUF = 13 * MiB;
constexpr size_t WS_SUMM = 996 * MiB;
constexpr size_t WS_CARRY = 1004 * MiB;
constexpr size_t WS_WIN = 16 * MiB;
constexpr size_t WS_WLRU = 30 * MiB, WS_WHY = 32 * MiB, WS_WOUT = 34 * MiB;
constexpr size_t WS_U = 36 * MiB;
constexpr size_t WS_Z16 = 36 * MiB, WS_HN = 36 * MiB;
constexpr size_t WS_YHY = 100 * MiB;
constexpr size_t WS_PG = 164 * MiB;
constexpr size_t WS_P0 = 292 * MiB;
constexpr size_t WS_P1 = 356 * MiB;
constexpr size_t WS_PHY = 420 * MiB;
constexpr size_t WS_MIX = 356 * MiB;
constexpr size_t WS_HS = 740 * MiB;
constexpr size_t WS_YLRU = 292 * MiB;
constexpr size_t WS_AF = 804 * MiB, WS_AB = 932 * MiB;
constexpr size_t WS_MIXF = 484 * MiB;
constexpr size_t WS_ACT = 292 * MiB;
constexpr size_t WS_R2 = 612 * MiB;
constexpr size_t WS_YZ = 612 * MiB;
constexpr size_t WS_KF = 868 * MiB;
constexpr size_t WS_WDN = 612 * MiB;
constexpr size_t WS_WGU = 676 * MiB;
constexpr size_t WS_YS = 676 * MiB;
constexpr size_t WS_XR = 612 * MiB;
constexpr size_t WS_HF = 740 * MiB;
constexpr size_t WS_KC = 868 * MiB;
constexpr size_t WS_END = 1024 * MiB;

__device__ __forceinline__ float bf2f(bf16_t b) { return __uint_as_float(((unsigned)b) << 16); }
__device__ __forceinline__ bf16_t f2bf(float f) { unsigned u = __float_as_uint(f); u += 0x7fffu + ((u >> 16) & 1u); return (bf16_t)(u >> 16); }
__device__ __forceinline__ unsigned pk2(float lo, float hi) { unsigned r; asm("v_cvt_pk_bf16_f32 %0, %1, %2" : "=v"(r) : "v"(lo), "v"(hi)); return r; }
__device__ __forceinline__ float fexp(float x) { return __builtin_amdgcn_exp2f(x * 1.4426950408889634f); }
__device__ __forceinline__ float sigmoidf_(float x) { return __builtin_amdgcn_rcpf(1.0f + fexp(-x)); }
__device__ __forceinline__ float gelu_tanh(float x) { const float u = 0.7978845608028654f * (x + 0.044715f * x * x * x); return x * sigmoidf_(2.0f * u); }
__device__ __forceinline__ float swiglu(float g, float u) { const float g_ = fminf(g, 7.0f); const float u_ = fminf(fmaxf(u, -7.0f), 7.0f); return (u_ + 1.0f) * (g_ * sigmoidf_(1.702f * g_)); }
__device__ __forceinline__ float wave_sum(float v) {
#pragma unroll
    for (int o = 1; o < 64; o <<= 1) v += __shfl_xor(v, o);
    return v;
}
__device__ __forceinline__ int expert_offpad(const int* cnt, int e) { int o = 0; for (int i = 0; i < e; ++i) o += (cnt[i] + 255) & ~255; return o; }
__device__ __forceinline__ float hy_delta_abs(int c) {
    const float lo = -4.605170185988091f / 1.5f, hi = -4.605170185988091f / 0.3f;
    return fabsf(lo + (hi - lo) * ((float)c / 1023.0f));
}
#define LAS __attribute__((address_space(3)))
constexpr int NWAVES = 8, NTHREADS = 512, LDS_BYTES = 147456, MISC_OFF = 131072;

typedef long l64x2 __attribute__((ext_vector_type(2)));
namespace pg8 {
constexpr int BM = 256, BK = 64, HALF = 128, HTB = HALF * BK * 2, NXCD = 8, WGM = 8, KD = 1024;
__host__ __device__ __forceinline__ int lds_byte(int r, int c) { const int st = (r >> 4) * 2 + (c >> 5), rr = r & 15, cc = c & 31, ob = rr * 64 + cc * 2; return st * 1024 + (ob ^ (((ob >> 9) & 1) << 5)); }
__host__ __device__ __forceinline__ void stage_rc(int b, int& R, int& C) { const int st = b / 1024, sb = b % 1024, swz = sb ^ (((sb >> 9) & 1) << 5); R = (st >> 1) * 16 + swz / 64; C = (st & 1) * 32 + (swz % 64) / 2; }
__host__ __device__ __forceinline__ int perm32(int rho) { const int n = rho >> 4, i = rho & 15; return 8 * (i >> 2) + 4 * n + (i & 3); }

struct Unit { const char* A; const char* B; int pm, pn, e, gm; };

struct DenseOrder {
    int nM, nN, nwg, G, c;
    __device__ __forceinline__ void init(int nM_, int nN_, int G_, int c_) { nM = nM_; nN = nN_; nwg = nM * nN; G = G_; c = c_; }
    __device__ __forceinline__ bool tile(int i, int& pm, int& pn) const {
        const long Lx = (long)i * G + c; if (Lx >= nwg) return false;
        int wgid = (int)Lx; { const int q = nwg / NXCD, r = nwg % NXCD, xcd = wgid % NXCD, off = wgid / NXCD; wgid = (xcd < r ? xcd * (q + 1) : r * (q + 1) + (xcd - r) * q) + off; }
        const int nig = WGM * nN, gid = wgid / nig, fm = gid * WGM, gsz = (nM - fm) < WGM ? (nM - fm) : WGM;
        pm = fm + ((wgid % nig) % gsz); pn = (wgid % nig) / gsz; return true;
    }
};

__device__ __forceinline__ unsigned cvt_pk_bf16(float lo, float hi) { unsigned r; asm volatile("v_cvt_pk_bf16_f32 %0, %1, %2" : "=v"(r) : "v"(lo), "v"(hi)); return r; }

template <class Epi, class Sched, bool GATHER, int ESZ = 2>
__device__ __forceinline__ void gemm_phase(LAS unsigned char* lds, const Sched& S, const Epi& E) {
    int tid_ = threadIdx.x; asm volatile("" : "+v"(tid_));
    const int tid = tid_, wid = __builtin_amdgcn_readfirstlane(tid >> 6), lane = tid & 63, wr = wid >> 2, wc = wid & 3, fr = lane & 15, fq = lane >> 4;
    constexpr int K = KD, ROWB = K * ESZ  , nt = ROWB / (BK * 2);
    int Rr[2], Cc[2]; unsigned voffB[2];
#pragma unroll
    for (int i = 0; i < 2; ++i) { int R, C; stage_rc(tid * 16 + i * 8192, R, C); Rr[i] = R; Cc[i] = C; const int Rb = (R & ~31) + perm32(R & 31); voffB[i] = (unsigned)(Rb * ROWB + C * 2); }
    constexpr size_t kstep = (size_t)(BK * 2);
    constexpr size_t hstep = (size_t)HALF * ROWB;
    const unsigned ldsw = (unsigned)wid * 1024u;
    const int aoff = lds_byte(wr * 64 + fr, fq * 8), boff = lds_byte(wc * 32 + fr, fq * 8);
#define PG8_SA(b, h) (((b) * 2 + (h)) * HTB)
#define PG8_SB(b, h) ((4 + (b) * 2 + (h)) * HTB)
#define PG8_GLDS(gp, lp) __builtin_amdgcn_global_load_lds((const unsigned*)(gp), (LAS unsigned*)(lp), 16, 0, 0)
#define PG8_STAGEB(bufoff, gbase) do { PG8_GLDS((const char*)(gbase) + voffB[0], lds + (bufoff) + ldsw); PG8_GLDS((const char*)(gbase) + voffB[1], lds + (bufoff) + ldsw + 8192); } while (0)
#define PG8_STAGEA(bufoff, gbase, o0, o1) do { PG8_GLDS((const char*)(gbase) + (o0), lds + (bufoff) + ldsw); PG8_GLDS((const char*)(gbase) + (o1), lds + (bufoff) + ldsw + 8192); } while (0)
#define PG8_LDA(dst, b, h) do { _Pragma("unroll") for (int m = 0; m < 4; ++m) _Pragma("unroll") for (int k = 0; k < 2; ++k) dst[m][k] = *(const LAS bf16x8*)(lds + PG8_SA(b, h) + aoff + m * 2048 + k * 1024); } while (0)
#define PG8_LDB(dst, b, h) do { _Pragma("unroll") for (int n = 0; n < 2; ++n) _Pragma("unroll") for (int k = 0; k < 2; ++k) dst[n][k] = *(const LAS bf16x8*)(lds + PG8_SB(b, h) + boff + n * 2048 + k * 1024); } while (0)
#define PG8_MMA(ai, bj, At, Bt) do { __builtin_amdgcn_s_setprio(1); _Pragma("unroll") for (int m = 0; m < 4; ++m) _Pragma("unroll") for (int n = 0; n < 2; ++n) _Pragma("unroll") for (int k = 0; k < 2; ++k) \
        { if constexpr (ESZ == 2) acc[ai][bj][m][n] = __builtin_amdgcn_mfma_f32_16x16x32_bf16(Bt[n][k], At[m][k], acc[ai][bj][m][n], 0, 0, 0); \
          else { const l64x2 b_ = __builtin_bit_cast(l64x2, Bt[n][k]), a_ = __builtin_bit_cast(l64x2, At[m][k]); \
                 acc[ai][bj][m][n] = __builtin_amdgcn_mfma_f32_16x16x32_fp8_fp8(b_.x, a_.x, acc[ai][bj][m][n], 0, 0, 0); acc[ai][bj][m][n] = __builtin_amdgcn_mfma_f32_16x16x32_fp8_fp8(b_.y, a_.y, acc[ai][bj][m][n], 0, 0, 0); } } \
        __builtin_amdgcn_s_setprio(0); } while (0)
#define PG8_WAIT_V(n) asm volatile("s_waitcnt vmcnt(" #n ")" ::: "memory")
#define PG8_WAIT_L(n) asm volatile("s_waitcnt lgkmcnt(" #n ")" ::: "memory")
#define PG8_WAIT_V8_UNLESS(flag) asm volatile("s_cmp_lg_u32 %0, 0\n\ts_cbranch_scc1 .Lskipw%=\n\ts_waitcnt vmcnt(8)\n.Lskipw%=:" :: "s"(flag) : "scc", "memory")
#define PG8_BAR __builtin_amdgcn_s_barrier()
#define PG8_SCHED __builtin_amdgcn_sched_barrier(0)
    Unit cur, nxt; int ui = 0;
    if (!S.next(0, cur)) return;
    LAS int* tokbuf = (LAS int*)(lds + MISC_OFF + 3072);
#define PG8_AOFF(par, h, i) (GATHER ? ((unsigned)tokbuf[(par) * 256 + (h) * HALF + Rr[i]] * (unsigned)ROWB + (unsigned)(Cc[i] * 2)) : ((unsigned)(Rr[i] * ROWB + Cc[i] * 2) + (unsigned)((h) * hstep)))
    LAS float* side = (LAS float*)(lds + MISC_OFF + 6144);
    if (GATHER || Sched::NSIDE > 0) {
        if (GATHER && tid < 256) tokbuf[tid] = S.ROWTOK_row(cur, tid);
        if (Sched::NSIDE > 0 && tid < 256 * Sched::NSIDE) side[tid] = *S.side_addr(cur, tid >> 8, tid & 255);
        asm volatile("s_waitcnt vmcnt(0) lgkmcnt(0)" ::: "memory"); __builtin_amdgcn_s_barrier(); }
    f32x4 acc[2][2][4][2];
#pragma unroll
    for (int a = 0; a < 2; ++a)
#pragma unroll
        for (int b = 0; b < 2; ++b)
#pragma unroll
            for (int m = 0; m < 4; ++m)
#pragma unroll
                for (int n = 0; n < 2; ++n) acc[a][b][m][n] = (f32x4){0.f, 0.f, 0.f, 0.f};
    bf16x8 At[4][2], B0[2][2], B1[2][2];
    const char* cA = cur.A; const char* cB = cur.B;
    PG8_STAGEB(PG8_SB(0, 0), cB); PG8_STAGEB(PG8_SB(0, 1), cB + hstep); PG8_STAGEA(PG8_SA(0, 0), cA, PG8_AOFF(0, 0, 0), PG8_AOFF(0, 0, 1)); PG8_STAGEA(PG8_SA(0, 1), cA, PG8_AOFF(0, 1, 0), PG8_AOFF(0, 1, 1));
    if (wr == 1) PG8_BAR;
    PG8_WAIT_V(2); PG8_BAR;
    PG8_STAGEB(PG8_SB(1, 0), cB + kstep); PG8_STAGEA(PG8_SA(1, 0), cA + kstep, PG8_AOFF(0, 0, 0), PG8_AOFF(0, 0, 1)); PG8_STAGEB(PG8_SB(1, 1), cB + hstep + kstep);
    PG8_WAIT_V(6); PG8_BAR;
    for (;;) {
        const bool has_next = S.next(ui + 1, nxt);
        const char* nA = has_next ? nxt.A : cA; const char* nB = has_next ? nxt.B : cB;
        const int pc = ui & 1, pn_ = has_next ? (pc ^ 1) : pc;
        if (Sched::NSIDE > 0 && has_next && wid < 4 * Sched::NSIDE) __builtin_amdgcn_global_load_lds((const unsigned*)S.side_addr(nxt, wid >> 2, (wid & 3) * 64 + lane), (LAS unsigned*)(side + ((ui + 1) % 3) * 512 + wid * 64), 4, 0, 0);
        if (GATHER && has_next && wid < 4) __builtin_amdgcn_global_load_lds((const unsigned*)(S.ROWTOK + S.rowoff(nxt) + wid * 64 + lane), (LAS unsigned*)(tokbuf + pn_ * 256 + wid * 64), 4, 0, 0);
        for (int t = 0; t < nt; t += 2) {
            const bool last = (t == nt - 2);
            const char* a1 = cA + (size_t)(t + 1) * kstep;
            const char* a2 = last ? nA : cA + (size_t)(t + 2) * kstep; const char* b2 = last ? nB : cB + (size_t)(t + 2) * kstep;
            const char* a3 = a2 + kstep; const char* b3 = b2 + kstep;
            const int px = last ? pn_ : pc;
            PG8_LDB(B0, 0, 0); PG8_LDB(B1, 0, 1); PG8_SCHED; PG8_LDA(At, 0, 0); PG8_STAGEA(PG8_SA(1, 1), a1, PG8_AOFF(pc, 1, 0), PG8_AOFF(pc, 1, 1));
            PG8_WAIT_V(8); PG8_WAIT_L(0); PG8_BAR; PG8_MMA(0, 0, At, B0); PG8_MMA(0, 1, At, B1); PG8_BAR; PG8_SCHED;
            PG8_LDA(At, 0, 1); PG8_STAGEB(PG8_SB(0, 0), b2); PG8_STAGEB(PG8_SB(0, 1), b2 + hstep); PG8_STAGEA(PG8_SA(0, 0), a2, PG8_AOFF(px, 0, 0), PG8_AOFF(px, 0, 1));
            PG8_WAIT_V(8); PG8_WAIT_L(0); PG8_BAR; PG8_MMA(1, 0, At, B0); PG8_MMA(1, 1, At, B1); PG8_BAR; PG8_SCHED;
            PG8_LDB(B0, 1, 0); PG8_LDB(B1, 1, 1); PG8_SCHED; PG8_LDA(At, 1, 0); PG8_STAGEA(PG8_SA(0, 1), a2, PG8_AOFF(px, 1, 0), PG8_AOFF(px, 1, 1));
            PG8_WAIT_V(8); PG8_WAIT_L(0); PG8_BAR; PG8_MMA(0, 0, At, B0); PG8_MMA(0, 1, At, B1); PG8_BAR; PG8_SCHED;
            PG8_LDA(At, 1, 1); PG8_STAGEB(PG8_SB(1, 0), b3); PG8_STAGEB(PG8_SB(1, 1), b3 + hstep); PG8_STAGEA(PG8_SA(1, 0), a3, PG8_AOFF(px, 0, 0), PG8_AOFF(px, 0, 1));
            PG8_WAIT_V(8); PG8_WAIT_L(0); PG8_BAR; PG8_MMA(1, 0, At, B0); PG8_MMA(1, 1, At, B1); PG8_BAR; PG8_SCHED;
        }
        if (wr == 0) PG8_BAR;
        bool keep = false;
        if constexpr (Epi::CHAIN) keep = E(acc, cur, wr, wc, fr, fq, (const LAS float*)(side + (ui % 3) * 512)); else E(acc, cur, wr, wc, fr, fq, (const LAS float*)(side + (ui % 3) * 512));
        if (!has_next) break;
        if (!keep) {
#pragma unroll
        for (int a = 0; a < 2; ++a)
#pragma unroll
            for (int b = 0; b < 2; ++b)
#pragma unroll
                for (int m = 0; m < 4; ++m)
#pragma unroll
                    for (int n = 0; n < 2; ++n) acc[a][b][m][n] = (f32x4){0.f, 0.f, 0.f, 0.f};
        }
        cur = nxt; cA = nA; cB = nB; ++ui;
        if (wr == 1) PG8_BAR;
    }
    PG8_WAIT_V(0);
    PG8_BAR;
#undef PG8_SA
#undef PG8_AOFF
#undef PG8_SB
#undef PG8_GLDS
#undef PG8_STAGEA
#undef PG8_STAGEB
#undef PG8_LDA
#undef PG8_LDB
#undef PG8_MMA
#undef PG8_WAIT_V
#undef PG8_WAIT_L
#undef PG8_WAIT_V8_UNLESS
#undef PG8_BAR
#undef PG8_SCHED
}

__device__ __forceinline__ void store8bf(bf16_t* p, const f32x4 v0, const f32x4 v1) {
    u32x4 w; w.x = cvt_pk_bf16(v0[0], v0[1]); w.y = cvt_pk_bf16(v0[2], v0[3]); w.z = cvt_pk_bf16(v1[0], v1[1]); w.w = cvt_pk_bf16(v1[2], v1[3]); *(u32x4*)p = w;
}
__device__ __forceinline__ void load8bf(const bf16_t* p, f32x4& v0, f32x4& v1) {
    const u32x4 w = *(const u32x4*)p;
    v0 = (f32x4){__uint_as_float(w.x << 16), __uint_as_float(w.x & 0xffff0000u), __uint_as_float(w.y << 16), __uint_as_float(w.y & 0xffff0000u)};
    v1 = (f32x4){__uint_as_float(w.z << 16), __uint_as_float(w.z & 0xffff0000u), __uint_as_float(w.w << 16), __uint_as_float(w.w & 0xffff0000u)};
}
__device__ __forceinline__ f32x2 lo2(const f32x4 v) { return (f32x2){v.x, v.y}; }
__device__ __forceinline__ f32x2 hi2(const f32x4 v) { return (f32x2){v.z, v.w}; }
__device__ __forceinline__ f32x2 sigmoid2(const f32x2 x) { const f32x2 t = x * -1.4426950408889634f; const f32x2 d = (f32x2){__builtin_amdgcn_exp2f(t.x), __builtin_amdgcn_exp2f(t.y)} + 1.0f; return (f32x2){__builtin_amdgcn_rcpf(d.x), __builtin_amdgcn_rcpf(d.y)}; }
__device__ __forceinline__ f32x2 swiglu2(const f32x2 g, const f32x2 u) {
    const f32x2 g_ = (f32x2){fminf(g.x, 7.0f), fminf(g.y, 7.0f)}; const f32x2 u_ = (f32x2){fminf(fmaxf(u.x, -7.0f), 7.0f), fminf(fmaxf(u.y, -7.0f), 7.0f)};
    const f32x2 t = g_ * (-1.702f * 1.4426950408889634f); const f32x2 d = (f32x2){__builtin_amdgcn_exp2f(t.x), __builtin_amdgcn_exp2f(t.y)} + 1.0f;
    const f32x2 p = g_ * (f32x2){__builtin_amdgcn_rcpf(d.x), __builtin_amdgcn_rcpf(d.y)}; return u_ * p + p; }
__device__ __forceinline__ void store8bf2(bf16_t* p, const f32x2 a, const f32x2 b, const f32x2 c, const f32x2 d) {
    u32x4 w; w.x = cvt_pk_bf16(a.x, a.y); w.y = cvt_pk_bf16(b.x, b.y); w.z = cvt_pk_bf16(c.x, c.y); w.w = cvt_pk_bf16(d.x, d.y); *(u32x4*)p = w; }
#define EPI_ROWS(ai, m) ((ai) * HALF + wr * 64 + (m) * 16 + fr)
#define EPI_COLS(bj) ((bj) * HALF + wc * 32 + 8 * fq)

struct EpiNone {
    static constexpr bool CHAIN = false;
    __device__ __forceinline__ void operator()(const f32x4 (&acc)[2][2][4][2], const Unit&, int, int, int, int, const LAS float*) const {
#pragma unroll
        for (int a = 0; a < 2; ++a)
#pragma unroll
            for (int b = 0; b < 2; ++b)
#pragma unroll
                for (int m = 0; m < 4; ++m)
#pragma unroll
                    for (int n = 0; n < 2; ++n) asm volatile("" :: "v"(acc[a][b][m][n]));
    }
};
struct EpiProbeStore {
    static constexpr bool CHAIN = false;
    bf16_t* dst;
    __device__ __forceinline__ void operator()(const f32x4 (&acc)[2][2][4][2], const Unit& u, int wr, int wc, int fr, int fq, const LAS float* side) const {
#pragma unroll
        for (int ai = 0; ai < 2; ++ai)
#pragma unroll
            for (int m = 0; m < 4; ++m) {
#if defined(PROBE_LOCAL)
                bf16_t* rowp = dst + (size_t)(blockIdx.x * 256 + EPI_ROWS(ai, m)) * 256;
#elif defined(PROBE_MIXED)
                bf16_t* rowp = (blockIdx.x & 3) ? dst + (size_t)(blockIdx.x * 256 + EPI_ROWS(ai, m)) * 256 : dst + (size_t)(u.pm * BM + EPI_ROWS(ai, m)) * 4096 + (u.pn & 15) * 256;
#elif defined(PROBE_WIDE)
                bf16_t* rowp = dst + (size_t)(u.pm * BM + EPI_ROWS(ai, m)) * 4096 + (u.pn & 15) * 256;
#else
                bf16_t* rowp = dst + (size_t)(u.pm * BM + EPI_ROWS(ai, m)) * 1024 + (u.pn & 3) * 256;
#endif
#pragma unroll
                for (int bj = 0; bj < 2; ++bj) store8bf(rowp + EPI_COLS(bj), acc[ai][bj][m][0], acc[ai][bj][m][1]); }
    }
};
struct EpiIn {
    static constexpr bool CHAIN = false;
    bf16_t *P0, *P1, *PHY, *PG; const float* bias;
    __device__ __forceinline__ void operator()(const f32x4 (&acc)[2][2][4][2], const Unit& u, int wr, int wc, int fr, int fq, const LAS float* side) const {
        const int seg = u.pn >> 2; bf16_t* dst; int ld, colt; int act = 0;
        if (seg == 0) { dst = P0; ld = 1024; colt = u.pn * 256; }
        else if (seg == 1) { dst = P1; ld = 1024; colt = u.pn * 256 - 1024; }
        else if (seg < 5) { dst = PHY; ld = 3072; colt = u.pn * 256 - 2048; }
        else { dst = PG; ld = 2048; colt = (u.pn - 20) * 128; act = 2; }
        f32x4 bv[2][2];
#pragma unroll
        for (int bj = 0; bj < 2; ++bj)
#pragma unroll
            for (int n = 0; n < 2; ++n) bv[bj][n] = *(const LAS f32x4*)(side + EPI_COLS(bj) + 4 * n);
        if (act == 2) {
#pragma unroll
            for (int ai = 0; ai < 2; ++ai)
#pragma unroll
                for (int m = 0; m < 4; ++m) { bf16_t* rowp = dst + (size_t)(u.pm * BM + EPI_ROWS(ai, m)) * ld + colt + wc * 32 + 8 * fq;
                    f32x2 rho[4], sh[4];
#pragma unroll
                    for (int n = 0; n < 2; ++n)
#pragma unroll
                        for (int hh = 0; hh < 2; ++hh) {
                            const f32x2 al = (hh ? hi2(acc[ai][0][m][n]) : lo2(acc[ai][0][m][n])) + (hh ? hi2(bv[0][n]) : lo2(bv[0][n]));
                            f32x2 ah = (hh ? hi2(acc[ai][1][m][n]) : lo2(acc[ai][1][m][n])) + (hh ? hi2(bv[1][n]) : lo2(bv[1][n]));
                            ah = (f32x2){fmaxf(ah.x, -80.0f), fmaxf(ah.y, -80.0f)};
                            const f32x2 tl = al * -1.4426950408889634f, th = ah * -1.4426950408889634f;
                            const f32x2 dl = (f32x2){__builtin_amdgcn_exp2f(tl.x), __builtin_amdgcn_exp2f(tl.y)} + 1.0f, dh = (f32x2){__builtin_amdgcn_exp2f(th.x), __builtin_amdgcn_exp2f(th.y)} + 1.0f;
                            sh[2 * n + hh] = (f32x2){__builtin_amdgcn_rcpf(dh.x), __builtin_amdgcn_rcpf(dh.y)};
                            rho[2 * n + hh] = dh * (f32x2){__builtin_amdgcn_rcpf(dl.x), __builtin_amdgcn_rcpf(dl.y)}; }
                    store8bf2(rowp, rho[0], rho[1], rho[2], rho[3]); store8bf2(rowp + 1024, sh[0], sh[1], sh[2], sh[3]); }
            return;
        }
#pragma unroll
        for (int ai = 0; ai < 2; ++ai)
#pragma unroll
            for (int m = 0; m < 4; ++m) { bf16_t* rowp = dst + (size_t)(u.pm * BM + EPI_ROWS(ai, m)) * ld + colt;
#pragma unroll
                for (int bj = 0; bj < 2; ++bj) { f32x2 a = lo2(acc[ai][bj][m][0]) + lo2(bv[bj][0]), b = hi2(acc[ai][bj][m][0]) + hi2(bv[bj][0]), c = lo2(acc[ai][bj][m][1]) + lo2(bv[bj][1]), d = hi2(acc[ai][bj][m][1]) + hi2(bv[bj][1]);
                    store8bf2(rowp + EPI_COLS(bj), a, b, c, d); } }
    }
};
struct EpiMix {
    static constexpr bool CHAIN = true;
    const bf16_t* PG; bf16_t* MIX;
    __device__ __forceinline__ bool operator()(f32x4 (&acc)[2][2][4][2], const Unit& u, int wr, int wc, int fr, int fq, const LAS float*) const {
#pragma unroll
        for (int ai = 0; ai < 2; ++ai)
#pragma unroll
            for (int m = 0; m < 4; ++m) { const size_t row = (size_t)(u.pm * BM + EPI_ROWS(ai, m));
#pragma unroll
                for (int bj = 0; bj < 2; ++bj) { const int col = u.pn * 256 + EPI_COLS(bj);
                    f32x4 h0, h1; load8bf(PG + row * 2048 + (u.e == 0 ? 0 : 1024) + col, h0, h1);
                    if (u.e == 0) { acc[ai][bj][m][0] *= h0; acc[ai][bj][m][1] *= h1; }
                    else store8bf(MIX + row * 1024 + col, h0 * acc[ai][bj][m][0], h1 * acc[ai][bj][m][1]); } }
        return u.e == 0;
    }
};
struct EpiH {
    static constexpr bool CHAIN = false;
    const float* x; bf16_t* HB; unsigned char* HB8;
    __device__ __forceinline__ void operator()(const f32x4 (&acc)[2][2][4][2], const Unit& u, int wr, int wc, int fr, int fq, const LAS float* side) const {
#pragma unroll
        for (int ai = 0; ai < 2; ++ai)
#pragma unroll
            for (int m = 0; m < 4; ++m) { const size_t row = (size_t)(u.pm * BM + EPI_ROWS(ai, m));
#pragma unroll
                for (int bj = 0; bj < 2; ++bj) { const size_t o = row * 1024 + u.pn * 256 + EPI_COLS(bj);
                    const f32x4 v0 = *(const f32x4*)(x + o) + acc[ai][bj][m][0], v1 = *(const f32x4*)(x + o + 4) + acc[ai][bj][m][1];
                    store8bf(HB + o, v0, v1);
#ifdef GU_FP8
                    { int w0 = __builtin_amdgcn_cvt_pk_fp8_f32(v0.x, v0.y, 0, false); w0 = __builtin_amdgcn_cvt_pk_fp8_f32(v0.z, v0.w, w0, true);
                      int w1 = __builtin_amdgcn_cvt_pk_fp8_f32(v1.x, v1.y, 0, false); w1 = __builtin_amdgcn_cvt_pk_fp8_f32(v1.z, v1.w, w1, true);
                      *(u32x2*)(HB8 + o) = (u32x2){(unsigned)w0, (unsigned)w1}; }
#endif
                } }
    }
};
struct EpiGU {
    static constexpr bool CHAIN = false;
    const float* bgu; const float* ROWRS; bf16_t* ACT;
    __device__ __forceinline__ void operator()(const f32x4 (&acc)[2][2][4][2], const Unit& u, int wr, int wc, int fr, int fq, const LAS float* side) const {
        const int colp = u.pn * 128 + wc * 32 + 8 * fq;
        f32x4 bg[2], bu[2];
#pragma unroll
        for (int n = 0; n < 2; ++n) { bg[n] = *(const LAS f32x4*)(side + wc * 32 + 8 * fq + 4 * n); bu[n] = *(const LAS f32x4*)(side + 128 + wc * 32 + 8 * fq + 4 * n); }
#pragma unroll
        for (int ai = 0; ai < 2; ++ai)
#pragma unroll
            for (int m = 0; m < 4; ++m) { const size_t row = (size_t)u.gm * BM + EPI_ROWS(ai, m); const float rs = side[256 + EPI_ROWS(ai, m)];
                f32x2 o[4];
#pragma unroll
                for (int n = 0; n < 2; ++n) {
                    o[2 * n] = swiglu2(lo2(acc[ai][0][m][n]) * rs + lo2(bg[n]), lo2(acc[ai][1][m][n]) * rs + lo2(bu[n]));
                    o[2 * n + 1] = swiglu2(hi2(acc[ai][0][m][n]) * rs + hi2(bg[n]), hi2(acc[ai][1][m][n]) * rs + hi2(bu[n])); }
#ifdef DN_FP8
                { int w0 = __builtin_amdgcn_cvt_pk_fp8_f32(o[0].x, o[0].y, 0, false); w0 = __builtin_amdgcn_cvt_pk_fp8_f32(o[1].x, o[1].y, w0, true);
                  int w1 = __builtin_amdgcn_cvt_pk_fp8_f32(o[2].x, o[2].y, 0, false); w1 = __builtin_amdgcn_cvt_pk_fp8_f32(o[3].x, o[3].y, w1, true);
                  *(u32x2*)((unsigned char*)ACT + row * 1024 + colp) = (u32x2){(unsigned)w0, (unsigned)w1}; } }
#else
                store8bf2(ACT + row * 1024 + colp, o[0], o[1], o[2], o[3]); }
#endif
    }
};
struct EpiDN {
    static constexpr bool CHAIN = false;
    const float* bdn; const float* ROWGATE; bf16_t* YS;
    __device__ __forceinline__ void operator()(const f32x4 (&acc)[2][2][4][2], const Unit& u, int wr, int wc, int fr, int fq, const LAS float* side) const {
        f32x4 bv[2][2];
#pragma unroll
        for (int bj = 0; bj < 2; ++bj)
#pragma unroll
            for (int n = 0; n < 2; ++n) bv[bj][n] = *(const LAS f32x4*)(side + EPI_COLS(bj) + 4 * n);
#pragma unroll
        for (int ai = 0; ai < 2; ++ai)
#pragma unroll
            for (int m = 0; m < 4; ++m) { const size_t row = (size_t)u.gm * BM + EPI_ROWS(ai, m); const float gt = side[256 + EPI_ROWS(ai, m)];
#pragma unroll
                for (int bj = 0; bj < 2; ++bj) {
                    const f32x2 a = (lo2(acc[ai][bj][m][0]) + lo2(bv[bj][0])) * gt, b = (hi2(acc[ai][bj][m][0]) + hi2(bv[bj][0])) * gt, c = (lo2(acc[ai][bj][m][1]) + lo2(bv[bj][1])) * gt, d = (hi2(acc[ai][bj][m][1]) + hi2(bv[bj][1])) * gt;
#ifdef YS_FP8
                    int w0 = __builtin_amdgcn_cvt_pk_fp8_f32(a.x, a.y, 0, false); w0 = __builtin_amdgcn_cvt_pk_fp8_f32(b.x, b.y, w0, true);
                    int w1 = __builtin_amdgcn_cvt_pk_fp8_f32(c.x, c.y, 0, false); w1 = __builtin_amdgcn_cvt_pk_fp8_f32(d.x, d.y, w1, true);
                    *(u32x2*)((unsigned char*)YS + row * 1024 + u.pn * 256 + EPI_COLS(bj)) = (u32x2){(unsigned)w0, (unsigned)w1};
#else
                    store8bf2(YS + row * 1024 + u.pn * 256 + EPI_COLS(bj), a, b, c, d);
#endif
                } }
    }
};

template <int NS> struct SchedDenseT {
    static constexpr int NSIDE = NS; const float* bias;
    __device__ __forceinline__ const float* side_addr(const Unit& u, int, int idx) const {
        const int p = u.pn - 20; return p < 0 ? bias + u.pn * 256 + idx : bias + (idx < 128 ? 5120 + 128 * p + idx : 6144 + 128 * p + (idx - 128)); }
    DenseOrder O; const char* A; const char* B;
    __device__ __forceinline__ bool next(int i, Unit& u) const { int pm, pn; if (!O.tile(i, pm, pn)) return false; u.pm = pm; u.pn = pn; u.e = 0; u.gm = pm;
        u.A = A + (size_t)pm * (BM * KD * 2); u.B = B + (size_t)pn * (BM * KD * 2); return true; }
    static constexpr const unsigned* ROWTOK = nullptr; __device__ __forceinline__ int ROWTOK_row(const Unit&, int) const { return 0; } __device__ __forceinline__ size_t rowoff(const Unit&) const { return 0; }
};
struct SchedDenseProbe {
    static constexpr int NSIDE = 0; __device__ __forceinline__ const float* side_addr(const Unit&, int, int) const { return nullptr; }
    DenseOrder O; const char* A; const char* B;
    __device__ __forceinline__ bool next(int i, Unit& u) const { int pm, pn; if (!O.tile(i, pm, pn)) return false; u.pm = pm; u.pn = pn; u.e = 0; u.gm = pm;
        u.A = A + (size_t)(pm & 1) * (BM * KD * 2); u.B = B + (size_t)(pn & 1) * (BM * KD * 2); return true; }
    static constexpr const unsigned* ROWTOK = nullptr; __device__ __forceinline__ int ROWTOK_row(const Unit&, int) const { return 0; } __device__ __forceinline__ size_t rowoff(const Unit&) const { return 0; }
};
struct SchedMix {
    static constexpr int NSIDE = 0; __device__ __forceinline__ const float* side_addr(const Unit&, int, int) const { return nullptr; }
    DenseOrder O; const char* A0; const char* A1; const char* B0; const char* B1;
    __device__ __forceinline__ bool next(int i, Unit& u) const { int pm, pn; if (!O.tile(i >> 1, pm, pn)) return false; const int w = i & 1; u.pm = pm; u.pn = pn; u.e = w; u.gm = pm;
        u.A = (w ? A1 : A0) + (size_t)pm * (BM * KD * 2); u.B = (w ? B1 : B0) + (size_t)pn * (BM * KD * 2); return true; }
    static constexpr const unsigned* ROWTOK = nullptr; __device__ __forceinline__ int ROWTOK_row(const Unit&, int) const { return 0; } __device__ __forceinline__ size_t rowoff(const Unit&) const { return 0; }
};
template <int NT, bool GATHER> struct SchedMoE {
    static constexpr int NSIDE = 2; const float* sbias; const float* srow;
    __device__ __forceinline__ const float* side_addr(const Unit& u, int k, int idx) const {
        if (k == 1) return srow + (size_t)u.e * T + u.pm + idx;
        return NT == 8 ? sbias + u.e * 2048 + (idx < 128 ? 128 * u.pn + idx : 1024 + 128 * u.pn + idx - 128) : sbias + u.e * 1024 + 256 * u.pn + idx; }
    const LAS int* ptile; int G, c; const char* A; const char* B; size_t bstride  ; const int* ROWTOK; int esz = 2  ;
    __device__ __forceinline__ bool next(int i, Unit& u) const {
        const int ngm = __builtin_amdgcn_readfirstlane(ptile[32]);
        int gm, pn;
        if (G == 256) {
            const int x = c & 7, y = c >> 3; gm = i * (256 / NT) + x * (32 / NT) + y / NT; pn = y % NT;
#ifdef LAST_SPREAD
            if ((i + 1) * (256 / NT) > ngm) gm = i * (256 / NT) + (y / NT) * 8 + x;
#endif
            if (gm >= ngm) return false;
#ifdef DN_REVERSE
            if (NT == 4) gm = ngm - 1 - gm;
#endif
        } else { const long Lx = (long)i * G + c; if (Lx >= (long)ngm * NT) return false; gm = (int)(Lx / NT); pn = (int)(Lx % NT); }
        int e = 0;
#pragma unroll 1
        for (int q = 1; q < 32; ++q) e += (__builtin_amdgcn_readfirstlane(ptile[q]) <= gm) ? 1 : 0;
        u.pm = (gm - __builtin_amdgcn_readfirstlane(ptile[e])) * BM; u.gm = gm; u.pn = pn; u.e = e;
        u.A = GATHER ? A : A + (size_t)gm * (BM * KD * esz); u.B = B + (size_t)e * bstride + (size_t)pn * (BM * KD * esz); return true; }
    __device__ __forceinline__ int ROWTOK_row(const Unit& u, int r) const { return GATHER ? ROWTOK[(size_t)u.e * T + u.pm + r] : 0; }
    __device__ __forceinline__ size_t rowoff(const Unit& u) const { return (size_t)u.e * T + u.pm; }
};
}
struct Args { const float* in[33]; float* out; unsigned char* ws; int ph_lo, ph_hi, li, pad; };
#define LDS_WAIT() asm volatile("s_waitcnt lgkmcnt(0)" ::: "memory")

struct Frame {
    LAS unsigned char* lds; int tid, lane, wave, G, bid; const float* const* in; float* out; unsigned char* ws;
};

#ifndef DUPMASK
#define DUPMASK 0
#endif
#define REP(bit) for (int rep_ = 0; rep_ < (((DUPMASK >> (bit)) & 1) ? 2 : 1); ++rep_)

#define XB_TMO      128
#define XB_XCNT(j)  (256  + 64 * (j))
#define XB_XSUB(j)  (1280 + 64 * (j))
#define XB_XGEN(j)  (2304 + 64 * (j))
#define XB_TOP      3328
#define XB_TOPGEN   3392
#define XCD_BAR_WORDS 3456
#define XB_SPIN_CAP (1u << 18)

__device__ __forceinline__ unsigned xb_ld(unsigned* p)              { return __hip_atomic_load(p, __ATOMIC_RELAXED, __HIP_MEMORY_SCOPE_AGENT); }
__device__ __forceinline__ unsigned xb_add(unsigned* p, unsigned v) { return __hip_atomic_fetch_add(p, v, __ATOMIC_RELAXED, __HIP_MEMORY_SCOPE_AGENT); }
__device__ __forceinline__ unsigned xb_xcc_id() { return (unsigned)__builtin_amdgcn_s_getreg((3 << 11) | 20) & 0xFu; }
#define XB_SPIN(cond, bar) do { unsigned _sp = 0; while (cond) { __builtin_amdgcn_s_sleep(1); \
    if ((++_sp & 255u) == 0u) { if (xb_ld(&(bar)[XB_TMO])) break; if (_sp > XB_SPIN_CAP) { atomicAdd(&(bar)[XB_TMO], 1u); break; } } } } while (0)

struct XcdBarrier {
    unsigned* bar; unsigned x;
    volatile LAS unsigned* st;
};

__device__ __forceinline__ XcdBarrier xcd_barrier_post(unsigned* bar, volatile LAS unsigned* st) {
    XcdBarrier b; b.bar = bar; b.x = xb_xcc_id(); b.st = st;
    if (threadIdx.x == 0) (void)xb_add(&bar[XB_XCNT(b.x)], 1u);
    return b;
}
__device__ __forceinline__ void xcd_barrier_complete(unsigned* bar, unsigned x, unsigned& nloc, unsigned& nx) {
    const unsigned G = gridDim.x * gridDim.y * gridDim.z;
    unsigned sum, cnt, mine, sp = 0u;
    for (;;) {
        sum = 0u; cnt = 0u; mine = 0u;
#pragma unroll
        for (unsigned j = 0; j < 16; ++j) { const unsigned c = xb_ld(&bar[XB_XCNT(j)]); sum += c; cnt += (c > 0u) ? 1u : 0u; mine = (j == x) ? c : mine; }
        if (sum == G) break;
        __builtin_amdgcn_s_sleep(1);
        if ((++sp & 255u) == 0u) { if (xb_ld(&bar[XB_TMO])) break; if (sp > XB_SPIN_CAP) { atomicAdd(&bar[XB_TMO], 1u); break; } }
    }
    nloc = mine > 0u ? mine : 1u; nx = cnt > 0u ? cnt : 1u;
}

__device__ __forceinline__ void xcd_barrier(const XcdBarrier& b) {
    asm volatile("s_waitcnt vmcnt(0)" ::: "memory");
    __syncthreads();
    if (threadIdx.x == 0) {
        unsigned* bar = b.bar;
        __builtin_amdgcn_s_waitcnt(0);
        unsigned nloc = b.st[0], nx = b.st[1];
        if (nloc == 0u) { xcd_barrier_complete(bar, b.x, nloc, nx); b.st[0] = nloc; b.st[1] = nx; }
        const unsigned old = xb_add(&bar[XB_XSUB(b.x)], 1u);
        const unsigned gen = old / nloc;
        if (old + 1u == (gen + 1u) * nloc) {
            __builtin_amdgcn_fence(__ATOMIC_RELEASE, "agent");
            asm volatile("s_waitcnt vmcnt(0)" ::: "memory");
            const unsigned og = xb_add(&bar[XB_TOP], 1u);
            const unsigned tg = og / nx;
            if (og + 1u == (tg + 1u) * nx) xb_add(&bar[XB_TOPGEN], 1u);
            else XB_SPIN(xb_ld(&bar[XB_TOPGEN]) == tg, bar);
            __builtin_amdgcn_fence(__ATOMIC_ACQUIRE, "agent");
            xb_add(&bar[XB_XGEN(b.x)], 1u);
            asm volatile("s_waitcnt vmcnt(0)" ::: "memory");
        } else {
            XB_SPIN(xb_ld(&bar[XB_XGEN(b.x)]) == gen, bar);
            __builtin_amdgcn_fence(__ATOMIC_ACQUIRE, "agent");
            asm volatile("s_waitcnt vmcnt(0)" ::: "memory");
        }
    }
    __syncthreads();
}


__device__ __forceinline__ void stagger_delay(int cls, int ticks_per_class) {
    if (cls > 0) { const unsigned long long t0 = __builtin_amdgcn_s_memrealtime(); const unsigned long long want = (unsigned long long)(cls * ticks_per_class);
        while (__builtin_amdgcn_s_memrealtime() - t0 < want) __builtin_amdgcn_s_sleep(32); }
}
namespace hy {
constexpr int TW128_OFF = MISC_OFF + 1024, TWT_OFF = MISC_OFF + 2048;

__host__ __device__ constexpr float twc16(int m) { return m == 0 ? 1.f : m == 1 ? 0.92387953251128674f : m == 2 ? 0.70710678118654752f : m == 3 ? 0.38268343236508977f : m == 4 ? 0.f : m == 5 ? -0.38268343236508977f : m == 6 ? -0.70710678118654752f : -0.92387953251128674f; }
__host__ __device__ constexpr float tws16(int m) { return m == 0 ? 0.f : m == 1 ? 0.38268343236508977f : m == 2 ? 0.70710678118654752f : m == 3 ? 0.92387953251128674f : m == 4 ? 1.f : m == 5 ? 0.92387953251128674f : m == 6 ? 0.70710678118654752f : 0.38268343236508977f; }
template <int N> __host__ __device__ constexpr int brev(int i) { int r = 0; for (int b = 1, c = N >> 1; b < N; b <<= 1, c >>= 1) if (i & b) r |= c; return r; }

typedef f32x2 P2;
template <int N, bool INV> __device__ __forceinline__ void fft_reg(P2 (&xr)[N], P2 (&xi)[N]) {
#pragma unroll
    for (int len = N; len >= 2; len >>= 1) {
        const int half = len >> 1;
#pragma unroll
        for (int start = 0; start < N; start += len) {
#pragma unroll
            for (int j = 0; j < half; ++j) {
                const int i0 = start + j, i1 = i0 + half;
                const P2 ar = xr[i0], ai = xi[i0], br = xr[i1], bi = xi[i1];
                xr[i0] = ar + br; xi[i0] = ai + bi;
                const P2 tr = ar - br, ti = ai - bi;
                const int m = j * (16 / len);
                if (m == 0) { xr[i1] = tr; xi[i1] = ti; }
                else if (m == 4) { if (INV) { xr[i1] = -ti; xi[i1] = tr; } else { xr[i1] = ti; xi[i1] = -tr; } }
                else { const float c = twc16(m), s = INV ? tws16(m) : -tws16(m); xr[i1] = tr * c - ti * s; xi[i1] = tr * s + ti * c; }
            }
        }
    }
}
__device__ __forceinline__ unsigned pkh(float a, float b) { return __builtin_bit_cast(unsigned, __builtin_amdgcn_cvt_pkrtz(a, b)); }
__device__ __forceinline__ u32x2 pkc(const P2 re, const P2 im) { u32x2 r; r.x = pkh(re.x, re.y); r.y = pkh(im.x, im.y); return r; }
__device__ __forceinline__ float h2f_lo(unsigned u) { return (float)__builtin_bit_cast(_Float16, (unsigned short)(u & 0xffffu)); }
__device__ __forceinline__ float h2f_hi(unsigned u) { return (float)__builtin_bit_cast(_Float16, (unsigned short)(u >> 16)); }
__device__ __forceinline__ P2 unpk2(unsigned u) { return (P2){h2f_lo(u), h2f_hi(u)}; }
#ifdef YZ_BF8
typedef unsigned yz_t;
__device__ __forceinline__ yz_t pkyz(const P2 re, const P2 im) { int v = __builtin_amdgcn_cvt_pk_bf8_f32(re.x, re.y, 0, false); v = __builtin_amdgcn_cvt_pk_bf8_f32(im.x, im.y, v, true); return (unsigned)v; }
__device__ __forceinline__ P2 yzre(const yz_t u) { return __builtin_amdgcn_cvt_pk_f32_bf8((int)u, false); }
__device__ __forceinline__ P2 yzim(const yz_t u) { return __builtin_amdgcn_cvt_pk_f32_bf8((int)u, true); }
#ifdef KF_BF8
constexpr float KF_SCALE = 64.0f, YZ_ZSCALE = 1.0f / 1024.0f;
#else
constexpr float KF_SCALE = 1.0f, YZ_ZSCALE = 1.0f / 16.0f;
#endif
#else
typedef u32x2 yz_t;
__device__ __forceinline__ yz_t pkyz(const P2 re, const P2 im) { return pkc(re, im); }
__device__ __forceinline__ P2 yzre(const yz_t u) { return unpk2(u.x); }
__device__ __forceinline__ P2 yzim(const yz_t u) { return unpk2(u.y); }
constexpr float YZ_ZSCALE = 1.0f, KF_SCALE = 1.0f;
#endif
#ifdef KF_BF8
typedef yz_t kf_t;
#define KF_PK(re, im) pkyz(re, im)
#define KF_RE(u) yzre(u)
#define KF_IM(u) yzim(u)
#else
typedef u32x2 kf_t;
#define KF_PK(re, im) pkc(re, im)
#define KF_RE(u) unpk2((u).x)
#define KF_IM(u) unpk2((u).y)
#endif
__device__ __forceinline__ P2 bf2p(unsigned u) { return (P2){__uint_as_float(u << 16), __uint_as_float(u & 0xffff0000u)}; }
__device__ __forceinline__ void cmul(P2& xr, P2& xi, float c, float s) { const P2 r = xr * c - xi * s, i = xr * s + xi * c; xr = r; xi = i; }

__device__ __forceinline__ void init_tw128(Frame& F) {
    __syncthreads();
    if (F.tid < 128) { float s, c; sincospif((float)F.tid * (1.0f / 64.0f), &s, &c); ((LAS f32x2*)(F.lds + TW128_OFF))[F.tid] = (f32x2){c, s}; }
    __syncthreads();
}
__device__ __forceinline__ void tile_tw(Frame& F, int a, bool inv) {
    if (F.tid < 128) { const int m = (a * F.tid) & (L2X - 1); float s, c; sincospif((float)m * (1.0f / 8192.0f), &s, &c); ((LAS f32x2*)(F.lds + TWT_OFF))[F.tid] = (f32x2){c, inv ? s : -s}; }
}
template <bool INV> __device__ __forceinline__ void stage1(Frame& F, P2 (&xr)[16], P2 (&xi)[16], int s) {
    fft_reg<16, INV>(xr, xi);
    const LAS f32x2* tw = (const LAS f32x2*)(F.lds + TW128_OFF); LAS f32x4* tile = (LAS f32x4*)F.lds;
#pragma unroll
    for (int q = 0; q < 16; ++q) { const int p = brev<16>(q); const f32x2 w = tw[s * q]; const float c = w.x, sn = INV ? w.y : -w.y;
        P2 a = xr[p], b = xi[p]; cmul(a, b, c, sn);
        tile[(s * 16 + q) * 64 + F.lane] = (f32x4){a.x, a.y, b.x, b.y}; }
}
__device__ __forceinline__ void stage2_read(Frame& F, P2 (&xr)[8], P2 (&xi)[8], int qq) {
    const LAS f32x4* tile = (const LAS f32x4*)F.lds;
#pragma unroll
    for (int s = 0; s < 8; ++s) { const f32x4 v = tile[(s * 16 + qq) * 64 + F.lane]; xr[s] = (P2){v.x, v.y}; xi[s] = (P2){v.z, v.w}; }
}
__device__ __forceinline__ void hyq2(const bf16_t* __restrict__ PHY, size_t row, int tl, int col, const float (&w)[3][2], const float (&b)[2], float& q0, float& q1) {
    q0 = b[0]; q1 = b[1];
#pragma unroll
    for (int k = 0; k < 3; ++k) { const int tt = tl + k - 1; const bool ok = (tt >= 0) && (tt < L);
        const unsigned u = ok ? *(const unsigned*)(PHY + (row + k - 1) * 3072 + col) : 0u;
        q0 += w[k][0] * __uint_as_float(u << 16); q1 += w[k][1] * __uint_as_float(u & 0xffff0000u); }
}
struct ConvW { float w[3][3][2]; float b[3][2]; };
__device__ __forceinline__ void load_convw(ConvW& W, const float* __restrict__ cw, const float* __restrict__ cb, int c0) {
#pragma unroll
    for (int seg = 0; seg < 3; ++seg) {
#pragma unroll
        for (int k = 0; k < 3; ++k) { const f32x2 v = *(const f32x2*)(cw + k * 3072 + seg * 1024 + c0); W.w[seg][k][0] = v.x; W.w[seg][k][1] = v.y; }
        const f32x2 v = *(const f32x2*)(cb + seg * 1024 + c0); W.b[seg][0] = v.x; W.b[seg][1] = v.y; }
}


__device__ __forceinline__ void bf8_to_f(const u32x4 u, float (&f)[8]) {
    f[0] = __uint_as_float(u.x << 16); f[1] = __uint_as_float(u.x & 0xffff0000u); f[2] = __uint_as_float(u.y << 16); f[3] = __uint_as_float(u.y & 0xffff0000u);
    f[4] = __uint_as_float(u.z << 16); f[5] = __uint_as_float(u.z & 0xffff0000u); f[6] = __uint_as_float(u.w << 16); f[7] = __uint_as_float(u.w & 0xffff0000u);
}
__device__ __forceinline__ void prepass(Frame& F) {
    const bf16_t* PHY = (const bf16_t*)(F.ws + WS_PHY); bf16_t* Z16 = (bf16_t*)(F.ws + WS_Z16); bf16_t* X1Q = (bf16_t*)(F.ws + WS_YHY); const float* cw = F.in[12]; const float* cb = F.in[13];
    const int gw = F.bid * NWAVES + F.wave, NGW = F.G * NWAVES;
#pragma unroll 1
    for (int item = gw; item < (T / 16) * 2; item += NGW) {
        const int half = item & 1, row0 = (item >> 1) * 16, tl0 = row0 & (L - 1), c0 = half * 512 + 8 * F.lane;
        float w[3][3][8], bs[3][8];
#pragma unroll
        for (int seg = 0; seg < 3; ++seg) {
#pragma unroll
            for (int k = 0; k < 3; ++k) { const f32x4 a = *(const f32x4*)(cw + k * 3072 + seg * 1024 + c0), b = *(const f32x4*)(cw + k * 3072 + seg * 1024 + c0 + 4);
                w[seg][k][0] = a.x; w[seg][k][1] = a.y; w[seg][k][2] = a.z; w[seg][k][3] = a.w; w[seg][k][4] = b.x; w[seg][k][5] = b.y; w[seg][k][6] = b.z; w[seg][k][7] = b.w; }
            const f32x4 a = *(const f32x4*)(cb + seg * 1024 + c0), b = *(const f32x4*)(cb + seg * 1024 + c0 + 4);
            bs[seg][0] = a.x; bs[seg][1] = a.y; bs[seg][2] = a.z; bs[seg][3] = a.w; bs[seg][4] = b.x; bs[seg][5] = b.y; bs[seg][6] = b.z; bs[seg][7] = b.w; }
        const u32x4 zero4 = (u32x4){0u, 0u, 0u, 0u};
        u32x4 prev[3], cur[3];
#pragma unroll
        for (int seg = 0; seg < 3; ++seg) { prev[seg] = tl0 > 0 ? *(const u32x4*)(PHY + (size_t)(row0 - 1) * 3072 + seg * 1024 + c0) : zero4; cur[seg] = *(const u32x4*)(PHY + (size_t)row0 * 3072 + seg * 1024 + c0); }
#pragma unroll 1
        for (int sub = 0; sub < 4; ++sub) {
            u32x4 nx[4][3];
#pragma unroll
            for (int r = 0; r < 4; ++r)
#pragma unroll
                for (int seg = 0; seg < 3; ++seg) { const int tn = tl0 + sub * 4 + r + 1; nx[r][seg] = tn < L ? *(const u32x4*)(PHY + (size_t)(row0 + sub * 4 + r + 1) * 3072 + seg * 1024 + c0) : zero4; }
#pragma unroll
            for (int r = 0; r < 4; ++r) {
                float q[3][8];
#pragma unroll
                for (int seg = 0; seg < 3; ++seg) { float a[8], b[8], c[8]; bf8_to_f(prev[seg], a); bf8_to_f(cur[seg], b); bf8_to_f(nx[r][seg], c);
#pragma unroll
                    for (int e = 0; e < 8; ++e) q[seg][e] = bs[seg][e] + w[seg][0][e] * a[e] + w[seg][1][e] * b[e] + w[seg][2][e] * c[e];
                    prev[seg] = cur[seg]; cur[seg] = nx[r][seg]; }
                const size_t o = (size_t)(row0 + sub * 4 + r) * 1024 + c0;
                u32x4 zo, xo;
                zo.x = pk2(q[2][0] * q[0][0], q[2][1] * q[0][1]); zo.y = pk2(q[2][2] * q[0][2], q[2][3] * q[0][3]); zo.z = pk2(q[2][4] * q[0][4], q[2][5] * q[0][5]); zo.w = pk2(q[2][6] * q[0][6], q[2][7] * q[0][7]);
                xo.x = pk2(q[1][0], q[1][1]); xo.y = pk2(q[1][2], q[1][3]); xo.z = pk2(q[1][4], q[1][5]); xo.w = pk2(q[1][6], q[1][7]);
                *(u32x4*)(Z16 + o) = zo; *(u32x4*)(X1Q + o) = xo;
            }
        }
    }
}

__device__ __forceinline__ void prep_w4frag(Frame& F) {
    const float* w4 = F.in[20]; u32x4* WF4 = (u32x4*)(F.ws + WS_WF4);
    for (int idx = F.bid * NTHREADS + F.tid; idx < 2 * 64 * 2 * 64; idx += F.G * NTHREADS) {
        const int lane = idx & 63, s = (idx >> 6) & 1, cb = (idx >> 7) & 63, dir = idx >> 13; const int col = dir * 1024 + 16 * cb + (lane & 15), k0 = 32 * s + 8 * (lane >> 4);
        u32x4 o; o.x = pk2(w4[(k0 + 0) * 2048 + col], w4[(k0 + 1) * 2048 + col]); o.y = pk2(w4[(k0 + 2) * 2048 + col], w4[(k0 + 3) * 2048 + col]);
        o.z = pk2(w4[(k0 + 4) * 2048 + col], w4[(k0 + 5) * 2048 + col]); o.w = pk2(w4[(k0 + 6) * 2048 + col], w4[(k0 + 7) * 2048 + col]);
        WF4[idx] = o; }
}
__device__ __forceinline__ void fa_load(const float* __restrict__ w4, int c0, int bt, f32x2 (&wf)[16], f32x2 (&wb)[16]) {
#pragma unroll
    for (int e = 0; e < 16; ++e) { wf[e] = *(const f32x2*)(w4 + (16 * bt + e) * 2048 + c0); wb[e] = *(const f32x2*)(w4 + (16 * bt + e) * 2048 + 1024 + c0); }
}
__device__ __forceinline__ void fa_compute(const LAS f32x4* hrow, int bt, const f32x2 (&wf)[16], const f32x2 (&wb)[16], float (&r0)[16], float (&r1)[16], float& l0, float& l1, bool lag0) {
#pragma unroll
    for (int e4 = 0; e4 < 4; ++e4) { const int u4 = 4 * bt + e4; __builtin_amdgcn_sched_barrier(0);
#pragma unroll
        for (int j = 0; j < 16; ++j) { const f32x4 hv = hrow[(8 * j) * 16 + u4];
#pragma unroll
            for (int e = 0; e < 4; ++e) { r0[j] += hv[e] * (j < 8 ? wf[4 * e4 + e].x : wb[4 * e4 + e].x); r1[j] += hv[e] * (j < 8 ? wf[4 * e4 + e].y : wb[4 * e4 + e].y); } }
        if (lag0) { const f32x4 hv = hrow[u4];
#pragma unroll
            for (int e = 0; e < 4; ++e) { l0 += hv[e] * wb[4 * e4 + e].x; l1 += hv[e] * wb[4 * e4 + e].y; } } }
}
template <bool DRY = false> __device__ __forceinline__ void filter_pass_a(Frame& F, int k_lo = 0, int k_hi = 1 << 20) {
    const float* HH3 = (const float*)(F.ws + WS_HH3); const float* w4 = F.in[20]; float* NORM = (float*)(F.ws + WS_NORMP); kf_t* YK = (kf_t*)(F.ws + WS_KF);
    const int s = F.wave; const LAS f32x2* twt = (const LAS f32x2*)(F.lds + TWT_OFF);
    for (int kk = k_lo, tl = F.bid + k_lo * F.G; kk < k_hi && tl < 128 * 8; ++kk, tl += F.G) {
        const int n1 = tl >> 3, ct = tl & 7, c0 = ct * 128 + 2 * F.lane;
        tile_tw(F, n1, false);
        { const int rw = F.tid >> 2, part = F.tid & 3; const int n = n1 + 128 * rw; const int t = n < L ? n : ((2 * L - n) & (L - 1));
          const f32x4* src = (const f32x4*)(HH3 + t * 64 + part * 16); LAS f32x4* dst = (LAS f32x4*)(F.lds + rw * 256 + part * 64);
          const f32x4 a = src[0], b = src[1], c = src[2], d = src[3]; dst[0] = a; dst[1] = b; dst[2] = c; dst[3] = d; }
        __syncthreads();
        P2 xr[16], xi[16]; P2 lag0 = (P2){0.f, 0.f};
        const P2 da = (P2){hy_delta_abs(c0), hy_delta_abs(c0 + 1)};
        { const u32x4* WF4 = (const u32x4*)(F.ws + WS_WF4); const int cb = ct * 8 + s, jl = F.lane & 15, ql = F.lane >> 4;
          bf16x8 bfr[2][2];
#pragma unroll
          for (int dir = 0; dir < 2; ++dir)
#pragma unroll
              for (int ks = 0; ks < 2; ++ks) bfr[dir][ks] = __builtin_bit_cast(bf16x8, WF4[(((dir * 64 + cb) * 2 + ks) * 64) + F.lane]);
          LAS float* kt = (LAS float*)(F.lds + 32768);
#pragma unroll
          for (int m = 0; m < 8; ++m) {
              bf16x8 afr[2];
#pragma unroll
              for (int ks = 0; ks < 2; ++ks) { const LAS f32x4* hp = (const LAS f32x4*)(F.lds + (16 * m + jl) * 256 + (32 * ks + 8 * ql) * 4); const f32x4 x0 = hp[0], x1 = hp[1];
                  u32x4 pk; pk.x = pk2(x0.x, x0.y); pk.y = pk2(x0.z, x0.w); pk.z = pk2(x1.x, x1.y); pk.w = pk2(x1.z, x1.w); afr[ks] = __builtin_bit_cast(bf16x8, pk); }
              f32x4 d = (f32x4){0.f, 0.f, 0.f, 0.f};
              d = __builtin_amdgcn_mfma_f32_16x16x32_bf16(afr[0], bfr[m >> 2][0], d, 0, 0, 0); d = __builtin_amdgcn_mfma_f32_16x16x32_bf16(afr[1], bfr[m >> 2][1], d, 0, 0, 0);
#pragma unroll
              for (int r = 0; r < 4; ++r) kt[(16 * m + 4 * ql + r) * 132 + 16 * s + jl] = d[r]; }
          if (n1 == 0 && s == 0) { const LAS float* h0 = (const LAS float*)F.lds;
#pragma unroll 4
              for (int u = 0; u < 64; ++u) { const f32x2 wb = *(const f32x2*)(w4 + u * 2048 + 1024 + c0); lag0 += h0[u] * wb; } }
          __syncthreads();
#pragma unroll
          for (int j = 0; j < 16; ++j) xr[j] = *(const LAS f32x2*)(kt + (s + 8 * j) * 132 + 2 * F.lane);
        }
        __syncthreads();
        P2 na = (P2){0.f, 0.f};
#pragma unroll
        for (int j = 0; j < 16; ++j) { const int n = n1 + 128 * (s + 8 * j); const int t = j < 8 ? n : ((2 * L - n) & (L - 1)); const float tt = (float)t * (1.0f / (float)(L - 1));
            P2 v = xr[j] * (P2){fexp(-tt * da.x), fexp(-tt * da.y)};
            if (n == L) v = (P2){0.f, 0.f};
            if (j == 0) v += lag0;
            xr[j] = v; xi[j] = (P2){0.f, 0.f}; na += (P2){fabsf(v.x), fabsf(v.y)}; }
        { LAS f32x2* nred = (LAS f32x2*)(F.lds + MISC_OFF + 12288); nred[s * 64 + F.lane] = na; }
        stage1<false>(F, xr, xi, s);
        __syncthreads();
        if (s == 0) { const LAS f32x2* nred = (const LAS f32x2*)(F.lds + MISC_OFF + 12288); f32x2 a = nred[F.lane];
#pragma unroll
            for (int w = 1; w < 8; ++w) { const f32x2 b = nred[w * 64 + F.lane]; a.x += b.x; a.y += b.y; }
            if (!DRY) *(f32x2*)(NORM + (size_t)n1 * 1024 + c0) = a; else asm volatile("" :: "v"(a)); }
#pragma unroll
        for (int h = 0; h < 2; ++h) { const int qq = s + 8 * h; P2 a[8], b[8];
            stage2_read(F, a, b, qq); fft_reg<8, false>(a, b);
#pragma unroll
            for (int r = 0; r < 8; ++r) { const int p = brev<8>(r), k2 = qq + 16 * r; const f32x2 w = twt[k2];
                P2 x = a[p], y = b[p]; cmul(x, y, w.x, w.y);
                if (!DRY) YK[((size_t)k2 * 128 + n1) * 512 + (c0 >> 1)] = KF_PK(x, y); else asm volatile("" :: "v"(x), "v"(y)); } }
        __syncthreads();
    }
}
template <bool DRY = false> __device__ __forceinline__ void filter_pass_b(Frame& F) {
    const float* NORM = (const float*)(F.ws + WS_NORMP); kf_t* KF = (kf_t*)(F.ws + WS_KF); const int s = F.wave;
    for (int tl = F.bid; tl < 128 * 8; tl += F.G) {
        const int k2 = tl >> 3, ct = tl & 7, c0 = ct * 128 + 2 * F.lane; const size_t base = (size_t)k2 * 128 * 512 + (c0 >> 1);
        { LAS float* nsum = (LAS float*)(F.lds + MISC_OFF + 12288); const int ch = F.tid & 127, qt = F.tid >> 7; float a = 0.f;
#pragma unroll 8
          for (int i = 0; i < 32; ++i) a += NORM[(size_t)(qt * 32 + i) * 1024 + ct * 128 + ch];
          __syncthreads(); nsum[qt * 128 + ch] = a; __syncthreads(); }
        P2 sc;
        { const LAS float* nsum = (const LAS float*)(F.lds + MISC_OFF + 12288); const int ch = 2 * F.lane;
          sc.x = 1.0f / ((nsum[ch] + nsum[128 + ch]) + (nsum[256 + ch] + nsum[384 + ch])); sc.y = 1.0f / ((nsum[ch + 1] + nsum[128 + ch + 1]) + (nsum[256 + ch + 1] + nsum[384 + ch + 1])); }
        P2 xr[16], xi[16];
#pragma unroll
        for (int j = 0; j < 16; ++j) { const kf_t u = KF[base + (size_t)(s + 8 * j) * 512]; xr[j] = KF_RE(u); xi[j] = KF_IM(u); }
        stage1<false>(F, xr, xi, s);
        __syncthreads();
#pragma unroll
        for (int h = 0; h < 2; ++h) { const int qq = s + 8 * h; P2 a[8], b[8];
            stage2_read(F, a, b, qq); fft_reg<8, false>(a, b);
#pragma unroll
            for (int r = 0; r < 8; ++r) { const int p = brev<8>(r), k1 = qq + 16 * r;
                const kf_t o_ = KF_PK(a[p] * (sc * KF_SCALE), b[p] * (sc * KF_SCALE)); if (!DRY) KF[base + (size_t)k1 * 512] = o_; else asm volatile("" :: "v"(o_)); } }
        __syncthreads();
    }
}
__device__ __forceinline__ void data_pass_a(Frame& F) {
    const bf16_t* Z16 = (const bf16_t*)(F.ws + WS_Z16); yz_t* YZ = (yz_t*)(F.ws + WS_YZ); const int s = F.wave; const LAS f32x2* twt = (const LAS f32x2*)(F.lds + TWT_OFF);
    unsigned zn[16];
    auto zload = [&](int tl, unsigned (&z)[16]) { const int ct = tl & 7, n1 = (tl >> 3) & 127, p = tl >> 10, c0 = ct * 128 + 2 * F.lane;
#pragma unroll
        for (int j = 0; j < 8; ++j) { const int t = n1 + 128 * (s + 8 * j);
            z[2 * j] = *(const unsigned*)(Z16 + ((size_t)(2 * p) * L + t) * 1024 + c0); z[2 * j + 1] = *(const unsigned*)(Z16 + ((size_t)(2 * p + 1) * L + t) * 1024 + c0); } };
    if (F.bid < 2 * 128 * 8) zload(F.bid, zn);
    for (int tl = F.bid; tl < 2 * 128 * 8; tl += F.G) {
        const int ct = tl & 7, n1 = (tl >> 3) & 127, p = tl >> 10, c0 = ct * 128 + 2 * F.lane;
        tile_tw(F, n1, false);
        P2 xr[16], xi[16];
#pragma unroll
        for (int j = 0; j < 8; ++j) { xr[j] = bf2p(zn[2 * j]); xi[j] = bf2p(zn[2 * j + 1]); }
        if (tl + F.G < 2 * 128 * 8) zload(tl + F.G, zn);
#pragma unroll
        for (int j = 8; j < 16; ++j) { xr[j] = (P2){0.f, 0.f}; xi[j] = (P2){0.f, 0.f}; }
        stage1<false>(F, xr, xi, s);
        __syncthreads();
#pragma unroll
        for (int h = 0; h < 2; ++h) { const int qq = s + 8 * h; P2 a[8], b[8];
            stage2_read(F, a, b, qq); fft_reg<8, false>(a, b);
#pragma unroll
            for (int r = 0; r < 8; ++r) { const int pp = brev<8>(r), k2 = qq + 16 * r; const f32x2 w = twt[k2];
                P2 x = a[pp], y = b[pp]; cmul(x, y, w.x, w.y);
                YZ[(((size_t)p * 128 + k2) * 128 + n1) * 512 + (c0 >> 1)] = pkyz(x, y); } }
        __syncthreads();
    }
}
template <bool DRY = false> __device__ __forceinline__ void data_pass_b(Frame& F) {
    yz_t* YZ = (yz_t*)(F.ws + WS_YZ); const kf_t* KF = (const kf_t*)(F.ws + WS_KF); const int s = F.wave;
    const LAS f32x2* twt = (const LAS f32x2*)(F.lds + TWT_OFF); const LAS f32x2* tw = (const LAS f32x2*)(F.lds + TW128_OFF); LAS f32x4* tile = (LAS f32x4*)F.lds;
    int* qctr = (int*)(F.ws + WS_CTL) + 128 + (DRY ? 1 : 0); LAS int* qslot = (LAS int*)(F.lds + MISC_OFF + 768);
    for (;;) {
        __syncthreads();
        if (F.tid == 0) *qslot = atomicAdd(qctr, 1);
        __syncthreads();
        const int tl = *qslot; if (tl >= 128 * 8) break;
        const int k2 = tl >> 3, ct = tl & 7, c0 = ct * 128 + 2 * F.lane; const size_t kbase = (size_t)k2 * 128 * 512 + (c0 >> 1);
        tile_tw(F, k2, true);
#pragma unroll 1
        for (int p = 0; p < 2; ++p) {
            const size_t base = ((size_t)p * 128 + k2) * 128 * 512 + (c0 >> 1);
            kf_t kfp[2][8];
#pragma unroll
            for (int h = 0; h < 2; ++h)
#pragma unroll
                for (int r = 0; r < 8; ++r) kfp[h][r] = KF[kbase + (size_t)(s + 8 * h + 16 * r) * 512];
            { P2 xr[16], xi[16];
#pragma unroll
              for (int j = 0; j < 16; ++j) { const yz_t u = YZ[base + (size_t)(s + 8 * j) * 512]; xr[j] = yzre(u); xi[j] = yzim(u); }
              stage1<false>(F, xr, xi, s); }
            __syncthreads();
#pragma unroll
            for (int h = 0; h < 2; ++h) { const int qq = s + 8 * h; P2 a[8], b[8], gr[8], gi[8];
                if (h == 1) __builtin_amdgcn_sched_barrier(0);
                stage2_read(F, a, b, qq); fft_reg<8, false>(a, b);
#pragma unroll
                for (int r = 0; r < 8; ++r) { const int pp = brev<8>(r); const P2 kr = KF_RE(kfp[h][r]), ki = KF_IM(kfp[h][r]);
                    gr[r] = a[pp] * kr - b[pp] * ki; gi[r] = a[pp] * ki + b[pp] * kr; }
                fft_reg<8, true>(gr, gi);
#pragma unroll
                for (int bq = 0; bq < 8; ++bq) { const int pp = brev<8>(bq); const f32x2 w = tw[bq * qq];
                    P2 x = gr[pp], y = gi[pp]; cmul(x, y, w.x, w.y);
                    tile[(bq * 16 + qq) * 64 + F.lane] = (f32x4){x.x, x.y, y.x, y.y}; } }
            __syncthreads();
            { P2 xr[16], xi[16];
#pragma unroll
              for (int q = 0; q < 16; ++q) { const f32x4 v = tile[(s * 16 + q) * 64 + F.lane]; xr[q] = (P2){v.x, v.y}; xi[q] = (P2){v.z, v.w}; }
              fft_reg<16, true>(xr, xi);
#pragma unroll
              for (int a = 0; a < 16; ++a) { const int pp = brev<16>(a), m2 = s + 8 * a; const f32x2 w = twt[m2];
                  P2 x = xr[pp], y = xi[pp]; cmul(x, y, w.x, w.y);
                  if (!DRY) YZ[base + (size_t)m2 * 512] = pkyz(x * YZ_ZSCALE, y * YZ_ZSCALE); else asm volatile("" :: "v"(x), "v"(y)); } }
            __syncthreads();
        }
    }
}
template <bool DRY = false> __device__ __forceinline__ void data_pass_c(Frame& F) {
    const bf16_t* Z16 = (const bf16_t*)(F.ws + WS_Z16); const yz_t* YZ = (const yz_t*)(F.ws + WS_YZ); bf16_t* YHY = (bf16_t*)(F.ws + WS_YHY); const float* hbias = F.in[22]; const int s = F.wave;
    yz_t yzn[16];
    auto yzload = [&](int tl, yz_t (&y)[16]) { const int ct = tl & 7, m2 = (tl >> 3) & 127, p = tl >> 10, c0 = ct * 128 + 2 * F.lane;
#pragma unroll
        for (int j = 0; j < 16; ++j) y[j] = YZ[(((size_t)p * 128 + (s + 8 * j)) * 128 + m2) * 512 + (c0 >> 1)]; };
    if (F.bid < 2 * 128 * 8) yzload(F.bid, yzn);
    for (int tl = F.bid; tl < 2 * 128 * 8; tl += F.G) {
        const int ct = tl & 7, m2 = (tl >> 3) & 127, p = tl >> 10, c0 = ct * 128 + 2 * F.lane;
        unsigned uzp[2][4][2], uxp[2][4][2];
#pragma unroll
        for (int h = 0; h < 2; ++h)
#pragma unroll
            for (int r = 0; r < 4; ++r)
#pragma unroll
                for (int bb = 0; bb < 2; ++bb) { const size_t row = (size_t)(2 * p + bb) * L + 128 * (s + 8 * h + 16 * r) + m2;
                    uzp[h][r][bb] = *(const unsigned*)(Z16 + row * 1024 + c0); uxp[h][r][bb] = *(const unsigned*)(YHY + row * 1024 + c0); }
        { P2 xr[16], xi[16];
#pragma unroll
          for (int j = 0; j < 16; ++j) { xr[j] = yzre(yzn[j]); xi[j] = yzim(yzn[j]); }
          if (tl + F.G < 2 * 128 * 8) yzload(tl + F.G, yzn);
          stage1<true>(F, xr, xi, s); }
        __syncthreads();
        const P2 hb = *(const f32x2*)(hbias + c0);
#pragma unroll
        for (int h = 0; h < 2; ++h) { const int qq = s + 8 * h; P2 a[8], b[8];
            stage2_read(F, a, b, qq); fft_reg<8, true>(a, b);
#pragma unroll
            for (int r = 0; r < 4; ++r) { const int pp = brev<8>(r), t = 128 * (qq + 16 * r) + m2;
#pragma unroll
                for (int bb = 0; bb < 2; ++bb) { const size_t row = (size_t)(2 * p + bb) * L + t;
                    const P2 z = bf2p(uzp[h][r][bb]), x1 = bf2p(uxp[h][r][bb]);
                    const P2 cv = (bb == 0 ? a[pp] : b[pp]) * (1.0f / ((float)L2X * YZ_ZSCALE * KF_SCALE));
                    const P2 y = x1 * (cv + hb * z);
                    if (!DRY) *(unsigned*)(YHY + row * 1024 + c0) = pk2(y.x, y.y); else asm volatile("" :: "v"(y)); } } }
        __syncthreads();
    }
}
}
namespace lru {
__device__ __forceinline__ f32x2 sig2(const f32x2 x) { const f32x2 t = x * -1.4426950408889634f; const f32x2 d = (f32x2){__builtin_amdgcn_exp2f(t.x), __builtin_amdgcn_exp2f(t.y)} + 1.0f; return (f32x2){__builtin_amdgcn_rcpf(d.x), __builtin_amdgcn_rcpf(d.y)}; }
constexpr int TC = 64, NCH = L / TC, MB = TC / 16;

__device__ __forceinline__ void prep_wfrag(Frame& F) {
    const float* wa = F.in[6]; const float* wi = F.in[8]; u32x4* WF = (u32x4*)(F.ws + WS_WLRUF);
    for (int idx = F.bid * NTHREADS + F.tid; idx < 2 * 16 * 2 * 4 * 2 * 64; idx += F.G * NTHREADS) {
        const int lane = idx & 63, s = (idx >> 6) & 1, n = (idx >> 7) & 3, mat = (idx >> 9) & 1, h = (idx >> 10) & 15, dir = idx >> 14;
        const float* W = (mat == 0 ? wa : wi) + ((size_t)(dir * 16 + h) * 64) * 64; const int jo = 16 * n + (lane & 15), i0 = 32 * s + 8 * (lane >> 4);
        u32x4 o; o.x = pk2(W[(i0 + 0) * 64 + jo], W[(i0 + 1) * 64 + jo]); o.y = pk2(W[(i0 + 2) * 64 + jo], W[(i0 + 3) * 64 + jo]);
        o.z = pk2(W[(i0 + 4) * 64 + jo], W[(i0 + 5) * 64 + jo]); o.w = pk2(W[(i0 + 6) * 64 + jo], W[(i0 + 7) * 64 + jo]);
        WF[idx] = o;
    }
}

__device__ __forceinline__ void load_rows(const bf16_t* __restrict__ P0, int b, int t0, int m, int h, int j, int q, u32x4 (&pv)[2][4]) {
#pragma unroll
    for (int s = 0; s < 2; ++s)
#pragma unroll
        for (int tap = 0; tap < 4; ++tap) { const int tl = t0 + 16 * m + j + tap - 2; const bool ok = (tl >= 0) && (tl < L);
            const size_t off = ok ? (WS_P0 - WS_CTL - 8192) + (((size_t)b * L + tl) * 1024 + 64 * h + 32 * s + 8 * q) * 2 : (size_t)0;
            pv[s][tap] = *(const u32x4*)((const char*)P0 + off); }
}
__device__ __forceinline__ void stage1(Frame& F) {
    const bf16_t* P0 = (const bf16_t*)(F.ws + WS_CTL + 8192);
    const float* cw = F.in[4]; const float* cb = F.in[5]; const float* ba = F.in[7]; const float* bi = F.in[9]; const float* lam = F.in[10];
    const u32x4* WF = (const u32x4*)(F.ws + WS_WLRUF); f32x2* SUMM = (f32x2*)(F.ws + WS_SUMM);
    u32x2* HS = (u32x2*)(F.ws + WS_HS); u32x2* AF = (u32x2*)(F.ws + WS_AF); u32x2* AB = (u32x2*)(F.ws + WS_AB);
    LAS float* cwl = (LAS float*)(F.lds + MISC_OFF + 4096);
    LAS unsigned* hfl = (LAS unsigned*)(F.lds + F.wave * 8192) + F.lane;
    const LAS u32x4* wl = (const LAS u32x4*)(F.lds + 65536) + F.lane;
    asm volatile("" : "+v"(wl)); asm volatile("" : "+v"(hfl));
    const int lane = F.lane, j = lane & 15, q = lane >> 4;
    bf16x8 idf[2];
#pragma unroll
    for (int par = 0; par < 2; ++par) { const int kp = 16 * par + j;
#pragma unroll
        for (int jj = 0; jj < 8; ++jj) idf[par][jj] = (short)((q == (kp >> 3) && jj == (kp & 7)) ? 0x3F80 : 0); }
#pragma unroll 1
    for (int bix = F.bid; bix < NB * 16 * (NCH / 8); bix += F.G) {
        const int h = (bix >> 4) & 15, b = bix >> 8, chunk = (bix & 15) * 8 + F.wave; const int t0 = chunk * TC; const int task = ((b * NCH + chunk) << 4) + h;
        __syncthreads();
        if (F.tid < 320) cwl[F.tid] = F.tid < 256 ? cw[(F.tid >> 6) * 1024 + 64 * h + (F.tid & 63)] : cb[64 * h + (F.tid & 63)];
#pragma unroll
        for (int i = 0; i < 4; ++i) { const int e = F.tid + 512 * i; const int dir_ = e >> 10, rest = e & 1023;
            ((LAS u32x4*)(F.lds + 65536))[e] = WF[((size_t)(dir_ * 16 + h) * 16) * 64 + rest]; }
        __syncthreads();
#pragma unroll
        for (int dir = 0; dir < 2; ++dir) {
            float bac[4], bic[4], spc[4], cst[4], arun[4];
#pragma unroll
            for (int n = 0; n < 4; ++n) { const int c = 64 * h + 16 * n + j; bac[n] = ba[dir * 1024 + c]; bic[n] = bi[dir * 1024 + c]; spc[n] = -8.0f * 1.4426950408889634f * log1pf(expf(-lam[dir * 1024 + c])); cst[n] = 0.f; arun[n] = 1.f; }
            u32x4 pvn[2][4];
            load_rows(P0, b, t0, dir == 0 ? 0 : MB - 1, h, j, q, pvn);
#pragma unroll 1
            for (int mm = 0; mm < MB; ++mm) {
                const int m = dir == 0 ? mm : MB - 1 - mm;
                bf16x8 afr[2];
#pragma unroll
                for (int s = 0; s < 2; ++s) { const int chb = 32 * s + 8 * q; f32x2 xp[4];
                    { const f32x4 b0 = *(const LAS f32x4*)(cwl + 256 + chb), b1 = *(const LAS f32x4*)(cwl + 256 + chb + 4);
                      xp[0] = (f32x2){b0.x, b0.y}; xp[1] = (f32x2){b0.z, b0.w}; xp[2] = (f32x2){b1.x, b1.y}; xp[3] = (f32x2){b1.z, b1.w}; }
#pragma unroll
                    for (int tap = 0; tap < 4; ++tap) { const u32x4 pq = pvn[s][tap];
                        const f32x4 w0 = *(const LAS f32x4*)(cwl + tap * 64 + chb), w1 = *(const LAS f32x4*)(cwl + tap * 64 + chb + 4);
                        xp[0] += (f32x2){w0.x, w0.y} * (f32x2){__uint_as_float(pq.x << 16), __uint_as_float(pq.x & 0xffff0000u)}; xp[1] += (f32x2){w0.z, w0.w} * (f32x2){__uint_as_float(pq.y << 16), __uint_as_float(pq.y & 0xffff0000u)};
                        xp[2] += (f32x2){w1.x, w1.y} * (f32x2){__uint_as_float(pq.z << 16), __uint_as_float(pq.z & 0xffff0000u)}; xp[3] += (f32x2){w1.z, w1.w} * (f32x2){__uint_as_float(pq.w << 16), __uint_as_float(pq.w & 0xffff0000u)}; }
                    u32x4 pk; pk.x = pk2(xp[0].x, xp[0].y); pk.y = pk2(xp[1].x, xp[1].y); pk.z = pk2(xp[2].x, xp[2].y); pk.w = pk2(xp[3].x, xp[3].y); afr[s] = __builtin_bit_cast(bf16x8, pk); }
                __builtin_amdgcn_sched_barrier(0);
                if (mm + 1 < MB) load_rows(P0, b, t0, dir == 0 ? m + 1 : m - 1, h, j, q, pvn);
                f32x4 dx[4], da[4], di[4];
#pragma unroll
                for (int n = 0; n < 4; ++n) { const f32x4 z4 = (f32x4){0.f, 0.f, 0.f, 0.f};
                    dx[n] = __builtin_amdgcn_mfma_f32_16x16x32_bf16(afr[n >> 1], idf[n & 1], z4, 0, 0, 0);
                    const bf16x8 wa0 = __builtin_bit_cast(bf16x8, wl[(((dir * 2 + 0) * 4 + n) * 2 + 0) * 64]), wa1 = __builtin_bit_cast(bf16x8, wl[(((dir * 2 + 0) * 4 + n) * 2 + 1) * 64]);
                    const bf16x8 wi0 = __builtin_bit_cast(bf16x8, wl[(((dir * 2 + 1) * 4 + n) * 2 + 0) * 64]), wi1 = __builtin_bit_cast(bf16x8, wl[(((dir * 2 + 1) * 4 + n) * 2 + 1) * 64]);
                    da[n] = __builtin_amdgcn_mfma_f32_16x16x32_bf16(afr[0], wa0, z4, 0, 0, 0); da[n] = __builtin_amdgcn_mfma_f32_16x16x32_bf16(afr[1], wa1, da[n], 0, 0, 0);
                    di[n] = __builtin_amdgcn_mfma_f32_16x16x32_bf16(afr[0], wi0, z4, 0, 0, 0); di[n] = __builtin_amdgcn_mfma_f32_16x16x32_bf16(afr[1], wi1, di[n], 0, 0, 0); }
                float P[4][4], S[4][4], PT[4], ST[4];
#pragma unroll
                for (int n = 0; n < 4; ++n) { float av[4], bv[4];
#pragma unroll
                    for (int hp = 0; hp < 2; ++hp) {
                        const f32x2 rg = sig2((f32x2){da[n][2 * hp], da[n][2 * hp + 1]} + bac[n]), ig = sig2((f32x2){di[n][2 * hp], di[n][2 * hp + 1]} + bic[n]);
                        const f32x2 tq = rg * spc[n];
                        const f32x2 a = (f32x2){__builtin_amdgcn_exp2f(tq.x), __builtin_amdgcn_exp2f(tq.y)};
                        const f32x2 w = 1.0f - a * a;
                        const f32x2 mult = (f32x2){__builtin_amdgcn_sqrtf(fmaxf(w.x, 0.f)), __builtin_amdgcn_sqrtf(fmaxf(w.y, 0.f))};
                        const f32x2 bq = mult * (ig * (f32x2){dx[n][2 * hp], dx[n][2 * hp + 1]});
                        av[2 * hp] = a.x; av[2 * hp + 1] = a.y; bv[2 * hp] = bq.x; bv[2 * hp + 1] = bq.y; }
                    if (dir == 0) { P[n][0] = av[0]; S[n][0] = bv[0];
#pragma unroll
                        for (int r = 1; r < 4; ++r) { P[n][r] = P[n][r - 1] * av[r]; S[n][r] = av[r] * S[n][r - 1] + bv[r]; } }
                    else { P[n][3] = av[3]; S[n][3] = bv[3];
#pragma unroll
                        for (int r = 2; r >= 0; --r) { P[n][r] = P[n][r + 1] * av[r]; S[n][r] = av[r] * S[n][r + 1] + bv[r]; } }
                    PT[n] = dir == 0 ? P[n][3] : P[n][0]; ST[n] = dir == 0 ? S[n][3] : S[n][0]; }
                float pt[4][4], st[4][4];
#pragma unroll
                for (int n = 0; n < 4; ++n)
#pragma unroll
                    for (int g = 0; g < 4; ++g) { pt[n][g] = __shfl(PT[n], j + 16 * g); st[n][g] = __shfl(ST[n], j + 16 * g); }
#pragma unroll
                for (int n = 0; n < 4; ++n) {
                    float C = cst[n], A = arun[n], Cq = 0.f, Aq = 1.f;
#pragma unroll
                    for (int gg = 0; gg < 4; ++gg) { const int g = dir == 0 ? gg : 3 - gg; if (g == q) { Cq = C; Aq = A; } C = pt[n][g] * C + st[n][g]; A *= pt[n][g]; }
                    cst[n] = C; arun[n] = A;
                    float hl[4], ac[4];
#pragma unroll
                    for (int hp = 0; hp < 2; ++hp) { const f32x2 pp = (f32x2){P[n][2 * hp], P[n][2 * hp + 1]}; const f32x2 hq = (f32x2){S[n][2 * hp], S[n][2 * hp + 1]} + pp * Cq, aq = pp * Aq;
                        hl[2 * hp] = hq.x; hl[2 * hp + 1] = hq.y; ac[2 * hp] = aq.x; ac[2 * hp + 1] = aq.y; }
                    const size_t fo = ((size_t)(task * MB + m) * 4 + n) * 64 + lane;
                    if (dir == 0) {
                        hfl[((m * 4 + n) * 2 + 0) * 64] = pk2(hl[0], hl[1]); hfl[((m * 4 + n) * 2 + 1) * 64] = pk2(hl[2], hl[3]);
                        AF[fo] = (u32x2){pk2(ac[0], ac[1]), pk2(ac[2], ac[3])};
                    } else {
                        { const unsigned u0 = hfl[((m * 4 + n) * 2 + 0) * 64], u1 = hfl[((m * 4 + n) * 2 + 1) * 64];
                          hl[0] += __uint_as_float(u0 << 16); hl[1] += __uint_as_float(u0 & 0xffff0000u); hl[2] += __uint_as_float(u1 << 16); hl[3] += __uint_as_float(u1 & 0xffff0000u); }
                        HS[fo] = (u32x2){pk2(hl[0], hl[1]), pk2(hl[2], hl[3])}; AB[fo] = (u32x2){pk2(ac[0], ac[1]), pk2(ac[2], ac[3])};
                    }
                }
            }
            if (q == 0) {
#pragma unroll
                for (int n = 0; n < 4; ++n) SUMM[((size_t)(dir * NB + b) * NCH + chunk) * 1024 + 64 * h + 16 * n + j] = (f32x2){arun[n], cst[n]};
            }
        }
    }
}
__device__ __forceinline__ void stage2(Frame& F) {
    const bf16_t* P1 = (const bf16_t*)(F.ws + WS_P1); bf16_t* YLRU = (bf16_t*)(F.ws + WS_YLRU); const float* CARRY = (const float*)(F.ws + WS_CARRY);
    const u32x2* HS = (const u32x2*)(F.ws + WS_HS); const u32x2* AF = (const u32x2*)(F.ws + WS_AF); const u32x2* AB = (const u32x2*)(F.ws + WS_AB);
    LAS float* buf = (LAS float*)(F.lds + F.wave * 8192);
    const int lane = F.lane, j = lane & 15, q = lane >> 4, tk = lane >> 2, cg = lane & 3;
    const int gw = F.bid * NWAVES + F.wave, NGW = F.G * NWAVES;
    struct In { u32x2 hs[4], af[4], ab[4]; float cf[4], cbk[4]; u32x4 g0, g1; };
    auto issue = [&](int item, In& I) {
        const int m = item & (MB - 1), task = item >> 2, h = task & 15, chunk = (task >> 4) & (NCH - 1), b = task >> 11;
#pragma unroll
        for (int n = 0; n < 4; ++n) { const size_t fo = ((size_t)item * 4 + n) * 64 + lane; I.hs[n] = HS[fo]; I.af[n] = AF[fo]; I.ab[n] = AB[fo];
            const int c = 64 * h + 16 * n + j; I.cf[n] = CARRY[((size_t)(0 * NB + b) * NCH + chunk) * 1024 + c]; I.cbk[n] = CARRY[((size_t)(1 * NB + b) * NCH + chunk) * 1024 + c]; }
        const size_t o = ((size_t)b * L + chunk * TC + 16 * m + tk) * 1024 + 64 * h + 16 * cg;
        I.g0 = *(const u32x4*)(P1 + o); I.g1 = *(const u32x4*)(P1 + o + 8); };
    auto finish = [&](int item, const In& I) {
        const int m = item & (MB - 1), task = item >> 2, h = task & 15, chunk = (task >> 4) & (NCH - 1), b = task >> 11;
#pragma unroll
        for (int n = 0; n < 4; ++n) {
            const float h0 = __uint_as_float(I.hs[n].x << 16) + __uint_as_float(I.af[n].x << 16) * I.cf[n] + __uint_as_float(I.ab[n].x << 16) * I.cbk[n];
            const float h1 = __uint_as_float(I.hs[n].x & 0xffff0000u) + __uint_as_float(I.af[n].x & 0xffff0000u) * I.cf[n] + __uint_as_float(I.ab[n].x & 0xffff0000u) * I.cbk[n];
            const float h2 = __uint_as_float(I.hs[n].y << 16) + __uint_as_float(I.af[n].y << 16) * I.cf[n] + __uint_as_float(I.ab[n].y << 16) * I.cbk[n];
            const float h3 = __uint_as_float(I.hs[n].y & 0xffff0000u) + __uint_as_float(I.af[n].y & 0xffff0000u) * I.cf[n] + __uint_as_float(I.ab[n].y & 0xffff0000u) * I.cbk[n];
            buf[(4 * q + 0) * 68 + 16 * n + j] = h0; buf[(4 * q + 1) * 68 + 16 * n + j] = h1; buf[(4 * q + 2) * 68 + 16 * n + j] = h2; buf[(4 * q + 3) * 68 + 16 * n + j] = h3;
        }
        LDS_WAIT();
        const size_t o = ((size_t)b * L + chunk * TC + 16 * m + tk) * 1024 + 64 * h + 16 * cg;
        const LAS f32x4* br = (const LAS f32x4*)(buf + tk * 68 + 16 * cg);
        const f32x4 v0 = br[0], v1 = br[1], v2 = br[2], v3 = br[3];
        float gg[16];
        { const unsigned w[8] = {I.g0.x, I.g0.y, I.g0.z, I.g0.w, I.g1.x, I.g1.y, I.g1.z, I.g1.w};
#pragma unroll
          for (int i = 0; i < 8; ++i) { gg[2 * i] = gelu_tanh(__uint_as_float(w[i] << 16)); gg[2 * i + 1] = gelu_tanh(__uint_as_float(w[i] & 0xffff0000u)); } }
        u32x4 y0, y1;
        y0.x = pk2(v0.x * gg[0], v0.y * gg[1]); y0.y = pk2(v0.z * gg[2], v0.w * gg[3]); y0.z = pk2(v1.x * gg[4], v1.y * gg[5]); y0.w = pk2(v1.z * gg[6], v1.w * gg[7]);
        y1.x = pk2(v2.x * gg[8], v2.y * gg[9]); y1.y = pk2(v2.z * gg[10], v2.w * gg[11]); y1.z = pk2(v3.x * gg[12], v3.y * gg[13]); y1.w = pk2(v3.z * gg[14], v3.w * gg[15]);
        *(u32x4*)(YLRU + o) = y0; *(u32x4*)(YLRU + o + 8) = y1;
        LDS_WAIT(); };
    constexpr int NIT = NB * NCH * 16 * MB;
    In A, B; int item = gw;
    if (item < NIT) issue(item, A);
#pragma unroll 1
    for (; item < NIT; item += 2 * NGW) {
        if (item + NGW < NIT) issue(item + NGW, B);
        finish(item, A);
        if (item + NGW >= NIT) break;
        if (item + 2 * NGW < NIT) issue(item + 2 * NGW, A);
        finish(item + NGW, B);
    }
}
__device__ __forceinline__ void carry(Frame& F) {
    const f32x2* SUMM = (const f32x2*)(F.ws + WS_SUMM); float* CARRY = (float*)(F.ws + WS_CARRY);
    for (int idx = F.bid * NTHREADS + F.tid; idx < 2 * NB * 1024; idx += F.G * NTHREADS) {
        const int c = idx & 1023, db = idx >> 10, dir = db >> 2; const size_t base = (size_t)db * NCH * 1024 + c;
        float C = 0.f;
#pragma unroll 1
        for (int k0 = 0; k0 < NCH; k0 += 16) {
            f32x2 v[16];
#pragma unroll
            for (int i = 0; i < 16; ++i) { const int k = dir == 0 ? (k0 + i) : (NCH - 1 - k0 - i); v[i] = SUMM[base + (size_t)k * 1024]; }
#pragma unroll
            for (int i = 0; i < 16; ++i) { const int k = dir == 0 ? (k0 + i) : (NCH - 1 - k0 - i); CARRY[base + (size_t)k * 1024] = C; C = v[i].x * C + v[i].y; }
        }
    }
}
}
__device__ __forceinline__ void transpose_item(const float* __restrict__ W, int ldw, int k0, int n0, bf16_t* __restrict__ WT, size_t orow0, const float* __restrict__ kscale, LAS float* scr, int lane) {
    const int r8 = lane >> 3, c4 = (lane & 7) * 4;
#pragma unroll
    for (int i = 0; i < 8; ++i) { const int kk = 8 * i + r8; f32x4 v = *(const f32x4*)(W + (size_t)(k0 + kk) * ldw + n0 + c4);
        if (kscale) { const float s = kscale[k0 + kk]; v = v * s; }
        scr[kk * 33 + c4 + 0] = v.x; scr[kk * 33 + c4 + 1] = v.y; scr[kk * 33 + c4 + 2] = v.z; scr[kk * 33 + c4 + 3] = v.w; }
    LDS_WAIT();
    const int c = lane & 7;
#pragma unroll
    for (int j = 0; j < 4; ++j) { const int n = (lane >> 3) + 8 * j; const LAS float* s = scr + (8 * c) * 33 + n;
        u32x4 o; o.x = pk2(s[0 * 33], s[1 * 33]); o.y = pk2(s[2 * 33], s[3 * 33]); o.z = pk2(s[4 * 33], s[5 * 33]); o.w = pk2(s[6 * 33], s[7 * 33]);
        *(u32x4*)(WT + (orow0 + n) * 1024 + k0 + 8 * c) = o; }
    LDS_WAIT();
}

__device__ __forceinline__ void phase_prep(Frame& F) {
    LAS float* scr = (LAS float*)(F.lds + F.wave * 16384);
    const int gw = F.bid * NWAVES + F.wave, NGW = F.G * NWAVES;
    constexpr int I_IN = (1024 / 64) * (NIN / 32), I_SQ = (1024 / 64) * (1024 / 32);
    for (int it = gw; it < I_IN + 3 * I_SQ; it += NGW) {
        int r = it; const float* W; int N; bf16_t* WT;
        if (r < I_IN) { W = F.in[2]; N = NIN; WT = (bf16_t*)(F.ws + WS_WIN); }
        else { r -= I_IN; const int q = r / I_SQ; r -= q * I_SQ; N = 1024; W = q == 0 ? F.in[11] : q == 1 ? F.in[23] : F.in[24]; WT = (bf16_t*)(F.ws + (q == 0 ? WS_WLRU : q == 1 ? WS_WHY : WS_WOUT)); }
        const int nblk = N / 32, kb = r / nblk, nb = r % nblk;
        int orow = 32 * nb;
        if (N == NIN && orow >= 5120) { const int which = (orow - 5120) >> 10, cc = (orow - 5120) & 1023; orow = 5120 + 256 * (cc >> 7) + 128 * which + (cc & 127); }
        transpose_item(W, N, 64 * kb, 32 * nb, WT, (size_t)orow, nullptr, scr, F.lane);
    }
    { const float* x = F.in[0]; const float* g = F.in[1]; bf16_t* U = (bf16_t*)(F.ws + WS_U);
      f32x4 gg[4];
#pragma unroll
      for (int j = 0; j < 4; ++j) gg[j] = ((const f32x4*)g)[F.lane + 64 * j];
      auto ld = [&](int row, f32x4 (&v)[4]) { const f32x4* xr = (const f32x4*)(x + (size_t)row * D) + F.lane;
#pragma unroll
          for (int j = 0; j < 4; ++j) v[j] = xr[64 * j]; };
      auto fin = [&](int row, const f32x4 (&v)[4]) { float s = 0.f;
#pragma unroll
          for (int j = 0; j < 4; ++j) s += v[j].x * v[j].x + v[j].y * v[j].y + v[j].z * v[j].z + v[j].w * v[j].w;
          const float rstd = rsqrtf(wave_sum(s) * (1.0f / D) + EPS);
#pragma unroll
          for (int j = 0; j < 4; ++j) { u32x2 w; w.x = pk2(v[j].x * rstd * gg[j].x, v[j].y * rstd * gg[j].y); w.y = pk2(v[j].z * rstd * gg[j].z, v[j].w * rstd * gg[j].w);
              ((u32x2*)(U + (size_t)row * D))[F.lane + 64 * j] = w; } };
      f32x4 va[4], vb[4], vc[4]; int row = gw;
      if (row < T) ld(row, va);
      if (row + NGW < T) ld(row + NGW, vb);
#pragma unroll 1
      for (; row < T; row += 3 * NGW) {
          if (row + 2 * NGW < T) ld(row + 2 * NGW, vc);
          fin(row, va);
          if (row + NGW >= T) break;
          if (row + 3 * NGW < T) ld(row + 3 * NGW, va);
          fin(row + NGW, vb);
          if (row + 2 * NGW >= T) break;
          if (row + 4 * NGW < T) ld(row + 4 * NGW, vb);
          fin(row + 2 * NGW, vc);
      } }
    { const float *w1 = F.in[14], *b1 = F.in[15], *w2 = F.in[16], *b2 = F.in[17], *w3 = F.in[18], *b3 = F.in[19], *freq = F.in[21]; float* HH3 = (float*)(F.ws + WS_HH3);
      LAS float* feat = scr; LAS float* h1 = scr + 64; LAS float* h2 = scr + 128; const int u = F.lane; const float fr = freq[u];
#pragma unroll 1
      for (int t = gw; t < L; t += NGW) {
        asm volatile("" ::: "memory");
        if (u < HYEMB) { float f; if (u == 0) f = (float)t / (float)(L - 1);
            else { const int j = (u - 1) & 15; const float band = 1e-4f + (float)j * ((15.0f - 1e-4f) / 15.0f); const float arg = (6.283185307179586f * (float)t / (float)L) * band; f = (u <= 16) ? cosf(arg) : -sinf(arg); }
            feat[u] = f; }
        LDS_WAIT();
        float s = b1[u];
#pragma unroll 1
        for (int f = 0; f < HYEMB; ++f) s += feat[f] * w1[f * 64 + u];
        h1[u] = sinf(fr * s); LDS_WAIT();
        s = b2[u];
#pragma unroll 4
        for (int f = 0; f < 64; ++f) s += h1[f] * w2[f * 64 + u];
        h2[u] = sinf(fr * s); LDS_WAIT();
        s = b3[u];
#pragma unroll 4
        for (int f = 0; f < 64; ++f) s += h2[f] * w3[f * 64 + u];
        HH3[t * 64 + u] = sinf(fr * s); LDS_WAIT(); } }
    lru::prep_wfrag(F); hy::prep_w4frag(F);
    { u32x4* WRGF = (u32x4*)(F.ws + WS_WRG); const float* g = F.in[25]; const float* wr = F.in[26];
      for (int idx = F.bid * NTHREADS + F.tid; idx < 32 * 2 * 2 * 64; idx += F.G * NTHREADS) {
          const int lane = idx & 63, part = (idx >> 6) & 1, tile = (idx >> 7) & 1, s = idx >> 8; const int e = 16 * tile + (lane & 15), k0 = 32 * s + 8 * (lane >> 4);
          float w[8];
#pragma unroll
          for (int jj = 0; jj < 8; ++jj) { const float v = g[k0 + jj] * wr[(k0 + jj) * 32 + e]; const float hi = __uint_as_float(pk2(v, v) << 16); w[jj] = part == 0 ? hi : v - hi; }
          u32x4 o; o.x = pk2(w[0], w[1]); o.y = pk2(w[2], w[3]); o.z = pk2(w[4], w[5]); o.w = pk2(w[6], w[7]); WRGF[idx] = o; } }
}

template <int KIND, bool DYN> __device__ __forceinline__ void convert_weights(Frame& F, int rank, int nranks, int rnd_lo = 0, int rnd_hi = 1 << 20) {
    LAS float* scr = (LAS float*)(F.lds + F.wave * 16384);
    const int gw = rank * NWAVES + F.wave, NGW = nranks * NWAVES;
    constexpr int IPE = KIND == 0 ? (1024 / 64) * (2048 / 32) : (1024 / 64) * (1024 / 32), TOTAL_ALL = NE * IPE;
    const int TOTAL = (long)rnd_hi * NGW < (long)TOTAL_ALL ? rnd_hi * NGW : TOTAL_ALL;
    int* ctr = (int*)(F.ws + WS_CTL) + 130;
    auto claim = [&]() { int v = 0; if (DYN && F.lane == 0) v = atomicAdd(ctr, 1); return v; };
    const float* Wc = nullptr; bf16_t* WTc = nullptr; size_t orowc = 0; int k0c = 0; f32x4 vc[8];
    auto decode_load = [&](int it, const float*& W, bf16_t*& WT, size_t& orow, int& k0, f32x4 (&v)[8]) {
        const int e = it / IPE, r = it - e * IPE; int ldw, n0;
        if (KIND == 0) { const int kb = r / 64, nb = r % 64; n0 = 32 * nb; const int which = n0 >> 10, pn = (n0 & 1023) >> 7, j0 = n0 & 127;
            W = F.in[28] + (size_t)e * 1024 * 2048; ldw = 2048; k0 = 64 * kb; WT = (bf16_t*)(F.ws + WS_WGU); orow = (size_t)e * 2048 + 256 * pn + 128 * which + j0; }
        else { const int kb = r / 32, nb = r % 32; n0 = 32 * nb;
            W = F.in[30] + (size_t)e * 1024 * 1024; ldw = 1024; k0 = 64 * kb; WT = (bf16_t*)(F.ws + WS_WDN); orow = (size_t)e * 1024 + 32 * nb; }
        const int r8 = F.lane >> 3, c4 = (F.lane & 7) * 4;
#pragma unroll
        for (int i = 0; i < 8; ++i) { const int kk = 8 * i + r8; v[i] = *(const f32x4*)(W + (size_t)(k0 + kk) * ldw + n0 + c4); if (KIND == 0) v[i] = v[i] * F.in[25][k0 + kk]; }
    };
    int it, itn, raw2 = 0;
    if (DYN) { const int r0 = claim(), r1 = claim(); raw2 = claim(); it = __builtin_amdgcn_readfirstlane(r0); itn = __builtin_amdgcn_readfirstlane(r1); }
    else { it = rnd_lo * NGW + gw; itn = it + NGW; }
    if (it < TOTAL) decode_load(it, Wc, WTc, orowc, k0c, vc);
#pragma unroll 1
    while (it < TOTAL) {
        const float* Wn = nullptr; bf16_t* WTn = nullptr; size_t orown = 0; int k0n = 0; f32x4 vn[8];
        const bool more = itn < TOTAL;
        if (more) decode_load(itn, Wn, WTn, orown, k0n, vn);
        { const int r8 = F.lane >> 3, c4 = (F.lane & 7) * 4;
#pragma unroll
          for (int i = 0; i < 8; ++i) { const int kk = 8 * i + r8; scr[kk * 33 + c4 + 0] = vc[i].x; scr[kk * 33 + c4 + 1] = vc[i].y; scr[kk * 33 + c4 + 2] = vc[i].z; scr[kk * 33 + c4 + 3] = vc[i].w; }
          LDS_WAIT();
          const int c = F.lane & 7;
#pragma unroll
          for (int j = 0; j < 4; ++j) { const int n = (F.lane >> 3) + 8 * j; const LAS float* s = scr + (8 * c) * 33 + n;
#ifdef DN_FP8
#ifdef GU_FP8
              if (true) {
#else
              if (KIND == 1) {
#endif
                  int w0 = __builtin_amdgcn_cvt_pk_fp8_f32(s[0 * 33], s[1 * 33], 0, false); w0 = __builtin_amdgcn_cvt_pk_fp8_f32(s[2 * 33], s[3 * 33], w0, true);
                  int w1 = __builtin_amdgcn_cvt_pk_fp8_f32(s[4 * 33], s[5 * 33], 0, false); w1 = __builtin_amdgcn_cvt_pk_fp8_f32(s[6 * 33], s[7 * 33], w1, true);
                  *(u32x2*)((unsigned char*)WTc + (orowc + n) * 1024 + k0c + 8 * c) = (u32x2){(unsigned)w0, (unsigned)w1}; } else
#endif
              { u32x4 o; o.x = pk2(s[0 * 33], s[1 * 33]); o.y = pk2(s[2 * 33], s[3 * 33]); o.z = pk2(s[4 * 33], s[5 * 33]); o.w = pk2(s[6 * 33], s[7 * 33]);
              *(u32x4*)(WTc + (orowc + n) * 1024 + k0c + 8 * c) = o; } }
          LDS_WAIT(); }
        if (more) { Wc = Wn; WTc = WTn; orowc = orown; k0c = k0n;
#pragma unroll
            for (int i = 0; i < 8; ++i) vc[i] = vn[i]; }
        it = itn;
        if (DYN) { itn = __builtin_amdgcn_readfirstlane(raw2); raw2 = claim(); } else itn += NGW;
    }
}
__device__ __forceinline__ void phase_router_a(Frame& F) {
#ifdef MIXDESYNC
    convert_weights<0, false>(F, F.bid, F.G, 2 * MIXDESYNC); convert_weights<1, false>(F, F.bid, F.G);
#else
    REP(11) { convert_weights<0, false>(F, F.bid, F.G); convert_weights<1, false>(F, F.bid, F.G); }
#endif
    __syncthreads();
    { const f32x4* src = (const f32x4*)(F.ws + WS_WRG); LAS f32x4* dst = (LAS f32x4*)F.lds;
      for (int i = F.tid; i < 32 * 2 * 2 * 64; i += NTHREADS) dst[i] = src[i]; }
    LAS int* hist = (LAS int*)(F.lds + MISC_OFF);
    if (F.tid < 32) hist[F.tid] = 0;
    __syncthreads();
    const LAS u32x4* wl = (const LAS u32x4*)F.lds + F.lane;
    const bf16_t* HB = (const bf16_t*)(F.ws + WS_HN); const float* br = F.in[27];
    int* EROWTOK = (int*)(F.ws + WS_EROWTOK); float* EROWRS = (float*)(F.ws + WS_EROWRS); float* EROWGATE = (float*)(F.ws + WS_EROWGATE); int* TOKCODE = (int*)(F.ws + WS_TOKROW); LAS int* base = hist + 32;
    for (int g0 = 0; g0 < T / 16; g0 += F.G * NWAVES) {
        const int grp = g0 + F.bid * NWAVES + F.wave; const bool act = grp < T / 16;
        int te_[4] = {0, 0, 0, 0}, lr_[4] = {0, 0, 0, 0}; float gt_[4] = {0.f, 0.f, 0.f, 0.f}, rs_ = 0.f;
        const int n = F.lane & 15, g = F.lane >> 4; const int t = grp * 16 + n;
        if (act) {
        const u32x4* hp = (const u32x4*)(HB + (size_t)t * D + 8 * g);
        f32x4 acc[2] = {(f32x4){0.f, 0.f, 0.f, 0.f}, (f32x4){0.f, 0.f, 0.f, 0.f}}; f32x2 ss2 = (f32x2){0.f, 0.f};
        u32x4 hb[8];
#pragma unroll
        for (int u = 0; u < 8; ++u) hb[u] = hp[u * 4];
#pragma unroll 1
        for (int s0 = 0; s0 < 32; s0 += 8) {
#pragma unroll
            for (int u = 0; u < 8; ++u) { const int s = s0 + u; const u32x4 cur = hb[u];
                if (s0 + 8 < 32) hb[u] = hp[(s + 8) * 4];
                const bf16x8 bfr = __builtin_bit_cast(bf16x8, cur);
#pragma unroll
                for (int tile = 0; tile < 2; ++tile) {
                    acc[tile] = __builtin_amdgcn_mfma_f32_16x16x32_bf16(__builtin_bit_cast(bf16x8, wl[((s * 2 + tile) * 2 + 0) * 64]), bfr, acc[tile], 0, 0, 0);
                    acc[tile] = __builtin_amdgcn_mfma_f32_16x16x32_bf16(__builtin_bit_cast(bf16x8, wl[((s * 2 + tile) * 2 + 1) * 64]), bfr, acc[tile], 0, 0, 0); }
                const f32x2 a = (f32x2){__uint_as_float(cur.x << 16), __uint_as_float(cur.x & 0xffff0000u)}, b = (f32x2){__uint_as_float(cur.y << 16), __uint_as_float(cur.y & 0xffff0000u)};
                const f32x2 c = (f32x2){__uint_as_float(cur.z << 16), __uint_as_float(cur.z & 0xffff0000u)}, d = (f32x2){__uint_as_float(cur.w << 16), __uint_as_float(cur.w & 0xffff0000u)};
                ss2 += a * a; ss2 += b * b; ss2 += c * c; ss2 += d * d; }
        }
        float ss = ss2.x + ss2.y; ss += __shfl_xor(ss, 16); ss += __shfl_xor(ss, 32);
        const float rstd = rsqrtf(ss * (1.0f / D) + EPS);
        float v[8];
#pragma unroll
        for (int q = 0; q < 8; ++q) v[q] = acc[q >> 2][q & 3] * rstd + br[16 * (q >> 2) + 4 * g + (q & 3)];
        float tv[4]; int te[4];
#pragma unroll
        for (int k = 0; k < 4; ++k) {
            float mx = -3.0e38f; int mi = 0;
#pragma unroll
            for (int q = 0; q < 8; ++q) { const int ex = 16 * (q >> 2) + 4 * g + (q & 3); if (v[q] > mx) { mx = v[q]; mi = ex; } }
#pragma unroll
            for (int o = 16; o <= 32; o <<= 1) { const float om = __shfl_xor(mx, o); const int oi = __shfl_xor(mi, o); if (om > mx || (om == mx && oi < mi)) { mx = om; mi = oi; } }
            tv[k] = mx; te[k] = mi;
#pragma unroll
            for (int q = 0; q < 8; ++q) { const int ex = 16 * (q >> 2) + 4 * g + (q & 3); if (ex == mi) v[q] = -3.0e38f; }
        }
        const float e1 = __expf(tv[1] - tv[0]), e2 = __expf(tv[2] - tv[0]), e3 = __expf(tv[3] - tv[0]); const float inv = 1.0f / (1.0f + e1 + e2 + e3);
        if (g == 0) {
            gt_[0] = inv; gt_[1] = e1 * inv; gt_[2] = e2 * inv; gt_[3] = e3 * inv; rs_ = rstd;
#pragma unroll
            for (int k = 0; k < 4; ++k) { te_[k] = te[k]; lr_[k] = atomicAdd((int*)&hist[te[k]], 1); }
        }
        }
        __syncthreads();
        if (F.tid < 32) base[F.tid] = hist[F.tid] != 0 ? atomicAdd((int*)(F.ws + WS_CTL) + F.tid, hist[F.tid]) : 0;
        __syncthreads();
        if (act && g == 0) { int code[4];
#pragma unroll
            for (int k = 0; k < 4; ++k) { const int e = te_[k], pos = base[e] + lr_[k]; const size_t o = (size_t)e * T + pos;
                EROWTOK[o] = t; EROWRS[o] = rs_; EROWGATE[o] = gt_[k]; code[k] = (e << 15) | pos; }
            *(int4*)(TOKCODE + t * 4) = make_int4(code[0], code[1], code[2], code[3]); }
        __syncthreads();
        if (F.tid < 32) hist[F.tid] = 0;
        __syncthreads();
    }
}
__device__ __forceinline__ const LAS int* build_ptile(Frame& F) {
    LAS int* pt = (LAS int*)(F.lds + MISC_OFF + 256);
    __syncthreads();
    if (F.tid == 0) { const int* cnt = (const int*)(F.ws + WS_CTL); int o = 0; for (int e = 0; e < 32; ++e) { pt[e] = o; o += (cnt[e] + 255) >> 8; } pt[32] = o; }
    __syncthreads();
    return pt;
}
__device__ __forceinline__ void phase_router_b(Frame& F) {
    const LAS int* pt = build_ptile(F);
    LAS int* hist = (LAS int*)(F.lds + MISC_OFF); LAS int* base = hist + 32;
    const int* TOPE = (const int*)(F.ws + WS_TOPE); const float* TOPG = (const float*)(F.ws + WS_TOPG); const float* TOKRS = (const float*)(F.ws + WS_TOKRS);
    int* ROWTOK = (int*)(F.ws + WS_ROWTOK); float* ROWGATE = (float*)(F.ws + WS_ROWGATE); float* ROWRS = (float*)(F.ws + WS_ROWRS); int* TOKROW = (int*)(F.ws + WS_TOKROW);
    int* cursor = (int*)(F.ws + WS_CTL) + 64; const int* cnt = (const int*)(F.ws + WS_CTL);
    for (int chunk = F.bid; chunk < T * 4 / NTHREADS; chunk += F.G) {
        __syncthreads();
        if (F.tid < 32) hist[F.tid] = 0;
        __syncthreads();
        const int idx = chunk * NTHREADS + F.tid; const int e = TOPE[idx]; const int lr = atomicAdd((int*)&hist[e], 1);
        __syncthreads();
        if (F.tid < 32) base[F.tid] = hist[F.tid] ? atomicAdd(cursor + F.tid, hist[F.tid]) : 0;
        __syncthreads();
        const int row = pt[e] * 256 + base[e] + lr;
        ROWTOK[row] = idx >> 2; ROWGATE[row] = TOPG[idx]; ROWRS[row] = TOKRS[idx >> 2]; TOKROW[idx] = row;
    }
    if (F.bid == 0) for (int e = F.wave; e < 32; e += NWAVES) { const int r0 = pt[e] * 256 + cnt[e], r1 = pt[e + 1] * 256; for (int r = r0 + F.lane; r < r1; r += 64) { ROWTOK[r] = 0; ROWGATE[r] = 0.f; ROWRS[r] = 0.f; } }
}
#ifdef YS_FP8
__device__ __forceinline__ void phase_final(Frame& F) {
    const int gw = F.bid * NWAVES + F.wave, NGW = F.G * NWAVES;
    float* out = F.out; const bf16_t* HB = (const bf16_t*)(F.ws + WS_HN); const unsigned char* YS8 = (const unsigned char*)(F.ws + WS_YS); const int* TOKROW = (const int*)(F.ws + WS_TOKROW); const float* g = F.in[32];
    const LAS int* pt = build_ptile(F);
    struct In { u32x4 h[2]; u32x2 y[4][2]; };
    auto issue = [&](int t, const int4 rows, In& I) {
#pragma unroll
        for (int j = 0; j < 2; ++j) I.h[j] = ((const u32x4*)(HB + (size_t)t * D))[F.lane + 64 * j];
#pragma unroll
        for (int k = 0; k < 4; ++k) { const int code = k == 0 ? rows.x : k == 1 ? rows.y : k == 2 ? rows.z : rows.w; const size_t row = (size_t)(pt[code >> 15] * 256 + (code & 32767));
#pragma unroll
            for (int j = 0; j < 2; ++j) I.y[k][j] = ((const u32x2*)(YS8 + row * D))[F.lane + 64 * j]; } };
    auto finish = [&](int t, const In& I) {
        float v[2][8]; float s = 0.f;
#pragma unroll
        for (int j = 0; j < 2; ++j) { const unsigned hw[4] = {I.h[j].x, I.h[j].y, I.h[j].z, I.h[j].w};
#pragma unroll
            for (int i = 0; i < 4; ++i) { v[j][2 * i] = __uint_as_float(hw[i] << 16); v[j][2 * i + 1] = __uint_as_float(hw[i] & 0xffff0000u); }
#pragma unroll
            for (int k = 0; k < 4; ++k) { const f32x2 a = __builtin_amdgcn_cvt_pk_f32_fp8((int)I.y[k][j].x, false), b = __builtin_amdgcn_cvt_pk_f32_fp8((int)I.y[k][j].x, true),
                                                      c = __builtin_amdgcn_cvt_pk_f32_fp8((int)I.y[k][j].y, false), d = __builtin_amdgcn_cvt_pk_f32_fp8((int)I.y[k][j].y, true);
                v[j][0] += a.x; v[j][1] += a.y; v[j][2] += b.x; v[j][3] += b.y; v[j][4] += c.x; v[j][5] += c.y; v[j][6] += d.x; v[j][7] += d.y; }
#pragma unroll
            for (int i = 0; i < 8; ++i) s += v[j][i] * v[j][i]; }
        const float rstd = rsqrtf(wave_sum(s) * (1.0f / D) + EPS);
#pragma unroll
        for (int j = 0; j < 2; ++j) { const f32x4 g0 = ((const f32x4*)g)[2 * (F.lane + 64 * j)], g1 = ((const f32x4*)g)[2 * (F.lane + 64 * j) + 1];
            f32x4* o = (f32x4*)(out + (size_t)t * D) + 2 * (F.lane + 64 * j);
            o[0] = (f32x4){v[j][0] * rstd * g0.x, v[j][1] * rstd * g0.y, v[j][2] * rstd * g0.z, v[j][3] * rstd * g0.w};
            o[1] = (f32x4){v[j][4] * rstd * g1.x, v[j][5] * rstd * g1.y, v[j][6] * rstd * g1.z, v[j][7] * rstd * g1.w}; } };
    int t = gw;
    int4 rowsA = make_int4(0, 0, 0, 0), rowsB = make_int4(0, 0, 0, 0); In dA, dB;
    if (t < T) rowsA = *(const int4*)(TOKROW + t * 4);
    if (t + NGW < T) rowsB = *(const int4*)(TOKROW + (t + NGW) * 4);
    if (t < T) issue(t, rowsA, dA);
#pragma unroll 1
    for (; t < T; t += 2 * NGW) {
        const int t1 = t + NGW, t2 = t + 2 * NGW, t3 = t + 3 * NGW;
        if (t2 < T) rowsA = *(const int4*)(TOKROW + t2 * 4);
        if (t1 < T) issue(t1, rowsB, dB);
        finish(t, dA);
        if (t1 >= T) break;
        if (t3 < T) rowsB = *(const int4*)(TOKROW + t3 * 4);
        if (t2 < T) issue(t2, rowsA, dA);
        finish(t1, dB);
    }
}
#else
__device__ __forceinline__ void phase_final(Frame& F) {
    const int gw = F.bid * NWAVES + F.wave, NGW = F.G * NWAVES;
    float* out = F.out; const bf16_t* HB = (const bf16_t*)(F.ws + WS_HN); const bf16_t* YS = (const bf16_t*)(F.ws + WS_YS); const int* TOKROW = (const int*)(F.ws + WS_TOKROW); const float* g = F.in[32];
    const LAS int* pt = build_ptile(F);
    auto issue = [&](int t, const int4 rows, u32x2 (&d)[5][4]) {
#pragma unroll
        for (int j = 0; j < 4; ++j) d[0][j] = ((const u32x2*)(HB + (size_t)t * D))[F.lane + 64 * j];
#pragma unroll
        for (int k = 0; k < 4; ++k) { const int code = k == 0 ? rows.x : k == 1 ? rows.y : k == 2 ? rows.z : rows.w; const size_t row = (size_t)(pt[code >> 15] * 256 + (code & 32767));
#pragma unroll
            for (int j = 0; j < 4; ++j) d[1 + k][j] = ((const u32x2*)(YS + row * D))[F.lane + 64 * j]; } };
    auto finish = [&](int t, const u32x2 (&d)[5][4]) {
        f32x4 v[4];
#pragma unroll
        for (int j = 0; j < 4; ++j) { v[j] = (f32x4){__uint_as_float(d[0][j].x << 16), __uint_as_float(d[0][j].x & 0xffff0000u), __uint_as_float(d[0][j].y << 16), __uint_as_float(d[0][j].y & 0xffff0000u)};
#pragma unroll
            for (int k = 1; k < 5; ++k) { const u32x2 w = d[k][j];
                v[j].x += __uint_as_float(w.x << 16); v[j].y += __uint_as_float(w.x & 0xffff0000u); v[j].z += __uint_as_float(w.y << 16); v[j].w += __uint_as_float(w.y & 0xffff0000u); } }
        float s = 0.f;
#pragma unroll
        for (int j = 0; j < 4; ++j) s += v[j].x * v[j].x + v[j].y * v[j].y + v[j].z * v[j].z + v[j].w * v[j].w;
        const float rstd = rsqrtf(wave_sum(s) * (1.0f / D) + EPS);
#pragma unroll
        for (int j = 0; j < 4; ++j) { const f32x4 gg = ((const f32x4*)g)[F.lane + 64 * j];
            ((f32x4*)(out + (size_t)t * D))[F.lane + 64 * j] = (f32x4){v[j].x * rstd * gg.x, v[j].y * rstd * gg.y, v[j].z * rstd * gg.z, v[j].w * rstd * gg.w}; } };
    int t = gw;
    int4 rowsA = make_int4(0, 0, 0, 0), rowsB = make_int4(0, 0, 0, 0); u32x2 dA[5][4], dB[5][4];
    if (t < T) rowsA = *(const int4*)(TOKROW + t * 4);
    if (t + NGW < T) rowsB = *(const int4*)(TOKROW + (t + NGW) * 4);
    if (t < T) issue(t, rowsA, dA);
#pragma unroll 1
    for (; t < T; t += 2 * NGW) {
        const int t1 = t + NGW, t2 = t + 2 * NGW, t3 = t + 3 * NGW;
        if (t2 < T) rowsA = *(const int4*)(TOKROW + t2 * 4);
        if (t1 < T) issue(t1, rowsB, dB);
        finish(t, dA);
        if (t1 >= T) break;
        if (t3 < T) rowsB = *(const int4*)(TOKROW + t3 * 4);
        if (t2 < T) issue(t2, rowsA, dA);
        finish(t1, dB);
    }
}

#endif
__global__ void __launch_bounds__(NTHREADS, 2) mega(Args args) {
    extern __shared__ __attribute__((aligned(16))) unsigned char lds_raw[];
    cg::grid_group grid = cg::this_grid();
    Frame F; F.lds = (LAS unsigned char*)lds_raw; F.tid = threadIdx.x; F.lane = F.tid & 63; F.wave = __builtin_amdgcn_readfirstlane(F.tid >> 6); F.G = gridDim.x; F.bid = blockIdx.x;
    F.in = args.in; F.out = args.out; F.ws = args.ws;
    const int lo = args.ph_lo, hi = args.ph_hi;
    if (F.tid < 2) ((LAS unsigned*)(F.lds + MISC_OFF + 512))[F.tid] = 0u;
    __syncthreads();
    (void)xcd_barrier_post((unsigned*)(args.ws + WS_CTL + 16384) + args.li * XCD_BAR_WORDS, (volatile LAS unsigned*)(F.lds + MISC_OFF + 512));
#ifndef STAG1
#define STAG1 650
#endif
#define IN(k) (lo <= (k) && (k) < hi)
#define FRESH() do { size_t z_ = 0; F.tid = threadIdx.x; asm volatile("" : "+s"(z_), "+v"(F.tid)); F.ws = args.ws + z_; F.lane = F.tid & 63; ws = F.ws; } while (0)
#ifdef PROBE_PHASE
#define TS(k) do { if (blockIdx.x == 0 && threadIdx.x == 0) ((unsigned long long*)(args.ws + WS_CTL + 2048))[k] = __builtin_amdgcn_s_memrealtime(); } while (0)
#else
#define TS(k) do {} while (0)
#endif
#define SEAM(k) do { if (IN(k) && IN((k) + 1)) { if (hi > 1000) grid.sync();   else { XcdBarrier xb_; xb_.bar = (unsigned*)(args.ws + WS_CTL + 16384) + args.li * XCD_BAR_WORDS; xb_.x = xb_xcc_id(); xb_.st = (volatile LAS unsigned*)(F.lds + MISC_OFF + 512); xcd_barrier(xb_); if ((DUPMASK >> 21) & 1) xcd_barrier(xb_); } } } while (0)
    unsigned char* ws = args.ws;
    if (IN(0)) { TS(0); FRESH(); REP(0) phase_prep(F); } SEAM(0);
    if (IN(1)) { TS(1); FRESH();
        pg8::SchedDenseT<1> S; S.bias = args.in[3]; S.O.init(T / 256, NIN / 256, F.G, F.bid); S.A = (const char*)(ws + WS_U); S.B = (const char*)(ws + WS_WIN);
        pg8::EpiIn E{(bf16_t*)(ws + WS_P0), (bf16_t*)(ws + WS_P1), (bf16_t*)(ws + WS_PHY), (bf16_t*)(ws + WS_PG), args.in[3]};
#ifdef DESYNC1
        const int nbefore_ = DESYNC1 == 2 ? (((F.bid >> 3) & 1) ? 0 : 4) : DESYNC1 == 4 ? ((F.bid >> 3) & 3) : DESYNC1 == 3 ? 2 * ((F.bid >> 3) & 1) + 1 : 0;
        if (nbefore_ > 0) { hy::init_tw128(F); hy::filter_pass_a<false>(F, 0, nbefore_); __syncthreads(); }
#endif
        pg8::gemm_phase<pg8::EpiIn, pg8::SchedDenseT<1>, false>(F.lds, S, E); if ((DUPMASK >> 1) & 1) { pg8::gemm_phase<pg8::EpiIn, pg8::SchedDenseT<1>, false>(F.lds, S, E); } if ((DUPMASK >> 13) & 1) { pg8::EpiProbeStore E1{(bf16_t*)(ws + WS_YZ)}; pg8::gemm_phase<pg8::EpiProbeStore, pg8::SchedDenseT<1>, false>(F.lds, S, E1); } if ((DUPMASK >> 12) & 1) { pg8::EpiNone E0; pg8::gemm_phase<pg8::EpiNone, pg8::SchedDenseT<1>, false>(F.lds, S, E0); }
        if ((DUPMASK >> 18) & 1) { pg8::EpiNone E0; pg8::SchedDenseProbe SP; SP.O = S.O; SP.A = S.A; SP.B = S.B; pg8::gemm_phase<pg8::EpiNone, pg8::SchedDenseProbe, false>(F.lds, SP, E0); }
#ifdef DESYNC1
        if (nbefore_ < 4) { __syncthreads(); hy::init_tw128(F); hy::filter_pass_a<false>(F, nbefore_); }
#else
        hy::init_tw128(F); if ((DUPMASK >> 14) & 1) hy::filter_pass_a<true>(F); hy::filter_pass_a<false>(F);
#endif
    } SEAM(1);
#ifdef P2_ALTERNATE
    if (IN(2)) { TS(2); FRESH();
        const bool rev_ = ((F.bid >> 3) & 1) != 0;
        if (!rev_) { lru::stage1(F); __syncthreads(); hy::init_tw128(F); hy::filter_pass_b<false>(F); hy::prepass(F); }
        else { hy::prepass(F); __syncthreads(); FRESH(); hy::init_tw128(F); hy::filter_pass_b<false>(F); __syncthreads(); FRESH(); lru::stage1(F); }
    } SEAM(2);
#else
    if (IN(2)) { TS(2); FRESH(); REP(4) lru::stage1(F); __syncthreads(); hy::init_tw128(F); if ((DUPMASK >> 15) & 1) hy::filter_pass_b<true>(F); hy::filter_pass_b<false>(F); REP(2) hy::prepass(F); } SEAM(2);
#endif
    if (IN(3)) { TS(3); FRESH(); hy::init_tw128(F); REP(3) hy::data_pass_a(F); } SEAM(3);
    if (IN(4)) { TS(4); FRESH(); REP(16) lru::carry(F); hy::init_tw128(F); if ((DUPMASK >> 17) & 1) hy::data_pass_b<true>(F); hy::data_pass_b<false>(F); } SEAM(4);
    if (IN(5)) { TS(5); FRESH(); hy::init_tw128(F); if ((DUPMASK >> 5) & 1) hy::data_pass_c<true>(F); hy::data_pass_c<false>(F); __syncthreads(); REP(6) lru::stage2(F); } SEAM(5);
    if (IN(6)) { TS(6); FRESH();
        pg8::SchedMix S; S.O.init(T / 256, D / 256, F.G, F.bid); S.A0 = (const char*)(ws + WS_YLRU); S.A1 = (const char*)(ws + WS_YHY); S.B0 = (const char*)(ws + WS_WLRU); S.B1 = (const char*)(ws + WS_WHY);
        pg8::EpiMix E{(const bf16_t*)(ws + WS_PG), (bf16_t*)(ws + WS_MIX)};
#ifdef MIXDESYNC
        const int cls_ = (F.bid >> 3) & 3; constexpr int RND_ = MIXDESYNC;
        if (cls_ > 0) { convert_weights<0, false>(F, F.bid, F.G, 0, RND_ * cls_ / 4); __syncthreads(); }
#endif
        pg8::gemm_phase<pg8::EpiMix, pg8::SchedMix, false>(F.lds, S, E); if ((DUPMASK >> 7) & 1) { pg8::gemm_phase<pg8::EpiMix, pg8::SchedMix, false>(F.lds, S, E); }
#ifdef MIXDESYNC
        __syncthreads(); convert_weights<0, false>(F, F.bid, F.G, RND_ * cls_ / 4, RND_);
#endif
    } SEAM(6);
    if (IN(7)) { TS(7); FRESH();
        pg8::SchedDenseT<0> S; S.bias = nullptr; S.O.init(T / 256, D / 256, F.G, F.bid); S.A = (const char*)(ws + WS_MIX); S.B = (const char*)(ws + WS_WOUT);
        pg8::EpiH E{args.in[0], (bf16_t*)(ws + WS_HN), (unsigned char*)(ws + WS_HB8)};
        { u32x4* z = (u32x4*)(ws + WS_EROWTOK); const u32x4 z4 = (u32x4){0u, 0u, 0u, 0u};
          for (int i = F.bid * NTHREADS + F.tid; i < 3 * NE * T / 4; i += F.G * NTHREADS) z[i] = z4; }
#ifdef MIXDESYNC
        const int cls_ = (F.bid >> 3) & 3; constexpr int RND_ = MIXDESYNC; const int rrem_ = RND_;
        if (cls_ > 0) { convert_weights<0, false>(F, F.bid, F.G, RND_, RND_ + rrem_ * cls_ / 4); __syncthreads(); }
#endif
        pg8::gemm_phase<pg8::EpiH, pg8::SchedDenseT<0>, false>(F.lds, S, E); if ((DUPMASK >> 8) & 1) { pg8::gemm_phase<pg8::EpiH, pg8::SchedDenseT<0>, false>(F.lds, S, E); }
#ifdef MIXDESYNC
        __syncthreads(); convert_weights<0, false>(F, F.bid, F.G, RND_ + rrem_ * cls_ / 4, 2 * RND_);
#endif
    } SEAM(7);
    if (IN(8)) { TS(8); FRESH(); phase_router_a(F); } SEAM(8);
    if (IN(10)) { TS(10); FRESH();
        const LAS int* pt = build_ptile(F);
#ifdef GU_FP8
        pg8::SchedMoE<8, true> S{args.in[29], (const float*)(ws + WS_EROWRS), pt, F.G, F.bid, (const char*)(ws + WS_HB8), (const char*)(ws + WS_WGU), (size_t)2048 * 1024 * 1, (const int*)(ws + WS_EROWTOK), 1};
#else
        pg8::SchedMoE<8, true> S{args.in[29], (const float*)(ws + WS_EROWRS), pt, F.G, F.bid, (const char*)(ws + WS_HN), (const char*)(ws + WS_WGU), (size_t)2048 * 1024 * 2, (const int*)(ws + WS_EROWTOK)};
#endif
        pg8::EpiGU E{args.in[29], (const float*)(ws + WS_ROWRS), (bf16_t*)(ws + WS_ACT)};
#ifdef DESYNC_GU
        { const int rounds_ = (pt[32] * 8 + F.G - 1) / F.G; pg8::Unit u_; if (!S.next(rounds_ - 1, u_)) stagger_delay(1, DESYNC_GU); }
#endif
#ifdef GU_FP8
        pg8::gemm_phase<pg8::EpiGU, pg8::SchedMoE<8, true>, true, 1>(F.lds, S, E);
#else
        pg8::gemm_phase<pg8::EpiGU, pg8::SchedMoE<8, true>, true>(F.lds, S, E);
#endif
        if ((DUPMASK >> 9) & 1) { pg8::gemm_phase<pg8::EpiGU, pg8::SchedMoE<8, true>, true>(F.lds, S, E); }
        if ((DUPMASK >> 19) & 1) { pg8::EpiNone E0; pg8::gemm_phase<pg8::EpiNone, pg8::SchedMoE<8, true>, true>(F.lds, S, E0); }
    } SEAM(10);
    if (IN(11)) { TS(11); FRESH();
        const LAS int* pt = build_ptile(F);
#ifdef DN_FP8
        pg8::SchedMoE<4, false> S{args.in[31], (const float*)(ws + WS_EROWGATE), pt, F.G, F.bid, (const char*)(ws + WS_ACT), (const char*)(ws + WS_WDN), (size_t)1024 * 1024 * 1, nullptr, 1};
#else
        pg8::SchedMoE<4, false> S{args.in[31], (const float*)(ws + WS_EROWGATE), pt, F.G, F.bid, (const char*)(ws + WS_ACT), (const char*)(ws + WS_WDN), (size_t)1024 * 1024 * 2, nullptr};
#endif
        pg8::EpiDN E{args.in[31], (const float*)(ws + WS_ROWGATE), (bf16_t*)(ws + WS_YS)};
#ifdef DESYNC_DN
        { const int rounds_ = (pt[32] * 4 + F.G - 1) / F.G; pg8::Unit u_; if (!S.next(rounds_ - 1, u_)) stagger_delay(1, DESYNC_DN); }
#endif
#ifdef DN_FP8
        pg8::gemm_phase<pg8::EpiDN, pg8::SchedMoE<4, false>, false, 1>(F.lds, S, E);
#else
        pg8::gemm_phase<pg8::EpiDN, pg8::SchedMoE<4, false>, false>(F.lds, S, E);
#endif
        if ((DUPMASK >> 10) & 1) { pg8::gemm_phase<pg8::EpiDN, pg8::SchedMoE<4, false>, false>(F.lds, S, E); }
        if ((DUPMASK >> 20) & 1) { pg8::EpiNone E0; pg8::gemm_phase<pg8::EpiNone, pg8::SchedMoE<4, false>, false>(F.lds, S, E0); }
    } SEAM(11);
    if (IN(12)) { TS(12); FRESH(); phase_final(F); }
#undef IN
#undef SEAM
}
static int g_grid = 0;
static void launch_mega(Args a, int lo, int hi, hipStream_t stream, int li = 0) {
    a.ph_lo = lo; a.ph_hi = hi; a.li = li; a.pad = 0; void* params[] = {&a};
    hipError_t e = hipLaunchCooperativeKernel((const void*)mega, dim3(g_grid), dim3(NTHREADS), params, LDS_BYTES, stream);
    if (e != hipSuccess) fprintf(stderr, "kernel_launch: cooperative launch [%d,%d) failed: %s (grid %d)\n", lo, hi, hipGetErrorString(e), g_grid);
}
extern "C" void kernel_launch(void* const* d_in, const int* in_sizes, int n_in, void* d_out, int out_size, void* d_ws, size_t ws_size, hipStream_t stream) {
    if (n_in != 33 || out_size != T * D || ws_size < WS_END) { fprintf(stderr, "kernel_launch: unexpected shapes n_in %d out %d ws %zu\n", n_in, out_size, ws_size); return; }
    if (g_grid == 0) {
        int dev = 0, cus = 0, per_cu = 0;
        (void)hipGetDevice(&dev); (void)hipDeviceGetAttribute(&cus, hipDeviceAttributeMultiprocessorCount, dev);
        if (hipFuncSetAttribute((const void*)mega, hipFuncAttributeMaxDynamicSharedMemorySize, LDS_BYTES) != hipSuccess) { fprintf(stderr, "kernel_launch: hipFuncSetAttribute failed\n"); g_grid = -1; return; }
        if (hipOccupancyMaxActiveBlocksPerMultiprocessor(&per_cu, (const void*)mega, NTHREADS, LDS_BYTES) != hipSuccess || per_cu < 1) { fprintf(stderr, "kernel_launch: occupancy query says %d\n", per_cu); g_grid = -1; return; }
        g_grid = cus;
    }
    if (g_grid < 0) return;
    const float* in[33]; for (int i = 0; i < 33; ++i) in[i] = (const float*)d_in[i];
    unsigned char* ws = (unsigned char*)d_ws; float* out = (float*)d_out;
    int* cnt = (int*)(ws + WS_CTL); float* NORM = (float*)(ws + WS_NORM); float* HH3 = (float*)(ws + WS_HH3);
    bf16_t* YLRU = (bf16_t*)(ws + WS_YLRU); bf16_t* HN = (bf16_t*)(ws + WS_HN); bf16_t* YHY = (bf16_t*)(ws + WS_YHY);
    bf16_t* PG = (bf16_t*)(ws + WS_PG); bf16_t* P0 = (bf16_t*)(ws + WS_P0); bf16_t* P1 = (bf16_t*)(ws + WS_P1); bf16_t* PHY = (bf16_t*)(ws + WS_PHY);
    bf16_t* MIX = (bf16_t*)(ws + WS_MIX); float* MIXF = (float*)(ws + WS_MIXF); bf16_t* ACT = (bf16_t*)(ws + WS_ACT); bf16_t* YS = (bf16_t*)(ws + WS_YS);
    float* XR = (float*)(ws + WS_XR); float* HF = (float*)(ws + WS_HF); float* KC = (float*)(ws + WS_KC);
    int* ROWTOK = (int*)(ws + WS_ROWTOK); float* ROWGATE = (float*)(ws + WS_ROWGATE); float* ROWRS = (float*)(ws + WS_ROWRS);
    (void)hipMemsetAsync(ws + WS_CTL, 0, CTL_BYTES, stream);
    Args a{}; for (int i = 0; i < 33; ++i) a.in[i] = in[i]; a.out = out; a.ws = ws;
    launch_mega(a, 0, 13, stream);
}
```

```cpp
#define DUPMASK 0x0
#define DESYNC1 4
#define DN_REVERSE 1
#define P2_ALTERNATE 1
#define YS_FP8 1
#define YZ_BF8 1
#define KF_BF8 1
#define DN_FP8 1
#define GU_FP8 1
#define MX_FP8 1
#define W8_SCALE 32
#define P0_ALTERNATE 1
#define FB_IN_P3 1
#define CONV_IN_P2 1
#define LAG0_SPLIT 1
#define PTILE_ONCE 1
#define CARRY_BATCH 64
#include <hip/hip_runtime.h>
#include <hip/hip_cooperative_groups.h>
#include <cstdio>
#include <cstdint>
namespace cg = cooperative_groups;

typedef unsigned short bf16_t;
typedef float f32x4 __attribute__((ext_vector_type(4)));
typedef float f32x2 __attribute__((ext_vector_type(2)));
typedef unsigned u32x4 __attribute__((ext_vector_type(4)));
typedef unsigned u32x2 __attribute__((ext_vector_type(2)));
typedef short bf16x8 __attribute__((ext_vector_type(8)));

constexpr int T = 32768, D = 1024, L = 8192, NB = 4, NE = 32, TOPK = 4, NIN = 7168, L2X = 16384;
constexpr int HEADS = 16, HBLK = 64, HYFF = 64, HYEMB = 33;
constexpr int NPAD = T * TOPK + NE * 256;
constexpr float EPS = 1e-5f;

constexpr size_t MiB = 1u << 20;
constexpr size_t WS_CTL = 0;
constexpr size_t CTL_BYTES = 64 * 1024;
constexpr size_t WS_NORM = 4096;
constexpr size_t WS_HH3 = 2 * MiB;
constexpr size_t WS_WRG = 4 * MiB;
constexpr size_t WS_TOPE = 5 * MiB;
constexpr size_t WS_TOPG = 6 * MiB;
constexpr size_t WS_TOKRS = 7 * MiB;
constexpr size_t WS_ROWTOK = 8 * MiB;
constexpr size_t WS_ROWGATE = 9 * MiB;
constexpr size_t WS_ROWRS = 10 * MiB;
constexpr size_t WS_TOKROW = 11 * MiB;
constexpr size_t WS_WF4 = 14 * MiB;
constexpr size_t WS_NORMP = 15 * MiB;
constexpr size_t WS_EROWTOK = 164 * MiB, WS_EROWRS = 168 * MiB, WS_EROWGATE = 172 * MiB;
constexpr size_t WS_HB8 = 100 * MiB;
constexpr size_t WS_WLRUF = 13 * MiB;
constexpr size_t WS_SUMM = 996 * MiB;
constexpr size_t WS_CARRY = 1004 * MiB;
constexpr size_t WS_WIN = 16 * MiB;
constexpr size_t WS_WLRU = 30 * MiB, WS_WHY = 32 * MiB, WS_WOUT = 34 * MiB;
constexpr size_t WS_U = 36 * MiB;
constexpr size_t WS_Z16 = 36 * MiB, WS_HN = 36 * MiB;
constexpr size_t WS_YHY = 100 * MiB;
constexpr size_t WS_PG = 164 * MiB;
constexpr size_t WS_P0 = 292 * MiB;
constexpr size_t WS_P1 = 356 * MiB;
constexpr size_t WS_PHY = 420 * MiB;
constexpr size_t WS_MIX = 356 * MiB;
constexpr size_t WS_HS = 740 * MiB;
constexpr size_t WS_YLRU = 292 * MiB;
constexpr size_t WS_AF = 804 * MiB, WS_AB = 932 * MiB;
constexpr size_t WS_MIXF = 484 * MiB;
constexpr size_t WS_ACT = 292 * MiB;
constexpr size_t WS_R2 = 612 * MiB;
constexpr size_t WS_YZ = 612 * MiB;
constexpr size_t WS_KF = 868 * MiB;
#ifdef CONV_IN_P2
constexpr size_t WS_WDN = 900 * MiB;
#else
constexpr size_t WS_WDN = 612 * MiB;
#endif
constexpr size_t WS_WGU = 676 * MiB;
constexpr size_t WS_YS = 676 * MiB;
constexpr size_t WS_XR = 612 * MiB;
constexpr size_t WS_HF = 740 * MiB;
constexpr size_t WS_KC = 868 * MiB;
constexpr size_t WS_END = 1024 * MiB;

__device__ __forceinline__ float bf2f(bf16_t b) { return __uint_as_float(((unsigned)b) << 16); }
__device__ __forceinline__ bf16_t f2bf(float f) { unsigned u = __float_as_uint(f); u += 0x7fffu + ((u >> 16) & 1u); return (bf16_t)(u >> 16); }
__device__ __forceinline__ unsigned pk2(float lo, float hi) { unsigned r; asm("v_cvt_pk_bf16_f32 %0, %1, %2" : "=v"(r) : "v"(lo), "v"(hi)); return r; }
__device__ __forceinline__ float fexp(float x) { return __builtin_amdgcn_exp2f(x * 1.4426950408889634f); }
__device__ __forceinline__ float sigmoidf_(float x) { return __builtin_amdgcn_rcpf(1.0f + fexp(-x)); }
__device__ __forceinline__ float gelu_tanh(float x) { const float u = 0.7978845608028654f * (x + 0.044715f * x * x * x); return x * sigmoidf_(2.0f * u); }
__device__ __forceinline__ float swiglu(float g, float u) { const float g_ = fminf(g, 7.0f); const float u_ = fminf(fmaxf(u, -7.0f), 7.0f); return (u_ + 1.0f) * (g_ * sigmoidf_(1.702f * g_)); }
__device__ __forceinline__ float wave_sum(float v) {
#pragma unroll
    for (int o = 1; o < 64; o <<= 1) v += __shfl_xor(v, o);
    return v;
}
__device__ __forceinline__ int expert_offpad(const int* cnt, int e) { int o = 0; for (int i = 0; i < e; ++i) o += (cnt[i] + 255) & ~255; return o; }
__device__ __forceinline__ float hy_delta_abs(int c) {
    const float lo = -4.605170185988091f / 1.5f, hi = -4.605170185988091f / 0.3f;
    return fabsf(lo + (hi - lo) * ((float)c / 1023.0f));
}
#define LAS __attribute__((address_space(3)))
constexpr int NWAVES = 8, NTHREADS = 512, LDS_BYTES = 147456, MISC_OFF = 131072;

typedef long l64x2 __attribute__((ext_vector_type(2)));
typedef short bf16x8_ __attribute__((ext_vector_type(8)));
typedef int i32x8_ __attribute__((ext_vector_type(8)));
template <bool MX> struct FragSel { typedef bf16x8_ a_t[4][2]; typedef bf16x8_ b_t[2][2]; };
template <> struct FragSel<true> { typedef i32x8_ a_t[4]; typedef i32x8_ b_t[2]; };
typedef int i32x4 __attribute__((ext_vector_type(4)));
typedef int i32x8 __attribute__((ext_vector_type(8)));
namespace pg8 {
constexpr int BM = 256, BK = 64, HALF = 128, HTB = HALF * BK * 2, NXCD = 8, WGM = 8, KD = 1024;
__host__ __device__ __forceinline__ int lds_byte(int r, int c) { const int st = (r >> 4) * 2 + (c >> 5), rr = r & 15, cc = c & 31, ob = rr * 64 + cc * 2; return st * 1024 + (ob ^ (((ob >> 9) & 1) << 5)); }
__host__ __device__ __forceinline__ void stage_rc(int b, int& R, int& C) { const int st = b / 1024, sb = b % 1024, swz = sb ^ (((sb >> 9) & 1) << 5); R = (st >> 1) * 16 + swz / 64; C = (st & 1) * 32 + (swz % 64) / 2; }
__host__ __device__ __forceinline__ int perm32(int rho) { const int n = rho >> 4, i = rho & 15; return 8 * (i >> 2) + 4 * n + (i & 3); }

struct Unit { const char* A; const char* B; int pm, pn, e, gm; };

struct DenseOrder {
    int nM, nN, nwg, G, c;
    __device__ __forceinline__ void init(int nM_, int nN_, int G_, int c_) { nM = nM_; nN = nN_; nwg = nM * nN; G = G_; c = c_; }
    __device__ __forceinline__ bool tile(int i, int& pm, int& pn) const {
        const long Lx = (long)i * G + c; if (Lx >= nwg) return false;
        int wgid = (int)Lx; { const int q = nwg / NXCD, r = nwg % NXCD, xcd = wgid % NXCD, off = wgid / NXCD; wgid = (xcd < r ? xcd * (q + 1) : r * (q + 1) + (xcd - r) * q) + off; }
        const int nig = WGM * nN, gid = wgid / nig, fm = gid * WGM, gsz = (nM - fm) < WGM ? (nM - fm) : WGM;
        pm = fm + ((wgid % nig) % gsz); pn = (wgid % nig) / gsz; return true;
    }
};

__device__ __forceinline__ unsigned cvt_pk_bf16(float lo, float hi) { unsigned r; asm volatile("v_cvt_pk_bf16_f32 %0, %1, %2" : "=v"(r) : "v"(lo), "v"(hi)); return r; }

template <class Epi, class Sched, bool GATHER, int ESZ = 2>
__device__ __forceinline__ void gemm_phase(LAS unsigned char* lds, const Sched& S, const Epi& E) {
    int tid_ = threadIdx.x; asm volatile("" : "+v"(tid_));
    const int tid = tid_, wid = __builtin_amdgcn_readfirstlane(tid >> 6), lane = tid & 63, wr = wid >> 2, wc = wid & 3, fr = lane & 15, fq = lane >> 4;
    constexpr int K = KD, ROWB = K * ESZ  , nt = ROWB / (BK * 2);
    int Rr[2], Cc[2]; unsigned voffB[2];
#pragma unroll
    for (int i = 0; i < 2; ++i) { int R, C; stage_rc(tid * 16 + i * 8192, R, C); Rr[i] = R; Cc[i] = C; const int Rb = (R & ~31) + perm32(R & 31); voffB[i] = (unsigned)(Rb * ROWB + C * 2); }
    constexpr size_t kstep = (size_t)(BK * 2);
    constexpr size_t hstep = (size_t)HALF * ROWB;
    const unsigned ldsw = (unsigned)wid * 1024u;
    const int aoff = lds_byte(wr * 64 + fr, fq * 8), boff = lds_byte(wc * 32 + fr, fq * 8);
#define PG8_SA(b, h) (((b) * 2 + (h)) * HTB)
#define PG8_SB(b, h) ((4 + (b) * 2 + (h)) * HTB)
#define PG8_GLDS(gp, lp) __builtin_amdgcn_global_load_lds((const unsigned*)(gp), (LAS unsigned*)(lp), 16, 0, 0)
#define PG8_STAGEB(bufoff, gbase) do { PG8_GLDS((const char*)(gbase) + voffB[0], lds + (bufoff) + ldsw); PG8_GLDS((const char*)(gbase) + voffB[1], lds + (bufoff) + ldsw + 8192); } while (0)
#define PG8_STAGEA(bufoff, gbase, o0, o1) do { PG8_GLDS((const char*)(gbase) + (o0), lds + (bufoff) + ldsw); PG8_GLDS((const char*)(gbase) + (o1), lds + (bufoff) + ldsw + 8192); } while (0)
#ifdef MX_FP8
#define PG8_LDA(dst, b, h) do { if constexpr (ESZ == 1) { _Pragma("unroll") for (int m = 0; m < 4; ++m) { const LAS unsigned char* p_ = lds + PG8_SA(b, h) + aoff + m * 2048; \
        dst[m] = __builtin_shufflevector(*(const LAS i32x4*)p_, *(const LAS i32x4*)(p_ + 1024), 0, 1, 2, 3, 4, 5, 6, 7); } } else PG8_LDA2(dst, b, h); } while (0)
#define PG8_LDB(dst, b, h) do { if constexpr (ESZ == 1) { _Pragma("unroll") for (int n = 0; n < 2; ++n) { const LAS unsigned char* p_ = lds + PG8_SB(b, h) + boff + n * 2048; \
        dst[n] = __builtin_shufflevector(*(const LAS i32x4*)p_, *(const LAS i32x4*)(p_ + 1024), 0, 1, 2, 3, 4, 5, 6, 7); } } else PG8_LDB2(dst, b, h); } while (0)
#else
#define PG8_LDA(dst, b, h) PG8_LDA2(dst, b, h)
#define PG8_LDB(dst, b, h) PG8_LDB2(dst, b, h)
#endif
#define PG8_LDA2(dst, b, h) do { _Pragma("unroll") for (int m = 0; m < 4; ++m) _Pragma("unroll") for (int k = 0; k < 2; ++k) dst[m][k] = *(const LAS bf16x8*)(lds + PG8_SA(b, h) + aoff + m * 2048 + k * 1024); } while (0)
#define PG8_LDB2(dst, b, h) do { _Pragma("unroll") for (int n = 0; n < 2; ++n) _Pragma("unroll") for (int k = 0; k < 2; ++k) dst[n][k] = *(const LAS bf16x8*)(lds + PG8_SB(b, h) + boff + n * 2048 + k * 1024); } while (0)
#ifdef MX_FP8
#define PG8_MMA(ai, bj, At, Bt) do { if constexpr (ESZ == 1) { __builtin_amdgcn_s_setprio(1); _Pragma("unroll") for (int m = 0; m < 4; ++m) _Pragma("unroll") for (int n = 0; n < 2; ++n) { \
              \
            asm volatile("s_nop 1\n\tv_mfma_f32_16x16x128_f8f6f4 %0, %1, %2, %0" : "+v"(acc[ai][bj][m][n]) : "v"(Bt[n]), "v"(At[m])); }        __builtin_amdgcn_s_setprio(0); } else PG8_MMA2(ai, bj, At, Bt); } while (0)
#else
#define PG8_MMA(ai, bj, At, Bt) PG8_MMA2(ai, bj, At, Bt)
#endif
#define PG8_MMA2(ai, bj, At, Bt) do { __builtin_amdgcn_s_setprio(1); _Pragma("unroll") for (int m = 0; m < 4; ++m) _Pragma("unroll") for (int n = 0; n < 2; ++n) _Pragma("unroll") for (int k = 0; k < 2; ++k) \
        { if constexpr (ESZ == 2) acc[ai][bj][m][n] = __builtin_amdgcn_mfma_f32_16x16x32_bf16(Bt[n][k], At[m][k], acc[ai][bj][m][n], 0, 0, 0); \
          else { const l64x2 b_ = __builtin_bit_cast(l64x2, Bt[n][k]), a_ = __builtin_bit_cast(l64x2, At[m][k]); \
                 acc[ai][bj][m][n] = __builtin_amdgcn_mfma_f32_16x16x32_fp8_fp8(b_.x, a_.x, acc[ai][bj][m][n], 0, 0, 0); acc[ai][bj][m][n] = __builtin_amdgcn_mfma_f32_16x16x32_fp8_fp8(b_.y, a_.y, acc[ai][bj][m][n], 0, 0, 0); } } \
        __builtin_amdgcn_s_setprio(0); } while (0)
#define PG8_WAIT_V(n) asm volatile("s_waitcnt vmcnt(" #n ")" ::: "memory")
#define PG8_WAIT_L(n) asm volatile("s_waitcnt lgkmcnt(" #n ")" ::: "memory")
#define PG8_WAIT_V8_UNLESS(flag) asm volatile("s_cmp_lg_u32 %0, 0\n\ts_cbranch_scc1 .Lskipw%=\n\ts_waitcnt vmcnt(8)\n.Lskipw%=:" :: "s"(flag) : "scc", "memory")
#define PG8_BAR __builtin_amdgcn_s_barrier()
#define PG8_SCHED __builtin_amdgcn_sched_barrier(0)
    Unit cur, nxt; int ui = 0;
    if (!S.next(0, cur)) return;
    LAS int* tokbuf = (LAS int*)(lds + MISC_OFF + 3072);
#define PG8_AOFF(par, h, i) (GATHER ? ((unsigned)tokbuf[(par) * 256 + (h) * HALF + Rr[i]] * (unsigned)ROWB + (unsigned)(Cc[i] * 2)) : ((unsigned)(Rr[i] * ROWB + Cc[i] * 2) + (unsigned)((h) * hstep)))
    LAS float* side = (LAS float*)(lds + MISC_OFF + 6144);
    if (GATHER || Sched::NSIDE > 0) {
        if (GATHER && tid < 256) tokbuf[tid] = S.ROWTOK_row(cur, tid);
        if (Sched::NSIDE > 0 && tid < 256 * Sched::NSIDE) side[tid] = *S.side_addr(cur, tid >> 8, tid & 255);
        asm volatile("s_waitcnt vmcnt(0) lgkmcnt(0)" ::: "memory"); __builtin_amdgcn_s_barrier(); }
    f32x4 acc[2][2][4][2];
#pragma unroll
    for (int a = 0; a < 2; ++a)
#pragma unroll
        for (int b = 0; b < 2; ++b)
#pragma unroll
            for (int m = 0; m < 4; ++m)
#pragma unroll
                for (int n = 0; n < 2; ++n) acc[a][b][m][n] = (f32x4){0.f, 0.f, 0.f, 0.f};
#ifdef MX_FP8
    typename FragSel<ESZ == 1>::a_t At; typename FragSel<ESZ == 1>::b_t B0, B1;
#else
    bf16x8 At[4][2], B0[2][2], B1[2][2];
#endif
    const char* cA = cur.A; const char* cB = cur.B;
    PG8_STAGEB(PG8_SB(0, 0), cB); PG8_STAGEB(PG8_SB(0, 1), cB + hstep); PG8_STAGEA(PG8_SA(0, 0), cA, PG8_AOFF(0, 0, 0), PG8_AOFF(0, 0, 1)); PG8_STAGEA(PG8_SA(0, 1), cA, PG8_AOFF(0, 1, 0), PG8_AOFF(0, 1, 1));
    if (wr == 1) PG8_BAR;
    PG8_WAIT_V(2); PG8_BAR;
    PG8_STAGEB(PG8_SB(1, 0), cB + kstep); PG8_STAGEA(PG8_SA(1, 0), cA + kstep, PG8_AOFF(0, 0, 0), PG8_AOFF(0, 0, 1)); PG8_STAGEB(PG8_SB(1, 1), cB + hstep + kstep);
    PG8_WAIT_V(6); PG8_BAR;
    for (;;) {
        const bool has_next = S.next(ui + 1, nxt);
        const char* nA = has_next ? nxt.A : cA; const char* nB = has_next ? nxt.B : cB;
        const int pc = ui & 1, pn_ = has_next ? (pc ^ 1) : pc;
        if (Sched::NSIDE > 0 && has_next && wid < 4 * Sched::NSIDE) __builtin_amdgcn_global_load_lds((const unsigned*)S.side_addr(nxt, wid >> 2, (wid & 3) * 64 + lane), (LAS unsigned*)(side + ((ui + 1) % 3) * 512 + wid * 64), 4, 0, 0);
        if (GATHER && has_next && wid < 4) __builtin_amdgcn_global_load_lds((const unsigned*)(S.ROWTOK + S.rowoff(nxt) + wid * 64 + lane), (LAS unsigned*)(tokbuf + pn_ * 256 + wid * 64), 4, 0, 0);
#pragma unroll 1
        for (int t = 0; t < nt; t += 2) {
            const bool last = (t == nt - 2);
            const char* a1 = cA + (size_t)(t + 1) * kstep;
            const char* a2 = last ? nA : cA + (size_t)(t + 2) * kstep; const char* b2 = last ? nB : cB + (size_t)(t + 2) * kstep;
            const char* a3 = a2 + kstep; const char* b3 = b2 + kstep;
            const int px = last ? pn_ : pc;
            PG8_LDB(B0, 0, 0); PG8_LDB(B1, 0, 1); PG8_SCHED; PG8_LDA(At, 0, 0); PG8_STAGEA(PG8_SA(1, 1), a1, PG8_AOFF(pc, 1, 0), PG8_AOFF(pc, 1, 1));
            PG8_WAIT_V(8); PG8_WAIT_L(0); PG8_BAR; PG8_MMA(0, 0, At, B0); PG8_MMA(0, 1, At, B1); PG8_BAR; PG8_SCHED;
            PG8_LDA(At, 0, 1); PG8_STAGEB(PG8_SB(0, 0), b2); PG8_STAGEB(PG8_SB(0, 1), b2 + hstep); PG8_STAGEA(PG8_SA(0, 0), a2, PG8_AOFF(px, 0, 0), PG8_AOFF(px, 0, 1));
            PG8_WAIT_V(8); PG8_WAIT_L(0); PG8_BAR; PG8_MMA(1, 0, At, B0); PG8_MMA(1, 1, At, B1); PG8_BAR; PG8_SCHED;
            PG8_LDB(B0, 1, 0); PG8_LDB(B1, 1, 1); PG8_SCHED; PG8_LDA(At, 1, 0); PG8_STAGEA(PG8_SA(0, 1), a2, PG8_AOFF(px, 1, 0), PG8_AOFF(px, 1, 1));
            PG8_WAIT_V(8); PG8_WAIT_L(0); PG8_BAR; PG8_MMA(0, 0, At, B0); PG8_MMA(0, 1, At, B1); PG8_BAR; PG8_SCHED;
            PG8_LDA(At, 1, 1); PG8_STAGEB(PG8_SB(1, 0), b3); PG8_STAGEB(PG8_SB(1, 1), b3 + hstep); PG8_STAGEA(PG8_SA(1, 0), a3, PG8_AOFF(px, 0, 0), PG8_AOFF(px, 0, 1));
            PG8_WAIT_V(8); PG8_WAIT_L(0); PG8_BAR; PG8_MMA(1, 0, At, B0); PG8_MMA(1, 1, At, B1); PG8_BAR; PG8_SCHED;
        }
#ifdef MX_FP8
        if constexpr (ESZ == 1) asm volatile("s_nop 15\n\ts_nop 15" ::: "memory");
#endif
        if (wr == 0) PG8_BAR;
        bool keep = false;
        if constexpr (Epi::CHAIN) keep = E(acc, cur, wr, wc, fr, fq, (const LAS float*)(side + (ui % 3) * 512)); else E(acc, cur, wr, wc, fr, fq, (const LAS float*)(side + (ui % 3) * 512));
        if (!has_next) break;
        if (!keep) {
#pragma unroll
        for (int a = 0; a < 2; ++a)
#pragma unroll
            for (int b = 0; b < 2; ++b)
#pragma unroll
                for (int m = 0; m < 4; ++m)
#pragma unroll
                    for (int n = 0; n < 2; ++n) acc[a][b][m][n] = (f32x4){0.f, 0.f, 0.f, 0.f};
        }
        cur = nxt; cA = nA; cB = nB; ++ui;
        if (wr == 1) PG8_BAR;
    }
    PG8_WAIT_V(0);
    PG8_BAR;
#undef PG8_SA
#undef PG8_AOFF
#undef PG8_SB
#undef PG8_GLDS
#undef PG8_STAGEA
#undef PG8_STAGEB
#undef PG8_LDA
#undef PG8_LDA2
#undef PG8_LDB
#undef PG8_LDB2
#undef PG8_MMA
#undef PG8_MMA2
#undef PG8_WAIT_V
#undef PG8_WAIT_L
#undef PG8_WAIT_V8_UNLESS
#undef PG8_BAR
#undef PG8_SCHED
}

__device__ __forceinline__ void store8bf(bf16_t* p, const f32x4 v0, const f32x4 v1) {
    u32x4 w; w.x = cvt_pk_bf16(v0[0], v0[1]); w.y = cvt_pk_bf16(v0[2], v0[3]); w.z = cvt_pk_bf16(v1[0], v1[1]); w.w = cvt_pk_bf16(v1[2], v1[3]); *(u32x4*)p = w;
}
__device__ __forceinline__ void load8bf(const bf16_t* p, f32x4& v0, f32x4& v1) {
    const u32x4 w = *(const u32x4*)p;
    v0 = (f32x4){__uint_as_float(w.x << 16), __uint_as_float(w.x & 0xffff0000u), __uint_as_float(w.y << 16), __uint_as_float(w.y & 0xffff0000u)};
    v1 = (f32x4){__uint_as_float(w.z << 16), __uint_as_float(w.z & 0xffff0000u), __uint_as_float(w.w << 16), __uint_as_float(w.w & 0xffff0000u)};
}
__device__ __forceinline__ f32x2 lo2(const f32x4 v) { return (f32x2){v.x, v.y}; }
__device__ __forceinline__ f32x2 hi2(const f32x4 v) { return (f32x2){v.z, v.w}; }
__device__ __forceinline__ f32x2 sigmoid2(const f32x2 x) { const f32x2 t = x * -1.4426950408889634f; const f32x2 d = (f32x2){__builtin_amdgcn_exp2f(t.x), __builtin_amdgcn_exp2f(t.y)} + 1.0f; return (f32x2){__builtin_amdgcn_rcpf(d.x), __builtin_amdgcn_rcpf(d.y)}; }
__device__ __forceinline__ f32x2 swiglu2(const f32x2 g, const f32x2 u) {
    const f32x2 g_ = (f32x2){fminf(g.x, 7.0f), fminf(g.y, 7.0f)}; const f32x2 u_ = (f32x2){fminf(fmaxf(u.x, -7.0f), 7.0f), fminf(fmaxf(u.y, -7.0f), 7.0f)};
    const f32x2 t = g_ * (-1.702f * 1.4426950408889634f); const f32x2 d = (f32x2){__builtin_amdgcn_exp2f(t.x), __builtin_amdgcn_exp2f(t.y)} + 1.0f;
    const f32x2 p = g_ * (f32x2){__builtin_amdgcn_rcpf(d.x), __builtin_amdgcn_rcpf(d.y)}; return u_ * p + p; }
__device__ __forceinline__ void store8bf2(bf16_t* p, const f32x2 a, const f32x2 b, const f32x2 c, const f32x2 d) {
    u32x4 w; w.x = cvt_pk_bf16(a.x, a.y); w.y = cvt_pk_bf16(b.x, b.y); w.z = cvt_pk_bf16(c.x, c.y); w.w = cvt_pk_bf16(d.x, d.y); *(u32x4*)p = w; }
#define EPI_ROWS(ai, m) ((ai) * HALF + wr * 64 + (m) * 16 + fr)
#define EPI_COLS(bj) ((bj) * HALF + wc * 32 + 8 * fq)

struct EpiNone {
    static constexpr bool CHAIN = false;
    __device__ __forceinline__ void operator()(const f32x4 (&acc)[2][2][4][2], const Unit&, int, int, int, int, const LAS float*) const {
#pragma unroll
        for (int a = 0; a < 2; ++a)
#pragma unroll
            for (int b = 0; b < 2; ++b)
#pragma unroll
                for (int m = 0; m < 4; ++m)
#pragma unroll
                    for (int n = 0; n < 2; ++n) asm volatile("" :: "v"(acc[a][b][m][n]));
    }
};
struct EpiProbeStore {
    static constexpr bool CHAIN = false;
    bf16_t* dst;
    __device__ __forceinline__ void operator()(const f32x4 (&acc)[2][2][4][2], const Unit& u, int wr, int wc, int fr, int fq, const LAS float* side) const {
#pragma unroll
        for (int ai = 0; ai < 2; ++ai)
#pragma unroll
            for (int m = 0; m < 4; ++m) {
#if defined(PROBE_LOCAL)
                bf16_t* rowp = dst + (size_t)(blockIdx.x * 256 + EPI_ROWS(ai, m)) * 256;
#elif defined(PROBE_MIXED)
                bf16_t* rowp = (blockIdx.x & 3) ? dst + (size_t)(blockIdx.x * 256 + EPI_ROWS(ai, m)) * 256 : dst + (size_t)(u.pm * BM + EPI_ROWS(ai, m)) * 4096 + (u.pn & 15) * 256;
#elif defined(PROBE_WIDE)
                bf16_t* rowp = dst + (size_t)(u.pm * BM + EPI_ROWS(ai, m)) * 4096 + (u.pn & 15) * 256;
#else
                bf16_t* rowp = dst + (size_t)(u.pm * BM + EPI_ROWS(ai, m)) * 1024 + (u.pn & 3) * 256;
#endif
#pragma unroll
                for (int bj = 0; bj < 2; ++bj) store8bf(rowp + EPI_COLS(bj), acc[ai][bj][m][0], acc[ai][bj][m][1]); }
    }
};
struct EpiIn {
    static constexpr bool CHAIN = false;
    bf16_t *P0, *P1, *PHY, *PG; const float* bias;
    __device__ __forceinline__ void operator()(const f32x4 (&acc)[2][2][4][2], const Unit& u, int wr, int wc, int fr, int fq, const LAS float* side) const {
        const int seg = u.pn >> 2; bf16_t* dst; int ld, colt; int act = 0;
        if (seg == 0) { dst = P0; ld = 1024; colt = u.pn * 256; }
        else if (seg == 1) { dst = P1; ld = 1024; colt = u.pn * 256 - 1024; }
        else if (seg < 5) { dst = PHY; ld = 3072; colt = u.pn * 256 - 2048; }
        else { dst = PG; ld = 2048; colt = (u.pn - 20) * 128; act = 2; }
        f32x4 bv[2][2];
#pragma unroll
        for (int bj = 0; bj < 2; ++bj)
#pragma unroll
            for (int n = 0; n < 2; ++n) bv[bj][n] = *(const LAS f32x4*)(side + EPI_COLS(bj) + 4 * n);
        if (act == 2) {
#pragma unroll
            for (int ai = 0; ai < 2; ++ai)
#pragma unroll
                for (int m = 0; m < 4; ++m) { bf16_t* rowp = dst + (size_t)(u.pm * BM + EPI_ROWS(ai, m)) * ld + colt + wc * 32 + 8 * fq;
                    f32x2 rho[4], sh[4];
#pragma unroll
                    for (int n = 0; n < 2; ++n)
#pragma unroll
                        for (int hh = 0; hh < 2; ++hh) {
                            const f32x2 al = (hh ? hi2(acc[ai][0][m][n]) : lo2(acc[ai][0][m][n])) + (hh ? hi2(bv[0][n]) : lo2(bv[0][n]));
                            f32x2 ah = (hh ? hi2(acc[ai][1][m][n]) : lo2(acc[ai][1][m][n])) + (hh ? hi2(bv[1][n]) : lo2(bv[1][n]));
                            ah = (f32x2){fmaxf(ah.x, -80.0f), fmaxf(ah.y, -80.0f)};
                            const f32x2 tl = al * -1.4426950408889634f, th = ah * -1.4426950408889634f;
                            const f32x2 dl = (f32x2){__builtin_amdgcn_exp2f(tl.x), __builtin_amdgcn_exp2f(tl.y)} + 1.0f, dh = (f32x2){__builtin_amdgcn_exp2f(th.x), __builtin_amdgcn_exp2f(th.y)} + 1.0f;
                            sh[2 * n + hh] = (f32x2){__builtin_amdgcn_rcpf(dh.x), __builtin_amdgcn_rcpf(dh.y)};
                            rho[2 * n + hh] = dh * (f32x2){__builtin_amdgcn_rcpf(dl.x), __builtin_amdgcn_rcpf(dl.y)}; }
                    store8bf2(rowp, rho[0], rho[1], rho[2], rho[3]); store8bf2(rowp + 1024, sh[0], sh[1], sh[2], sh[3]); }
            return;
        }
#pragma unroll
        for (int ai = 0; ai < 2; ++ai)
#pragma unroll
            for (int m = 0; m < 4; ++m) { bf16_t* rowp = dst + (size_t)(u.pm * BM + EPI_ROWS(ai, m)) * ld + colt;
#pragma unroll
                for (int bj = 0; bj < 2; ++bj) { f32x2 a = lo2(acc[ai][bj][m][0]) + lo2(bv[bj][0]), b = hi2(acc[ai][bj][m][0]) + hi2(bv[bj][0]), c = lo2(acc[ai][bj][m][1]) + lo2(bv[bj][1]), d = hi2(acc[ai][bj][m][1]) + hi2(bv[bj][1]);
                    store8bf2(rowp + EPI_COLS(bj), a, b, c, d); } }
    }
};
struct EpiMix {
    static constexpr bool CHAIN = true;
    const bf16_t* PG; bf16_t* MIX;
    __device__ __forceinline__ bool operator()(f32x4 (&acc)[2][2][4][2], const Unit& u, int wr, int wc, int fr, int fq, const LAS float*) const {
#pragma unroll
        for (int ai = 0; ai < 2; ++ai)
#pragma unroll
            for (int m = 0; m < 4; ++m) { const size_t row = (size_t)(u.pm * BM + EPI_ROWS(ai, m));
#pragma unroll
                for (int bj = 0; bj < 2; ++bj) { const int col = u.pn * 256 + EPI_COLS(bj);
                    f32x4 h0, h1; load8bf(PG + row * 2048 + (u.e == 0 ? 0 : 1024) + col, h0, h1);
                    if (u.e == 0) { acc[ai][bj][m][0] *= h0; acc[ai][bj][m][1] *= h1; }
                    else store8bf(MIX + row * 1024 + col, h0 * acc[ai][bj][m][0], h1 * acc[ai][bj][m][1]); } }
        return u.e == 0;
    }
};
struct EpiH {
    static constexpr bool CHAIN = false;
    const float* x; bf16_t* HB; unsigned char* HB8;
    __device__ __forceinline__ void operator()(const f32x4 (&acc)[2][2][4][2], const Unit& u, int wr, int wc, int fr, int fq, const LAS float* side) const {
#pragma unroll
        for (int ai = 0; ai < 2; ++ai)
#pragma unroll
            for (int m = 0; m < 4; ++m) { const size_t row = (size_t)(u.pm * BM + EPI_ROWS(ai, m));
#pragma unroll
                for (int bj = 0; bj < 2; ++bj) { const size_t o = row * 1024 + u.pn * 256 + EPI_COLS(bj);
                    const f32x4 v0 = *(const f32x4*)(x + o) + acc[ai][bj][m][0], v1 = *(const f32x4*)(x + o + 4) + acc[ai][bj][m][1];
                    store8bf(HB + o, v0, v1);
#ifdef GU_FP8
                    { int w0 = __builtin_amdgcn_cvt_pk_fp8_f32(v0.x, v0.y, 0, false); w0 = __builtin_amdgcn_cvt_pk_fp8_f32(v0.z, v0.w, w0, true);
                      int w1 = __builtin_amdgcn_cvt_pk_fp8_f32(v1.x, v1.y, 0, false); w1 = __builtin_amdgcn_cvt_pk_fp8_f32(v1.z, v1.w, w1, true);
                      *(u32x2*)(HB8 + o) = (u32x2){(unsigned)w0, (unsigned)w1}; }
#endif
                } }
    }
};
struct EpiGU {
    static constexpr bool CHAIN = false;
    const float* bgu; const float* ROWRS; bf16_t* ACT;
    __device__ __forceinline__ void operator()(const f32x4 (&acc)[2][2][4][2], const Unit& u, int wr, int wc, int fr, int fq, const LAS float* side) const {
        const int colp = u.pn * 128 + wc * 32 + 8 * fq;
        f32x4 bg[2], bu[2];
#pragma unroll
        for (int n = 0; n < 2; ++n) { bg[n] = *(const LAS f32x4*)(side + wc * 32 + 8 * fq + 4 * n); bu[n] = *(const LAS f32x4*)(side + 128 + wc * 32 + 8 * fq + 4 * n); }
#pragma unroll
        for (int ai = 0; ai < 2; ++ai)
#pragma unroll
            for (int m = 0; m < 4; ++m) { const size_t row = (size_t)u.gm * BM + EPI_ROWS(ai, m); const float rs = side[256 + EPI_ROWS(ai, m)];
                f32x2 o[4];
#pragma unroll
                for (int n = 0; n < 2; ++n) {
                    o[2 * n] = swiglu2(lo2(acc[ai][0][m][n]) * rs + lo2(bg[n]), lo2(acc[ai][1][m][n]) * rs + lo2(bu[n]));
                    o[2 * n + 1] = swiglu2(hi2(acc[ai][0][m][n]) * rs + hi2(bg[n]), hi2(acc[ai][1][m][n]) * rs + hi2(bu[n])); }
#ifdef DN_FP8
                { int w0 = __builtin_amdgcn_cvt_pk_fp8_f32(o[0].x, o[0].y, 0, false); w0 = __builtin_amdgcn_cvt_pk_fp8_f32(o[1].x, o[1].y, w0, true);
                  int w1 = __builtin_amdgcn_cvt_pk_fp8_f32(o[2].x, o[2].y, 0, false); w1 = __builtin_amdgcn_cvt_pk_fp8_f32(o[3].x, o[3].y, w1, true);
                  *(u32x2*)((unsigned char*)ACT + row * 1024 + colp) = (u32x2){(unsigned)w0, (unsigned)w1}; } }
#else
                store8bf2(ACT + row * 1024 + colp, o[0], o[1], o[2], o[3]); }
#endif
    }
};
struct EpiDN {
    static constexpr bool CHAIN = false;
    const float* bdn; const float* ROWGATE; bf16_t* YS;
    __device__ __forceinline__ void operator()(const f32x4 (&acc)[2][2][4][2], const Unit& u, int wr, int wc, int fr, int fq, const LAS float* side) const {
        f32x4 bv[2][2];
#pragma unroll
        for (int bj = 0; bj < 2; ++bj)
#pragma unroll
            for (int n = 0; n < 2; ++n) bv[bj][n] = *(const LAS f32x4*)(side + EPI_COLS(bj) + 4 * n);
#pragma unroll
        for (int ai = 0; ai < 2; ++ai)
#pragma unroll
            for (int m = 0; m < 4; ++m) { const size_t row = (size_t)u.gm * BM + EPI_ROWS(ai, m); const float gt = side[256 + EPI_ROWS(ai, m)];
#pragma unroll
                for (int bj = 0; bj < 2; ++bj) {
#ifdef W8_SCALE
                    constexpr float iw_ = 1.0f / (float)W8_SCALE;
                    const f32x2 a = (lo2(acc[ai][bj][m][0]) * iw_ + lo2(bv[bj][0])) * gt, b = (hi2(acc[ai][bj][m][0]) * iw_ + hi2(bv[bj][0])) * gt, c = (lo2(acc[ai][bj][m][1]) * iw_ + lo2(bv[bj][1])) * gt, d = (hi2(acc[ai][bj][m][1]) * iw_ + hi2(bv[bj][1])) * gt;
#else
                    const f32x2 a = (lo2(acc[ai][bj][m][0]) + lo2(bv[bj][0])) * gt, b = (hi2(acc[ai][bj][m][0]) + hi2(bv[bj][0])) * gt, c = (lo2(acc[ai][bj][m][1]) + lo2(bv[bj][1])) * gt, d = (hi2(acc[ai][bj][m][1]) + hi2(bv[bj][1])) * gt;
#endif
#ifdef YS_FP8
                    int w0 = __builtin_amdgcn_cvt_pk_fp8_f32(a.x, a.y, 0, false); w0 = __builtin_amdgcn_cvt_pk_fp8_f32(b.x, b.y, w0, true);
                    int w1 = __builtin_amdgcn_cvt_pk_fp8_f32(c.x, c.y, 0, false); w1 = __builtin_amdgcn_cvt_pk_fp8_f32(d.x, d.y, w1, true);
                    *(u32x2*)((unsigned char*)YS + row * 1024 + u.pn * 256 + EPI_COLS(bj)) = (u32x2){(unsigned)w0, (unsigned)w1};
#else
                    store8bf2(YS + row * 1024 + u.pn * 256 + EPI_COLS(bj), a, b, c, d);
#endif
                } }
    }
};

template <int NS> struct SchedDenseT {
    static constexpr int NSIDE = NS; const float* bias;
    __device__ __forceinline__ const float* side_addr(const Unit& u, int, int idx) const {
        const int p = u.pn - 20; return p < 0 ? bias + u.pn * 256 + idx : bias + (idx < 128 ? 5120 + 128 * p + idx : 6144 + 128 * p + (idx - 128)); }
    DenseOrder O; const char* A; const char* B;
    __device__ __forceinline__ bool next(int i, Unit& u) const { int pm, pn; if (!O.tile(i, pm, pn)) return false; u.pm = pm; u.pn = pn; u.e = 0; u.gm = pm;
        u.A = A + (size_t)pm * (BM * KD * 2); u.B = B + (size_t)pn * (BM * KD * 2); return true; }
    static constexpr const unsigned* ROWTOK = nullptr; __device__ __forceinline__ int ROWTOK_row(const Unit&, int) const { return 0; } __device__ __forceinline__ size_t rowoff(const Unit&) const { return 0; }
};
struct SchedDenseProbe {
    static constexpr int NSIDE = 0; __device__ __forceinline__ const float* side_addr(const Unit&, int, int) const { return nullptr; }
    DenseOrder O; const char* A; const char* B;
    __device__ __forceinline__ bool next(int i, Unit& u) const { int pm, pn; if (!O.tile(i, pm, pn)) return false; u.pm = pm; u.pn = pn; u.e = 0; u.gm = pm;
        u.A = A + (size_t)(pm & 1) * (BM * KD * 2); u.B = B + (size_t)(pn & 1) * (BM * KD * 2); return true; }
    static constexpr const unsigned* ROWTOK = nullptr; __device__ __forceinline__ int ROWTOK_row(const Unit&, int) const { return 0; } __device__ __forceinline__ size_t rowoff(const Unit&) const { return 0; }
};
struct SchedMix {
    static constexpr int NSIDE = 0; __device__ __forceinline__ const float* side_addr(const Unit&, int, int) const { return nullptr; }
    DenseOrder O; const char* A0; const char* A1; const char* B0; const char* B1;
    __device__ __forceinline__ bool next(int i, Unit& u) const { int pm, pn; if (!O.tile(i >> 1, pm, pn)) return false; const int w = i & 1; u.pm = pm; u.pn = pn; u.e = w; u.gm = pm;
        u.A = (w ? A1 : A0) + (size_t)pm * (BM * KD * 2); u.B = (w ? B1 : B0) + (size_t)pn * (BM * KD * 2); return true; }
    static constexpr const unsigned* ROWTOK = nullptr; __device__ __forceinline__ int ROWTOK_row(const Unit&, int) const { return 0; } __device__ __forceinline__ size_t rowoff(const Unit&) const { return 0; }
};
template <int NT, bool GATHER> struct SchedMoE {
    static constexpr int NSIDE = 2; const float* sbias; const float* srow;
    __device__ __forceinline__ const float* side_addr(const Unit& u, int k, int idx) const {
        if (k == 1) return srow + (size_t)u.e * T + u.pm + idx;
        return NT == 8 ? sbias + u.e * 2048 + (idx < 128 ? 128 * u.pn + idx : 1024 + 128 * u.pn + idx - 128) : sbias + u.e * 1024 + 256 * u.pn + idx; }
    const LAS int* ptile; int G, c; const char* A; const char* B; size_t bstride  ; const int* ROWTOK; int esz = 2  ;
    __device__ __forceinline__ bool next(int i, Unit& u) const {
        const int ngm = __builtin_amdgcn_readfirstlane(ptile[32]);
        int gm, pn;
        if (G == 256) {
            const int x = c & 7, y = c >> 3; gm = i * (256 / NT) + x * (32 / NT) + y / NT; pn = y % NT;
#ifdef LAST_SPREAD
            if ((i + 1) * (256 / NT) > ngm) gm = i * (256 / NT) + (y / NT) * 8 + x;
#endif
            if (gm >= ngm) return false;
#ifdef DN_REVERSE
            if (NT == 4) gm = ngm - 1 - gm;
#endif
        } else { const long Lx = (long)i * G + c; if (Lx >= (long)ngm * NT) return false; gm = (int)(Lx / NT); pn = (int)(Lx % NT); }
        const int e = __builtin_amdgcn_readfirstlane((int)((const LAS unsigned short*)((const LAS unsigned char*)ptile + 768))[gm]);
        u.pm = (gm - __builtin_amdgcn_readfirstlane(ptile[e])) * BM; u.gm = gm; u.pn = pn; u.e = e;
        u.A = GATHER ? A : A + (size_t)gm * (BM * KD * esz); u.B = B + (size_t)e * bstride + (size_t)pn * (BM * KD * esz); return true; }
    __device__ __forceinline__ int ROWTOK_row(const Unit& u, int r) const { return GATHER ? ROWTOK[(size_t)u.e * T + u.pm + r] : 0; }
    __device__ __forceinline__ size_t rowoff(const Unit& u) const { return (size_t)u.e * T + u.pm; }
};
}
struct Args { const float* in[33]; float* out; unsigned char* ws; int ph_lo, ph_hi, li, pad; };
#define LDS_WAIT() asm volatile("s_waitcnt lgkmcnt(0)" ::: "memory")

struct Frame {
    LAS unsigned char* lds; int tid, lane, wave, G, bid; const float* const* in; float* out; unsigned char* ws;
};

#ifndef DUPMASK
#define DUPMASK 0
#endif
#define REP(bit) for (int rep_ = 0; rep_ < (((DUPMASK >> (bit)) & 1) ? 2 : 1); ++rep_)

#define XB_TMO      128
#define XB_XCNT(j)  (256  + 64 * (j))
#define XB_XSUB(j)  (1280 + 64 * (j))
#define XB_XGEN(j)  (2304 + 64 * (j))
#define XB_TOP      3328
#define XB_TOPGEN   3392
#define XCD_BAR_WORDS 3456
#define XB_SPIN_CAP (1u << 18)

__device__ __forceinline__ unsigned xb_ld(unsigned* p)              { return __hip_atomic_load(p, __ATOMIC_RELAXED, __HIP_MEMORY_SCOPE_AGENT); }
__device__ __forceinline__ unsigned xb_add(unsigned* p, unsigned v) { return __hip_atomic_fetch_add(p, v, __ATOMIC_RELAXED, __HIP_MEMORY_SCOPE_AGENT); }
__device__ __forceinline__ unsigned xb_xcc_id() { return (unsigned)__builtin_amdgcn_s_getreg((3 << 11) | 20) & 0xFu; }
#define XB_SPIN(cond, bar) do { unsigned _sp = 0; while (cond) { __builtin_amdgcn_s_sleep(1); \
    if ((++_sp & 255u) == 0u) { if (xb_ld(&(bar)[XB_TMO])) break; if (_sp > XB_SPIN_CAP) { atomicAdd(&(bar)[XB_TMO], 1u); break; } } } } while (0)

struct XcdBarrier {
    unsigned* bar; unsigned x;
    volatile LAS unsigned* st;
};

__device__ __forceinline__ XcdBarrier xcd_barrier_post(unsigned* bar, volatile LAS unsigned* st) {
    XcdBarrier b; b.bar = bar; b.x = xb_xcc_id(); b.st = st;
    if (threadIdx.x == 0) (void)xb_add(&bar[XB_XCNT(b.x)], 1u);
    return b;
}
__device__ __forceinline__ void xcd_barrier_complete(unsigned* bar, unsigned x, unsigned& nloc, unsigned& nx) {
    const unsigned G = gridDim.x * gridDim.y * gridDim.z;
    unsigned sum, cnt, mine, sp = 0u;
    for (;;) {
        sum = 0u; cnt = 0u; mine = 0u;
#pragma unroll
        for (unsigned j = 0; j < 16; ++j) { const unsigned c = xb_ld(&bar[XB_XCNT(j)]); sum += c; cnt += (c > 0u) ? 1u : 0u; mine = (j == x) ? c : mine; }
        if (sum == G) break;
        __builtin_amdgcn_s_sleep(1);
        if ((++sp & 255u) == 0u) { if (xb_ld(&bar[XB_TMO])) break; if (sp > XB_SPIN_CAP) { atomicAdd(&bar[XB_TMO], 1u); break; } }
    }
    nloc = mine > 0u ? mine : 1u; nx = cnt > 0u ? cnt : 1u;
}

__device__ __forceinline__ void xcd_barrier(const XcdBarrier& b) {
    asm volatile("s_waitcnt vmcnt(0)" ::: "memory");
    __syncthreads();
    if (threadIdx.x == 0) {
        unsigned* bar = b.bar;
        __builtin_amdgcn_s_waitcnt(0);
        unsigned nloc = b.st[0], nx = b.st[1];
        if (nloc == 0u) { xcd_barrier_complete(bar, b.x, nloc, nx); b.st[0] = nloc; b.st[1] = nx; }
        const unsigned old = xb_add(&bar[XB_XSUB(b.x)], 1u);
        const unsigned gen = old / nloc;
        if (old + 1u == (gen + 1u) * nloc) {
            __builtin_amdgcn_fence(__ATOMIC_RELEASE, "agent");
            asm volatile("s_waitcnt vmcnt(0)" ::: "memory");
            const unsigned og = xb_add(&bar[XB_TOP], 1u);
            const unsigned tg = og / nx;
            if (og + 1u == (tg + 1u) * nx) xb_add(&bar[XB_TOPGEN], 1u);
            else XB_SPIN(xb_ld(&bar[XB_TOPGEN]) == tg, bar);
            __builtin_amdgcn_fence(__ATOMIC_ACQUIRE, "agent");
            xb_add(&bar[XB_XGEN(b.x)], 1u);
            asm volatile("s_waitcnt vmcnt(0)" ::: "memory");
        } else {
            XB_SPIN(xb_ld(&bar[XB_XGEN(b.x)]) == gen, bar);
            __builtin_amdgcn_fence(__ATOMIC_ACQUIRE, "agent");
            asm volatile("s_waitcnt vmcnt(0)" ::: "memory");
        }
    }
    __syncthreads();
}


__device__ __forceinline__ void stagger_delay(int cls, int ticks_per_class) {
    if (cls > 0) { const unsigned long long t0 = __builtin_amdgcn_s_memrealtime(); const unsigned long long want = (unsigned long long)(cls * ticks_per_class);
        while (__builtin_amdgcn_s_memrealtime() - t0 < want) __builtin_amdgcn_s_sleep(32); }
}
namespace hy {
constexpr int TW128_OFF = MISC_OFF + 1024, TWT_OFF = MISC_OFF + 2048;

__host__ __device__ constexpr float twc16(int m) { return m == 0 ? 1.f : m == 1 ? 0.92387953251128674f : m == 2 ? 0.70710678118654752f : m == 3 ? 0.38268343236508977f : m == 4 ? 0.f : m == 5 ? -0.38268343236508977f : m == 6 ? -0.70710678118654752f : -0.92387953251128674f; }
__host__ __device__ constexpr float tws16(int m) { return m == 0 ? 0.f : m == 1 ? 0.38268343236508977f : m == 2 ? 0.70710678118654752f : m == 3 ? 0.92387953251128674f : m == 4 ? 1.f : m == 5 ? 0.92387953251128674f : m == 6 ? 0.70710678118654752f : 0.38268343236508977f; }
template <int N> __host__ __device__ constexpr int brev(int i) { int r = 0; for (int b = 1, c = N >> 1; b < N; b <<= 1, c >>= 1) if (i & b) r |= c; return r; }

typedef f32x2 P2;
template <int N, bool INV> __device__ __forceinline__ void fft_reg(P2 (&xr)[N], P2 (&xi)[N]) {
#pragma unroll
    for (int len = N; len >= 2; len >>= 1) {
        const int half = len >> 1;
#pragma unroll
        for (int start = 0; start < N; start += len) {
#pragma unroll
            for (int j = 0; j < half; ++j) {
                const int i0 = start + j, i1 = i0 + half;
                const P2 ar = xr[i0], ai = xi[i0], br = xr[i1], bi = xi[i1];
                xr[i0] = ar + br; xi[i0] = ai + bi;
                const P2 tr = ar - br, ti = ai - bi;
                const int m = j * (16 / len);
                if (m == 0) { xr[i1] = tr; xi[i1] = ti; }
                else if (m == 4) { if (INV) { xr[i1] = -ti; xi[i1] = tr; } else { xr[i1] = ti; xi[i1] = -tr; } }
                else { const float c = twc16(m), s = INV ? tws16(m) : -tws16(m); xr[i1] = tr * c - ti * s; xi[i1] = tr * s + ti * c; }
            }
        }
    }
}
__device__ __forceinline__ unsigned pkh(float a, float b) { return __builtin_bit_cast(unsigned, __builtin_amdgcn_cvt_pkrtz(a, b)); }
__device__ __forceinline__ u32x2 pkc(const P2 re, const P2 im) { u32x2 r; r.x = pkh(re.x, re.y); r.y = pkh(im.x, im.y); return r; }
__device__ __forceinline__ float h2f_lo(unsigned u) { return (float)__builtin_bit_cast(_Float16, (unsigned short)(u & 0xffffu)); }
__device__ __forceinline__ float h2f_hi(unsigned u) { return (float)__builtin_bit_cast(_Float16, (unsigned short)(u >> 16)); }
__device__ __forceinline__ P2 unpk2(unsigned u) { return (P2){h2f_lo(u), h2f_hi(u)}; }
#ifdef YZ_BF8
typedef unsigned yz_t;
__device__ __forceinline__ yz_t pkyz(const P2 re, const P2 im) { int v = __builtin_amdgcn_cvt_pk_bf8_f32(re.x, re.y, 0, false); v = __builtin_amdgcn_cvt_pk_bf8_f32(im.x, im.y, v, true); return (unsigned)v; }
__device__ __forceinline__ P2 yzre(const yz_t u) { return __builtin_amdgcn_cvt_pk_f32_bf8((int)u, false); }
__device__ __forceinline__ P2 yzim(const yz_t u) { return __builtin_amdgcn_cvt_pk_f32_bf8((int)u, true); }
#ifdef KF_BF8
constexpr float KF_SCALE = 64.0f, YZ_ZSCALE = 1.0f / 1024.0f;
#else
constexpr float KF_SCALE = 1.0f, YZ_ZSCALE = 1.0f / 16.0f;
#endif
#else
typedef u32x2 yz_t;
__device__ __forceinline__ yz_t pkyz(const P2 re, const P2 im) { return pkc(re, im); }
__device__ __forceinline__ P2 yzre(const yz_t u) { return unpk2(u.x); }
__device__ __forceinline__ P2 yzim(const yz_t u) { return unpk2(u.y); }
constexpr float YZ_ZSCALE = 1.0f, KF_SCALE = 1.0f;
#endif
#ifdef KF_BF8
typedef yz_t kf_t;
#define KF_PK(re, im) pkyz(re, im)
#define KF_RE(u) yzre(u)
#define KF_IM(u) yzim(u)
#else
typedef u32x2 kf_t;
#define KF_PK(re, im) pkc(re, im)
#define KF_RE(u) unpk2((u).x)
#define KF_IM(u) unpk2((u).y)
#endif
__device__ __forceinline__ P2 bf2p(unsigned u) { return (P2){__uint_as_float(u << 16), __uint_as_float(u & 0xffff0000u)}; }
__device__ __forceinline__ void cmul(P2& xr, P2& xi, float c, float s) { const P2 r = xr * c - xi * s, i = xr * s + xi * c; xr = r; xi = i; }

__device__ __forceinline__ void init_tw128(Frame& F) {
    __syncthreads();
    if (F.tid < 128) { float s, c; sincospif((float)F.tid * (1.0f / 64.0f), &s, &c); ((LAS f32x2*)(F.lds + TW128_OFF))[F.tid] = (f32x2){c, s}; }
    __syncthreads();
}
__device__ __forceinline__ void tile_tw(Frame& F, int a, bool inv) {
    if (F.tid < 128) { const int m = (a * F.tid) & (L2X - 1); float s, c; sincospif((float)m * (1.0f / 8192.0f), &s, &c); ((LAS f32x2*)(F.lds + TWT_OFF))[F.tid] = (f32x2){c, inv ? s : -s}; }
}
template <bool INV> __device__ __forceinline__ void stage1(Frame& F, P2 (&xr)[16], P2 (&xi)[16], int s) {
    fft_reg<16, INV>(xr, xi);
    const LAS f32x2* tw = (const LAS f32x2*)(F.lds + TW128_OFF); LAS f32x4* tile = (LAS f32x4*)F.lds;
#pragma unroll
    for (int q = 0; q < 16; ++q) { const int p = brev<16>(q); const f32x2 w = tw[s * q]; const float c = w.x, sn = INV ? w.y : -w.y;
        P2 a = xr[p], b = xi[p]; cmul(a, b, c, sn);
        tile[(s * 16 + q) * 64 + F.lane] = (f32x4){a.x, a.y, b.x, b.y}; }
}
__device__ __forceinline__ void stage2_read(Frame& F, P2 (&xr)[8], P2 (&xi)[8], int qq) {
    const LAS f32x4* tile = (const LAS f32x4*)F.lds;
#pragma unroll
    for (int s = 0; s < 8; ++s) { const f32x4 v = tile[(s * 16 + qq) * 64 + F.lane]; xr[s] = (P2){v.x, v.y}; xi[s] = (P2){v.z, v.w}; }
}
__device__ __forceinline__ void hyq2(const bf16_t* __restrict__ PHY, size_t row, int tl, int col, const float (&w)[3][2], const float (&b)[2], float& q0, float& q1) {
    q0 = b[0]; q1 = b[1];
#pragma unroll
    for (int k = 0; k < 3; ++k) { const int tt = tl + k - 1; const bool ok = (tt >= 0) && (tt < L);
        const unsigned u = ok ? *(const unsigned*)(PHY + (row + k - 1) * 3072 + col) : 0u;
        q0 += w[k][0] * __uint_as_float(u << 16); q1 += w[k][1] * __uint_as_float(u & 0xffff0000u); }
}
struct ConvW { float w[3][3][2]; float b[3][2]; };
__device__ __forceinline__ void load_convw(ConvW& W, const float* __restrict__ cw, const float* __restrict__ cb, int c0) {
#pragma unroll
    for (int seg = 0; seg < 3; ++seg) {
#pragma unroll
        for (int k = 0; k < 3; ++k) { const f32x2 v = *(const f32x2*)(cw + k * 3072 + seg * 1024 + c0); W.w[seg][k][0] = v.x; W.w[seg][k][1] = v.y; }
        const f32x2 v = *(const f32x2*)(cb + seg * 1024 + c0); W.b[seg][0] = v.x; W.b[seg][1] = v.y; }
}


__device__ __forceinline__ void bf8_to_f(const u32x4 u, float (&f)[8]) {
    f[0] = __uint_as_float(u.x << 16); f[1] = __uint_as_float(u.x & 0xffff0000u); f[2] = __uint_as_float(u.y << 16); f[3] = __uint_as_float(u.y & 0xffff0000u);
    f[4] = __uint_as_float(u.z << 16); f[5] = __uint_as_float(u.z & 0xffff0000u); f[6] = __uint_as_float(u.w << 16); f[7] = __uint_as_float(u.w & 0xffff0000u);
}
__device__ __forceinline__ void prepass(Frame& F) {
    const bf16_t* PHY = (const bf16_t*)(F.ws + WS_PHY); bf16_t* Z16 = (bf16_t*)(F.ws + WS_Z16); bf16_t* X1Q = (bf16_t*)(F.ws + WS_YHY); const float* cw = F.in[12]; const float* cb = F.in[13];
    const int gw = F.bid * NWAVES + F.wave, NGW = F.G * NWAVES;
#pragma unroll 1
    for (int item = gw; item < (T / 16) * 2; item += NGW) {
        const int half = item & 1, row0 = (item >> 1) * 16, tl0 = row0 & (L - 1), c0 = half * 512 + 8 * F.lane;
        float w[3][3][8], bs[3][8];
#pragma unroll
        for (int seg = 0; seg < 3; ++seg) {
#pragma unroll
            for (int k = 0; k < 3; ++k) { const f32x4 a = *(const f32x4*)(cw + k * 3072 + seg * 1024 + c0), b = *(const f32x4*)(cw + k * 3072 + seg * 1024 + c0 + 4);
                w[seg][k][0] = a.x; w[seg][k][1] = a.y; w[seg][k][2] = a.z; w[seg][k][3] = a.w; w[seg][k][4] = b.x; w[seg][k][5] = b.y; w[seg][k][6] = b.z; w[seg][k][7] = b.w; }
            const f32x4 a = *(const f32x4*)(cb + seg * 1024 + c0), b = *(const f32x4*)(cb + seg * 1024 + c0 + 4);
            bs[seg][0] = a.x; bs[seg][1] = a.y; bs[seg][2] = a.z; bs[seg][3] = a.w; bs[seg][4] = b.x; bs[seg][5] = b.y; bs[seg][6] = b.z; bs[seg][7] = b.w; }
        const u32x4 zero4 = (u32x4){0u, 0u, 0u, 0u};
        u32x4 prev[3], cur[3];
#pragma unroll
        for (int seg = 0; seg < 3; ++seg) { prev[seg] = tl0 > 0 ? *(const u32x4*)(PHY + (size_t)(row0 - 1) * 3072 + seg * 1024 + c0) : zero4; cur[seg] = *(const u32x4*)(PHY + (size_t)row0 * 3072 + seg * 1024 + c0); }
#pragma unroll 1
        for (int sub = 0; sub < 4; ++sub) {
            u32x4 nx[4][3];
#pragma unroll
            for (int r = 0; r < 4; ++r)
#pragma unroll
                for (int seg = 0; seg < 3; ++seg) { const int tn = tl0 + sub * 4 + r + 1; nx[r][seg] = tn < L ? *(const u32x4*)(PHY + (size_t)(row0 + sub * 4 + r + 1) * 3072 + seg * 1024 + c0) : zero4; }
#pragma unroll
            for (int r = 0; r < 4; ++r) {
                float q[3][8];
#pragma unroll
                for (int seg = 0; seg < 3; ++seg) { float a[8], b[8], c[8]; bf8_to_f(prev[seg], a); bf8_to_f(cur[seg], b); bf8_to_f(nx[r][seg], c);
#pragma unroll
                    for (int e = 0; e < 8; ++e) q[seg][e] = bs[seg][e] + w[seg][0][e] * a[e] + w[seg][1][e] * b[e] + w[seg][2][e] * c[e];
                    prev[seg] = cur[seg]; cur[seg] = nx[r][seg]; }
                const size_t o = (size_t)(row0 + sub * 4 + r) * 1024 + c0;
                u32x4 zo, xo;
                zo.x = pk2(q[2][0] * q[0][0], q[2][1] * q[0][1]); zo.y = pk2(q[2][2] * q[0][2], q[2][3] * q[0][3]); zo.z = pk2(q[2][4] * q[0][4], q[2][5] * q[0][5]); zo.w = pk2(q[2][6] * q[0][6], q[2][7] * q[0][7]);
                xo.x = pk2(q[1][0], q[1][1]); xo.y = pk2(q[1][2], q[1][3]); xo.z = pk2(q[1][4], q[1][5]); xo.w = pk2(q[1][6], q[1][7]);
                *(u32x4*)(Z16 + o) = zo; *(u32x4*)(X1Q + o) = xo;
            }
        }
    }
}

__device__ __forceinline__ void prep_w4frag(Frame& F) {
    const float* w4 = F.in[20]; u32x4* WF4 = (u32x4*)(F.ws + WS_WF4);
    for (int idx = F.bid * NTHREADS + F.tid; idx < 2 * 64 * 2 * 64; idx += F.G * NTHREADS) {
        const int lane = idx & 63, s = (idx >> 6) & 1, cb = (idx >> 7) & 63, dir = idx >> 13; const int col = dir * 1024 + 16 * cb + (lane & 15), k0 = 32 * s + 8 * (lane >> 4);
        u32x4 o; o.x = pk2(w4[(k0 + 0) * 2048 + col], w4[(k0 + 1) * 2048 + col]); o.y = pk2(w4[(k0 + 2) * 2048 + col], w4[(k0 + 3) * 2048 + col]);
        o.z = pk2(w4[(k0 + 4) * 2048 + col], w4[(k0 + 5) * 2048 + col]); o.w = pk2(w4[(k0 + 6) * 2048 + col], w4[(k0 + 7) * 2048 + col]);
        WF4[idx] = o; }
}
__device__ __forceinline__ void fa_load(const float* __restrict__ w4, int c0, int bt, f32x2 (&wf)[16], f32x2 (&wb)[16]) {
#pragma unroll
    for (int e = 0; e < 16; ++e) { wf[e] = *(const f32x2*)(w4 + (16 * bt + e) * 2048 + c0); wb[e] = *(const f32x2*)(w4 + (16 * bt + e) * 2048 + 1024 + c0); }
}
__device__ __forceinline__ void fa_compute(const LAS f32x4* hrow, int bt, const f32x2 (&wf)[16], const f32x2 (&wb)[16], float (&r0)[16], float (&r1)[16], float& l0, float& l1, bool lag0) {
#pragma unroll
    for (int e4 = 0; e4 < 4; ++e4) { const int u4 = 4 * bt + e4; __builtin_amdgcn_sched_barrier(0);
#pragma unroll
        for (int j = 0; j < 16; ++j) { const f32x4 hv = hrow[(8 * j) * 16 + u4];
#pragma unroll
            for (int e = 0; e < 4; ++e) { r0[j] += hv[e] * (j < 8 ? wf[4 * e4 + e].x : wb[4 * e4 + e].x); r1[j] += hv[e] * (j < 8 ? wf[4 * e4 + e].y : wb[4 * e4 + e].y); } }
        if (lag0) { const f32x4 hv = hrow[u4];
#pragma unroll
            for (int e = 0; e < 4; ++e) { l0 += hv[e] * wb[4 * e4 + e].x; l1 += hv[e] * wb[4 * e4 + e].y; } } }
}
template <bool DRY = false> __device__ __forceinline__ void filter_pass_a(Frame& F, int k_lo = 0, int k_hi = 1 << 20) {
    const float* HH3 = (const float*)(F.ws + WS_HH3); const float* w4 = F.in[20]; float* NORM = (float*)(F.ws + WS_NORMP); kf_t* YK = (kf_t*)(F.ws + WS_KF);
    const int s = F.wave; const LAS f32x2* twt = (const LAS f32x2*)(F.lds + TWT_OFF);
    for (int kk = k_lo, tl = F.bid + k_lo * F.G; kk < k_hi && tl < 128 * 8; ++kk, tl += F.G) {
        const int n1 = tl >> 3, ct = tl & 7, c0 = ct * 128 + 2 * F.lane;
        tile_tw(F, n1, false);
        { const int rw = F.tid >> 2, part = F.tid & 3; const int n = n1 + 128 * rw; const int t = n < L ? n : ((2 * L - n) & (L - 1));
          const f32x4* src = (const f32x4*)(HH3 + t * 64 + part * 16); LAS f32x4* dst = (LAS f32x4*)(F.lds + rw * 256 + part * 64);
          const f32x4 a = src[0], b = src[1], c = src[2], d = src[3]; dst[0] = a; dst[1] = b; dst[2] = c; dst[3] = d; }
        __syncthreads();
        P2 xr[16], xi[16]; P2 lag0 = (P2){0.f, 0.f};
        const P2 da = (P2){hy_delta_abs(c0), hy_delta_abs(c0 + 1)};
        { const u32x4* WF4 = (const u32x4*)(F.ws + WS_WF4); const int cb = ct * 8 + s, jl = F.lane & 15, ql = F.lane >> 4;
          bf16x8 bfr[2][2];
#pragma unroll
          for (int dir = 0; dir < 2; ++dir)
#pragma unroll
              for (int ks = 0; ks < 2; ++ks) bfr[dir][ks] = __builtin_bit_cast(bf16x8, WF4[(((dir * 64 + cb) * 2 + ks) * 64) + F.lane]);
          LAS float* kt = (LAS float*)(F.lds + 32768);
#pragma unroll
          for (int m = 0; m < 8; ++m) {
              bf16x8 afr[2];
#pragma unroll
              for (int ks = 0; ks < 2; ++ks) { const LAS f32x4* hp = (const LAS f32x4*)(F.lds + (16 * m + jl) * 256 + (32 * ks + 8 * ql) * 4); const f32x4 x0 = hp[0], x1 = hp[1];
                  u32x4 pk; pk.x = pk2(x0.x, x0.y); pk.y = pk2(x0.z, x0.w); pk.z = pk2(x1.x, x1.y); pk.w = pk2(x1.z, x1.w); afr[ks] = __builtin_bit_cast(bf16x8, pk); }
              f32x4 d = (f32x4){0.f, 0.f, 0.f, 0.f};
              d = __builtin_amdgcn_mfma_f32_16x16x32_bf16(afr[0], bfr[m >> 2][0], d, 0, 0, 0); d = __builtin_amdgcn_mfma_f32_16x16x32_bf16(afr[1], bfr[m >> 2][1], d, 0, 0, 0);
#pragma unroll
              for (int r = 0; r < 4; ++r) kt[(16 * m + 4 * ql + r) * 132 + 16 * s + jl] = d[r]; }
#ifdef LAG0_SPLIT
          if (n1 == 0) { const LAS float* h0 = (const LAS float*)F.lds; f32x2 wv[8]; P2 pl = (P2){0.f, 0.f};
#pragma unroll
              for (int u = 0; u < 8; ++u) wv[u] = *(const f32x2*)(w4 + (8 * s + u) * 2048 + 1024 + c0);
#pragma unroll
              for (int u = 0; u < 8; ++u) pl += h0[8 * s + u] * wv[u];
              ((LAS f32x2*)(F.lds + MISC_OFF + 8192))[s * 64 + F.lane] = pl; }
          __syncthreads();
          if (n1 == 0 && s == 0) { const LAS f32x2* lp = (const LAS f32x2*)(F.lds + MISC_OFF + 8192);
#pragma unroll
              for (int w = 0; w < 8; ++w) { const f32x2 b = lp[w * 64 + F.lane]; lag0 += b; } }
#else
          if (n1 == 0 && s == 0) { const LAS float* h0 = (const LAS float*)F.lds;
#pragma unroll 4
              for (int u = 0; u < 64; ++u) { const f32x2 wb = *(const f32x2*)(w4 + u * 2048 + 1024 + c0); lag0 += h0[u] * wb; } }
          __syncthreads();
#endif
#pragma unroll
          for (int j = 0; j < 16; ++j) xr[j] = *(const LAS f32x2*)(kt + (s + 8 * j) * 132 + 2 * F.lane);
        }
        __syncthreads();
        P2 na = (P2){0.f, 0.f};
#pragma unroll
        for (int j = 0; j < 16; ++j) { const int n = n1 + 128 * (s + 8 * j); const int t = j < 8 ? n : ((2 * L - n) & (L - 1)); const float tt = (float)t * (1.0f / (float)(L - 1));
            P2 v = xr[j] * (P2){fexp(-tt * da.x), fexp(-tt * da.y)};
            if (n == L) v = (P2){0.f, 0.f};
            if (j == 0) v += lag0;
            xr[j] = v; xi[j] = (P2){0.f, 0.f}; na += (P2){fabsf(v.x), fabsf(v.y)}; }
        { LAS f32x2* nred = (LAS f32x2*)(F.lds + MISC_OFF + 12288); nred[s * 64 + F.lane] = na; }
        stage1<false>(F, xr, xi, s);
        __syncthreads();
        if (s == 0) { const LAS f32x2* nred = (const LAS f32x2*)(F.lds + MISC_OFF + 12288); f32x2 a = nred[F.lane];
#pragma unroll
            for (int w = 1; w < 8; ++w) { const f32x2 b = nred[w * 64 + F.lane]; a.x += b.x; a.y += b.y; }
            if (!DRY) *(f32x2*)(NORM + (size_t)n1 * 1024 + c0) = a; else asm volatile("" :: "v"(a)); }
#pragma unroll
        for (int h = 0; h < 2; ++h) { const int qq = s + 8 * h; P2 a[8], b[8];
            stage2_read(F, a, b, qq); fft_reg<8, false>(a, b);
#pragma unroll
            for (int r = 0; r < 8; ++r) { const int p = brev<8>(r), k2 = qq + 16 * r; const f32x2 w = twt[k2];
                P2 x = a[p], y = b[p]; cmul(x, y, w.x, w.y);
                if (!DRY) YK[((size_t)k2 * 128 + n1) * 512 + (c0 >> 1)] = KF_PK(x, y); else asm volatile("" :: "v"(x), "v"(y)); } }
        __syncthreads();
    }
}
template <bool DRY = false> __device__ __forceinline__ void filter_pass_b(Frame& F) {
    const float* NORM = (const float*)(F.ws + WS_NORMP); kf_t* KF = (kf_t*)(F.ws + WS_KF); const int s = F.wave;
    for (int tl = F.bid; tl < 128 * 8; tl += F.G) {
        const int k2 = tl >> 3, ct = tl & 7, c0 = ct * 128 + 2 * F.lane; const size_t base = (size_t)k2 * 128 * 512 + (c0 >> 1);
        { LAS float* nsum = (LAS float*)(F.lds + MISC_OFF + 12288); const int ch = F.tid & 127, qt = F.tid >> 7; float a = 0.f;
#pragma unroll 8
          for (int i = 0; i < 32; ++i) a += NORM[(size_t)(qt * 32 + i) * 1024 + ct * 128 + ch];
          __syncthreads(); nsum[qt * 128 + ch] = a; __syncthreads(); }
        P2 sc;
        { const LAS float* nsum = (const LAS float*)(F.lds + MISC_OFF + 12288); const int ch = 2 * F.lane;
          sc.x = 1.0f / ((nsum[ch] + nsum[128 + ch]) + (nsum[256 + ch] + nsum[384 + ch])); sc.y = 1.0f / ((nsum[ch + 1] + nsum[128 + ch + 1]) + (nsum[256 + ch + 1] + nsum[384 + ch + 1])); }
        P2 xr[16], xi[16];
#pragma unroll
        for (int j = 0; j < 16; ++j) { const kf_t u = KF[base + (size_t)(s + 8 * j) * 512]; xr[j] = KF_RE(u); xi[j] = KF_IM(u); }
        stage1<false>(F, xr, xi, s);
        __syncthreads();
#pragma unroll
        for (int h = 0; h < 2; ++h) { const int qq = s + 8 * h; P2 a[8], b[8];
            stage2_read(F, a, b, qq); fft_reg<8, false>(a, b);
#pragma unroll
            for (int r = 0; r < 8; ++r) { const int p = brev<8>(r), k1 = qq + 16 * r;
                const kf_t o_ = KF_PK(a[p] * (sc * KF_SCALE), b[p] * (sc * KF_SCALE)); if (!DRY) KF[base + (size_t)k1 * 512] = o_; else asm volatile("" :: "v"(o_)); } }
        __syncthreads();
    }
}
__device__ __forceinline__ void data_pass_a(Frame& F) {
    const bf16_t* Z16 = (const bf16_t*)(F.ws + WS_Z16); yz_t* YZ = (yz_t*)(F.ws + WS_YZ); const int s = F.wave; const LAS f32x2* twt = (const LAS f32x2*)(F.lds + TWT_OFF);
    unsigned zn[16];
    auto zload = [&](int tl, unsigned (&z)[16]) { const int ct = tl & 7, n1 = (tl >> 3) & 127, p = tl >> 10, c0 = ct * 128 + 2 * F.lane;
#pragma unroll
        for (int j = 0; j < 8; ++j) { const int t = n1 + 128 * (s + 8 * j);
            z[2 * j] = *(const unsigned*)(Z16 + ((size_t)(2 * p) * L + t) * 1024 + c0); z[2 * j + 1] = *(const unsigned*)(Z16 + ((size_t)(2 * p + 1) * L + t) * 1024 + c0); } };
    if (F.bid < 2 * 128 * 8) zload(F.bid, zn);
    for (int tl = F.bid; tl < 2 * 128 * 8; tl += F.G) {
        const int ct = tl & 7, n1 = (tl >> 3) & 127, p = tl >> 10, c0 = ct * 128 + 2 * F.lane;
        tile_tw(F, n1, false);
        P2 xr[16], xi[16];
#pragma unroll
        for (int j = 0; j < 8; ++j) { xr[j] = bf2p(zn[2 * j]); xi[j] = bf2p(zn[2 * j + 1]); }
        if (tl + F.G < 2 * 128 * 8) zload(tl + F.G, zn);
#pragma unroll
        for (int j = 8; j < 16; ++j) { xr[j] = (P2){0.f, 0.f}; xi[j] = (P2){0.f, 0.f}; }
        stage1<false>(F, xr, xi, s);
        __syncthreads();
#pragma unroll
        for (int h = 0; h < 2; ++h) { const int qq = s + 8 * h; P2 a[8], b[8];
            stage2_read(F, a, b, qq); fft_reg<8, false>(a, b);
#pragma unroll
            for (int r = 0; r < 8; ++r) { const int pp = brev<8>(r), k2 = qq + 16 * r; const f32x2 w = twt[k2];
                P2 x = a[pp], y = b[pp]; cmul(x, y, w.x, w.y);
                YZ[(((size_t)p * 128 + k2) * 128 + n1) * 512 + (c0 >> 1)] = pkyz(x, y); } }
        __syncthreads();
    }
}
template <bool DRY = false> __device__ __forceinline__ void data_pass_b(Frame& F) {
    yz_t* YZ = (yz_t*)(F.ws + WS_YZ); const kf_t* KF = (const kf_t*)(F.ws + WS_KF); const int s = F.wave;
    const LAS f32x2* twt = (const LAS f32x2*)(F.lds + TWT_OFF); const LAS f32x2* tw = (const LAS f32x2*)(F.lds + TW128_OFF); LAS f32x4* tile = (LAS f32x4*)F.lds;
    int* qctr = (int*)(F.ws + WS_CTL) + 128 + (DRY ? 1 : 0); LAS int* qslot = (LAS int*)(F.lds + MISC_OFF + 768);
    for (;;) {
        __syncthreads();
        if (F.tid == 0) *qslot = atomicAdd(qctr, 1);
        __syncthreads();
        const int tl = *qslot; if (tl >= 128 * 8) break;
        const int k2 = tl >> 3, ct = tl & 7, c0 = ct * 128 + 2 * F.lane; const size_t kbase = (size_t)k2 * 128 * 512 + (c0 >> 1);
        tile_tw(F, k2, true);
#pragma unroll 1
        for (int p = 0; p < 2; ++p) {
            const size_t base = ((size_t)p * 128 + k2) * 128 * 512 + (c0 >> 1);
            kf_t kfp[2][8];
#pragma unroll
            for (int h = 0; h < 2; ++h)
#pragma unroll
                for (int r = 0; r < 8; ++r) kfp[h][r] = KF[kbase + (size_t)(s + 8 * h + 16 * r) * 512];
            { P2 xr[16], xi[16];
#pragma unroll
              for (int j = 0; j < 16; ++j) { const yz_t u = YZ[base + (size_t)(s + 8 * j) * 512]; xr[j] = yzre(u); xi[j] = yzim(u); }
              stage1<false>(F, xr, xi, s); }
            __syncthreads();
#pragma unroll
            for (int h = 0; h < 2; ++h) { const int qq = s + 8 * h; P2 a[8], b[8], gr[8], gi[8];
                if (h == 1) __builtin_amdgcn_sched_barrier(0);
                stage2_read(F, a, b, qq); fft_reg<8, false>(a, b);
#pragma unroll
                for (int r = 0; r < 8; ++r) { const int pp = brev<8>(r); const P2 kr = KF_RE(kfp[h][r]), ki = KF_IM(kfp[h][r]);
                    gr[r] = a[pp] * kr - b[pp] * ki; gi[r] = a[pp] * ki + b[pp] * kr; }
                fft_reg<8, true>(gr, gi);
#pragma unroll
                for (int bq = 0; bq < 8; ++bq) { const int pp = brev<8>(bq); const f32x2 w = tw[bq * qq];
                    P2 x = gr[pp], y = gi[pp]; cmul(x, y, w.x, w.y);
                    tile[(bq * 16 + qq) * 64 + F.lane] = (f32x4){x.x, x.y, y.x, y.y}; } }
            __syncthreads();
            { P2 xr[16], xi[16];
#pragma unroll
              for (int q = 0; q < 16; ++q) { const f32x4 v = tile[(s * 16 + q) * 64 + F.lane]; xr[q] = (P2){v.x, v.y}; xi[q] = (P2){v.z, v.w}; }
              fft_reg<16, true>(xr, xi);
#pragma unroll
              for (int a = 0; a < 16; ++a) { const int pp = brev<16>(a), m2 = s + 8 * a; const f32x2 w = twt[m2];
                  P2 x = xr[pp], y = xi[pp]; cmul(x, y, w.x, w.y);
                  if (!DRY) YZ[base + (size_t)m2 * 512] = pkyz(x * YZ_ZSCALE, y * YZ_ZSCALE); else asm volatile("" :: "v"(x), "v"(y)); } }
            __syncthreads();
        }
    }
}
template <bool DRY = false> __device__ __forceinline__ void data_pass_c(Frame& F) {
    const bf16_t* Z16 = (const bf16_t*)(F.ws + WS_Z16); const yz_t* YZ = (const yz_t*)(F.ws + WS_YZ); bf16_t* YHY = (bf16_t*)(F.ws + WS_YHY); const float* hbias = F.in[22]; const int s = F.wave;
    yz_t yzn[16];
    auto yzload = [&](int tl, yz_t (&y)[16]) { const int ct = tl & 7, m2 = (tl >> 3) & 127, p = tl >> 10, c0 = ct * 128 + 2 * F.lane;
#pragma unroll
        for (int j = 0; j < 16; ++j) y[j] = YZ[(((size_t)p * 128 + (s + 8 * j)) * 128 + m2) * 512 + (c0 >> 1)]; };
    if (F.bid < 2 * 128 * 8) yzload(F.bid, yzn);
    for (int tl = F.bid; tl < 2 * 128 * 8; tl += F.G) {
        const int ct = tl & 7, m2 = (tl >> 3) & 127, p = tl >> 10, c0 = ct * 128 + 2 * F.lane;
        unsigned uzp[2][4][2], uxp[2][4][2];
#pragma unroll
        for (int h = 0; h < 2; ++h)
#pragma unroll
            for (int r = 0; r < 4; ++r)
#pragma unroll
                for (int bb = 0; bb < 2; ++bb) { const size_t row = (size_t)(2 * p + bb) * L + 128 * (s + 8 * h + 16 * r) + m2;
                    uzp[h][r][bb] = *(const unsigned*)(Z16 + row * 1024 + c0); uxp[h][r][bb] = *(const unsigned*)(YHY + row * 1024 + c0); }
        { P2 xr[16], xi[16];
#pragma unroll
          for (int j = 0; j < 16; ++j) { xr[j] = yzre(yzn[j]); xi[j] = yzim(yzn[j]); }
          if (tl + F.G < 2 * 128 * 8) yzload(tl + F.G, yzn);
          stage1<true>(F, xr, xi, s); }
        __syncthreads();
        const P2 hb = *(const f32x2*)(hbias + c0);
#pragma unroll
        for (int h = 0; h < 2; ++h) { const int qq = s + 8 * h; P2 a[8], b[8];
            stage2_read(F, a, b, qq); fft_reg<8, true>(a, b);
#pragma unroll
            for (int r = 0; r < 4; ++r) { const int pp = brev<8>(r), t = 128 * (qq + 16 * r) + m2;
#pragma unroll
                for (int bb = 0; bb < 2; ++bb) { const size_t row = (size_t)(2 * p + bb) * L + t;
                    const P2 z = bf2p(uzp[h][r][bb]), x1 = bf2p(uxp[h][r][bb]);
                    const P2 cv = (bb == 0 ? a[pp] : b[pp]) * (1.0f / ((float)L2X * YZ_ZSCALE * KF_SCALE));
                    const P2 y = x1 * (cv + hb * z);
                    if (!DRY) *(unsigned*)(YHY + row * 1024 + c0) = pk2(y.x, y.y); else asm volatile("" :: "v"(y)); } } }
        __syncthreads();
    }
}
}
namespace lru {
__device__ __forceinline__ f32x2 sig2(const f32x2 x) { const f32x2 t = x * -1.4426950408889634f; const f32x2 d = (f32x2){__builtin_amdgcn_exp2f(t.x), __builtin_amdgcn_exp2f(t.y)} + 1.0f; return (f32x2){__builtin_amdgcn_rcpf(d.x), __builtin_amdgcn_rcpf(d.y)}; }
constexpr int TC = 64, NCH = L / TC, MB = TC / 16;

__device__ __forceinline__ void prep_wfrag(Frame& F) {
    const float* wa = F.in[6]; const float* wi = F.in[8]; u32x4* WF = (u32x4*)(F.ws + WS_WLRUF);
    for (int idx = F.bid * NTHREADS + F.tid; idx < 2 * 16 * 2 * 4 * 2 * 64; idx += F.G * NTHREADS) {
        const int lane = idx & 63, s = (idx >> 6) & 1, n = (idx >> 7) & 3, mat = (idx >> 9) & 1, h = (idx >> 10) & 15, dir = idx >> 14;
        const float* W = (mat == 0 ? wa : wi) + ((size_t)(dir * 16 + h) * 64) * 64; const int jo = 16 * n + (lane & 15), i0 = 32 * s + 8 * (lane >> 4);
        u32x4 o; o.x = pk2(W[(i0 + 0) * 64 + jo], W[(i0 + 1) * 64 + jo]); o.y = pk2(W[(i0 + 2) * 64 + jo], W[(i0 + 3) * 64 + jo]);
        o.z = pk2(W[(i0 + 4) * 64 + jo], W[(i0 + 5) * 64 + jo]); o.w = pk2(W[(i0 + 6) * 64 + jo], W[(i0 + 7) * 64 + jo]);
        WF[idx] = o;
    }
}

__device__ __forceinline__ void load_rows(const bf16_t* __restrict__ P0, int b, int t0, int m, int h, int j, int q, u32x4 (&pv)[2][4]) {
#pragma unroll
    for (int s = 0; s < 2; ++s)
#pragma unroll
        for (int tap = 0; tap < 4; ++tap) { const int tl = t0 + 16 * m + j + tap - 2; const bool ok = (tl >= 0) && (tl < L);
            const size_t off = ok ? (WS_P0 - WS_CTL - 8192) + (((size_t)b * L + tl) * 1024 + 64 * h + 32 * s + 8 * q) * 2 : (size_t)0;
            pv[s][tap] = *(const u32x4*)((const char*)P0 + off); }
}
__device__ __forceinline__ void stage1(Frame& F) {
    const bf16_t* P0 = (const bf16_t*)(F.ws + WS_CTL + 8192);
    const float* cw = F.in[4]; const float* cb = F.in[5]; const float* ba = F.in[7]; const float* bi = F.in[9]; const float* lam = F.in[10];
    const u32x4* WF = (const u32x4*)(F.ws + WS_WLRUF); f32x2* SUMM = (f32x2*)(F.ws + WS_SUMM);
    u32x2* HS = (u32x2*)(F.ws + WS_HS); u32x2* AF = (u32x2*)(F.ws + WS_AF); u32x2* AB = (u32x2*)(F.ws + WS_AB);
    LAS float* cwl = (LAS float*)(F.lds + MISC_OFF + 4096);
    LAS unsigned* hfl = (LAS unsigned*)(F.lds + F.wave * 8192) + F.lane;
    const LAS u32x4* wl = (const LAS u32x4*)(F.lds + 65536) + F.lane;
    asm volatile("" : "+v"(wl)); asm volatile("" : "+v"(hfl));
    const int lane = F.lane, j = lane & 15, q = lane >> 4;
    bf16x8 idf[2];
#pragma unroll
    for (int par = 0; par < 2; ++par) { const int kp = 16 * par + j;
#pragma unroll
        for (int jj = 0; jj < 8; ++jj) idf[par][jj] = (short)((q == (kp >> 3) && jj == (kp & 7)) ? 0x3F80 : 0); }
#pragma unroll 1
    for (int bix = F.bid; bix < NB * 16 * (NCH / 8); bix += F.G) {
        const int h = (bix >> 4) & 15, b = bix >> 8, chunk = (bix & 15) * 8 + F.wave; const int t0 = chunk * TC; const int task = ((b * NCH + chunk) << 4) + h;
        __syncthreads();
        if (F.tid < 320) cwl[F.tid] = F.tid < 256 ? cw[(F.tid >> 6) * 1024 + 64 * h + (F.tid & 63)] : cb[64 * h + (F.tid & 63)];
#pragma unroll
        for (int i = 0; i < 4; ++i) { const int e = F.tid + 512 * i; const int dir_ = e >> 10, rest = e & 1023;
            ((LAS u32x4*)(F.lds + 65536))[e] = WF[((size_t)(dir_ * 16 + h) * 16) * 64 + rest]; }
        __syncthreads();
#pragma unroll
        for (int dir = 0; dir < 2; ++dir) {
            float bac[4], bic[4], spc[4], cst[4], arun[4];
#pragma unroll
            for (int n = 0; n < 4; ++n) { const int c = 64 * h + 16 * n + j; bac[n] = ba[dir * 1024 + c]; bic[n] = bi[dir * 1024 + c]; spc[n] = -8.0f * 1.4426950408889634f * log1pf(expf(-lam[dir * 1024 + c])); cst[n] = 0.f; arun[n] = 1.f; }
            u32x4 pvn[2][4];
            load_rows(P0, b, t0, dir == 0 ? 0 : MB - 1, h, j, q, pvn);
#pragma unroll 1
            for (int mm = 0; mm < MB; ++mm) {
                const int m = dir == 0 ? mm : MB - 1 - mm;
                bf16x8 afr[2];
#pragma unroll
                for (int s = 0; s < 2; ++s) { const int chb = 32 * s + 8 * q; f32x2 xp[4];
                    { const f32x4 b0 = *(const LAS f32x4*)(cwl + 256 + chb), b1 = *(const LAS f32x4*)(cwl + 256 + chb + 4);
                      xp[0] = (f32x2){b0.x, b0.y}; xp[1] = (f32x2){b0.z, b0.w}; xp[2] = (f32x2){b1.x, b1.y}; xp[3] = (f32x2){b1.z, b1.w}; }
#pragma unroll
                    for (int tap = 0; tap < 4; ++tap) { const u32x4 pq = pvn[s][tap];
                        const f32x4 w0 = *(const LAS f32x4*)(cwl + tap * 64 + chb), w1 = *(const LAS f32x4*)(cwl + tap * 64 + chb + 4);
                        xp[0] += (f32x2){w0.x, w0.y} * (f32x2){__uint_as_float(pq.x << 16), __uint_as_float(pq.x & 0xffff0000u)}; xp[1] += (f32x2){w0.z, w0.w} * (f32x2){__uint_as_float(pq.y << 16), __uint_as_float(pq.y & 0xffff0000u)};
                        xp[2] += (f32x2){w1.x, w1.y} * (f32x2){__uint_as_float(pq.z << 16), __uint_as_float(pq.z & 0xffff0000u)}; xp[3] += (f32x2){w1.z, w1.w} * (f32x2){__uint_as_float(pq.w << 16), __uint_as_float(pq.w & 0xffff0000u)}; }
                    u32x4 pk; pk.x = pk2(xp[0].x, xp[0].y); pk.y = pk2(xp[1].x, xp[1].y); pk.z = pk2(xp[2].x, xp[2].y); pk.w = pk2(xp[3].x, xp[3].y); afr[s] = __builtin_bit_cast(bf16x8, pk); }
                __builtin_amdgcn_sched_barrier(0);
                if (mm + 1 < MB) load_rows(P0, b, t0, dir == 0 ? m + 1 : m - 1, h, j, q, pvn);
                f32x4 dx[4], da[4], di[4];
#pragma unroll
                for (int n = 0; n < 4; ++n) { const f32x4 z4 = (f32x4){0.f, 0.f, 0.f, 0.f};
                    dx[n] = __builtin_amdgcn_mfma_f32_16x16x32_bf16(afr[n >> 1], idf[n & 1], z4, 0, 0, 0);
                    const bf16x8 wa0 = __builtin_bit_cast(bf16x8, wl[(((dir * 2 + 0) * 4 + n) * 2 + 0) * 64]), wa1 = __builtin_bit_cast(bf16x8, wl[(((dir * 2 + 0) * 4 + n) * 2 + 1) * 64]);
                    const bf16x8 wi0 = __builtin_bit_cast(bf16x8, wl[(((dir * 2 + 1) * 4 + n) * 2 + 0) * 64]), wi1 = __builtin_bit_cast(bf16x8, wl[(((dir * 2 + 1) * 4 + n) * 2 + 1) * 64]);
                    da[n] = __builtin_amdgcn_mfma_f32_16x16x32_bf16(afr[0], wa0, z4, 0, 0, 0); da[n] = __builtin_amdgcn_mfma_f32_16x16x32_bf16(afr[1], wa1, da[n], 0, 0, 0);
                    di[n] = __builtin_amdgcn_mfma_f32_16x16x32_bf16(afr[0], wi0, z4, 0, 0, 0); di[n] = __builtin_amdgcn_mfma_f32_16x16x32_bf16(afr[1], wi1, di[n], 0, 0, 0); }
                float P[4][4], S[4][4], PT[4], ST[4];
#pragma unroll
                for (int n = 0; n < 4; ++n) { float av[4], bv[4];
#pragma unroll
                    for (int hp = 0; hp < 2; ++hp) {
                        const f32x2 rg = sig2((f32x2){da[n][2 * hp], da[n][2 * hp + 1]} + bac[n]), ig = sig2((f32x2){di[n][2 * hp], di[n][2 * hp + 1]} + bic[n]);
                        const f32x2 tq = rg * spc[n];
                        const f32x2 a = (f32x2){__builtin_amdgcn_exp2f(tq.x), __builtin_amdgcn_exp2f(tq.y)};
                        const f32x2 w = 1.0f - a * a;
                        const f32x2 mult = (f32x2){__builtin_amdgcn_sqrtf(fmaxf(w.x, 0.f)), __builtin_amdgcn_sqrtf(fmaxf(w.y, 0.f))};
                        const f32x2 bq = mult * (ig * (f32x2){dx[n][2 * hp], dx[n][2 * hp + 1]});
                        av[2 * hp] = a.x; av[2 * hp + 1] = a.y; bv[2 * hp] = bq.x; bv[2 * hp + 1] = bq.y; }
                    if (dir == 0) { P[n][0] = av[0]; S[n][0] = bv[0];
#pragma unroll
                        for (int r = 1; r < 4; ++r) { P[n][r] = P[n][r - 1] * av[r]; S[n][r] = av[r] * S[n][r - 1] + bv[r]; } }
                    else { P[n][3] = av[3]; S[n][3] = bv[3];
#pragma unroll
                        for (int r = 2; r >= 0; --r) { P[n][r] = P[n][r + 1] * av[r]; S[n][r] = av[r] * S[n][r + 1] + bv[r]; } }
                    PT[n] = dir == 0 ? P[n][3] : P[n][0]; ST[n] = dir == 0 ? S[n][3] : S[n][0]; }
                float pt[4][4], st[4][4];
#pragma unroll
                for (int n = 0; n < 4; ++n)
#pragma unroll
                    for (int g = 0; g < 4; ++g) { pt[n][g] = __shfl(PT[n], j + 16 * g); st[n][g] = __shfl(ST[n], j + 16 * g); }
#pragma unroll
                for (int n = 0; n < 4; ++n) {
                    float C = cst[n], A = arun[n], Cq = 0.f, Aq = 1.f;
#pragma unroll
                    for (int gg = 0; gg < 4; ++gg) { const int g = dir == 0 ? gg : 3 - gg; if (g == q) { Cq = C; Aq = A; } C = pt[n][g] * C + st[n][g]; A *= pt[n][g]; }
                    cst[n] = C; arun[n] = A;
                    float hl[4], ac[4];
#pragma unroll
                    for (int hp = 0; hp < 2; ++hp) { const f32x2 pp = (f32x2){P[n][2 * hp], P[n][2 * hp + 1]}; const f32x2 hq = (f32x2){S[n][2 * hp], S[n][2 * hp + 1]} + pp * Cq, aq = pp * Aq;
                        hl[2 * hp] = hq.x; hl[2 * hp + 1] = hq.y; ac[2 * hp] = aq.x; ac[2 * hp + 1] = aq.y; }
                    const size_t fo = ((size_t)(task * MB + m) * 4 + n) * 64 + lane;
                    if (dir == 0) {
                        hfl[((m * 4 + n) * 2 + 0) * 64] = pk2(hl[0], hl[1]); hfl[((m * 4 + n) * 2 + 1) * 64] = pk2(hl[2], hl[3]);
                        AF[fo] = (u32x2){pk2(ac[0], ac[1]), pk2(ac[2], ac[3])};
                    } else {
                        { const unsigned u0 = hfl[((m * 4 + n) * 2 + 0) * 64], u1 = hfl[((m * 4 + n) * 2 + 1) * 64];
                          hl[0] += __uint_as_float(u0 << 16); hl[1] += __uint_as_float(u0 & 0xffff0000u); hl[2] += __uint_as_float(u1 << 16); hl[3] += __uint_as_float(u1 & 0xffff0000u); }
                        HS[fo] = (u32x2){pk2(hl[0], hl[1]), pk2(hl[2], hl[3])}; AB[fo] = (u32x2){pk2(ac[0], ac[1]), pk2(ac[2], ac[3])};
                    }
                }
            }
            if (q == 0) {
#pragma unroll
                for (int n = 0; n < 4; ++n) SUMM[((size_t)(dir * NB + b) * NCH + chunk) * 1024 + 64 * h + 16 * n + j] = (f32x2){arun[n], cst[n]};
            }
        }
    }
}
__device__ __forceinline__ void stage2(Frame& F) {
    const bf16_t* P1 = (const bf16_t*)(F.ws + WS_P1); bf16_t* YLRU = (bf16_t*)(F.ws + WS_YLRU); const float* CARRY = (const float*)(F.ws + WS_CARRY);
    const u32x2* HS = (const u32x2*)(F.ws + WS_HS); const u32x2* AF = (const u32x2*)(F.ws + WS_AF); const u32x2* AB = (const u32x2*)(F.ws + WS_AB);
    LAS float* buf = (LAS float*)(F.lds + F.wave * 8192);
    const int lane = F.lane, j = lane & 15, q = lane >> 4, tk = lane >> 2, cg = lane & 3;
    const int gw = F.bid * NWAVES + F.wave, NGW = F.G * NWAVES;
    struct In { u32x2 hs[4], af[4], ab[4]; float cf[4], cbk[4]; u32x4 g0, g1; };
    auto issue = [&](int item, In& I) {
        const int m = item & (MB - 1), task = item >> 2, h = task & 15, chunk = (task >> 4) & (NCH - 1), b = task >> 11;
#pragma unroll
        for (int n = 0; n < 4; ++n) { const size_t fo = ((size_t)item * 4 + n) * 64 + lane; I.hs[n] = HS[fo]; I.af[n] = AF[fo]; I.ab[n] = AB[fo];
            const int c = 64 * h + 16 * n + j; I.cf[n] = CARRY[((size_t)(0 * NB + b) * NCH + chunk) * 1024 + c]; I.cbk[n] = CARRY[((size_t)(1 * NB + b) * NCH + chunk) * 1024 + c]; }
        const size_t o = ((size_t)b * L + chunk * TC + 16 * m + tk) * 1024 + 64 * h + 16 * cg;
        I.g0 = *(const u32x4*)(P1 + o); I.g1 = *(const u32x4*)(P1 + o + 8); };
    auto finish = [&](int item, const In& I) {
        const int m = item & (MB - 1), task = item >> 2, h = task & 15, chunk = (task >> 4) & (NCH - 1), b = task >> 11;
#pragma unroll
        for (int n = 0; n < 4; ++n) {
            const float h0 = __uint_as_float(I.hs[n].x << 16) + __uint_as_float(I.af[n].x << 16) * I.cf[n] + __uint_as_float(I.ab[n].x << 16) * I.cbk[n];
            const float h1 = __uint_as_float(I.hs[n].x & 0xffff0000u) + __uint_as_float(I.af[n].x & 0xffff0000u) * I.cf[n] + __uint_as_float(I.ab[n].x & 0xffff0000u) * I.cbk[n];
            const float h2 = __uint_as_float(I.hs[n].y << 16) + __uint_as_float(I.af[n].y << 16) * I.cf[n] + __uint_as_float(I.ab[n].y << 16) * I.cbk[n];
            const float h3 = __uint_as_float(I.hs[n].y & 0xffff0000u) + __uint_as_float(I.af[n].y & 0xffff0000u) * I.cf[n] + __uint_as_float(I.ab[n].y & 0xffff0000u) * I.cbk[n];
            buf[(4 * q + 0) * 68 + 16 * n + j] = h0; buf[(4 * q + 1) * 68 + 16 * n + j] = h1; buf[(4 * q + 2) * 68 + 16 * n + j] = h2; buf[(4 * q + 3) * 68 + 16 * n + j] = h3;
        }
        LDS_WAIT();
        const size_t o = ((size_t)b * L + chunk * TC + 16 * m + tk) * 1024 + 64 * h + 16 * cg;
        const LAS f32x4* br = (const LAS f32x4*)(buf + tk * 68 + 16 * cg);
        const f32x4 v0 = br[0], v1 = br[1], v2 = br[2], v3 = br[3];
        float gg[16];
        { const unsigned w[8] = {I.g0.x, I.g0.y, I.g0.z, I.g0.w, I.g1.x, I.g1.y, I.g1.z, I.g1.w};
#pragma unroll
          for (int i = 0; i < 8; ++i) { gg[2 * i] = gelu_tanh(__uint_as_float(w[i] << 16)); gg[2 * i + 1] = gelu_tanh(__uint_as_float(w[i] & 0xffff0000u)); } }
        u32x4 y0, y1;
        y0.x = pk2(v0.x * gg[0], v0.y * gg[1]); y0.y = pk2(v0.z * gg[2], v0.w * gg[3]); y0.z = pk2(v1.x * gg[4], v1.y * gg[5]); y0.w = pk2(v1.z * gg[6], v1.w * gg[7]);
        y1.x = pk2(v2.x * gg[8], v2.y * gg[9]); y1.y = pk2(v2.z * gg[10], v2.w * gg[11]); y1.z = pk2(v3.x * gg[12], v3.y * gg[13]); y1.w = pk2(v3.z * gg[14], v3.w * gg[15]);
        *(u32x4*)(YLRU + o) = y0; *(u32x4*)(YLRU + o + 8) = y1;
        LDS_WAIT(); };
    constexpr int NIT = NB * NCH * 16 * MB;
    In A, B; int item = gw;
    if (item < NIT) issue(item, A);
#pragma unroll 1
    for (; item < NIT; item += 2 * NGW) {
        if (item + NGW < NIT) issue(item + NGW, B);
        finish(item, A);
        if (item + NGW >= NIT) break;
        if (item + 2 * NGW < NIT) issue(item + 2 * NGW, A);
        finish(item + NGW, B);
    }
}
#ifndef CARRY_BATCH
#define CARRY_BATCH 16
#endif
__device__ __forceinline__ void carry(Frame& F) {
    const f32x2* SUMM = (const f32x2*)(F.ws + WS_SUMM); float* CARRY = (float*)(F.ws + WS_CARRY);
    for (int idx = F.bid * NTHREADS + F.tid; idx < 2 * NB * 1024; idx += F.G * NTHREADS) {
        const int c = idx & 1023, db = idx >> 10, dir = db >> 2; const size_t base = (size_t)db * NCH * 1024 + c;
        float C = 0.f;
#pragma unroll 1
        for (int k0 = 0; k0 < NCH; k0 += CARRY_BATCH) {
            f32x2 v[CARRY_BATCH];
#pragma unroll
            for (int i = 0; i < CARRY_BATCH; ++i) { const int k = dir == 0 ? (k0 + i) : (NCH - 1 - k0 - i); v[i] = SUMM[base + (size_t)k * 1024]; }
#pragma unroll
            for (int i = 0; i < CARRY_BATCH; ++i) { const int k = dir == 0 ? (k0 + i) : (NCH - 1 - k0 - i); CARRY[base + (size_t)k * 1024] = C; C = v[i].x * C + v[i].y; }
        }
    }
}
}
__device__ __forceinline__ void transpose_item(const float* __restrict__ W, int ldw, int k0, int n0, bf16_t* __restrict__ WT, size_t orow0, const float* __restrict__ kscale, LAS float* scr, int lane) {
    const int r8 = lane >> 3, c4 = (lane & 7) * 4;
#pragma unroll
    for (int i = 0; i < 8; ++i) { const int kk = 8 * i + r8; f32x4 v = *(const f32x4*)(W + (size_t)(k0 + kk) * ldw + n0 + c4);
        if (kscale) { const float s = kscale[k0 + kk]; v = v * s; }
        scr[kk * 33 + c4 + 0] = v.x; scr[kk * 33 + c4 + 1] = v.y; scr[kk * 33 + c4 + 2] = v.z; scr[kk * 33 + c4 + 3] = v.w; }
    LDS_WAIT();
    const int c = lane & 7;
#pragma unroll
    for (int j = 0; j < 4; ++j) { const int n = (lane >> 3) + 8 * j; const LAS float* s = scr + (8 * c) * 33 + n;
        u32x4 o; o.x = pk2(s[0 * 33], s[1 * 33]); o.y = pk2(s[2 * 33], s[3 * 33]); o.z = pk2(s[4 * 33], s[5 * 33]); o.w = pk2(s[6 * 33], s[7 * 33]);
        *(u32x4*)(WT + (orow0 + n) * 1024 + k0 + 8 * c) = o; }
    LDS_WAIT();
}

__device__ __forceinline__ void phase_prep(Frame& F) {
    LAS float* scr = (LAS float*)(F.lds + F.wave * 16384);
    const int gw = F.bid * NWAVES + F.wave, NGW = F.G * NWAVES;
#ifdef P0_ALTERNATE
    auto part_a_ = [&]() {
    constexpr int I_IN = (1024 / 64) * (NIN / 32), I_SQ = (1024 / 64) * (1024 / 32);
    for (int it = gw; it < I_IN + 3 * I_SQ; it += NGW) {
        int r = it; const float* W; int N; bf16_t* WT;
        if (r < I_IN) { W = F.in[2]; N = NIN; WT = (bf16_t*)(F.ws + WS_WIN); }
        else { r -= I_IN; const int q = r / I_SQ; r -= q * I_SQ; N = 1024; W = q == 0 ? F.in[11] : q == 1 ? F.in[23] : F.in[24]; WT = (bf16_t*)(F.ws + (q == 0 ? WS_WLRU : q == 1 ? WS_WHY : WS_WOUT)); }
        const int nblk = N / 32, kb = r / nblk, nb = r % nblk;
        int orow = 32 * nb;
        if (N == NIN && orow >= 5120) { const int which = (orow - 5120) >> 10, cc = (orow - 5120) & 1023; orow = 5120 + 256 * (cc >> 7) + 128 * which + (cc & 127); }
        transpose_item(W, N, 64 * kb, 32 * nb, WT, (size_t)orow, nullptr, scr, F.lane);
    }
    };
    auto part_b_ = [&]() {
    { const float* x = F.in[0]; const float* g = F.in[1]; bf16_t* U = (bf16_t*)(F.ws + WS_U);
      f32x4 gg[4];
#pragma unroll
      for (int j = 0; j < 4; ++j) gg[j] = ((const f32x4*)g)[F.lane + 64 * j];
      auto ld = [&](int row, f32x4 (&v)[4]) { const f32x4* xr = (const f32x4*)(x + (size_t)row * D) + F.lane;
#pragma unroll
          for (int j = 0; j < 4; ++j) v[j] = xr[64 * j]; };
      auto fin = [&](int row, const f32x4 (&v)[4]) { float s = 0.f;
#pragma unroll
          for (int j = 0; j < 4; ++j) s += v[j].x * v[j].x + v[j].y * v[j].y + v[j].z * v[j].z + v[j].w * v[j].w;
          const float rstd = rsqrtf(wave_sum(s) * (1.0f / D) + EPS);
#pragma unroll
          for (int j = 0; j < 4; ++j) { u32x2 w; w.x = pk2(v[j].x * rstd * gg[j].x, v[j].y * rstd * gg[j].y); w.y = pk2(v[j].z * rstd * gg[j].z, v[j].w * rstd * gg[j].w);
              ((u32x2*)(U + (size_t)row * D))[F.lane + 64 * j] = w; } };
      f32x4 va[4], vb[4], vc[4]; int row = gw;
      if (row < T) ld(row, va);
      if (row + NGW < T) ld(row + NGW, vb);
#pragma unroll 1
      for (; row < T; row += 3 * NGW) {
          if (row + 2 * NGW < T) ld(row + 2 * NGW, vc);
          fin(row, va);
          if (row + NGW >= T) break;
          if (row + 3 * NGW < T) ld(row + 3 * NGW, va);
          fin(row + NGW, vb);
          if (row + 2 * NGW >= T) break;
          if (row + 4 * NGW < T) ld(row + 4 * NGW, vb);
          fin(row + 2 * NGW, vc);
      } }
    };
    if (((F.bid >> 3) & 1) == 0) { part_a_(); part_b_(); } else { part_b_(); part_a_(); }
#else
    constexpr int I_IN = (1024 / 64) * (NIN / 32), I_SQ = (1024 / 64) * (1024 / 32);
    for (int it = gw; it < I_IN + 3 * I_SQ; it += NGW) {
        int r = it; const float* W; int N; bf16_t* WT;
        if (r < I_IN) { W = F.in[2]; N = NIN; WT = (bf16_t*)(F.ws + WS_WIN); }
        else { r -= I_IN; const int q = r / I_SQ; r -= q * I_SQ; N = 1024; W = q == 0 ? F.in[11] : q == 1 ? F.in[23] : F.in[24]; WT = (bf16_t*)(F.ws + (q == 0 ? WS_WLRU : q == 1 ? WS_WHY : WS_WOUT)); }
        const int nblk = N / 32, kb = r / nblk, nb = r % nblk;
        int orow = 32 * nb;
        if (N == NIN && orow >= 5120) { const int which = (orow - 5120) >> 10, cc = (orow - 5120) & 1023; orow = 5120 + 256 * (cc >> 7) + 128 * which + (cc & 127); }
        transpose_item(W, N, 64 * kb, 32 * nb, WT, (size_t)orow, nullptr, scr, F.lane);
    }
    { const float* x = F.in[0]; const float* g = F.in[1]; bf16_t* U = (bf16_t*)(F.ws + WS_U);
      f32x4 gg[4];
#pragma unroll
      for (int j = 0; j < 4; ++j) gg[j] = ((const f32x4*)g)[F.lane + 64 * j];
      auto ld = [&](int row, f32x4 (&v)[4]) { const f32x4* xr = (const f32x4*)(x + (size_t)row * D) + F.lane;
#pragma unroll
          for (int j = 0; j < 4; ++j) v[j] = xr[64 * j]; };
      auto fin = [&](int row, const f32x4 (&v)[4]) { float s = 0.f;
#pragma unroll
          for (int j = 0; j < 4; ++j) s += v[j].x * v[j].x + v[j].y * v[j].y + v[j].z * v[j].z + v[j].w * v[j].w;
          const float rstd = rsqrtf(wave_sum(s) * (1.0f / D) + EPS);
#pragma unroll
          for (int j = 0; j < 4; ++j) { u32x2 w; w.x = pk2(v[j].x * rstd * gg[j].x, v[j].y * rstd * gg[j].y); w.y = pk2(v[j].z * rstd * gg[j].z, v[j].w * rstd * gg[j].w);
              ((u32x2*)(U + (size_t)row * D))[F.lane + 64 * j] = w; } };
      f32x4 va[4], vb[4], vc[4]; int row = gw;
      if (row < T) ld(row, va);
      if (row + NGW < T) ld(row + NGW, vb);
#pragma unroll 1
      for (; row < T; row += 3 * NGW) {
          if (row + 2 * NGW < T) ld(row + 2 * NGW, vc);
          fin(row, va);
          if (row + NGW >= T) break;
          if (row + 3 * NGW < T) ld(row + 3 * NGW, va);
          fin(row + NGW, vb);
          if (row + 2 * NGW >= T) break;
          if (row + 4 * NGW < T) ld(row + 4 * NGW, vb);
          fin(row + 2 * NGW, vc);
      } }
#endif
    { const float *w1 = F.in[14], *b1 = F.in[15], *w2 = F.in[16], *b2 = F.in[17], *w3 = F.in[18], *b3 = F.in[19], *freq = F.in[21]; float* HH3 = (float*)(F.ws + WS_HH3);
      LAS float* feat = scr; LAS float* h1 = scr + 64; LAS float* h2 = scr + 128; const int u = F.lane; const float fr = freq[u];
      float w1r[36], w2r[64], w3r[64];
#pragma unroll
      for (int f = 0; f < 36; ++f) w1r[f] = f < HYEMB ? w1[f * 64 + u] : 0.f;
#pragma unroll
      for (int f = 0; f < 64; ++f) { w2r[f] = w2[f * 64 + u]; w3r[f] = w3[f * 64 + u]; }
      const float b1u = b1[u], b2u = b2[u], b3u = b3[u];
#pragma unroll 1
      for (int t = gw; t < L; t += NGW) {
        asm volatile("" ::: "memory");
        { float f = 0.f;
          if (u < HYEMB) { if (u == 0) f = (float)t / (float)(L - 1);
            else { const int j = (u - 1) & 15; const float band = 1e-4f + (float)j * ((15.0f - 1e-4f) / 15.0f); const float arg = (6.283185307179586f * (float)t / (float)L) * band; f = (u <= 16) ? cosf(arg) : -sinf(arg); } }
          feat[u] = f; }
        LDS_WAIT();
        float s = b1u;
#pragma unroll
        for (int f4 = 0; f4 < 9; ++f4) { const f32x4 v = *(const LAS f32x4*)(feat + 4 * f4); s += v.x * w1r[4 * f4] + v.y * w1r[4 * f4 + 1] + v.z * w1r[4 * f4 + 2] + v.w * w1r[4 * f4 + 3]; }
        h1[u] = sinf(fr * s); LDS_WAIT();
        s = b2u;
#pragma unroll
        for (int f4 = 0; f4 < 16; ++f4) { const f32x4 v = *(const LAS f32x4*)(h1 + 4 * f4); s += v.x * w2r[4 * f4] + v.y * w2r[4 * f4 + 1] + v.z * w2r[4 * f4 + 2] + v.w * w2r[4 * f4 + 3]; }
        h2[u] = sinf(fr * s); LDS_WAIT();
        s = b3u;
#pragma unroll
        for (int f4 = 0; f4 < 16; ++f4) { const f32x4 v = *(const LAS f32x4*)(h2 + 4 * f4); s += v.x * w3r[4 * f4] + v.y * w3r[4 * f4 + 1] + v.z * w3r[4 * f4 + 2] + v.w * w3r[4 * f4 + 3]; }
        HH3[t * 64 + u] = sinf(fr * s); LDS_WAIT(); } }
    lru::prep_wfrag(F); hy::prep_w4frag(F);
    { u32x4* WRGF = (u32x4*)(F.ws + WS_WRG); const float* g = F.in[25]; const float* wr = F.in[26];
      for (int idx = F.bid * NTHREADS + F.tid; idx < 32 * 2 * 2 * 64; idx += F.G * NTHREADS) {
          const int lane = idx & 63, part = (idx >> 6) & 1, tile = (idx >> 7) & 1, s = idx >> 8; const int e = 16 * tile + (lane & 15), k0 = 32 * s + 8 * (lane >> 4);
          float w[8];
#pragma unroll
          for (int jj = 0; jj < 8; ++jj) { const float v = g[k0 + jj] * wr[(k0 + jj) * 32 + e]; const float hi = __uint_as_float(pk2(v, v) << 16); w[jj] = part == 0 ? hi : v - hi; }
          u32x4 o; o.x = pk2(w[0], w[1]); o.y = pk2(w[2], w[3]); o.z = pk2(w[4], w[5]); o.w = pk2(w[6], w[7]); WRGF[idx] = o; } }
}

template <int KIND, bool DYN> __device__ __forceinline__ void convert_weights(Frame& F, int rank, int nranks, int rnd_lo = 0, int rnd_hi = 1 << 20) {
    LAS float* scr = (LAS float*)(F.lds + F.wave * 16384);
    const int gw = rank * NWAVES + F.wave, NGW = nranks * NWAVES;
    constexpr int IPE = KIND == 0 ? (1024 / 64) * (2048 / 32) : (1024 / 64) * (1024 / 32), TOTAL_ALL = NE * IPE;
    const int TOTAL = (long)rnd_hi * NGW < (long)TOTAL_ALL ? rnd_hi * NGW : TOTAL_ALL;
    int* ctr = (int*)(F.ws + WS_CTL) + 130;
    auto claim = [&]() { int v = 0; if (DYN && F.lane == 0) v = atomicAdd(ctr, 1); return v; };
    const float* Wc = nullptr; bf16_t* WTc = nullptr; size_t orowc = 0; int k0c = 0; f32x4 vc[8];
    auto decode_load = [&](int it, const float*& W, bf16_t*& WT, size_t& orow, int& k0, f32x4 (&v)[8]) {
        const int e = it / IPE, r = it - e * IPE; int ldw, n0;
        if (KIND == 0) { const int kb = r / 64, nb = r % 64; n0 = 32 * nb; const int which = n0 >> 10, pn = (n0 & 1023) >> 7, j0 = n0 & 127;
            W = F.in[28] + (size_t)e * 1024 * 2048; ldw = 2048; k0 = 64 * kb; WT = (bf16_t*)(F.ws + WS_WGU); orow = (size_t)e * 2048 + 256 * pn + 128 * which + j0; }
        else { const int kb = r / 32, nb = r % 32; n0 = 32 * nb;
            W = F.in[30] + (size_t)e * 1024 * 1024; ldw = 1024; k0 = 64 * kb; WT = (bf16_t*)(F.ws + WS_WDN); orow = (size_t)e * 1024 + 32 * nb; }
        const int r8 = F.lane >> 3, c4 = (F.lane & 7) * 4;
#pragma unroll
        for (int i = 0; i < 8; ++i) { const int kk = 8 * i + r8; v[i] = *(const f32x4*)(W + (size_t)(k0 + kk) * ldw + n0 + c4); if (KIND == 0) v[i] = v[i] * F.in[25][k0 + kk];
#ifdef W8_SCALE
            v[i] = v[i] * (float)W8_SCALE;
#endif
        }
    };
    int it, itn, raw2 = 0;
    if (DYN) { const int r0 = claim(), r1 = claim(); raw2 = claim(); it = __builtin_amdgcn_readfirstlane(r0); itn = __builtin_amdgcn_readfirstlane(r1); }
    else { it = rnd_lo * NGW + gw; itn = it + NGW; }
    if (it < TOTAL) decode_load(it, Wc, WTc, orowc, k0c, vc);
#pragma unroll 1
    while (it < TOTAL) {
        const float* Wn = nullptr; bf16_t* WTn = nullptr; size_t orown = 0; int k0n = 0; f32x4 vn[8];
        const bool more = itn < TOTAL;
        if (more) decode_load(itn, Wn, WTn, orown, k0n, vn);
        { const int r8 = F.lane >> 3, c4 = (F.lane & 7) * 4;
#pragma unroll
          for (int i = 0; i < 8; ++i) { const int kk = 8 * i + r8; scr[kk * 33 + c4 + 0] = vc[i].x; scr[kk * 33 + c4 + 1] = vc[i].y; scr[kk * 33 + c4 + 2] = vc[i].z; scr[kk * 33 + c4 + 3] = vc[i].w; }
          LDS_WAIT();
          const int c = F.lane & 7;
#pragma unroll
          for (int j = 0; j < 4; ++j) { const int n = (F.lane >> 3) + 8 * j; const LAS float* s = scr + (8 * c) * 33 + n;
#ifdef DN_FP8
#ifdef GU_FP8
              if (true) {
#else
              if (KIND == 1) {
#endif
                  int w0 = __builtin_amdgcn_cvt_pk_fp8_f32(s[0 * 33], s[1 * 33], 0, false); w0 = __builtin_amdgcn_cvt_pk_fp8_f32(s[2 * 33], s[3 * 33], w0, true);
                  int w1 = __builtin_amdgcn_cvt_pk_fp8_f32(s[4 * 33], s[5 * 33], 0, false); w1 = __builtin_amdgcn_cvt_pk_fp8_f32(s[6 * 33], s[7 * 33], w1, true);
                  *(u32x2*)((unsigned char*)WTc + (orowc + n) * 1024 + k0c + 8 * c) = (u32x2){(unsigned)w0, (unsigned)w1}; } else
#endif
              { u32x4 o; o.x = pk2(s[0 * 33], s[1 * 33]); o.y = pk2(s[2 * 33], s[3 * 33]); o.z = pk2(s[4 * 33], s[5 * 33]); o.w = pk2(s[6 * 33], s[7 * 33]);
              *(u32x4*)(WTc + (orowc + n) * 1024 + k0c + 8 * c) = o; } }
          LDS_WAIT(); }
        if (more) { Wc = Wn; WTc = WTn; orowc = orown; k0c = k0n;
#pragma unroll
            for (int i = 0; i < 8; ++i) vc[i] = vn[i]; }
        it = itn;
        if (DYN) { itn = __builtin_amdgcn_readfirstlane(raw2); raw2 = claim(); } else itn += NGW;
    }
}
__device__ __forceinline__ void phase_router_a(Frame& F) {
#ifdef MIXDESYNC
    convert_weights<0, false>(F, F.bid, F.G, 2 * MIXDESYNC); convert_weights<1, false>(F, F.bid, F.G);
#else
#ifndef CONV_IN_P2
    REP(11) { convert_weights<0, false>(F, F.bid, F.G); convert_weights<1, false>(F, F.bid, F.G); }
#endif
#endif
    __syncthreads();
    { const f32x4* src = (const f32x4*)(F.ws + WS_WRG); LAS f32x4* dst = (LAS f32x4*)F.lds;
      for (int i = F.tid; i < 32 * 2 * 2 * 64; i += NTHREADS) dst[i] = src[i]; }
    LAS int* hist = (LAS int*)(F.lds + MISC_OFF);
    if (F.tid < 32) hist[F.tid] = 0;
    __syncthreads();
    const LAS u32x4* wl = (const LAS u32x4*)F.lds + F.lane;
    const bf16_t* HB = (const bf16_t*)(F.ws + WS_HN); const float* br = F.in[27];
    int* EROWTOK = (int*)(F.ws + WS_EROWTOK); float* EROWRS = (float*)(F.ws + WS_EROWRS); float* EROWGATE = (float*)(F.ws + WS_EROWGATE); int* TOKCODE = (int*)(F.ws + WS_TOKROW); LAS int* base = hist + 32;
    for (int g0 = 0; g0 < T / 16; g0 += F.G * NWAVES) {
        const int grp = g0 + F.bid * NWAVES + F.wave; const bool act = grp < T / 16;
        int te_[4] = {0, 0, 0, 0}, lr_[4] = {0, 0, 0, 0}; float gt_[4] = {0.f, 0.f, 0.f, 0.f}, rs_ = 0.f;
        const int n = F.lane & 15, g = F.lane >> 4; const int t = grp * 16 + n;
        if (act) {
        const u32x4* hp = (const u32x4*)(HB + (size_t)t * D + 8 * g);
        f32x4 acc[2] = {(f32x4){0.f, 0.f, 0.f, 0.f}, (f32x4){0.f, 0.f, 0.f, 0.f}}; f32x2 ss2 = (f32x2){0.f, 0.f};
        u32x4 hb[8];
#pragma unroll
        for (int u = 0; u < 8; ++u) hb[u] = hp[u * 4];
#pragma unroll 1
        for (int s0 = 0; s0 < 32; s0 += 8) {
#pragma unroll
            for (int u = 0; u < 8; ++u) { const int s = s0 + u; const u32x4 cur = hb[u];
                if (s0 + 8 < 32) hb[u] = hp[(s + 8) * 4];
                const bf16x8 bfr = __builtin_bit_cast(bf16x8, cur);
#pragma unroll
                for (int tile = 0; tile < 2; ++tile) {
                    acc[tile] = __builtin_amdgcn_mfma_f32_16x16x32_bf16(__builtin_bit_cast(bf16x8, wl[((s * 2 + tile) * 2 + 0) * 64]), bfr, acc[tile], 0, 0, 0);
                    acc[tile] = __builtin_amdgcn_mfma_f32_16x16x32_bf16(__builtin_bit_cast(bf16x8, wl[((s * 2 + tile) * 2 + 1) * 64]), bfr, acc[tile], 0, 0, 0); }
                const f32x2 a = (f32x2){__uint_as_float(cur.x << 16), __uint_as_float(cur.x & 0xffff0000u)}, b = (f32x2){__uint_as_float(cur.y << 16), __uint_as_float(cur.y & 0xffff0000u)};
                const f32x2 c = (f32x2){__uint_as_float(cur.z << 16), __uint_as_float(cur.z & 0xffff0000u)}, d = (f32x2){__uint_as_float(cur.w << 16), __uint_as_float(cur.w & 0xffff0000u)};
                ss2 += a * a; ss2 += b * b; ss2 += c * c; ss2 += d * d; }
        }
        float ss = ss2.x + ss2.y; ss += __shfl_xor(ss, 16); ss += __shfl_xor(ss, 32);
        const float rstd = rsqrtf(ss * (1.0f / D) + EPS);
        float v[8];
#pragma unroll
        for (int q = 0; q < 8; ++q) v[q] = acc[q >> 2][q & 3] * rstd + br[16 * (q >> 2) + 4 * g + (q & 3)];
        float tv[4]; int te[4];
#pragma unroll
        for (int k = 0; k < 4; ++k) {
            float mx = -3.0e38f; int mi = 0;
#pragma unroll
            for (int q = 0; q < 8; ++q) { const int ex = 16 * (q >> 2) + 4 * g + (q & 3); if (v[q] > mx) { mx = v[q]; mi = ex; } }
#pragma unroll
            for (int o = 16; o <= 32; o <<= 1) { const float om = __shfl_xor(mx, o); const int oi = __shfl_xor(mi, o); if (om > mx || (om == mx && oi < mi)) { mx = om; mi = oi; } }
            tv[k] = mx; te[k] = mi;
#pragma unroll
            for (int q = 0; q < 8; ++q) { const int ex = 16 * (q >> 2) + 4 * g + (q & 3); if (ex == mi) v[q] = -3.0e38f; }
        }
        const float e1 = __expf(tv[1] - tv[0]), e2 = __expf(tv[2] - tv[0]), e3 = __expf(tv[3] - tv[0]); const float inv = 1.0f / (1.0f + e1 + e2 + e3);
        if (g == 0) {
            gt_[0] = inv; gt_[1] = e1 * inv; gt_[2] = e2 * inv; gt_[3] = e3 * inv; rs_ = rstd;
#pragma unroll
            for (int k = 0; k < 4; ++k) { te_[k] = te[k]; lr_[k] = atomicAdd((int*)&hist[te[k]], 1); }
        }
        }
        __syncthreads();
        if (F.tid < 32) base[F.tid] = hist[F.tid] != 0 ? atomicAdd((int*)(F.ws + WS_CTL) + F.tid, hist[F.tid]) : 0;
        __syncthreads();
        if (act && g == 0) { int code[4];
#pragma unroll
            for (int k = 0; k < 4; ++k) { const int e = te_[k], pos = base[e] + lr_[k]; const size_t o = (size_t)e * T + pos;
                EROWTOK[o] = t;
#ifdef W8_SCALE
                EROWRS[o] = rs_ * (1.0f / (float)W8_SCALE);
#else
                EROWRS[o] = rs_;
#endif
                EROWGATE[o] = gt_[k]; code[k] = (e << 15) | pos; }
            *(int4*)(TOKCODE + t * 4) = make_int4(code[0], code[1], code[2], code[3]); }
        __syncthreads();
        if (F.tid < 32) hist[F.tid] = 0;
        __syncthreads();
    }
}
template <bool REUSE = false> __device__ __forceinline__ const LAS int* build_ptile(Frame& F) {
    LAS int* pt = (LAS int*)(F.lds + MISC_OFF + 256);
#ifdef PTILE_ONCE
    if (REUSE) return pt;
#endif
    __syncthreads();
    if (F.tid == 0) { const int* cnt = (const int*)(F.ws + WS_CTL); int o = 0; for (int e = 0; e < 32; ++e) { pt[e] = o; o += (cnt[e] + 255) >> 8; } pt[32] = o; }
    __syncthreads();
    { LAS unsigned short* te = (LAS unsigned short*)(F.lds + MISC_OFF + 1024);
      for (int g = F.tid; g < NPAD / 256; g += NTHREADS) { int e = 0;
#pragma unroll
          for (int q = 1; q < 32; ++q) e += (pt[q] <= g) ? 1 : 0;
          te[g] = (unsigned short)e; } }
    __syncthreads();
    return pt;
}
__device__ __forceinline__ void phase_router_b(Frame& F) {
    const LAS int* pt = build_ptile(F);
    LAS int* hist = (LAS int*)(F.lds + MISC_OFF); LAS int* base = hist + 32;
    const int* TOPE = (const int*)(F.ws + WS_TOPE); const float* TOPG = (const float*)(F.ws + WS_TOPG); const float* TOKRS = (const float*)(F.ws + WS_TOKRS);
    int* ROWTOK = (int*)(F.ws + WS_ROWTOK); float* ROWGATE = (float*)(F.ws + WS_ROWGATE); float* ROWRS = (float*)(F.ws + WS_ROWRS); int* TOKROW = (int*)(F.ws + WS_TOKROW);
    int* cursor = (int*)(F.ws + WS_CTL) + 64; const int* cnt = (const int*)(F.ws + WS_CTL);
    for (int chunk = F.bid; chunk < T * 4 / NTHREADS; chunk += F.G) {
        __syncthreads();
        if (F.tid < 32) hist[F.tid] = 0;
        __syncthreads();
        const int idx = chunk * NTHREADS + F.tid; const int e = TOPE[idx]; const int lr = atomicAdd((int*)&hist[e], 1);
        __syncthreads();
        if (F.tid < 32) base[F.tid] = hist[F.tid] ? atomicAdd(cursor + F.tid, hist[F.tid]) : 0;
        __syncthreads();
        const int row = pt[e] * 256 + base[e] + lr;
        ROWTOK[row] = idx >> 2; ROWGATE[row] = TOPG[idx]; ROWRS[row] = TOKRS[idx >> 2]; TOKROW[idx] = row;
    }
    if (F.bid == 0) for (int e = F.wave; e < 32; e += NWAVES) { const int r0 = pt[e] * 256 + cnt[e], r1 = pt[e + 1] * 256; for (int r = r0 + F.lane; r < r1; r += 64) { ROWTOK[r] = 0; ROWGATE[r] = 0.f; ROWRS[r] = 0.f; } }
}
#ifdef YS_FP8
__device__ __forceinline__ void phase_final(Frame& F) {
    const int gw = F.bid * NWAVES + F.wave, NGW = F.G * NWAVES;
    float* out = F.out; const bf16_t* HB = (const bf16_t*)(F.ws + WS_HN); const unsigned char* YS8 = (const unsigned char*)(F.ws + WS_YS); const int* TOKROW = (const int*)(F.ws + WS_TOKROW); const float* g = F.in[32];
    const LAS int* pt = build_ptile(F);
    struct In { u32x4 h[2]; u32x2 y[4][2]; };
    auto issue = [&](int t, const int4 rows, In& I) {
#pragma unroll
        for (int j = 0; j < 2; ++j) I.h[j] = ((const u32x4*)(HB + (size_t)t * D))[F.lane + 64 * j];
#pragma unroll
        for (int k = 0; k < 4; ++k) { const int code = k == 0 ? rows.x : k == 1 ? rows.y : k == 2 ? rows.z : rows.w; const size_t row = (size_t)(pt[code >> 15] * 256 + (code & 32767));
#pragma unroll
            for (int j = 0; j < 2; ++j) I.y[k][j] = ((const u32x2*)(YS8 + row * D))[F.lane + 64 * j]; } };
    auto finish = [&](int t, const In& I) {
        float v[2][8]; float s = 0.f;
#pragma unroll
        for (int j = 0; j < 2; ++j) { const unsigned hw[4] = {I.h[j].x, I.h[j].y, I.h[j].z, I.h[j].w};
#pragma unroll
            for (int i = 0; i < 4; ++i) { v[j][2 * i] = __uint_as_float(hw[i] << 16); v[j][2 * i + 1] = __uint_as_float(hw[i] & 0xffff0000u); }
#pragma unroll
            for (int k = 0; k < 4; ++k) { const f32x2 a = __builtin_amdgcn_cvt_pk_f32_fp8((int)I.y[k][j].x, false), b = __builtin_amdgcn_cvt_pk_f32_fp8((int)I.y[k][j].x, true),
                                                      c = __builtin_amdgcn_cvt_pk_f32_fp8((int)I.y[k][j].y, false), d = __builtin_amdgcn_cvt_pk_f32_fp8((int)I.y[k][j].y, true);
                v[j][0] += a.x; v[j][1] += a.y; v[j][2] += b.x; v[j][3] += b.y; v[j][4] += c.x; v[j][5] += c.y; v[j][6] += d.x; v[j][7] += d.y; }
#pragma unroll
            for (int i = 0; i < 8; ++i) s += v[j][i] * v[j][i]; }
        const float rstd = rsqrtf(wave_sum(s) * (1.0f / D) + EPS);
#pragma unroll
        for (int j = 0; j < 2; ++j) { const f32x4 g0 = ((const f32x4*)g)[2 * (F.lane + 64 * j)], g1 = ((const f32x4*)g)[2 * (F.lane + 64 * j) + 1];
            f32x4* o = (f32x4*)(out + (size_t)t * D) + 2 * (F.lane + 64 * j);
            o[0] = (f32x4){v[j][0] * rstd * g0.x, v[j][1] * rstd * g0.y, v[j][2] * rstd * g0.z, v[j][3] * rstd * g0.w};
            o[1] = (f32x4){v[j][4] * rstd * g1.x, v[j][5] * rstd * g1.y, v[j][6] * rstd * g1.z, v[j][7] * rstd * g1.w}; } };
    int t = gw;
    int4 rowsA = make_int4(0, 0, 0, 0), rowsB = make_int4(0, 0, 0, 0); In dA, dB;
    if (t < T) rowsA = *(const int4*)(TOKROW + t * 4);
    if (t + NGW < T) rowsB = *(const int4*)(TOKROW + (t + NGW) * 4);
    if (t < T) issue(t, rowsA, dA);
#pragma unroll 1
    for (; t < T; t += 2 * NGW) {
        const int t1 = t + NGW, t2 = t + 2 * NGW, t3 = t + 3 * NGW;
        if (t2 < T) rowsA = *(const int4*)(TOKROW + t2 * 4);
        if (t1 < T) issue(t1, rowsB, dB);
        finish(t, dA);
        if (t1 >= T) break;
        if (t3 < T) rowsB = *(const int4*)(TOKROW + t3 * 4);
        if (t2 < T) issue(t2, rowsA, dA);
        finish(t1, dB);
    }
}
#else
__device__ __forceinline__ void phase_final(Frame& F) {
    const int gw = F.bid * NWAVES + F.wave, NGW = F.G * NWAVES;
    float* out = F.out; const bf16_t* HB = (const bf16_t*)(F.ws + WS_HN); const bf16_t* YS = (const bf16_t*)(F.ws + WS_YS); const int* TOKROW = (const int*)(F.ws + WS_TOKROW); const float* g = F.in[32];
    const LAS int* pt = build_ptile<true>(F);
    auto issue = [&](int t, const int4 rows, u32x2 (&d)[5][4]) {
#pragma unroll
        for (int j = 0; j < 4; ++j) d[0][j] = ((const u32x2*)(HB + (size_t)t * D))[F.lane + 64 * j];
#pragma unroll
        for (int k = 0; k < 4; ++k) { const int code = k == 0 ? rows.x : k == 1 ? rows.y : k == 2 ? rows.z : rows.w; const size_t row = (size_t)(pt[code >> 15] * 256 + (code & 32767));
#pragma unroll
            for (int j = 0; j < 4; ++j) d[1 + k][j] = ((const u32x2*)(YS + row * D))[F.lane + 64 * j]; } };
    auto finish = [&](int t, const u32x2 (&d)[5][4]) {
        f32x4 v[4];
#pragma unroll
        for (int j = 0; j < 4; ++j) { v[j] = (f32x4){__uint_as_float(d[0][j].x << 16), __uint_as_float(d[0][j].x & 0xffff0000u), __uint_as_float(d[0][j].y << 16), __uint_as_float(d[0][j].y & 0xffff0000u)};
#pragma unroll
            for (int k = 1; k < 5; ++k) { const u32x2 w = d[k][j];
                v[j].x += __uint_as_float(w.x << 16); v[j].y += __uint_as_float(w.x & 0xffff0000u); v[j].z += __uint_as_float(w.y << 16); v[j].w += __uint_as_float(w.y & 0xffff0000u); } }
        float s = 0.f;
#pragma unroll
        for (int j = 0; j < 4; ++j) s += v[j].x * v[j].x + v[j].y * v[j].y + v[j].z * v[j].z + v[j].w * v[j].w;
        const float rstd = rsqrtf(wave_sum(s) * (1.0f / D) + EPS);
#pragma unroll
        for (int j = 0; j < 4; ++j) { const f32x4 gg = ((const f32x4*)g)[F.lane + 64 * j];
            ((f32x4*)(out + (size_t)t * D))[F.lane + 64 * j] = (f32x4){v[j].x * rstd * gg.x, v[j].y * rstd * gg.y, v[j].z * rstd * gg.z, v[j].w * rstd * gg.w}; } };
    int t = gw;
    int4 rowsA = make_int4(0, 0, 0, 0), rowsB = make_int4(0, 0, 0, 0); u32x2 dA[5][4], dB[5][4];
    if (t < T) rowsA = *(const int4*)(TOKROW + t * 4);
    if (t + NGW < T) rowsB = *(const int4*)(TOKROW + (t + NGW) * 4);
    if (t < T) issue(t, rowsA, dA);
#pragma unroll 1
    for (; t < T; t += 2 * NGW) {
        const int t1 = t + NGW, t2 = t + 2 * NGW, t3 = t + 3 * NGW;
        if (t2 < T) rowsA = *(const int4*)(TOKROW + t2 * 4);
        if (t1 < T) issue(t1, rowsB, dB);
        finish(t, dA);
        if (t1 >= T) break;
        if (t3 < T) rowsB = *(const int4*)(TOKROW + t3 * 4);
        if (t2 < T) issue(t2, rowsA, dA);
        finish(t1, dB);
    }
}

#endif
__global__ void __launch_bounds__(NTHREADS, 2) mega(Args args) {
    extern __shared__ __attribute__((aligned(16))) unsigned char lds_raw[];
    cg::grid_group grid = cg::this_grid();
    Frame F; F.lds = (LAS unsigned char*)lds_raw; F.tid = threadIdx.x; F.lane = F.tid & 63; F.wave = __builtin_amdgcn_readfirstlane(F.tid >> 6); F.G = gridDim.x; F.bid = blockIdx.x;
    F.in = args.in; F.out = args.out; F.ws = args.ws;
    const int lo = args.ph_lo, hi = args.ph_hi;
    if (F.tid < 2) ((LAS unsigned*)(F.lds + MISC_OFF + 512))[F.tid] = 0u;
    __syncthreads();
    (void)xcd_barrier_post((unsigned*)(args.ws + WS_CTL + 16384) + args.li * XCD_BAR_WORDS, (volatile LAS unsigned*)(F.lds + MISC_OFF + 512));
#ifndef STAG1
#define STAG1 650
#endif
#define IN(k) (lo <= (k) && (k) < hi)
#define FRESH() do { size_t z_ = 0; F.tid = threadIdx.x; asm volatile("" : "+s"(z_), "+v"(F.tid)); F.ws = args.ws + z_; F.lane = F.tid & 63; ws = F.ws; } while (0)
#ifdef PROBE_PHASE
#define TS(k) do { if (blockIdx.x == 0 && threadIdx.x == 0) ((unsigned long long*)(args.ws + WS_CTL + 2048))[k] = __builtin_amdgcn_s_memrealtime(); } while (0)
#else
#define TS(k) do {} while (0)
#endif
#define SEAM(k) do { if (IN(k) && IN((k) + 1)) { if (hi > 1000) grid.sync();   else { XcdBarrier xb_; xb_.bar = (unsigned*)(args.ws + WS_CTL + 16384) + args.li * XCD_BAR_WORDS; xb_.x = xb_xcc_id(); xb_.st = (volatile LAS unsigned*)(F.lds + MISC_OFF + 512); xcd_barrier(xb_); if ((DUPMASK >> 21) & 1) xcd_barrier(xb_); } } } while (0)
    unsigned char* ws = args.ws;
    if (IN(0)) { TS(0); FRESH(); REP(0) phase_prep(F); } SEAM(0);
    if (IN(1)) { TS(1); FRESH();
        pg8::SchedDenseT<1> S; S.bias = args.in[3]; S.O.init(T / 256, NIN / 256, F.G, F.bid); S.A = (const char*)(ws + WS_U); S.B = (const char*)(ws + WS_WIN);
        pg8::EpiIn E{(bf16_t*)(ws + WS_P0), (bf16_t*)(ws + WS_P1), (bf16_t*)(ws + WS_PHY), (bf16_t*)(ws + WS_PG), args.in[3]};
#ifdef DESYNC1
        const int nbefore_ = DESYNC1 == 2 ? (((F.bid >> 3) & 1) ? 0 : 4) : DESYNC1 == 4 ? ((F.bid >> 3) & 3) : DESYNC1 == 3 ? 2 * ((F.bid >> 3) & 1) + 1 : 0;
        if (nbefore_ > 0) { hy::init_tw128(F); hy::filter_pass_a<false>(F, 0, nbefore_); __syncthreads(); }
#endif
        pg8::gemm_phase<pg8::EpiIn, pg8::SchedDenseT<1>, false>(F.lds, S, E); if ((DUPMASK >> 1) & 1) { pg8::gemm_phase<pg8::EpiIn, pg8::SchedDenseT<1>, false>(F.lds, S, E); } if ((DUPMASK >> 13) & 1) { pg8::EpiProbeStore E1{(bf16_t*)(ws + WS_YZ)}; pg8::gemm_phase<pg8::EpiProbeStore, pg8::SchedDenseT<1>, false>(F.lds, S, E1); } if ((DUPMASK >> 12) & 1) { pg8::EpiNone E0; pg8::gemm_phase<pg8::EpiNone, pg8::SchedDenseT<1>, false>(F.lds, S, E0); }
        if ((DUPMASK >> 18) & 1) { pg8::EpiNone E0; pg8::SchedDenseProbe SP; SP.O = S.O; SP.A = S.A; SP.B = S.B; pg8::gemm_phase<pg8::EpiNone, pg8::SchedDenseProbe, false>(F.lds, SP, E0); }
#ifdef DESYNC1
        if (nbefore_ < 4) { __syncthreads(); hy::init_tw128(F); hy::filter_pass_a<false>(F, nbefore_); }
#else
        hy::init_tw128(F); if ((DUPMASK >> 14) & 1) hy::filter_pass_a<true>(F); hy::filter_pass_a<false>(F);
#endif
    } SEAM(1);
#ifdef P2_ALTERNATE
    if (IN(2)) { TS(2); FRESH();
        const bool rev_ = ((F.bid >> 3) & 1) != 0;
#ifdef FB_IN_P3
#ifdef CONV_IN_P2
        if (!rev_) { lru::stage1(F); __syncthreads(); FRESH(); hy::prepass(F); __syncthreads(); FRESH(); convert_weights<0, false>(F, F.bid, F.G); convert_weights<1, false>(F, F.bid, F.G); }
        else { hy::prepass(F); __syncthreads(); FRESH(); convert_weights<0, false>(F, F.bid, F.G); convert_weights<1, false>(F, F.bid, F.G); __syncthreads(); FRESH(); lru::stage1(F); }
#else
        if (!rev_) { lru::stage1(F); __syncthreads(); FRESH(); hy::prepass(F); }
        else { hy::prepass(F); __syncthreads(); FRESH(); lru::stage1(F); }
#endif
#else
        if (!rev_) { lru::stage1(F); __syncthreads(); hy::init_tw128(F); hy::filter_pass_b<false>(F); hy::prepass(F); }
        else { hy::prepass(F); __syncthreads(); FRESH(); hy::init_tw128(F); hy::filter_pass_b<false>(F); __syncthreads(); FRESH(); lru::stage1(F); }
#endif
    } SEAM(2);
#else
    if (IN(2)) { TS(2); FRESH(); REP(4) lru::stage1(F); __syncthreads(); hy::init_tw128(F); if ((DUPMASK >> 15) & 1) hy::filter_pass_b<true>(F); hy::filter_pass_b<false>(F); REP(2) hy::prepass(F); } SEAM(2);
#endif
#ifdef FB_IN_P3
    if (IN(3)) { TS(3); FRESH(); hy::init_tw128(F);
        if (((F.bid >> 3) & 1) == 0) { hy::data_pass_a(F); __syncthreads(); hy::filter_pass_b<false>(F); }
        else { hy::filter_pass_b<false>(F); __syncthreads(); hy::data_pass_a(F); }
    } SEAM(3);
#else
    if (IN(3)) { TS(3); FRESH(); hy::init_tw128(F); REP(3) hy::data_pass_a(F); } SEAM(3);
#endif
    if (IN(4)) { TS(4); FRESH(); REP(16) lru::carry(F); hy::init_tw128(F); if ((DUPMASK >> 17) & 1) hy::data_pass_b<true>(F); hy::data_pass_b<false>(F); } SEAM(4);
#ifdef P5_ALTERNATE
    if (IN(5)) { TS(5); FRESH();
        if (((F.bid >> 3) & 1) == 0) { hy::init_tw128(F); hy::data_pass_c<false>(F); __syncthreads(); FRESH(); lru::stage2(F); }
        else { lru::stage2(F); __syncthreads(); FRESH(); hy::init_tw128(F); hy::data_pass_c<false>(F); }
    } SEAM(5);
#else
    if (IN(5)) { TS(5); FRESH(); hy::init_tw128(F); if ((DUPMASK >> 5) & 1) hy::data_pass_c<true>(F); hy::data_pass_c<false>(F); __syncthreads(); REP(6) lru::stage2(F); } SEAM(5);
#endif
    if (IN(6)) { TS(6); FRESH();
        pg8::SchedMix S; S.O.init(T / 256, D / 256, F.G, F.bid); S.A0 = (const char*)(ws + WS_YLRU); S.A1 = (const char*)(ws + WS_YHY); S.B0 = (const char*)(ws + WS_WLRU); S.B1 = (const char*)(ws + WS_WHY);
        pg8::EpiMix E{(const bf16_t*)(ws + WS_PG), (bf16_t*)(ws + WS_MIX)};
#ifdef MIXDESYNC
        const int cls_ = (F.bid >> 3) & 3; constexpr int RND_ = MIXDESYNC;
        if (cls_ > 0) { convert_weights<0, false>(F, F.bid, F.G, 0, RND_ * cls_ / 4); __syncthreads(); }
#endif
        pg8::gemm_phase<pg8::EpiMix, pg8::SchedMix, false>(F.lds, S, E); if ((DUPMASK >> 7) & 1) { pg8::gemm_phase<pg8::EpiMix, pg8::SchedMix, false>(F.lds, S, E); }
#ifdef MIXDESYNC
        __syncthreads(); convert_weights<0, false>(F, F.bid, F.G, RND_ * cls_ / 4, RND_);
#endif
    } SEAM(6);
    if (IN(7)) { TS(7); FRESH();
        pg8::SchedDenseT<0> S; S.bias = nullptr; S.O.init(T / 256, D / 256, F.G, F.bid); S.A = (const char*)(ws + WS_MIX); S.B = (const char*)(ws + WS_WOUT);
        pg8::EpiH E{args.in[0], (bf16_t*)(ws + WS_HN), (unsigned char*)(ws + WS_HB8)};
        { u32x4* z = (u32x4*)(ws + WS_EROWTOK); const u32x4 z4 = (u32x4){0u, 0u, 0u, 0u};
          for (int i = F.bid * NTHREADS + F.tid; i < 3 * NE * T / 4; i += F.G * NTHREADS) z[i] = z4; }
#ifdef MIXDESYNC
        const int cls_ = (F.bid >> 3) & 3; constexpr int RND_ = MIXDESYNC; const int rrem_ = RND_;
        if (cls_ > 0) { convert_weights<0, false>(F, F.bid, F.G, RND_, RND_ + rrem_ * cls_ / 4); __syncthreads(); }
#endif
        pg8::gemm_phase<pg8::EpiH, pg8::SchedDenseT<0>, false>(F.lds, S, E); if ((DUPMASK >> 8) & 1) { pg8::gemm_phase<pg8::EpiH, pg8::SchedDenseT<0>, false>(F.lds, S, E); }
#ifdef MIXDESYNC
        __syncthreads(); convert_weights<0, false>(F, F.bid, F.G, RND_ + rrem_ * cls_ / 4, 2 * RND_);
#endif
    } SEAM(7);
    if (IN(8)) { TS(8); FRESH(); phase_router_a(F); } SEAM(8);
    if (IN(10)) { TS(10); FRESH();
        const LAS int* pt = build_ptile(F);
#ifdef GU_FP8
        pg8::SchedMoE<8, true> S{args.in[29], (const float*)(ws + WS_EROWRS), pt, F.G, F.bid, (const char*)(ws + WS_HB8), (const char*)(ws + WS_WGU), (size_t)2048 * 1024 * 1, (const int*)(ws + WS_EROWTOK), 1};
#else
        pg8::SchedMoE<8, true> S{args.in[29], (const float*)(ws + WS_EROWRS), pt, F.G, F.bid, (const char*)(ws + WS_HN), (const char*)(ws + WS_WGU), (size_t)2048 * 1024 * 2, (const int*)(ws + WS_EROWTOK)};
#endif
        pg8::EpiGU E{args.in[29], (const float*)(ws + WS_ROWRS), (bf16_t*)(ws + WS_ACT)};
#ifdef DESYNC_GU
        { const int rounds_ = (pt[32] * 8 + F.G - 1) / F.G; pg8::Unit u_; if (!S.next(rounds_ - 1, u_)) stagger_delay(1, DESYNC_GU); }
#endif
#ifdef GU_FP8
        pg8::gemm_phase<pg8::EpiGU, pg8::SchedMoE<8, true>, true, 1>(F.lds, S, E);
#else
        pg8::gemm_phase<pg8::EpiGU, pg8::SchedMoE<8, true>, true>(F.lds, S, E);
#endif
        if ((DUPMASK >> 9) & 1) { pg8::gemm_phase<pg8::EpiGU, pg8::SchedMoE<8, true>, true>(F.lds, S, E); }
        if ((DUPMASK >> 19) & 1) { pg8::EpiNone E0; pg8::gemm_phase<pg8::EpiNone, pg8::SchedMoE<8, true>, true>(F.lds, S, E0); }
    } SEAM(10);
    if (IN(11)) { TS(11); FRESH();
        const LAS int* pt = build_ptile<true>(F);
#ifdef DN_FP8
        pg8::SchedMoE<4, false> S{args.in[31], (const float*)(ws + WS_EROWGATE), pt, F.G, F.bid, (const char*)(ws + WS_ACT), (const char*)(ws + WS_WDN), (size_t)1024 * 1024 * 1, nullptr, 1};
#else
        pg8::SchedMoE<4, false> S{args.in[31], (const float*)(ws + WS_EROWGATE), pt, F.G, F.bid, (const char*)(ws + WS_ACT), (const char*)(ws + WS_WDN), (size_t)1024 * 1024 * 2, nullptr};
#endif
        pg8::EpiDN E{args.in[31], (const float*)(ws + WS_ROWGATE), (bf16_t*)(ws + WS_YS)};
#ifdef DESYNC_DN
        { const int rounds_ = (pt[32] * 4 + F.G - 1) / F.G; pg8::Unit u_; if (!S.next(rounds_ - 1, u_)) stagger_delay(1, DESYNC_DN); }
#endif
#ifdef DN_FP8
        pg8::gemm_phase<pg8::EpiDN, pg8::SchedMoE<4, false>, false, 1>(F.lds, S, E);
#else
        pg8::gemm_phase<pg8::EpiDN, pg8::SchedMoE<4, false>, false>(F.lds, S, E);
#endif
        if ((DUPMASK >> 10) & 1) { pg8::gemm_phase<pg8::EpiDN, pg8::SchedMoE<4, false>, false>(F.lds, S, E); }
        if ((DUPMASK >> 20) & 1) { pg8::EpiNone E0; pg8::gemm_phase<pg8::EpiNone, pg8::SchedMoE<4, false>, false>(F.lds, S, E0); }
    } SEAM(11);
    if (IN(12)) { TS(12); FRESH(); phase_final(F); }
#ifdef ECHO_A
    if (blockIdx.x == 0 && threadIdx.x == 0) { volatile unsigned long long* ts = (volatile unsigned long long*)(args.ws + WS_CTL + 2048); const unsigned long long tend = __builtin_amdgcn_s_memrealtime();
        const unsigned long long tb = (ECHO_B == 13) ? tend : ts[ECHO_B]; const unsigned long long dt = tb - ts[ECHO_A];
        while (__builtin_amdgcn_s_memrealtime() - tend < dt) __builtin_amdgcn_s_sleep(8); }
#endif
#undef IN
#undef SEAM
}
static int g_grid = 0;
static void launch_mega(Args a, int lo, int hi, hipStream_t stream, int li = 0) {
    a.ph_lo = lo; a.ph_hi = hi; a.li = li; a.pad = 0; void* params[] = {&a};
    hipError_t e = hipLaunchCooperativeKernel((const void*)mega, dim3(g_grid), dim3(NTHREADS), params, LDS_BYTES, stream);
    if (e != hipSuccess) fprintf(stderr, "kernel_launch: cooperative launch [%d,%d) failed: %s (grid %d)\n", lo, hi, hipGetErrorString(e), g_grid);
}
extern "C" void kernel_launch(void* const* d_in, const int* in_sizes, int n_in, void* d_out, int out_size, void* d_ws, size_t ws_size, hipStream_t stream) {
    if (n_in != 33 || out_size != T * D || ws_size < WS_END) { fprintf(stderr, "kernel_launch: unexpected shapes n_in %d out %d ws %zu\n", n_in, out_size, ws_size); return; }
    if (g_grid == 0) {
        int dev = 0, cus = 0, per_cu = 0;
        (void)hipGetDevice(&dev); (void)hipDeviceGetAttribute(&cus, hipDeviceAttributeMultiprocessorCount, dev);
        if (hipFuncSetAttribute((const void*)mega, hipFuncAttributeMaxDynamicSharedMemorySize, LDS_BYTES) != hipSuccess) { fprintf(stderr, "kernel_launch: hipFuncSetAttribute failed\n"); g_grid = -1; return; }
        if (hipOccupancyMaxActiveBlocksPerMultiprocessor(&per_cu, (const void*)mega, NTHREADS, LDS_BYTES) != hipSuccess || per_cu < 1) { fprintf(stderr, "kernel_launch: occupancy query says %d\n", per_cu); g_grid = -1; return; }
        g_grid = cus;
    }
    if (g_grid < 0) return;
    const float* in[33]; for (int i = 0; i < 33; ++i) in[i] = (const float*)d_in[i];
    unsigned char* ws = (unsigned char*)d_ws; float* out = (float*)d_out;
    int* cnt = (int*)(ws + WS_CTL); float* NORM = (float*)(ws + WS_NORM); float* HH3 = (float*)(ws + WS_HH3);
    bf16_t* YLRU = (bf16_t*)(ws + WS_YLRU); bf16_t* HN = (bf16_t*)(ws + WS_HN); bf16_t* YHY = (bf16_t*)(ws + WS_YHY);
    bf16_t* PG = (bf16_t*)(ws + WS_PG); bf16_t* P0 = (bf16_t*)(ws + WS_P0); bf16_t* P1 = (bf16_t*)(ws + WS_P1); bf16_t* PHY = (bf16_t*)(ws + WS_PHY);
    bf16_t* MIX = (bf16_t*)(ws + WS_MIX); float* MIXF = (float*)(ws + WS_MIXF); bf16_t* ACT = (bf16_t*)(ws + WS_ACT); bf16_t* YS = (bf16_t*)(ws + WS_YS);
    float* XR = (float*)(ws + WS_XR); float* HF = (float*)(ws + WS_HF); float* KC = (float*)(ws + WS_KC);
    int* ROWTOK = (int*)(ws + WS_ROWTOK); float* ROWGATE = (float*)(ws + WS_ROWGATE); float* ROWRS = (float*)(ws + WS_ROWRS);
    (void)hipMemsetAsync(ws + WS_CTL, 0, CTL_BYTES, stream);
    Args a{}; for (int i = 0; i < 33; ++i) a.in[i] = in[i]; a.out = out; a.ws = ws;
    launch_mega(a, 0, 13, stream);
}
```
